# Optimizing an MI355X kernel written in HIP

```python
import jax, jax.numpy as jnp
from jax import lax
import numpy as np

D_MODEL = 1024
BATCH = 16
SEQ = 2048
DEPTH = 2

CTX_LEN = 256
GRID_W = 64
N_MIXERS = 2
HEAD_DIM = 64
ATT_Q_HEADS = D_MODEL // HEAD_DIM
ATT_KV_HEADS = ATT_Q_HEADS // 4
ATT_GROUP = ATT_Q_HEADS // ATT_KV_HEADS
ATT_Q_DIM = ATT_Q_HEADS * HEAD_DIM
ATT_KV_DIM = ATT_KV_HEADS * HEAD_DIM
ATT_IN_DIM = ATT_Q_DIM + 2 * ATT_KV_DIM
WINDOW = 128
ATT_BLOCK = 128
ROPE_BASE = 10000.0
ROPE_AXIS_PAIRS = HEAD_DIM // 4
GLA_HEADS = 4
GLA_DK = D_MODEL // 2 // GLA_HEADS
GLA_DV = D_MODEL // GLA_HEADS
GLA_QK = GLA_HEADS * GLA_DK
GLA_V = GLA_HEADS * GLA_DV
GLA_QR = GLA_QK + GLA_V
GLA_GATE_RANK = 16
GLA_TAU = 16.0
GLA_CHUNK = 64
GLA_IN_DIM = GLA_QR + GLA_QK + GLA_V + 2 * GLA_GATE_RANK
N_EXPERTS = 16
CAPACITY_FACTOR = 2
EXPERT_FF = 2816
NORM_EPS = 1e-6

kernel_name = "hybrid_swa_gla_ec_moe_dit"

F32 = jnp.float32


def rms_norm(x, g):
    xf = x.astype(F32)
    y = xf * lax.rsqrt(jnp.mean(xf * xf, axis=-1, keepdims=True) + NORM_EPS)
    return (y * g.astype(F32)).astype(x.dtype)


def modulate(h, shift, scale):
    return h * (1 + scale) + shift


def axial_rope_tables(n):
    rows = n // GRID_W
    row = jnp.repeat(jnp.arange(rows, dtype=F32), GRID_W)
    col = jnp.tile(jnp.arange(GRID_W, dtype=F32), rows)
    inv = ROPE_BASE ** (-jnp.arange(ROPE_AXIS_PAIRS, dtype=F32) / ROPE_AXIS_PAIRS)
    ar = row[:, None] * inv
    ac = col[:, None] * inv
    ang = jnp.concatenate([ar, ar, ac, ac], axis=-1)
    return jnp.cos(ang), jnp.sin(ang)


def apply_rope(x, cos, sin):
    bshape = (cos.shape[0],) + (1,) * (x.ndim - 3) + (HEAD_DIM,)
    xf = x.astype(F32)
    xs = xf.reshape(xf.shape[:-1] + (2, 2, ROPE_AXIS_PAIRS))
    rot = jnp.stack([-xs[..., 1, :], xs[..., 0, :]], axis=-2).reshape(xf.shape)
    return (xf * cos.reshape(bshape) + rot * sin.reshape(bshape)).astype(x.dtype)


def window_attention(h, hc, w_in, w_out, sink, cos, sin, ctx_out):
    bsz, n, _ = h.shape
    n_ctx = hc.shape[1]
    scale = HEAD_DIM ** -0.5
    p = h @ w_in
    q = p[..., :ATT_Q_DIM].reshape(bsz, n, ATT_KV_HEADS, ATT_GROUP, HEAD_DIM)
    k = p[..., ATT_Q_DIM:ATT_Q_DIM + ATT_KV_DIM].reshape(bsz, n, ATT_KV_HEADS, HEAD_DIM)
    v = p[..., ATT_Q_DIM + ATT_KV_DIM:].reshape(bsz, n, ATT_KV_HEADS, HEAD_DIM)
    q = apply_rope(q, cos, sin)
    k = apply_rope(k, cos, sin)
    pkv = hc @ w_in[:, ATT_Q_DIM:]
    kc = pkv[..., :ATT_KV_DIM].reshape(bsz, n_ctx, ATT_KV_HEADS, HEAD_DIM).astype(F32)
    vc = pkv[..., ATT_KV_DIM:].reshape(bsz, n_ctx, ATT_KV_HEADS, HEAD_DIM).astype(F32)
    sink_f = sink.astype(F32).reshape(ATT_KV_HEADS, ATT_GROUP)

    nb = n // ATT_BLOCK
    qb = q.astype(F32).reshape(bsz, nb, ATT_BLOCK, ATT_KV_HEADS, ATT_GROUP, HEAD_DIM) * scale

    def band(z):
        zp = jnp.pad(z, ((0, 0), (ATT_BLOCK, ATT_BLOCK), (0, 0), (0, 0)))
        zp = zp.reshape(bsz, nb + 2, ATT_BLOCK, ATT_KV_HEADS, HEAD_DIM)
        return jnp.concatenate([zp[:, :-2], zp[:, 1:-1], zp[:, 2:]], axis=2).astype(F32)

    kb, vb = band(k), band(v)
    qpos = jnp.arange(nb)[:, None] * ATT_BLOCK + jnp.arange(ATT_BLOCK)[None, :]
    kpos = jnp.arange(nb)[:, None] * ATT_BLOCK - ATT_BLOCK + jnp.arange(3 * ATT_BLOCK)[None, :]
    valid = ((jnp.abs(qpos[:, :, None] - kpos[:, None, :]) <= WINDOW)
             & (kpos[:, None, :] >= 0) & (kpos[:, None, :] < n))
    s_b = jnp.einsum('bnqhgd,bnkhd->bnhgqk', qb, kb)
    s_b = jnp.where(valid[None, :, None, None], s_b, -jnp.inf)
    s_c = jnp.einsum('bnqhgd,bchd->bnhgqc', qb, kc)
    sink_b = sink_f[None, None, :, :, None]
    m = jnp.maximum(jnp.maximum(s_b.max(-1), s_c.max(-1)), sink_b)
    e_b = jnp.exp(s_b - m[..., None])
    e_c = jnp.exp(s_c - m[..., None])
    den = e_b.sum(-1) + e_c.sum(-1) + jnp.exp(sink_b - m)
    o = (jnp.einsum('bnhgqk,bnkhd->bnqhgd', e_b, vb)
         + jnp.einsum('bnhgqc,bchd->bnqhgd', e_c, vc))
    o = o / jnp.transpose(den, (0, 1, 4, 2, 3))[..., None]
    y = o.reshape(bsz, n, ATT_Q_DIM).astype(h.dtype) @ w_out
    if not ctx_out:
        return y, None
    qc = (hc @ w_in[:, :ATT_Q_DIM]).astype(F32).reshape(bsz, n_ctx, ATT_KV_HEADS, ATT_GROUP, HEAD_DIM) * scale
    s = jnp.einsum('bqhgd,bkhd->bhgqk', qc, kc)
    sink_c = jnp.broadcast_to(sink_f[None, :, :, None, None], s.shape[:-1] + (1,))
    pr = jax.nn.softmax(jnp.concatenate([sink_c, s], axis=-1), axis=-1)[..., 1:]
    oc = jnp.einsum('bhgqk,bkhd->bqhgd', pr, vc).reshape(bsz, n_ctx, ATT_Q_DIM)
    yc = oc.astype(hc.dtype) @ w_out
    return y, yc


def gla_kv_gates(p, gate_w2, gate_b):
    bsz, L, _ = p.shape
    k = p[..., :GLA_QK].reshape(bsz, L, GLA_HEADS, GLA_DK)
    v = p[..., GLA_QK:GLA_QK + GLA_V].reshape(bsz, L, GLA_HEADS, GLA_DV)
    lr = p[..., GLA_QK + GLA_V:].reshape(bsz, L, 2, GLA_GATE_RANK)
    z = jnp.einsum('blzr,zrk->blzk', lr, gate_w2) + gate_b
    lg = (jax.nn.log_sigmoid(z.astype(F32)) / GLA_TAU).reshape(bsz, L, 2, GLA_HEADS, GLA_DK)
    return k, v, lg[:, :, 0], lg[:, :, 1]


def gla_chunked(q, k, v, lg, s0):
    bsz, L, H, _ = k.shape
    dv = v.shape[-1]
    nc = L // GLA_CHUNK

    def blocks(a):
        return a.astype(F32).reshape(bsz, nc, GLA_CHUNK, H, a.shape[-1])

    q, k, v, lg = blocks(q), blocks(k), blocks(v), blocks(lg)
    b = jnp.cumsum(lg, axis=2)
    b_last = b[:, :, -1:]
    qt = q * jnp.exp(b)
    kt = k * jnp.exp(-b)
    tril = jnp.tril(jnp.ones((GLA_CHUNK, GLA_CHUNK), dtype=bool))
    a = jnp.where(tril, jnp.einsum('bnihd,bnjhd->bnhij', qt, kt), 0.0)
    o = jnp.einsum('bnhij,bnjhe->bnihe', a, v)
    ds = jnp.einsum('bnjhd,bnjhe->bnhde', k * jnp.exp(b_last - b), v)
    decay = jnp.exp(b_last[:, :, 0])

    def step(s, inp):
        dec, d = inp
        return dec[..., None] * s + d, s

    s_fin, s_start = lax.scan(step, s0, (jnp.moveaxis(decay, 1, 0), jnp.moveaxis(ds, 1, 0)))
    o = o + jnp.einsum('bnihd,nbhde->bnihe', qt, s_start)
    return o.reshape(bsz, L, H, dv), s_fin


def gla_final_state(k, v, lg):
    cum = jnp.cumsum(lg, axis=1)
    w = jnp.exp(cum[:, -1:] - cum)
    return jnp.einsum('blhd,blhe->bhde', k.astype(F32) * w, v.astype(F32))


def gla_mixer(h, hc, w_in, gate_w2, gate_b, norm_g, w_out, ctx_out):
    bsz, n, _ = h.shape
    n_ctx = hc.shape[1]

    def flip(a):
        return jnp.flip(a, axis=1)

    def readout(o, r):
        o = o * lax.rsqrt(jnp.mean(o * o, axis=-1, keepdims=True) + NORM_EPS)
        o = o * norm_g.astype(F32).reshape(GLA_HEADS, GLA_DV)
        o = o.reshape(o.shape[0], o.shape[1], GLA_V).astype(h.dtype) * jax.nn.silu(r)
        return o @ w_out

    p = h @ w_in
    q = p[..., :GLA_QK].reshape(bsz, n, GLA_HEADS, GLA_DK) * GLA_DK ** -0.5
    r = p[..., GLA_QK:GLA_QR]
    k, v, lg_f, lg_b = gla_kv_gates(p[..., GLA_QR:], gate_w2, gate_b)
    kc, vc, lgc_f, lgc_b = gla_kv_gates(hc @ w_in[:, GLA_QR:], gate_w2, gate_b)
    if ctx_out:
        pq = hc @ w_in[:, :GLA_QR]
        qc = pq[..., :GLA_QK].reshape(bsz, n_ctx, GLA_HEADS, GLA_DK) * GLA_DK ** -0.5
        rc = pq[..., GLA_QK:]
        s0 = jnp.zeros((bsz, GLA_HEADS, GLA_DK, GLA_DV), F32)
        oc_f, sc_f = gla_chunked(qc, kc, vc, lgc_f, s0)
        oc_b, sc_b = gla_chunked(flip(qc), flip(kc), flip(vc), flip(lgc_b), s0)
        yc = readout(oc_f + flip(oc_b), rc)
    else:
        sc_f = gla_final_state(kc, vc, lgc_f)
        sc_b = gla_final_state(flip(kc), flip(vc), flip(lgc_b))
        yc = None
    o_f, _ = gla_chunked(q, k, v, lg_f, sc_f)
    o_b, _ = gla_chunked(flip(q), flip(k), flip(v), flip(lg_b), sc_b)
    y = readout(o_f + flip(o_b), r)
    return y, yc


def ec_moe(h, w_router, w_gate, w_up, w_down):
    bsz, L, d = h.shape
    cap = CAPACITY_FACTOR * L // N_EXPERTS
    aff = jax.nn.softmax((h @ w_router).astype(F32), axis=-1)
    g, idx = lax.top_k(jnp.swapaxes(aff, 1, 2), cap)
    xs = jax.vmap(lambda hb, ib: hb[ib])(h, idx)
    a = jnp.einsum('becd,edf->becf', xs, w_gate)
    u = jnp.einsum('becd,edf->becf', xs, w_up)
    y = jnp.einsum('becf,efd->becd', jax.nn.silu(a) * u, w_down) * g[..., None].astype(h.dtype)
    return jax.vmap(lambda yb, ib: jnp.zeros((L, d), yb.dtype).at[ib.reshape(-1)].add(yb.reshape(-1, d)))(y, idx)


def setup_inputs(seed: int = 0) -> dict:
    key = jax.random.key(seed)
    ks = jax.random.split(key, 24)
    n_attn = (DEPTH + N_MIXERS - 1) // N_MIXERS
    n_gla = DEPTH // N_MIXERS

    def nrm(k, shape, scale):
        return jax.random.normal(k, shape, F32) * scale

    return {
        "x": nrm(ks[0], (BATCH, SEQ, D_MODEL), 1.0),
        "c": nrm(ks[1], (BATCH, D_MODEL), 1.0),
        "ctx": nrm(ks[2], (BATCH, CTX_LEN, D_MODEL), 1.0),
        "c_ctx": nrm(ks[3], (D_MODEL,), 1.0),
        "ada_w": nrm(ks[4], (DEPTH, D_MODEL, 6 * D_MODEL), 0.5 * D_MODEL ** -0.5),
        "ada_b": nrm(ks[5], (DEPTH, 6 * D_MODEL), 0.02),
        "norm1_g": 1.0 + nrm(ks[6], (DEPTH, D_MODEL), 0.02),
        "norm2_g": 1.0 + nrm(ks[7], (DEPTH, D_MODEL), 0.02),
        "attn_w_in": nrm(ks[8], (n_attn, D_MODEL, ATT_IN_DIM), D_MODEL ** -0.5),
        "attn_w_out": nrm(ks[9], (n_attn, ATT_Q_DIM, D_MODEL), ATT_Q_DIM ** -0.5),
        "attn_sink": nrm(ks[10], (n_attn, ATT_Q_HEADS), 0.5),
        "gla_w_in": nrm(ks[11], (n_gla, D_MODEL, GLA_IN_DIM), D_MODEL ** -0.5),
        "gla_gate_w2": nrm(ks[12], (n_gla, 2, GLA_GATE_RANK, GLA_QK), GLA_GATE_RANK ** -0.5),
        "gla_gate_b": nrm(ks[13], (n_gla, 2, GLA_QK), 0.1),
        "gla_norm_g": 1.0 + nrm(ks[14], (n_gla, GLA_V), 0.02),
        "gla_w_out": nrm(ks[15], (n_gla, GLA_V, D_MODEL), GLA_V ** -0.5),
        "router_w": nrm(ks[16], (DEPTH, D_MODEL, N_EXPERTS), D_MODEL ** -0.5),
        "exp_w_gate": nrm(ks[17], (DEPTH, N_EXPERTS, D_MODEL, EXPERT_FF), D_MODEL ** -0.5),
        "exp_w_up": nrm(ks[18], (DEPTH, N_EXPERTS, D_MODEL, EXPERT_FF), D_MODEL ** -0.5),
        "exp_w_down": nrm(ks[19], (DEPTH, N_EXPERTS, EXPERT_FF, D_MODEL), EXPERT_FF ** -0.5),
        "final_norm_g": 1.0 + nrm(ks[20], (D_MODEL,), 0.02),
    }


def reference(x, c, ctx, c_ctx, ada_w, ada_b, norm1_g, norm2_g, attn_w_in, attn_w_out, attn_sink,
              gla_w_in, gla_gate_w2, gla_gate_b, gla_norm_g, gla_w_out, router_w, exp_w_gate,
              exp_w_up, exp_w_down, final_norm_g):
    n = x.shape[1]
    cos, sin = axial_rope_tables(n)
    xc = ctx
    src = jax.nn.silu(c)
    src_c = jax.nn.silu(c_ctx)
    for i in range(DEPTH):
        last = i == DEPTH - 1
        j = i // N_MIXERS
        mod = src @ ada_w[i] + ada_b[i]
        mod_c = src_c @ ada_w[i] + ada_b[i]
        sh1, sc1, g1, sh2, sc2, g2 = jnp.split(mod[:, None, :], 6, axis=-1)
        sh1c, sc1c, g1c, sh2c, sc2c, g2c = jnp.split(mod_c, 6, axis=-1)
        h = modulate(rms_norm(x, norm1_g[i]), sh1, sc1)
        hc = modulate(rms_norm(xc, norm1_g[i]), sh1c, sc1c)
        if i % N_MIXERS == 0:
            y, yc = window_attention(h, hc, attn_w_in[j], attn_w_out[j], attn_sink[j], cos, sin, not last)
        else:
            y, yc = gla_mixer(h, hc, gla_w_in[j], gla_gate_w2[j], gla_gate_b[j], gla_norm_g[j],
                              gla_w_out[j], not last)
        x = x + g1 * y
        h = modulate(rms_norm(x, norm2_g[i]), sh2, sc2)
        x = x + g2 * ec_moe(h, router_w[i], exp_w_gate[i], exp_w_up[i], exp_w_down[i])
        if not last:
            xc = xc + g1c * yc
            hc = modulate(rms_norm(xc, norm2_g[i]), sh2c, sc2c)
            xc = xc + g2c * ec_moe(hc, router_w[i], exp_w_gate[i], exp_w_up[i], exp_w_down[i])
    return rms_norm(x, final_norm_g)
```

```cpp
#include <hip/hip_runtime.h>
#include <cstdio>
#include <cstdint>

#ifndef OPT_MASK
#define OPT_MASK 0x3FF
#endif
#ifndef MOE_FP8
#define MOE_FP8 1
#endif
#ifndef PROBE_MASK
#define PROBE_MASK 0
#endif
#ifndef ONE_LAUNCH
#define ONE_LAUNCH 1
#endif

#define GAS __attribute__((address_space(1)))
#define LAS __attribute__((address_space(3)))
typedef unsigned short bf16;
typedef unsigned v4u __attribute__((ext_vector_type(4)));
typedef unsigned v2u __attribute__((ext_vector_type(2)));
typedef float f32x4 __attribute__((ext_vector_type(4)));
typedef float f32x2 __attribute__((ext_vector_type(2)));
typedef short bf16x8 __attribute__((ext_vector_type(8)));

constexpr int D = 1024, NB = 16, SEQ = 2048, CTX = 256;
constexpr int NL = NB * SEQ, NC = NB * CTX, NT = NL + NC;
constexpr int NQH = 16, NKV = 4, HD = 64, ATT_N = 1536;
constexpr int GH = 4, GDK = 128, GDV = 256, GQK = 512, GV = 1024, GQR = 1536, GIN = 3104, GIN_PAD = 3328;
constexpr int NE = 16, FF = 2816, CAPL = 256, CAPC = 32, ESLOTS = NB * CAPL + NB * CAPC;
constexpr float EPS = 1e-6f;
constexpr float LOG2E = 1.4426950408889634f;
constexpr float QSCALE = 0.125f * LOG2E;
constexpr float GLA_QS = 0.08838834764831845f;
constexpr int EB = MOE_FP8 ? 1 : 2;
constexpr float F8_ACT = 16.f, F8_W = 256.f, F8_INV = 1.f / (16.f * 256.f);

constexpr size_t MiB = 1ull << 20;
constexpr size_t WS_CTL = 0, CTL_ZERO_BYTES = 1 * MiB;
constexpr size_t WS_MOD = 1 * MiB;
constexpr size_t WS_ROPE = WS_MOD + 896 * 1024;
constexpr size_t WS_WQKV = 2 * MiB;
constexpr size_t WS_WO0 = 5 * MiB;
constexpr size_t WS_WGIN = 7 * MiB;
constexpr size_t WS_WO1 = 14 * MiB;
constexpr size_t WS_AFF = 16 * MiB;
constexpr size_t WS_SLOT = 19 * MiB;
constexpr size_t WS_ROWIDX = 22 * MiB;
constexpr size_t WS_ROWG = 22 * MiB + 512 * 1024;
constexpr size_t WS_WUP = 24 * MiB;
constexpr size_t WS_WDN = WS_WUP + 352 * MiB;
constexpr size_t WS_XA = WS_WDN + 176 * MiB;
constexpr size_t WS_H = WS_XA + 144 * MiB;
constexpr size_t WS_E = WS_H + 72 * MiB;
constexpr size_t WS_Q = WS_E, WS_K = WS_E + 72 * MiB, WS_V = WS_E + 90 * MiB, WS_O = WS_E + 108 * MiB;
constexpr size_t WS_PG = WS_E, WS_OF = WS_E + 220 * MiB, WS_OB = WS_E + 284 * MiB;
constexpr size_t WS_QT = WS_E + 348 * MiB, WS_KT = WS_E + 420 * MiB, WS_DEC = WS_E + 492 * MiB;
constexpr size_t WS_XG = WS_E, WS_YS = WS_E, WS_ACT = WS_E + 144 * MiB;
constexpr size_t WS_H8 = WS_E;
constexpr size_t WS_TMP = WS_E + 540 * MiB;
constexpr size_t WS_END = WS_TMP + 50 * MiB;
constexpr int CW_BAR = 4096;

constexpr int RING_BYTES = 131072;
constexpr int LDS_BYTES = 147456;
constexpr int LDSCTL_OFF = LDS_BYTES - 1024, MISC_OFF = LDSCTL_OFF + 320;
constexpr int NWAVES = 8;

__device__ __forceinline__ float bf2f(bf16 v) { return __uint_as_float(((unsigned)v) << 16); }
typedef __bf16 hwbf16x2 __attribute__((ext_vector_type(2)));
__device__ __forceinline__ unsigned pk2(float lo, float hi) { const f32x2 v = {lo, hi}; return __builtin_bit_cast(unsigned, __builtin_convertvector(v, hwbf16x2)); }
__device__ __forceinline__ unsigned f2bf(float f) { return pk2(f, 0.f) & 0xffffu; }
__device__ __forceinline__ float clamp448(float v) { return __builtin_fminf(__builtin_fmaxf(v, -448.f), 448.f); }
__device__ __forceinline__ unsigned pk4_fp8(float a, float b, float c, float d) { int w = 0; w = __builtin_amdgcn_cvt_pk_fp8_f32(clamp448(a), clamp448(b), w, false); w = __builtin_amdgcn_cvt_pk_fp8_f32(clamp448(c), clamp448(d), w, true); return (unsigned)w; }
template <int CTRL, int RMASK> __device__ __forceinline__ float dpp_add(float x) { return x + __builtin_bit_cast(float, __builtin_amdgcn_update_dpp(0, __builtin_bit_cast(int, x), CTRL, RMASK, 0xf, false)); }
__device__ __forceinline__ float wave_sum(float v) {
    v = dpp_add<0xB1, 0xf>(v);
    v = dpp_add<0x4E, 0xf>(v);
    v = dpp_add<0x141, 0xf>(v);
    v = dpp_add<0x140, 0xf>(v);
    v = dpp_add<0x142, 0xa>(v);
    v = dpp_add<0x143, 0xc>(v);
    return __builtin_bit_cast(float, __builtin_amdgcn_readlane(__builtin_bit_cast(int, v), 63));
}
__device__ __forceinline__ float silu_f(float v) { return v / (1.f + expf(-v)); }
__device__ __forceinline__ float fexp(float x) { return __builtin_amdgcn_exp2f(x * LOG2E); }
__device__ __forceinline__ float flog(float x) { return __builtin_amdgcn_logf(x) * 0.6931471805599453f; }
__device__ __forceinline__ float fsilu(float v) { return v * __builtin_amdgcn_rcpf(1.f + fexp(-v)); }
template <int d> __device__ __forceinline__ float dpp_shr(float x) { return __builtin_bit_cast(float, __builtin_amdgcn_update_dpp(0, __builtin_bit_cast(int, x), 0x110 + d, 0xf, 0xf, true)); }
#define LDS_WAIT() asm volatile("s_waitcnt lgkmcnt(0)" ::: "memory")
#define LDS_SYNC() asm volatile("s_waitcnt lgkmcnt(0)\n\ts_barrier" ::: "memory")
#define VM_WAIT() asm volatile("s_waitcnt vmcnt(0)" ::: "memory")

struct P {
    const float *x, *c, *ctx, *c_ctx, *ada_w, *ada_b, *norm1_g, *norm2_g, *attn_w_in, *attn_w_out, *attn_sink,
        *gla_w_in, *gla_gate_w2, *gla_gate_b, *gla_norm_g, *gla_w_out, *router_w, *exp_w_gate, *exp_w_up, *exp_w_down, *final_norm_g;
    float* out; unsigned char* ws;
    int lo, hi;
};

namespace pg8 {
#define PG8_LAS __attribute__((address_space(3)))
typedef unsigned short bf16_t;
typedef unsigned u32x4 __attribute__((ext_vector_type(4)));
typedef unsigned u32x2 __attribute__((ext_vector_type(2)));
constexpr int BM = 256, BK = 64, HALF = 128, HTB = HALF * BK * 2, STAGE_BYTES = 8 * HTB, NXCD = 8, WGM = 8;
__host__ __device__ __forceinline__ int lds_byte(int r, int c) { const int st = (r >> 4) * 2 + (c >> 5), rr = r & 15, cc = c & 31, ob = rr * 64 + cc * 2; return st * 1024 + (ob ^ (((ob >> 9) & 1) << 5)); }
__host__ __device__ __forceinline__ void stage_rc(int b, int& R, int& C) { const int st = b / 1024, sb = b % 1024, swz = sb ^ (((sb >> 9) & 1) << 5); R = (st >> 1) * 16 + swz / 64; C = (st & 1) * 32 + (swz % 64) / 2; }
__host__ __device__ __forceinline__ int perm32(int rho) { const int n = rho >> 4, i = rho & 15; return 8 * (i >> 2) + 4 * n + (i & 3); }
struct Unit { int pm, pn; };
struct Gemm { const void* A; const void* Bt; int KB; const int* gidx; };
struct TileOrder {
    int nG, nM, nN, sM, G, c, per, nwg;
    __device__ __forceinline__ void init(int nG_, int nM_, int nN_, int sM_, int G_, int c_) { nG = nG_; nM = nM_; nN = nN_; sM = sM_; G = G_; c = c_; per = nM * nN; nwg = nG * per; }
    __device__ __forceinline__ bool next(int i, Unit& u) const {
        const long L = (long)i * G + c; if (L >= nwg) return false;
        int wgid = (int)L; { const int q = nwg / NXCD, r = nwg % NXCD, xcd = wgid % NXCD, off = wgid / NXCD; wgid = (xcd < r ? xcd * (q + 1) : r * (q + 1) + (xcd - r) * q) + off; }
        const int g = wgid / per, rem = wgid % per;
        const int nig = WGM * nN, gid = rem / nig, fm = gid * WGM, gsz = (nM - fm) < WGM ? (nM - fm) : WGM;
        u.pm = g * sM + fm + ((rem % nig) % gsz); u.pn = g * nN + (rem % nig) / gsz; return true;
    }
};
struct GlaInOrder {
    int G, c;
    __device__ __forceinline__ bool next(int i, Unit& u) const {
        constexpr int NLAT = (NL / BM) * 13, NALL = NLAT + (NC / BM) * 7;
        const long L = (long)i * G + c; if (L >= NALL) return false;
        int wgid = (int)L; { const int q = NALL / NXCD, xcd = wgid % NXCD, off = wgid / NXCD; wgid = xcd * q + off; }
        if (wgid < NLAT) { const int nig = WGM * 13, gid = wgid / nig, fm = gid * WGM; u.pm = fm + ((wgid % nig) % WGM); u.pn = (wgid % nig) / WGM; }
        else { const int r = wgid - NLAT; u.pm = NL / BM + (r & 15); u.pn = 6 + (r >> 4); }
        return true;
    }
};
__device__ __forceinline__ unsigned cvt_pk_bf16(float lo, float hi) { unsigned r; asm volatile("v_cvt_pk_bf16_f32 %0, %1, %2" : "=v"(r) : "v"(lo), "v"(hi)); return r; }

struct EpiQKV {
    static constexpr bool PERM = false;
    bf16_t *Q, *Kb, *Vb; const float* rope;
    __device__ __forceinline__ void operator()(const f32x4 (&acc)[2][2][4][2], const Unit& u, int wr, int wc, int fr, int fq) const {
        const int row0 = u.pm * BM + wr * 64 + fr; const bool latent = u.pm < (NL / BM);
        const int kind = u.pn < 4 ? 0 : (u.pn == 4 ? 1 : 2);
        const size_t boff = (kind >= 1 ? (size_t)(WS_K - WS_Q) / 2 : 0) + (kind == 2 ? (size_t)(WS_V - WS_K) / 2 : 0);
        bf16_t* base = Q + boff; const int ldc = kind == 0 ? 1024 : 256; const int colt = kind == 0 ? u.pn * BM : 0;
        const float sc = kind == 0 ? QSCALE : 1.f;
        f32x4 rc0[2][4], rc1[2][4];
#pragma unroll
        for (int ai = 0; ai < 2; ++ai)
#pragma unroll
            for (int m = 0; m < 4; ++m) { const int t = (row0 + ai * HALF + m * 16) & (SEQ - 1);
                rc0[ai][m] = (f32x4){1.f, 0.f, 1.f, 0.f}; rc1[ai][m] = rc0[ai][m];
                if (latent && kind != 2) { const int pos = (wc & 1) ? (t & 63) : (t >> 6); const f32x4* tp = (const f32x4*)(rope + (size_t)(pos * 16 + 4 * fq) * 2); rc0[ai][m] = tp[0]; rc1[ai][m] = tp[1]; } }
#pragma unroll
        for (int ai = 0; ai < 2; ++ai)
#pragma unroll
            for (int m = 0; m < 4; ++m) {
                const int r = row0 + ai * HALF + m * 16;
                const f32x4 cs0 = rc0[ai][m], cs1 = rc1[ai][m];
                const float cs[4] = {cs0[0], cs0[2], cs1[0], cs1[2]}, sn[4] = {cs0[1], cs0[3], cs1[1], cs1[3]};
                bf16_t* rowp = base + (size_t)r * ldc + colt + wc * 32 + 4 * fq;
#pragma unroll
                for (int bj = 0; bj < 2; ++bj) {
                    const f32x4 x0 = acc[ai][bj][m][0], x1 = acc[ai][bj][m][1]; float o0[4], o1[4];
#pragma unroll
                    for (int j = 0; j < 4; ++j) { o0[j] = (x0[j] * cs[j] - x1[j] * sn[j]) * sc; o1[j] = (x1[j] * cs[j] + x0[j] * sn[j]) * sc; }
                    u32x2 w0, w1; w0.x = cvt_pk_bf16(o0[0], o0[1]); w0.y = cvt_pk_bf16(o0[2], o0[3]); w1.x = cvt_pk_bf16(o1[0], o1[1]); w1.y = cvt_pk_bf16(o1[2], o1[3]);
                    *(u32x2*)(rowp + bj * HALF) = w0; *(u32x2*)(rowp + bj * HALF + 16) = w1;
                }
            }
    }
};
struct EpiResid {
    static constexpr bool PERM = false;
    const float *xlat, *xctx; float* XA; const float* mod_g;
    __device__ __forceinline__ void operator()(const f32x4 (&acc)[2][2][4][2], const Unit& u, int wr, int wc, int fr, int fq) const {
        const int row0 = u.pm * BM + wr * 64 + fr, col0 = u.pn * BM + wc * 32 + 4 * fq; const bool latent = u.pm < (NL / BM);
        const float* src = latent ? xlat : xctx - (size_t)NL * D; const int j = latent ? (u.pm >> 3) : 16;
        f32x4 gv[2][2];
#pragma unroll
        for (int bj = 0; bj < 2; ++bj)
#pragma unroll
            for (int n = 0; n < 2; ++n) gv[bj][n] = *(const f32x4*)(mod_g + (size_t)j * 6144 + col0 + bj * HALF + n * 16);
#pragma unroll
        for (int ai = 0; ai < 2; ++ai)
#pragma unroll
            for (int mp = 0; mp < 2; ++mp) { f32x4 xs[2][2][2];
#pragma unroll
                for (int mm = 0; mm < 2; ++mm) { const size_t off = (size_t)(row0 + ai * HALF + (2 * mp + mm) * 16) * D + col0;
#pragma unroll
                    for (int bj = 0; bj < 2; ++bj)
#pragma unroll
                        for (int n = 0; n < 2; ++n) xs[mm][bj][n] = *(const f32x4*)(src + off + bj * HALF + n * 16); }
                asm volatile("" : "+v"(xs[0][0][0]), "+v"(xs[0][0][1]), "+v"(xs[0][1][0]), "+v"(xs[0][1][1]), "+v"(xs[1][0][0]), "+v"(xs[1][0][1]), "+v"(xs[1][1][0]), "+v"(xs[1][1][1]) :: "memory");
#pragma unroll
                for (int mm = 0; mm < 2; ++mm) { const size_t off = (size_t)(row0 + ai * HALF + (2 * mp + mm) * 16) * D + col0;
#pragma unroll
                    for (int bj = 0; bj < 2; ++bj)
#pragma unroll
                        for (int n = 0; n < 2; ++n) *(f32x4*)(XA + off + bj * HALF + n * 16) = xs[mm][bj][n] + gv[bj][n] * acc[ai][bj][2 * mp + mm][n]; }
                asm volatile("" ::: "memory"); }
    }
};
struct EpiSwiglu {
    static constexpr bool PERM = true;
    unsigned char* ACT;
    __device__ __forceinline__ void operator()(const f32x4 (&acc)[2][2][4][2], const Unit& u, int wr, int wc, int fr, int fq) const {
        const int row0 = u.pm * BM + wr * 64 + fr, nl = u.pn % (FF / 128), col0 = nl * 128 + wc * 32 + 8 * fq;
        const float sin_ = MOE_FP8 ? F8_INV : 1.f, sout = MOE_FP8 ? F8_ACT : 1.f;
#pragma unroll
        for (int ai = 0; ai < 2; ++ai)
#pragma unroll
            for (int m = 0; m < 4; ++m) { float o[8];
#pragma unroll
                for (int n = 0; n < 2; ++n)
#pragma unroll
                    for (int j = 0; j < 4; ++j) { const float g = acc[ai][0][m][n][j] * sin_, up = acc[ai][1][m][n][j] * sin_; o[n * 4 + j] = g * __builtin_amdgcn_rcpf(1.f + __builtin_amdgcn_exp2f(g * -1.4426950408889634f)) * (up * sout); }
                unsigned char* dst = ACT + ((size_t)(row0 + ai * HALF + m * 16) * FF + col0) * EB;
                if (MOE_FP8) { u32x2 w; w.x = pk4_fp8(o[0], o[1], o[2], o[3]); w.y = pk4_fp8(o[4], o[5], o[6], o[7]); *(u32x2*)dst = w; }
                else { u32x4 w; w.x = cvt_pk_bf16(o[0], o[1]); w.y = cvt_pk_bf16(o[2], o[3]); w.z = cvt_pk_bf16(o[4], o[5]); w.w = cvt_pk_bf16(o[6], o[7]); *(u32x4*)dst = w; } }
    }
};
struct EpiDown {
    static constexpr bool PERM = true;
    bf16_t* YS; const float* rowg;
    __device__ __forceinline__ void operator()(const f32x4 (&acc)[2][2][4][2], const Unit& u, int wr, int wc, int fr, int fq) const {
        const int row0 = u.pm * BM + wr * 64 + fr, col0 = (u.pn & 3) * BM + wc * 32 + 8 * fq;
        float gr[2][4];
#pragma unroll
        for (int ai = 0; ai < 2; ++ai)
#pragma unroll
            for (int m = 0; m < 4; ++m) gr[ai][m] = rowg[row0 + ai * HALF + m * 16];
#pragma unroll
        for (int ai = 0; ai < 2; ++ai)
#pragma unroll
            for (int m = 0; m < 4; ++m) { const int r = row0 + ai * HALF + m * 16; const float g = gr[ai][m] * (MOE_FP8 ? F8_INV : 1.f);
#pragma unroll
                for (int bj = 0; bj < 2; ++bj) { const f32x4 v0 = acc[ai][bj][m][0] * g, v1 = acc[ai][bj][m][1] * g;
                    u32x4 w; w.x = cvt_pk_bf16(v0[0], v0[1]); w.y = cvt_pk_bf16(v0[2], v0[3]); w.z = cvt_pk_bf16(v1[0], v1[1]); w.w = cvt_pk_bf16(v1[2], v1[3]);
                    *(u32x4*)(YS + (size_t)r * D + col0 + bj * HALF) = w; } }
    }
};
struct EpiGlaIn {
    static constexpr bool PERM = true;
    bf16_t* PG;
    __device__ __forceinline__ void operator()(const f32x4 (&acc)[2][2][4][2], const Unit& u, int wr, int wc, int fr, int fq) const {
        const int row0 = u.pm * BM + wr * 64 + fr, col0 = u.pn * BM + wc * 32 + 8 * fq;
#pragma unroll
        for (int ai = 0; ai < 2; ++ai)
#pragma unroll
            for (int m = 0; m < 4; ++m) { const int r = row0 + ai * HALF + m * 16;
#pragma unroll
                for (int bj = 0; bj < 2; ++bj) { const f32x4 v0 = acc[ai][bj][m][0], v1 = acc[ai][bj][m][1];
                    u32x4 w; w.x = cvt_pk_bf16(v0[0], v0[1]); w.y = cvt_pk_bf16(v0[2], v0[3]); w.z = cvt_pk_bf16(v1[0], v1[1]); w.w = cvt_pk_bf16(v1[2], v1[3]);
                    if (col0 + bj * HALF < GIN) *(u32x4*)(PG + (size_t)r * GIN + col0 + bj * HALF) = w; } }
    }
};

typedef int v8i __attribute__((ext_vector_type(8)));
typedef int v4i __attribute__((ext_vector_type(4)));
__device__ __forceinline__ v8i cat8(bf16x8 lo, bf16x8 hi) { return __builtin_shufflevector(__builtin_bit_cast(v4i, lo), __builtin_bit_cast(v4i, hi), 0, 1, 2, 3, 4, 5, 6, 7); }
template <class Epi, class Sched, bool FP8 = false, bool ALIGN_EPI = true, bool GATHER = false>
__device__ __forceinline__ void gemm_phase(PG8_LAS unsigned char* lds, const Gemm g, const Sched& S, const Epi& E, const int tid) {
    const int wid = __builtin_amdgcn_readfirstlane(tid >> 6), lane = tid & 63, wr = wid >> 2, wc = wid & 3, fr = lane & 15, fq = lane >> 4;
    const int KB = g.KB, nt = KB / 128;
    unsigned voffA, voffB; int Rl, Cb;
    { int R, C; stage_rc(tid * 16, R, C); const int Rb = Epi::PERM ? ((R & ~31) + perm32(R & 31)) : R; voffA = (unsigned)(R * KB + C * 2); voffB = (unsigned)(Rb * KB + C * 2); Rl = R; Cb = C * 2; }
    unsigned gA[2][2], gN[2][2]; constexpr int GOFF = STAGE_BYTES;
    const unsigned r64 = 64u * (unsigned)KB;
    const unsigned kstep = 128u;
    const unsigned hstep = (unsigned)(HALF * KB);
    const unsigned tstep = 2u * hstep;
    const __amdgpu_buffer_rsrc_t rsA = __builtin_amdgcn_make_buffer_rsrc(const_cast<void*>(g.A), 0, 0x7fffffff, 0x00020000), rsB = __builtin_amdgcn_make_buffer_rsrc(const_cast<void*>(g.Bt), 0, 0x7fffffff, 0x00020000);
    const unsigned ldsw = (unsigned)wid * 1024u;
    const int aoff = lds_byte(wr * 64 + fr, fq * 8), boff = lds_byte(wc * 32 + fr, fq * 8);
    const int sw8 = (fr * 64 + (fq & 1) * 32) ^ (((fr >> 3) & 1) << 5);
    const int a8off = (wr * 8 + (fq >> 1)) * 1024 + sw8, b8off = (wc * 4 + (fq >> 1)) * 1024 + sw8;
#define PG8_SA(b, h) (((b) * 2 + (h)) * HTB)
#define PG8_SB(b, h) ((4 + (b) * 2 + (h)) * HTB)
#define PG8_STAGE(bufoff, rs, soff, voff) do { _Pragma("unroll") for (int _i = 0; _i < 2; ++_i) \
        __builtin_amdgcn_raw_ptr_buffer_load_lds(rs, (PG8_LAS void*)(lds + (bufoff) + ldsw + _i * 8192), 16, (int)(voff), (int)((soff) + _i * r64), 0, 0); } while (0)
#define PG8_STAGE_A(bufoff, h, soff, kofs, gsel) do { if constexpr (GATHER) { _Pragma("unroll") for (int _i = 0; _i < 2; ++_i) \
        __builtin_amdgcn_raw_ptr_buffer_load_lds(rsA, (PG8_LAS void*)(lds + (bufoff) + ldsw + _i * 8192), 16, (int)(gsel)[h][_i], (int)(kofs), 0, 0); } else PG8_STAGE(bufoff, rsA, soff, voffA); } while (0)
#define PG8_LDA(dst, b, h) do { _Pragma("unroll") for (int m = 0; m < 4; ++m) { if constexpr (FP8) dst##8[m] = cat8(*(const PG8_LAS bf16x8*)(lds + PG8_SA(b, h) + aoff + m * 2048), *(const PG8_LAS bf16x8*)(lds + PG8_SA(b, h) + aoff + m * 2048 + 1024)); \
        else { _Pragma("unroll") for (int k = 0; k < 2; ++k) dst[m][k] = *(const PG8_LAS bf16x8*)(lds + PG8_SA(b, h) + aoff + m * 2048 + k * 1024); } } } while (0)
#define PG8_LDB(dst, b, h) do { _Pragma("unroll") for (int n = 0; n < 2; ++n) { if constexpr (FP8) dst##8[n] = cat8(*(const PG8_LAS bf16x8*)(lds + PG8_SB(b, h) + boff + n * 2048), *(const PG8_LAS bf16x8*)(lds + PG8_SB(b, h) + boff + n * 2048 + 1024)); \
        else { _Pragma("unroll") for (int k = 0; k < 2; ++k) dst[n][k] = *(const PG8_LAS bf16x8*)(lds + PG8_SB(b, h) + boff + n * 2048 + k * 1024); } } } while (0)
#define PG8_MMA8(ai, bj, At, Bt) asm volatile("s_nop 1\n\t" \
        "v_mfma_scale_f32_16x16x128_f8f6f4 %0, %8, %10, %0, %14, %14 op_sel_hi:[0,0,0]\n\t" "v_mfma_scale_f32_16x16x128_f8f6f4 %1, %9, %10, %1, %14, %14 op_sel_hi:[0,0,0]\n\t" \
        "v_mfma_scale_f32_16x16x128_f8f6f4 %2, %8, %11, %2, %14, %14 op_sel_hi:[0,0,0]\n\t" "v_mfma_scale_f32_16x16x128_f8f6f4 %3, %9, %11, %3, %14, %14 op_sel_hi:[0,0,0]\n\t" \
        "v_mfma_scale_f32_16x16x128_f8f6f4 %4, %8, %12, %4, %14, %14 op_sel_hi:[0,0,0]\n\t" "v_mfma_scale_f32_16x16x128_f8f6f4 %5, %9, %12, %5, %14, %14 op_sel_hi:[0,0,0]\n\t" \
        "v_mfma_scale_f32_16x16x128_f8f6f4 %6, %8, %13, %6, %14, %14 op_sel_hi:[0,0,0]\n\t" "v_mfma_scale_f32_16x16x128_f8f6f4 %7, %9, %13, %7, %14, %14 op_sel_hi:[0,0,0]" \
        : "+v"(acc[ai][bj][0][0]), "+v"(acc[ai][bj][0][1]), "+v"(acc[ai][bj][1][0]), "+v"(acc[ai][bj][1][1]), "+v"(acc[ai][bj][2][0]), "+v"(acc[ai][bj][2][1]), "+v"(acc[ai][bj][3][0]), "+v"(acc[ai][bj][3][1]) \
        : "v"(Bt##8[0]), "v"(Bt##8[1]), "v"(At##8[0]), "v"(At##8[1]), "v"(At##8[2]), "v"(At##8[3]), "v"(scl8))
#define PG8_MMA(ai, bj, At, Bt) do { __builtin_amdgcn_s_setprio(1); if constexpr (FP8) { PG8_MMA8(ai, bj, At, Bt); } else { \
        _Pragma("unroll") for (int m = 0; m < 4; ++m) _Pragma("unroll") for (int n = 0; n < 2; ++n) _Pragma("unroll") for (int k = 0; k < 2; ++k) \
        acc[ai][bj][m][n] = __builtin_amdgcn_mfma_f32_16x16x32_bf16(Bt[n][k], At[m][k], acc[ai][bj][m][n], 0, 0, 0); } __builtin_amdgcn_s_setprio(0); } while (0)
#define PG8_WAIT_V(n) asm volatile("s_waitcnt vmcnt(" #n ")" ::: "memory")
#define PG8_WAIT_L(n) asm volatile("s_waitcnt lgkmcnt(" #n ")" ::: "memory")
#define PG8_BAR __builtin_amdgcn_s_barrier()
#define PG8_SCHED __builtin_amdgcn_sched_barrier(0)
    Unit cur, nxt; int ui = 0;
    if (!S.next(0, cur)) return;
    f32x4 acc[2][2][4][2];
#pragma unroll
    for (int a = 0; a < 2; ++a)
#pragma unroll
        for (int b = 0; b < 2; ++b)
#pragma unroll
            for (int m = 0; m < 4; ++m)
#pragma unroll
                for (int n = 0; n < 2; ++n) acc[a][b][m][n] = (f32x4){0.f, 0.f, 0.f, 0.f};
    int scl8 = 0x7f7f7f7f; asm volatile("" : "+v"(scl8));
    bf16x8 At[4][2], B0[2][2], B1[2][2]; v8i At8[4], B08[2], B18[2];
    unsigned cA = (unsigned)cur.pm * tstep, cB = (unsigned)cur.pn * tstep;
    if constexpr (GATHER) {
#pragma unroll
        for (int h = 0; h < 2; ++h)
#pragma unroll
            for (int i = 0; i < 2; ++i) { gA[h][i] = (unsigned)g.gidx[cur.pm * 256 + h * 128 + Rl + 64 * i] * (unsigned)KB + (unsigned)Cb; gN[h][i] = gA[h][i]; } }
    {
        PG8_STAGE(PG8_SB(0, 0), rsB, cB, voffB); PG8_STAGE(PG8_SB(0, 1), rsB, cB + hstep, voffB); PG8_STAGE_A(PG8_SA(0, 0), 0, cA, 0, gA); PG8_STAGE_A(PG8_SA(0, 1), 1, cA + hstep, 0, gA);
        if (wr == 1) PG8_BAR;
        PG8_WAIT_V(2); PG8_BAR;
        PG8_STAGE(PG8_SB(1, 0), rsB, cB + kstep, voffB); PG8_STAGE_A(PG8_SA(1, 0), 0, cA + kstep, kstep, gA); PG8_STAGE(PG8_SB(1, 1), rsB, cB + hstep + kstep, voffB);
        PG8_WAIT_V(6); PG8_BAR;
    }
    for (;;) {
        const bool has_next = S.next(ui + 1, nxt);
        const unsigned nA = has_next ? (unsigned)nxt.pm * tstep : cA, nB = has_next ? (unsigned)nxt.pn * tstep : cB;
        for (int t = 0; t < nt; t += 2) {
            const bool last = (t == nt - 2);
            const unsigned a1 = cA + (unsigned)(t + 1) * kstep;
            const unsigned a2 = last ? nA : cA + (unsigned)(t + 2) * kstep, b2 = last ? nB : cB + (unsigned)(t + 2) * kstep;
            const unsigned a3 = a2 + kstep, b3 = b2 + kstep;
            const unsigned k1 = (unsigned)(t + 1) * kstep, k2 = last ? 0u : (unsigned)(t + 2) * kstep, k3 = k2 + kstep;
            if constexpr (GATHER) {
                if (t == 0 && has_next && wid == 0) __builtin_amdgcn_global_load_lds((const unsigned*)(g.gidx + nxt.pm * 256 + lane * 4), (PG8_LAS unsigned*)(lds + GOFF + ((ui + 1) & 1) * 1024), 16, 0, 0);
                if (last && has_next) {
#pragma unroll
                    for (int h = 0; h < 2; ++h)
#pragma unroll
                        for (int i = 0; i < 2; ++i) gN[h][i] = (unsigned)*(const PG8_LAS int*)(lds + GOFF + ((ui + 1) & 1) * 1024 + (h * 128 + Rl + 64 * i) * 4) * (unsigned)KB + (unsigned)Cb; } }
            unsigned gS[2][2];
#pragma unroll
            for (int h = 0; h < 2; ++h)
#pragma unroll
                for (int i = 0; i < 2; ++i) gS[h][i] = last ? gN[h][i] : gA[h][i];
            PG8_LDB(B0, 0, 0); PG8_LDB(B1, 0, 1); PG8_SCHED; PG8_LDA(At, 0, 0); PG8_STAGE_A(PG8_SA(1, 1), 1, a1 + hstep, k1, gA);
            PG8_WAIT_V(8); PG8_WAIT_L(0); PG8_BAR; PG8_MMA(0, 0, At, B0); PG8_MMA(0, 1, At, B1); PG8_BAR; PG8_SCHED;
            PG8_LDA(At, 0, 1); PG8_STAGE(PG8_SB(0, 0), rsB, b2, voffB); PG8_STAGE(PG8_SB(0, 1), rsB, b2 + hstep, voffB); PG8_STAGE_A(PG8_SA(0, 0), 0, a2, k2, gS);
            PG8_WAIT_V(8); PG8_WAIT_L(0); PG8_BAR; PG8_MMA(1, 0, At, B0); PG8_MMA(1, 1, At, B1); PG8_BAR; PG8_SCHED;
            PG8_LDB(B0, 1, 0); PG8_LDB(B1, 1, 1); PG8_SCHED; PG8_LDA(At, 1, 0); PG8_STAGE_A(PG8_SA(0, 1), 1, a2 + hstep, k2, gS);
            PG8_WAIT_V(8); PG8_WAIT_L(0); PG8_BAR; PG8_MMA(0, 0, At, B0); PG8_MMA(0, 1, At, B1); PG8_BAR; PG8_SCHED;
            PG8_LDA(At, 1, 1); PG8_STAGE(PG8_SB(1, 0), rsB, b3, voffB); PG8_STAGE(PG8_SB(1, 1), rsB, b3 + hstep, voffB); PG8_STAGE_A(PG8_SA(1, 0), 0, a3, k3, gS);
            PG8_WAIT_V(8); PG8_WAIT_L(0); PG8_BAR; PG8_MMA(1, 0, At, B0); PG8_MMA(1, 1, At, B1); PG8_BAR; PG8_SCHED;
        }
        if constexpr (ALIGN_EPI) { if (wr == 0) PG8_BAR; }
        if constexpr (FP8) asm volatile("s_nop 15\n\ts_nop 15" ::: "memory");
        E(acc, cur, wr, wc, fr, fq);
        if (!has_next) break;
#pragma unroll
        for (int a = 0; a < 2; ++a)
#pragma unroll
            for (int b = 0; b < 2; ++b)
#pragma unroll
                for (int m = 0; m < 4; ++m)
#pragma unroll
                    for (int n = 0; n < 2; ++n) acc[a][b][m][n] = (f32x4){0.f, 0.f, 0.f, 0.f};
        cur = nxt; cA = nA; cB = nB; ++ui;
        if constexpr (GATHER) {
#pragma unroll
            for (int h = 0; h < 2; ++h)
#pragma unroll
                for (int i = 0; i < 2; ++i) gA[h][i] = gN[h][i]; }
        if constexpr (ALIGN_EPI) { if (wr == 1) PG8_BAR; }
    }
    PG8_WAIT_V(0);
    if constexpr (!ALIGN_EPI) { if (wr == 0) PG8_BAR; }
    PG8_BAR;
#undef PG8_STAGE_A
#undef PG8_SA
#undef PG8_SB
#undef PG8_STAGE
#undef PG8_LDA
#undef PG8_LDB
#undef PG8_MMA
#undef PG8_WAIT_V
#undef PG8_WAIT_L
#undef PG8_BAR
#undef PG8_SCHED
}
}

#define XB_TMO      128
#define XB_XCNT(j)  (256  + 64 * (j))
#define XB_XSUB(j)  (1280 + 64 * (j))
#define XB_XGEN(j)  (2304 + 64 * (j))
#define XB_TOP      3328
#define XB_TOPGEN   3392
#define XCD_BAR_WORDS 3456
#define XB_SPIN_CAP (1u << 18)
__device__ __forceinline__ unsigned xb_ld(unsigned* p)              { return __hip_atomic_load(p, __ATOMIC_RELAXED, __HIP_MEMORY_SCOPE_AGENT); }
__device__ __forceinline__ unsigned xb_add(unsigned* p, unsigned v) { return __hip_atomic_fetch_add(p, v, __ATOMIC_RELAXED, __HIP_MEMORY_SCOPE_AGENT); }
__device__ __forceinline__ unsigned xb_xcc_id() { return (unsigned)__builtin_amdgcn_s_getreg((3 << 11) | 20) & 0xFu; }
#define XB_SPIN(cond, bar) do { unsigned _sp = 0; while (cond) { __builtin_amdgcn_s_sleep(1); \
    if ((++_sp & 255u) == 0u) { if (xb_ld(&(bar)[XB_TMO])) break; if (_sp > XB_SPIN_CAP) { atomicAdd(&(bar)[XB_TMO], 1u); break; } } } } while (0)
struct XcdBarrier { unsigned* bar; unsigned x; volatile LAS unsigned* st; };
__device__ __forceinline__ XcdBarrier xcd_barrier_post(unsigned* bar, volatile LAS unsigned* st) {
    XcdBarrier b; b.bar = bar; b.x = xb_xcc_id(); b.st = st;
    if (threadIdx.x == 0) (void)xb_add(&bar[XB_XCNT(b.x)], 1u);
    return b;
}
__device__ __forceinline__ void xcd_barrier_complete(unsigned* bar, unsigned x, unsigned& nloc, unsigned& nx) {
    const unsigned G = gridDim.x * gridDim.y * gridDim.z;
    unsigned sum, cnt, mine, sp = 0u;
    for (;;) {
        sum = 0u; cnt = 0u; mine = 0u;
#pragma unroll
        for (unsigned j = 0; j < 16; ++j) { const unsigned c = xb_ld(&bar[XB_XCNT(j)]); sum += c; cnt += (c > 0u) ? 1u : 0u; mine = (j == x) ? c : mine; }
        if (sum == G) break;
        __builtin_amdgcn_s_sleep(1);
        if ((++sp & 255u) == 0u) { if (xb_ld(&bar[XB_TMO])) break; if (sp > XB_SPIN_CAP) { atomicAdd(&bar[XB_TMO], 1u); break; } }
    }
    nloc = mine > 0u ? mine : 1u; nx = cnt > 0u ? cnt : 1u;
}
__device__ __forceinline__ void xcd_barrier(const XcdBarrier& b, const bool thread0) {
    asm volatile("s_waitcnt vmcnt(0)" ::: "memory");
    __syncthreads();
    if (thread0) {
        unsigned* bar = b.bar;
        __builtin_amdgcn_s_waitcnt(0);
        unsigned nloc = b.st[0], nx = b.st[1];
        if (nloc == 0u) { xcd_barrier_complete(bar, b.x, nloc, nx); b.st[0] = nloc; b.st[1] = nx; }
        const unsigned old = xb_add(&bar[XB_XSUB(b.x)], 1u);
        const unsigned gen = old / nloc;
        if (old + 1u == (gen + 1u) * nloc) {
            __builtin_amdgcn_fence(__ATOMIC_RELEASE, "agent");
            asm volatile("s_waitcnt vmcnt(0)" ::: "memory");
            const unsigned og = xb_add(&bar[XB_TOP], 1u);
            const unsigned tg = og / nx;
            if (og + 1u == (tg + 1u) * nx) xb_add(&bar[XB_TOPGEN], 1u);
            else XB_SPIN(xb_ld(&bar[XB_TOPGEN]) == tg, bar);
            __builtin_amdgcn_fence(__ATOMIC_ACQUIRE, "agent");
            xb_add(&bar[XB_XGEN(b.x)], 1u);
            asm volatile("s_waitcnt vmcnt(0)" ::: "memory");
        } else {
            XB_SPIN(xb_ld(&bar[XB_XGEN(b.x)]) == gen, bar);
            __builtin_amdgcn_fence(__ATOMIC_ACQUIRE, "agent");
            asm volatile("s_waitcnt vmcnt(0)" ::: "memory");
        }
    }
    __syncthreads();
}

struct Frame {
    LAS unsigned char* lds;
    int tid, lane, wave, vcu, G;
    unsigned char* ws;
};
#define WSP(T, off) ((T*)(F.ws + (off)))

__device__ __forceinline__ void cvt_item(const float* W, int ldw, int nvalid, int k0, int n0, bf16* WT, int ldt, int drow0, LAS float* scr, int lane) {
    const int c4 = lane & 15, kr = lane >> 4;
    f32x4 v[16];
#pragma unroll
    for (int i = 0; i < 16; ++i) { const int r = 4 * i + kr; v[i] = (4 * c4 < nvalid) ? *(const GAS f32x4*)(W + (size_t)(k0 + r) * ldw + n0 + 4 * c4) : (f32x4){0.f, 0.f, 0.f, 0.f}; }
#pragma unroll
    for (int i = 0; i < 16; ++i) { const int r = 4 * i + kr; LAS float* s = scr + r * 65 + 4 * c4; s[0] = v[i][0]; s[1] = v[i][1]; s[2] = v[i][2]; s[3] = v[i][3]; }
    LDS_WAIT(); asm volatile("" ::: "memory");
    const int c = lane & 7;
#pragma unroll
    for (int j = 0; j < 8; ++j) { const int n = (lane >> 3) + 8 * j; const LAS float* s = scr + (8 * c) * 65 + n;
        v4u o; o.x = pk2(s[0 * 65], s[1 * 65]); o.y = pk2(s[2 * 65], s[3 * 65]); o.z = pk2(s[4 * 65], s[5 * 65]); o.w = pk2(s[6 * 65], s[7 * 65]);
        if (n < nvalid) *(GAS v4u*)(WT + (size_t)(drow0 + n) * ldt + k0 + 8 * c) = o; }
    LDS_WAIT(); asm volatile("" ::: "memory");
}

__device__ __forceinline__ void cvt8_load(const float* W, int ldw, int k0, int n0, f32x4 (&v)[16], int lane) {
    const int c4 = lane & 15, kr = lane >> 4;
#pragma unroll
    for (int i = 0; i < 16; ++i) v[i] = __builtin_nontemporal_load((const GAS f32x4*)(W + (size_t)(k0 + 4 * i + kr) * ldw + n0 + 4 * c4));
}
__device__ __forceinline__ void cvt8_finish(const f32x4 (&v)[16], int k0, unsigned char* WT, int ldt, int drow0, float scale, LAS float* scr, int lane) {
    const int c4 = lane & 15, kr = lane >> 4;
#pragma unroll
    for (int i = 0; i < 16; ++i) { const int r = 4 * i + kr; LAS float* s = scr + r * 65 + 4 * c4; s[0] = v[i][0]; s[1] = v[i][1]; s[2] = v[i][2]; s[3] = v[i][3]; }
    LDS_WAIT(); asm volatile("" ::: "memory");
    const int c = lane & 3;
#pragma unroll
    for (int j = 0; j < 4; ++j) { const int n = (lane >> 2) + 16 * j; const LAS float* s = scr + (16 * c) * 65 + n;
        v4u o;
        o.x = pk4_fp8(s[0 * 65] * scale, s[1 * 65] * scale, s[2 * 65] * scale, s[3 * 65] * scale); o.y = pk4_fp8(s[4 * 65] * scale, s[5 * 65] * scale, s[6 * 65] * scale, s[7 * 65] * scale);
        o.z = pk4_fp8(s[8 * 65] * scale, s[9 * 65] * scale, s[10 * 65] * scale, s[11 * 65] * scale); o.w = pk4_fp8(s[12 * 65] * scale, s[13 * 65] * scale, s[14 * 65] * scale, s[15 * 65] * scale);
        *(GAS v4u*)(WT + (size_t)(drow0 + n) * ldt + k0 + 16 * c) = o; }
    LDS_WAIT(); asm volatile("" ::: "memory");
}
struct ExpItem { const float* W; int ldw, k0, n0, ldt, drow0; unsigned char* WT; };
__device__ __forceinline__ ExpItem exp_item(const P& p, unsigned char* ws, int q, int half) {
    ExpItem e; const int le = q / 1056, rr = q % 1056, mk = rr / 352, ii = rr % 352;
    if (mk < 2) { const int kb2 = ii / 44, nb = ii % 44; e.n0 = 64 * nb; e.k0 = 64 * (2 * kb2 + half); e.W = (mk == 0 ? p.exp_w_gate : p.exp_w_up) + (size_t)le * D * FF; e.ldw = FF; e.ldt = D; e.drow0 = (e.n0 >> 7) * 256 + mk * 128 + (e.n0 & 127); e.WT = ws + WS_WUP + (size_t)le * 5632 * D; }
    else { const int kb2 = ii / 16, nb = ii % 16; e.n0 = 64 * nb; e.k0 = 64 * (2 * kb2 + half); e.W = p.exp_w_down + (size_t)le * FF * D; e.ldw = D; e.ldt = FF; e.drow0 = e.n0; e.WT = ws + WS_WDN + (size_t)le * D * FF; }
    return e;
}
constexpr int NPAIR_ALL = 32 * 1056;
__device__ __forceinline__ void cvt_pairs(const P& p, unsigned char* ws, LAS float* scr, int qfirst, int qstep, int qend, int lane) {
    f32x4 va[16], vb[16]; int q = qfirst;
    if (q < qend) { const ExpItem e = exp_item(p, ws, q, 0); cvt8_load(e.W, e.ldw, e.k0, e.n0, va, lane); }
    while (q < qend) {
        const ExpItem e0 = exp_item(p, ws, q, 0), e1 = exp_item(p, ws, q, 1);
        cvt8_load(e1.W, e1.ldw, e1.k0, e1.n0, vb, lane);
        cvt8_finish(va, e0.k0, e0.WT, e0.ldt, e0.drow0, F8_W, scr, lane);
        const int q2 = q + qstep;
        if (q2 < qend) { const ExpItem e2 = exp_item(p, ws, q2, 0); cvt8_load(e2.W, e2.ldw, e2.k0, e2.n0, va, lane); }
        cvt8_finish(vb, e1.k0, e1.WT, e1.ldt, e1.drow0, F8_W, scr, lane);
        q = q2;
    }
}
#ifndef BG_QKV
#define BG_QKV 1
#define BG_OUT0 2
#define BG_UP0 0
#define BG_DN0 2
#endif
constexpr int CVT_Q3 = NPAIR_ALL - BG_DN0 * 128 * 8, CVT_Q2 = CVT_Q3 - BG_UP0 * 64 * 8, CVT_Q1 = CVT_Q2 - BG_OUT0 * 192 * 8, CVT_SPLIT0 = CVT_Q1 - BG_QKV * 160 * 8;
static_assert(CVT_SPLIT0 >= NPAIR_ALL / 2, "background slices must stay inside layer 1");
#define BG_SLOT(first, qb, qe) do { if (MOE_FP8 && F.G == 256 && (int)blockIdx.x >= (first) && (qb) < (qe)) { __syncthreads(); \
    cvt_pairs(p, F.ws, (LAS float*)(F.lds + F.wave * 16640), (qb) + ((int)blockIdx.x - (first)) * 8 + F.wave, (256 - (first)) * 8, (qe), F.lane); } } while (0)
__device__ __forceinline__ void ph_pro(const P& p, Frame& F, bool do_cvt) {
    float* MOD = WSP(float, WS_MOD); float* ROPE = WSP(float, WS_ROPE);
    if (F.vcu == 255 % F.G) {
        for (int i = F.tid; i < 1024; i += 512) { const int pos = i >> 4, f = i & 15; const float inv = powf(10000.f, -(float)f / 16.f); const float ang = (float)pos * inv; ROPE[2 * i] = cosf(ang); ROPE[2 * i + 1] = sinf(ang); }
    }
    if (F.vcu < 192) {
        LAS float* ssrc = (LAS float*)F.lds; LAS float* red = (LAS float*)(F.lds + 69632);
        for (int i = F.tid; i < 17 * 1024; i += 512) { const int j = i >> 10, k = i & 1023; const float v = (j < 16) ? p.c[j * 1024 + k] : p.c_ctx[k]; ssrc[i] = silu_f(v); }
        __syncthreads();
        for (int u = F.vcu; u < 192; u += F.G) {
            const int l = u / 96, c0 = (u % 96) * 64, col = c0 + (F.tid & 63), ks = F.tid >> 6;
            const float* w = p.ada_w + ((size_t)l * 1024 + ks * 128) * 6144 + col;
            float acc[17];
#pragma unroll
            for (int j = 0; j < 17; ++j) acc[j] = 0.f;
            for (int k = 0; k < 128; k += 4) {
                const float w0 = w[(size_t)(k + 0) * 6144], w1 = w[(size_t)(k + 1) * 6144], w2 = w[(size_t)(k + 2) * 6144], w3 = w[(size_t)(k + 3) * 6144];
#pragma unroll
                for (int j = 0; j < 17; ++j) { const f32x4 s = *(const LAS f32x4*)(ssrc + j * 1024 + ks * 128 + k); acc[j] += s[0] * w0 + s[1] * w1 + s[2] * w2 + s[3] * w3; }
            }
#pragma unroll
            for (int j = 0; j < 17; ++j) red[(ks * 17 + j) * 64 + (F.tid & 63)] = acc[j];
            __syncthreads();
            for (int i = F.tid; i < 17 * 64; i += 512) { const int j = i >> 6, c = i & 63; float s = p.ada_b[l * 6144 + c0 + c];
#pragma unroll
                for (int q = 0; q < 8; ++q) s += red[(q * 17 + j) * 64 + c];
                MOD[(size_t)(l * 17 + j) * 6144 + c0 + c] = s; }
            __syncthreads();
        }
    }
    if (do_cvt) {
        __syncthreads();
        LAS float* scr = (LAS float*)(F.lds + F.wave * 16640);
        const int gw = F.vcu * NWAVES + F.wave, NGW = F.G * NWAVES;
        constexpr int I_QKV = 16 * 24, I_O = 16 * 16, I_GIN = 16 * 49, I_SMALL = I_QKV + I_O + I_GIN + I_O, I_E = 704, I_LE = 3 * I_E, NITEMS = I_SMALL + 32 * I_LE;
        for (int it = gw; it < I_SMALL; it += NGW) {
            int r = it;
            if (r < I_QKV) { cvt_item(p.attn_w_in, ATT_N, 64, 64 * (r / 24), 64 * (r % 24), WSP(bf16, WS_WQKV), D, 64 * (r % 24), scr, F.lane); continue; } r -= I_QKV;
            if (r < I_O) { cvt_item(p.attn_w_out, D, 64, 64 * (r / 16), 64 * (r % 16), WSP(bf16, WS_WO0), D, 64 * (r % 16), scr, F.lane); continue; } r -= I_O;
            if (r < I_GIN) { const int nb = r % 49; cvt_item(p.gla_w_in, GIN, nb == 48 ? 32 : 64, 64 * (r / 49), 64 * nb, WSP(bf16, WS_WGIN), D, 64 * nb, scr, F.lane); continue; } r -= I_GIN;
            cvt_item(p.gla_w_out, D, 64, 64 * (r / 16), 64 * (r % 16), WSP(bf16, WS_WO1), D, 64 * (r % 16), scr, F.lane);
        }
        constexpr int NEXP = 32 * I_LE;
        if (MOE_FP8) {
            cvt_pairs(p, F.ws, scr, gw, NGW, F.G == 256 ? CVT_SPLIT0 : NPAIR_ALL, F.lane);
        } else {
            for (int r = gw; r < NEXP; r += NGW) {
                const int le = r / I_LE, rr = r % I_LE, mk = rr / I_E, ii = rr % I_E;
                if (mk < 2) { const int kb = ii / 44, nb = ii % 44, n0 = 64 * nb; const float* W = (mk == 0 ? p.exp_w_gate : p.exp_w_up) + (size_t)le * D * FF; const int dr = (n0 >> 7) * 256 + mk * 128 + (n0 & 127);
                    cvt_item(W, FF, 64, 64 * kb, n0, WSP(bf16, WS_WUP) + (size_t)le * 5632 * D, D, dr, scr, F.lane); }
                else { const int kb = ii / 16, nb = ii % 16; cvt_item(p.exp_w_down + (size_t)le * FF * D, D, 64, 64 * kb, 64 * nb, WSP(bf16, WS_WDN) + (size_t)le * D * FF, FF, 64 * nb, scr, F.lane); }
            }
        }
        { v4u* z = (v4u*)(WSP(bf16, WS_WGIN) + (size_t)GIN * D); const int n16 = (GIN_PAD - GIN) * D * 2 / 16;
          for (int i = F.vcu * 512 + F.tid; i < n16; i += F.G * 512) z[i] = (v4u){0u, 0u, 0u, 0u}; }
    }
}

__device__ __forceinline__ void norm_mod_store(const f32x4 (&v)[4], float rstd, const float* g, const float* sh, const float* sc, bf16* orow, int lane) {
    f32x4 gv[4], shv[4], scv[4];
#pragma unroll
    for (int j = 0; j < 4; ++j) { const int c = 4 * (lane + 64 * j); gv[j] = *(const f32x4*)(g + c); shv[j] = *(const f32x4*)(sh + c); scv[j] = *(const f32x4*)(sc + c); }
#pragma unroll
    for (int j = 0; j < 4; ++j) { const int c = 4 * (lane + 64 * j);
        const f32x4 y = (v[j] * rstd * gv[j]) * (scv[j] + 1.f) + shv[j]; v2u o; o.x = pk2(y[0], y[1]); o.y = pk2(y[2], y[3]); *(v2u*)(orow + c) = o; }
}
__device__ __forceinline__ void ph_norm1(const P& p, Frame& F, int l) {
    const float* MOD = WSP(float, WS_MOD); bf16* H = WSP(bf16, WS_H); const float* XA = WSP(float, WS_XA);
    const int gw = F.vcu * NWAVES + F.wave, NGW = F.G * NWAVES; constexpr int RW = 3;
    f32x4 gv[4];
#pragma unroll
    for (int q = 0; q < 4; ++q) gv[q] = *(const f32x4*)(p.norm1_g + l * D + 4 * (F.lane + 64 * q));
    for (int r0 = gw; r0 < NT; r0 += RW * NGW) {
        f32x4 v[RW][4], shv[RW][4], scv[RW][4];
#pragma unroll
        for (int h = 0; h < RW; ++h) { const int r = r0 + h * NGW < NT ? r0 + h * NGW : r0;
            const float* xr = (l == 0) ? (r < NL ? p.x + (size_t)r * D : p.ctx + (size_t)(r - NL) * D) : XA + (size_t)r * D;
            const int j = r < NL ? r / SEQ : 16; const float* mr = MOD + (size_t)(l * 17 + j) * 6144;
#pragma unroll
            for (int q = 0; q < 4; ++q) { const int c = 4 * (F.lane + 64 * q); v[h][q] = *(const f32x4*)(xr + c); shv[h][q] = *(const f32x4*)(mr + c); scv[h][q] = *(const f32x4*)(mr + 1024 + c); } }
#pragma unroll
        for (int h = 0; h < RW; ++h) { const int r = r0 + h * NGW; if (r >= NT) break; float s = 0.f;
#pragma unroll
            for (int q = 0; q < 4; ++q) s += (v[h][q][0] * v[h][q][0] + v[h][q][1] * v[h][q][1]) + (v[h][q][2] * v[h][q][2] + v[h][q][3] * v[h][q][3]);
            const float rstd = 1.f / sqrtf(wave_sum(s) * (1.f / D) + EPS);
            bf16* orow = H + (size_t)r * D;
#pragma unroll
            for (int q = 0; q < 4; ++q) { const f32x4 y = (v[h][q] * rstd * gv[q]) * (scv[h][q] + 1.f) + shv[h][q]; v2u o; o.x = pk2(y[0], y[1]); o.y = pk2(y[2], y[3]); *(v2u*)(orow + 4 * (F.lane + 64 * q)) = o; } }
    }
}
__device__ __forceinline__ void ph_norm2r(const P& p, Frame& F, int l) {
    const float* MOD = WSP(float, WS_MOD); bf16* H = WSP(bf16, WS_H); const float* XA = WSP(float, WS_XA); float* AFF = WSP(float, WS_AFF);
    constexpr int HT = 1028;
    LAS float* rw = (LAS float*)F.lds; LAS float* h2t = (LAS float*)(F.lds + 65536); LAS float* part = (LAS float*)(F.lds + 65536 + 16 * HT * 4);
    for (int i = F.tid; i < D * NE / 4; i += 512) ((LAS f32x4*)rw)[i] = ((const f32x4*)(p.router_w + (size_t)l * D * NE))[i];
    const int ntile = (l == 0 ? NT : NL) / 16, lane = F.lane, w = F.wave;
    const float *g = p.norm2_g + l * D;
    f32x4 v[2][4], gq[4];
#pragma unroll
    for (int q = 0; q < 4; ++q) gq[q] = *(const f32x4*)(g + 4 * (lane + 64 * q));
    if (F.vcu < ntile) {
#pragma unroll
        for (int h = 0; h < 2; ++h)
#pragma unroll
            for (int q = 0; q < 4; ++q) v[h][q] = *(const f32x4*)(XA + (size_t)(F.vcu * 16 + 2 * w + h) * D + 4 * (lane + 64 * q)); }
    __syncthreads();
    for (int tile = F.vcu; tile < ntile; tile += F.G) {
        const int r0 = tile * 16;
        f32x4 shq[4], scq[4];
        { const int j = r0 < NL ? r0 / SEQ : 16; const float* mr = MOD + (size_t)(l * 17 + j) * 6144;
#pragma unroll
          for (int q = 0; q < 4; ++q) { shq[q] = *(const f32x4*)(mr + 3072 + 4 * (lane + 64 * q)); scq[q] = *(const f32x4*)(mr + 4096 + 4 * (lane + 64 * q)); } }
#pragma unroll
        for (int h = 0; h < 2; ++h) { const int r = r0 + 2 * w + h; float s = 0.f;
#pragma unroll
            for (int q = 0; q < 4; ++q) s += (v[h][q][0] * v[h][q][0] + v[h][q][1] * v[h][q][1]) + (v[h][q][2] * v[h][q][2] + v[h][q][3] * v[h][q][3]);
            const float rstd = 1.f / sqrtf(wave_sum(s) * (1.f / D) + EPS);
            bf16* orow = H + (size_t)r * D;
#pragma unroll
            for (int q = 0; q < 4; ++q) { const int c = 4 * (lane + 64 * q); const f32x4 gv = gq[q], shv = shq[q], scv = scq[q];
                const f32x4 y = (v[h][q] * rstd * gv) * (scv + 1.f) + shv;
                if (MOE_FP8) *(unsigned*)(WSP(unsigned char, WS_H8) + (size_t)r * D + c) = pk4_fp8(y[0] * F8_ACT, y[1] * F8_ACT, y[2] * F8_ACT, y[3] * F8_ACT);
                else { v2u o; o.x = pk2(y[0], y[1]); o.y = pk2(y[2], y[3]); *(v2u*)(orow + c) = o; }
                *(LAS f32x4*)(h2t + (2 * w + h) * HT + c) = y; } }
        if (tile + F.G < ntile) {
#pragma unroll
            for (int h = 0; h < 2; ++h)
#pragma unroll
                for (int q = 0; q < 4; ++q) v[h][q] = *(const f32x4*)(XA + (size_t)((tile + F.G) * 16 + 2 * w + h) * D + 4 * (lane + 64 * q)); }
        LDS_SYNC();
        { f32x4 acc = (f32x4){0.f, 0.f, 0.f, 0.f}; const int i16 = lane & 15, kq = lane >> 4;
#pragma unroll 8
          for (int it = 0; it < 32; ++it) { const int k = 128 * w + 4 * it + kq; acc = __builtin_amdgcn_mfma_f32_16x16x4f32(h2t[i16 * HT + k], rw[k * 16 + i16], acc, 0, 0, 0); }
#pragma unroll
          for (int r = 0; r < 4; ++r) part[(w * 16 + 4 * kq + r) * 16 + i16] = acc[r]; }
        LDS_SYNC();
        if (F.tid < 256) { const int i = F.tid >> 4, e = F.tid & 15; float a = 0.f;
#pragma unroll
            for (int w2 = 0; w2 < 8; ++w2) a += part[(w2 * 16 + i) * 16 + e];
            float m = a;
#pragma unroll
            for (int o = 1; o < 16; o <<= 1) m = fmaxf(m, __shfl_xor(m, o));
            const float pe = expf(a - m); float ssum = pe;
#pragma unroll
            for (int o = 1; o < 16; o <<= 1) ssum += __shfl_xor(ssum, o);
            AFF[(size_t)(r0 + i) * 16 + e] = pe / ssum; }
    }
    __syncthreads();
}
__device__ __forceinline__ void ph_topkg(const P& p, Frame& F, int l) {
    const float* AFF = WSP(float, WS_AFF); int* SLOT = WSP(int, WS_SLOT); int* ROWIDX = WSP(int, WS_ROWIDX); float* ROWG = WSP(float, WS_ROWG);
    const bf16* H = WSP(bf16, WS_H); bf16* XG = WSP(bf16, WS_XG);
    LAS int* hist = (LAS int*)F.lds;
    LAS int* sel = hist + 256;
    LAS int* wtot = sel + 256;
    LAS int* shr = wtot + 8;
    const int nunits = l == 0 ? 512 : 256, tid = F.tid, lane = F.lane;
    for (int u = F.vcu; u < nunits; u += F.G) {
        const bool lat = u < 256; const int b = (u & 255) >> 4, e = u & 15;
        const int L = lat ? SEQ : CTX, cap = lat ? CAPL : CAPC, row0 = lat ? b * SEQ : NL + b * CTX, s0 = lat ? b * CAPL : NB * CAPL + b * CAPC;
        unsigned key[4]; const bool act = 4 * tid < L;
#pragma unroll
        for (int q = 0; q < 4; ++q) key[q] = act ? __float_as_uint(AFF[(size_t)(row0 + 4 * tid + q) * 16 + e]) : 0u;
        unsigned prefix = 0u; int kk = cap;
#pragma unroll
        for (int pass = 0; pass < 4; ++pass) { const int shift = 24 - 8 * pass;
            if (tid < 256) hist[tid] = 0;
            LDS_SYNC();
            if (act) {
#pragma unroll
                for (int q = 0; q < 4; ++q) { const bool cand = pass == 0 ? true : ((key[q] >> (shift + 8)) == (prefix >> (shift + 8))); if (cand) __hip_atomic_fetch_add(&hist[(key[q] >> shift) & 255u], 1, __ATOMIC_RELAXED, __HIP_MEMORY_SCOPE_WORKGROUP); } }
            LDS_SYNC();
            if (F.wave == 0) { const int h0 = hist[4 * lane], h1 = hist[4 * lane + 1], h2 = hist[4 * lane + 2], h3 = hist[4 * lane + 3]; const int tot = h0 + h1 + h2 + h3;
                int suf = tot;
#pragma unroll
                for (int o = 1; o < 64; o <<= 1) { const int t = __shfl_down(suf, o); if (lane + o < 64) suf += t; }
                int above = suf - tot;
                if (above < kk && kk <= above + h3) { shr[0] = 4 * lane + 3; shr[1] = above; } above += h3;
                if (above < kk && kk <= above + h2) { shr[0] = 4 * lane + 2; shr[1] = above; } above += h2;
                if (above < kk && kk <= above + h1) { shr[0] = 4 * lane + 1; shr[1] = above; } above += h1;
                if (above < kk && kk <= above + h0) { shr[0] = 4 * lane + 0; shr[1] = above; } }
            LDS_SYNC();
            prefix |= (unsigned)shr[0] << shift; kk -= shr[1];
        }
        const int n_gt = cap - kk;
        int cg = 0, ce = 0;
#pragma unroll
        for (int q = 0; q < 4; ++q) { cg += (act && key[q] > prefix) ? 1 : 0; ce += (act && key[q] == prefix) ? 1 : 0; }
        int pk = cg | (ce << 16), inc = pk;
#pragma unroll
        for (int o = 1; o < 64; o <<= 1) { const int t = __shfl_up(inc, o); if (lane >= o) inc += t; }
        if (lane == 63) wtot[F.wave] = inc;
        LDS_SYNC();
        int base = 0;
#pragma unroll
        for (int w2 = 0; w2 < 8; ++w2) base += (w2 < F.wave) ? wtot[w2] : 0;
        int ex = base + inc - pk; int rg = ex & 0xffff, re = ex >> 16;
        if (act) {
#pragma unroll
            for (int q = 0; q < 4; ++q) { const int row = row0 + 4 * tid + q; int s = -1;
                if (key[q] > prefix) { s = rg; ++rg; } else if (key[q] == prefix) { if (re < kk) s = n_gt + re; ++re; }
                if (s >= 0) { ROWIDX[e * ESLOTS + s0 + s] = row; ROWG[e * ESLOTS + s0 + s] = __uint_as_float(key[q]); sel[s] = row; s += s0; }
                SLOT[(size_t)row * 16 + e] = s; } }
        LDS_SYNC();
    }
}
__device__ __forceinline__ void ph_combine(const P& p, Frame& F, int l) {
    const float* MOD = WSP(float, WS_MOD); bf16* H = WSP(bf16, WS_H); float* XA = WSP(float, WS_XA); const int* SLOT = WSP(int, WS_SLOT); const bf16* YS = WSP(bf16, WS_YS);
    const int gw = F.vcu * NWAVES + F.wave, NGW = F.G * NWAVES; const int nrows = l == 0 ? NT : NL;
    f32x4 gn[4];
#pragma unroll
    for (int q = 0; q < 4; ++q) gn[q] = *(const f32x4*)((l == 0 ? p.norm1_g + D : p.final_norm_g) + 4 * (F.lane + 64 * q));
    for (int r0 = gw; r0 < nrows; r0 += 2 * NGW) {
        int sv[2]; f32x4 v[2][4], acc[2][4];
#pragma unroll
        for (int h = 0; h < 2; ++h) { const int r = r0 + h * NGW; sv[h] = F.lane < 16 ? SLOT[(size_t)r * 16 + F.lane] : -1;
#pragma unroll
            for (int q = 0; q < 4; ++q) { v[h][q] = *(const f32x4*)(XA + (size_t)r * D + 4 * (F.lane + 64 * q)); acc[h][q] = (f32x4){0.f, 0.f, 0.f, 0.f}; } }
        unsigned mk[2]; v2u yv[2][4][4];
#pragma unroll
        for (int h = 0; h < 2; ++h) { mk[h] = (unsigned)(__ballot(sv[h] >= 0) & 0xffffull); unsigned m2 = mk[h];
#pragma unroll
            for (int i = 0; i < 4; ++i) {
                if (m2) { const int e = __builtin_ctz(m2); m2 &= m2 - 1; const int sl = __builtin_amdgcn_readlane(sv[h], e); const bf16* yr = YS + (size_t)(e * ESLOTS + sl) * D;
#pragma unroll
                    for (int q = 0; q < 4; ++q) yv[h][i][q] = *(const v2u*)(yr + 4 * (F.lane + 64 * q)); }
                else {
#pragma unroll
                    for (int q = 0; q < 4; ++q) yv[h][i][q] = (v2u){0u, 0u}; } }
            mk[h] = m2; }
        f32x4 g2v[2][4], shn[2][4], scn[2][4];
#pragma unroll
        for (int h = 0; h < 2; ++h) { const int r = r0 + h * NGW; const int j = r < NL ? r / SEQ : 16; const float* g2 = MOD + (size_t)(l * 17 + j) * 6144 + 5120; const float* m1 = MOD + (size_t)(17 + j) * 6144;
#pragma unroll
            for (int q = 0; q < 4; ++q) { const int c = 4 * (F.lane + 64 * q); g2v[h][q] = *(const f32x4*)(g2 + c); if (l == 0) { shn[h][q] = *(const f32x4*)(m1 + c); scn[h][q] = *(const f32x4*)(m1 + 1024 + c); } } }
#pragma unroll
        for (int h = 0; h < 2; ++h) {
#pragma unroll
            for (int i = 0; i < 4; ++i)
#pragma unroll
                for (int q = 0; q < 4; ++q) { const v2u w = yv[h][i][q]; acc[h][q][0] += __uint_as_float(w.x << 16); acc[h][q][1] += __uint_as_float(w.x & 0xffff0000u); acc[h][q][2] += __uint_as_float(w.y << 16); acc[h][q][3] += __uint_as_float(w.y & 0xffff0000u); }
            unsigned m2 = mk[h];
            while (m2) { const int e = __builtin_ctz(m2); m2 &= m2 - 1; const int sl = __builtin_amdgcn_readlane(sv[h], e); const bf16* yr = YS + (size_t)(e * ESLOTS + sl) * D;
#pragma unroll
                for (int q = 0; q < 4; ++q) { const v2u w = *(const v2u*)(yr + 4 * (F.lane + 64 * q)); acc[h][q][0] += __uint_as_float(w.x << 16); acc[h][q][1] += __uint_as_float(w.x & 0xffff0000u); acc[h][q][2] += __uint_as_float(w.y << 16); acc[h][q][3] += __uint_as_float(w.y & 0xffff0000u); } } }
#pragma unroll
        for (int h = 0; h < 2; ++h) { const int r = r0 + h * NGW;
            float* xr = XA + (size_t)r * D; float s = 0.f;
#pragma unroll
            for (int q = 0; q < 4; ++q) { v[h][q] = v[h][q] + g2v[h][q] * acc[h][q]; s += (v[h][q][0] * v[h][q][0] + v[h][q][1] * v[h][q][1]) + (v[h][q][2] * v[h][q][2] + v[h][q][3] * v[h][q][3]); }
            const float rstd = 1.f / sqrtf(wave_sum(s) * (1.f / D) + EPS);
            if (l == 0) {
#pragma unroll
                for (int q = 0; q < 4; ++q) *(f32x4*)(xr + 4 * (F.lane + 64 * q)) = v[h][q];
                bf16* orow = H + (size_t)r * D;
#pragma unroll
                for (int q = 0; q < 4; ++q) { const f32x4 y = (v[h][q] * rstd * gn[q]) * (scn[h][q] + 1.f) + shn[h][q]; v2u o; o.x = pk2(y[0], y[1]); o.y = pk2(y[2], y[3]); *(v2u*)(orow + 4 * (F.lane + 64 * q)) = o; }
            } else {
                float* orow = p.out + (size_t)r * D;
#pragma unroll
                for (int q = 0; q < 4; ++q) { const int c = 4 * (F.lane + 64 * q); *(f32x4*)(orow + c) = v[h][q] * rstd * gn[q]; }
            } }
    }
}
__device__ __forceinline__ void ph_readout(const P& p, Frame& F) {
    bf16* H = WSP(bf16, WS_H); const bf16* OF = WSP(bf16, WS_OF); const bf16* OB = WSP(bf16, WS_OB); const bf16* PG = WSP(bf16, WS_PG);
    const int gw = F.vcu * NWAVES + F.wave, NGW = F.G * NWAVES;
    f32x4 gnv[4];
#pragma unroll
    for (int q = 0; q < 4; ++q) gnv[q] = *(const f32x4*)(p.gla_norm_g + 4 * (F.lane + 64 * q));
    for (int r0 = gw; r0 < NL; r0 += 2 * NGW) {
        v2u a[2][4], b[2][4], rr[2][4];
#pragma unroll
        for (int h = 0; h < 2; ++h) { const int r = r0 + h * NGW;
#pragma unroll
            for (int q = 0; q < 4; ++q) { const int c = 4 * (F.lane + 64 * q); a[h][q] = *(const v2u*)(OF + (size_t)r * GV + c); b[h][q] = *(const v2u*)(OB + (size_t)r * GV + c); rr[h][q] = *(const v2u*)(PG + (size_t)r * GIN + GQK + c); } }
#pragma unroll
        for (int h = 0; h < 2; ++h) { const int r = r0 + h * NGW;
#pragma unroll
            for (int q = 0; q < 4; ++q) { const int c = 4 * (F.lane + 64 * q);
                f32x4 o; o[0] = __uint_as_float(a[h][q].x << 16) + __uint_as_float(b[h][q].x << 16); o[1] = __uint_as_float(a[h][q].x & 0xffff0000u) + __uint_as_float(b[h][q].x & 0xffff0000u);
                o[2] = __uint_as_float(a[h][q].y << 16) + __uint_as_float(b[h][q].y << 16); o[3] = __uint_as_float(a[h][q].y & 0xffff0000u) + __uint_as_float(b[h][q].y & 0xffff0000u);
                const float ss = wave_sum((o[0] * o[0] + o[1] * o[1]) + (o[2] * o[2] + o[3] * o[3]));
                const float rstd = 1.f / sqrtf(ss * (1.f / GDV) + EPS);
                const f32x4 gv = gnv[q];
                const float q0 = __uint_as_float(rr[h][q].x << 16), q1 = __uint_as_float(rr[h][q].x & 0xffff0000u), q2 = __uint_as_float(rr[h][q].y << 16), q3 = __uint_as_float(rr[h][q].y & 0xffff0000u);
                const float y0 = o[0] * rstd * gv[0] * fsilu(q0), y1 = o[1] * rstd * gv[1] * fsilu(q1), y2 = o[2] * rstd * gv[2] * fsilu(q2), y3 = o[3] * rstd * gv[3] * fsilu(q3);
                v2u w; w.x = pk2(y0, y1); w.y = pk2(y2, y3); *(v2u*)(H + (size_t)r * D + c) = w; } }
    }
}

typedef float f32x16 __attribute__((ext_vector_type(16)));
typedef short s16x4 __attribute__((ext_vector_type(4)));
__device__ __forceinline__ s16x4 lds_tr16(const LAS unsigned char* p) { return __builtin_bit_cast(s16x4, __builtin_amdgcn_ds_read_tr16_b64_v4i16((LAS s16x4*)p)); }
__device__ __forceinline__ int crow(int r, int hi) { return (r & 3) + 8 * (r >> 2) + 4 * hi; }
#define TR_RD(dst, ptr) asm volatile("ds_read_b64_tr_b16 %0, %1" : "=v"(dst) : "v"((unsigned)(uintptr_t)(ptr)) : "memory")
#define TR_WAIT4(a, b, c, d) asm volatile("s_waitcnt lgkmcnt(0)" : "+v"(a), "+v"(b), "+v"(c), "+v"(d) :: "memory")
__device__ __forceinline__ void ph_attn(const P& p, Frame& F) {
    const bf16* Q = WSP(bf16, WS_Q); const bf16* Kb = WSP(bf16, WS_K); const bf16* Vb = WSP(bf16, WS_V); bf16* O = WSP(bf16, WS_O);
    const int lane = F.lane, r32 = lane & 31, hi = lane >> 5, w = F.wave, gq = w >> 1, th = w & 1;
    LAS unsigned char* Ks = F.lds; LAS unsigned char* Vs = F.lds + 3 * 8192;
    const int kl = lane >> 3, chp = lane & 7;
    const int dgrp = (lane >> 4) & 1, qrow = (lane & 15) >> 2, pp = lane & 3;
    for (int u = F.vcu; u < 2048 + 256; u += F.G) {
        const bool lat = u < 2048; int b, hk, t0, qrow0;
        if (lat) { b = u >> 7; hk = (u >> 5) & 3; t0 = 64 * (u & 31); qrow0 = b * SEQ + t0; }
        else { const int uc = u - 2048; b = uc >> 4; hk = (uc >> 2) & 3; t0 = 64 * (uc & 3); qrow0 = NL + b * CTX + t0; }
        int jlo = 0, jhi = -1;
        if (lat) { jlo = t0 >= 128 ? 0 : (128 - t0) / 64; jhi = (SEQ - 64 - (t0 - 128)) / 64; if (jhi > 4) jhi = 4; }
        const int nt = 4 + (jhi - jlo + 1);
        const int hq = hk * 4 + gq; const int qr_row = qrow0 + 32 * th + r32;
#define ATT_KROW(it) ((it) < 4 ? NL + b * CTX + 64 * (it) : b * SEQ + t0 - 128 + 64 * (jlo + (it) - 4))
#define ATT_DMA(it, sl) do { const size_t so_ = ((size_t)(ATT_KROW(it) + 8 * w + kl) * 256 + hk * 64) * 2 + (size_t)((chp ^ kl) * 16); \
        __builtin_amdgcn_global_load_lds((const unsigned*)((const char*)Kb + so_), (LAS unsigned*)(Ks + (sl) * 8192 + w * 1024), 16, 0, 0); \
        __builtin_amdgcn_global_load_lds((const unsigned*)((const char*)Vb + so_), (LAS unsigned*)(Vs + (sl) * 8192 + w * 1024), 16, 0, 0); } while (0)
        bf16x8 qr[4];
#pragma unroll
        for (int d0 = 0; d0 < 4; ++d0) qr[d0] = *(const bf16x8*)(Q + (size_t)qr_row * 1024 + hq * 64 + d0 * 16 + hi * 8);
        ATT_DMA(0, 0); ATT_DMA(1, 1);
        float m = p.attn_sink[hq] * LOG2E, l = hi == 0 ? 1.f : 0.f;
        f32x16 o[2];
#pragma unroll
        for (int r = 0; r < 16; ++r) { o[0][r] = 0.f; o[1][r] = 0.f; }
        int sc = 0, sn2 = 2;
        for (int it = 0; it < nt; ++it) {
            if (it + 1 < nt) asm volatile("s_waitcnt vmcnt(2)" ::: "memory"); else asm volatile("s_waitcnt vmcnt(0)" ::: "memory");
            __builtin_amdgcn_s_barrier(); asm volatile("" ::: "memory");
            if (it + 2 < nt) ATT_DMA(it + 2, sn2);
            const int slot = sc * 8192;
            f32x16 p0, p1;
#pragma unroll
            for (int r = 0; r < 16; ++r) { p0[r] = 0.f; p1[r] = 0.f; }
#pragma unroll
            for (int d0 = 0; d0 < 4; ++d0) {
                const int off = r32 * 128 + (((2 * d0 + hi) ^ (r32 & 7)) * 16);
                const bf16x8 k0 = *(const LAS bf16x8*)(Ks + slot + off), k1 = *(const LAS bf16x8*)(Ks + slot + off + 32 * 128);
                p0 = __builtin_amdgcn_mfma_f32_32x32x16_bf16(k0, qr[d0], p0, 0, 0, 0);
                p1 = __builtin_amdgcn_mfma_f32_32x32x16_bf16(k1, qr[d0], p1, 0, 0, 0);
            }
            s16x4 vt[2][4][2];
#pragma unroll
            for (int dblk = 0; dblk < 2; ++dblk)
#pragma unroll
                for (int ks = 0; ks < 4; ++ks) { const int klo = 16 * ks + 4 * hi + qrow, khi = klo + 8, ch = 4 * dblk + 2 * dgrp + (pp >> 1), bo = (pp & 1) * 8;
                    TR_RD(vt[dblk][ks][0], Vs + slot + klo * 128 + ((ch ^ (klo & 7)) * 16) + bo); TR_RD(vt[dblk][ks][1], Vs + slot + khi * 128 + ((ch ^ (khi & 7)) * 16) + bo); }
            asm volatile("s_nop 7\n\ts_nop 7" : "+v"(p0), "+v"(p1));
            if (it >= 4) { const int j = jlo + it - 4;
                if (j == 0 || j == 4) { const int dq = 32 * th + r32;
                    const int sg = j == 0 ? 1 : -1;
#pragma unroll
                    for (int r = 0; r < 16; ++r) { const int kk = crow(r, hi);
                        p0[r] = sg * (dq - kk) > 0 ? -1e30f : p0[r]; p1[r] = sg * (dq - (kk + 32)) > 0 ? -1e30f : p1[r]; } } }
            float mx = p0[0];
#pragma unroll
            for (int r = 1; r < 16; ++r) mx = fmaxf(mx, p0[r]);
#pragma unroll
            for (int r = 0; r < 16; ++r) mx = fmaxf(mx, p1[r]);
            mx = fmaxf(mx, __shfl_xor(mx, 32));
            const float mn = fmaxf(m, mx);
            if (__any(mn > m)) { const float f = __builtin_amdgcn_exp2f(m - mn); l *= f;
#pragma unroll
                for (int r = 0; r < 16; ++r) { o[0][r] *= f; o[1][r] *= f; }
                m = mn; }
            float ls = 0.f;
#pragma unroll
            for (int r = 0; r < 16; ++r) { p0[r] = __builtin_amdgcn_exp2f(p0[r] - m); p1[r] = __builtin_amdgcn_exp2f(p1[r] - m); ls += p0[r] + p1[r]; }
            l += ls;
            v4u pw[4];
#pragma unroll
            for (int q4 = 0; q4 < 4; ++q4) { pw[0][q4] = pk2(p0[2 * q4], p0[2 * q4 + 1]); pw[1][q4] = pk2(p0[8 + 2 * q4], p0[9 + 2 * q4]); pw[2][q4] = pk2(p1[2 * q4], p1[2 * q4 + 1]); pw[3][q4] = pk2(p1[8 + 2 * q4], p1[9 + 2 * q4]); }
            asm volatile("s_waitcnt lgkmcnt(0)" : "+v"(vt[0][0][0]), "+v"(vt[0][0][1]), "+v"(vt[0][1][0]), "+v"(vt[0][1][1]), "+v"(vt[0][2][0]), "+v"(vt[0][2][1]), "+v"(vt[0][3][0]), "+v"(vt[0][3][1]),
                         "+v"(vt[1][0][0]), "+v"(vt[1][0][1]), "+v"(vt[1][1][0]), "+v"(vt[1][1][1]), "+v"(vt[1][2][0]), "+v"(vt[1][2][1]), "+v"(vt[1][3][0]), "+v"(vt[1][3][1]) :: "memory");
#pragma unroll
            for (int dblk = 0; dblk < 2; ++dblk)
#pragma unroll
                for (int ks = 0; ks < 4; ++ks) { const s16x4 vlo = vt[dblk][ks][0], vhi = vt[dblk][ks][1];
                    const bf16x8 vf = (bf16x8){vlo[0], vlo[1], vlo[2], vlo[3], vhi[0], vhi[1], vhi[2], vhi[3]};
                    o[dblk] = __builtin_amdgcn_mfma_f32_32x32x16_bf16(vf, __builtin_bit_cast(bf16x8, pw[ks]), o[dblk], 0, 0, 0); }
            sc = sc == 2 ? 0 : sc + 1; sn2 = sn2 == 2 ? 0 : sn2 + 1;
        }
#undef ATT_KROW
#undef ATT_DMA
        const float il = 1.f / (l + __shfl_xor(l, 32));
        bf16* orow = O + (size_t)qr_row * 1024 + hq * 64;
#pragma unroll
        for (int dblk = 0; dblk < 2; ++dblk)
#pragma unroll
            for (int rq = 0; rq < 4; ++rq) { v2u wv; wv.x = pk2(o[dblk][4 * rq] * il, o[dblk][4 * rq + 1] * il); wv.y = pk2(o[dblk][4 * rq + 2] * il, o[dblk][4 * rq + 3] * il);
                *(v2u*)(orow + 32 * dblk + 8 * rq + 4 * hi) = wv; }
        __builtin_amdgcn_s_barrier(); asm volatile("" ::: "memory");
    }
}
__device__ __forceinline__ void ph_attn_naive(const P& p, Frame& F) {
    const bf16* Q = WSP(bf16, WS_Q); const bf16* Kb = WSP(bf16, WS_K); const bf16* Vb = WSP(bf16, WS_V); bf16* O = WSP(bf16, WS_O);
    for (int i = F.vcu * 512 + F.tid; i < NT * NQH; i += F.G * 512) {
        const int r = i >> 4, hq = i & 15, hk = hq >> 2;
        float q[64], acc[64];
#pragma unroll
        for (int d = 0; d < 64; ++d) { q[d] = bf2f(Q[(size_t)r * 1024 + hq * 64 + d]); acc[d] = 0.f; }
        float m = p.attn_sink[hq] * LOG2E, l = 1.f;
        const bool lat = r < NL; const int b = lat ? r / SEQ : (r - NL) / CTX, t = r & (SEQ - 1);
        const int nlat = lat ? (min(SEQ - 1, t + 128) - max(0, t - 128) + 1) : 0, klo = max(0, t - 128);
        for (int kk = 0; kk < CTX + nlat; ++kk) {
            const int kr = kk < CTX ? NL + b * CTX + kk : b * SEQ + klo + (kk - CTX);
            const bf16* kp = Kb + (size_t)kr * 256 + hk * 64; const bf16* vp = Vb + (size_t)kr * 256 + hk * 64;
            float s = 0.f;
#pragma unroll
            for (int d = 0; d < 64; ++d) s += q[d] * bf2f(kp[d]);
            const float mn = fmaxf(m, s), sc = exp2f(m - mn), pe = exp2f(s - mn);
            l = l * sc + pe; m = mn;
#pragma unroll
            for (int d = 0; d < 64; ++d) acc[d] = acc[d] * sc + pe * bf2f(vp[d]);
        }
        const float il = 1.f / l;
#pragma unroll
        for (int d = 0; d < 64; ++d) O[(size_t)r * 1024 + hq * 64 + d] = (bf16)f2bf(acc[d] * il);
    }
}
__device__ __forceinline__ f32x4 mfma16(bf16x8 a, bf16x8 b, f32x4 c) { return __builtin_amdgcn_mfma_f32_16x16x32_bf16(a, b, c, 0, 0, 0); }
__device__ __forceinline__ int gla_rowmap(int b, int dir, int s) { return s < CTX ? NL + b * CTX + (dir ? CTX - 1 - s : s) : b * SEQ + (dir ? SEQ - 1 - (s - CTX) : s - CTX); }
__device__ __forceinline__ void ph_glaprep(const P& p, Frame& F) {
    const bf16* PG = WSP(bf16, WS_PG); bf16* QT = WSP(bf16, WS_QT); bf16* KT = WSP(bf16, WS_KT); float* DEC = WSP(float, WS_DEC);
    const int lane = F.lane, w = F.wave, c16 = lane & 15, g = lane >> 4;
    for (int uu = F.vcu; uu < NB * 2 * 36 * 2; uu += F.G) {
        const int hf = uu & 1, u = uu >> 1, c = u % 36, dir = (u / 36) & 1, b = u / 72;
        const int rowA = gla_rowmap(b, dir, 64 * c), rstep = dir ? -1 : 1;
        const size_t obase = ((size_t)(dir * NB + b) * 2304 + 64 * c) * 512;
        bf16x8 lrf[4];
#pragma unroll
        for (int tt = 0; tt < 4; ++tt) { lrf[tt] = (bf16x8){0, 0, 0, 0, 0, 0, 0, 0};
            if (g < 2) lrf[tt] = *(const bf16x8*)(PG + (size_t)(rowA + rstep * (16 * tt + c16)) * GIN + 3072 + 16 * dir + 8 * g); }
#pragma unroll 1
        for (int ctl = 0; ctl < 2; ++ctl) { const int col0 = 256 * hf + 16 * (2 * w + ctl);
            v4u wp = (v4u){0u, 0u, 0u, 0u};
            if (g < 2) { const float* wsrc = p.gla_gate_w2 + (size_t)(dir * 16 + 8 * g) * 512 + col0 + c16;
                wp.x = pk2(wsrc[0], wsrc[512]); wp.y = pk2(wsrc[1024], wsrc[1536]); wp.z = pk2(wsrc[2048], wsrc[2560]); wp.w = pk2(wsrc[3072], wsrc[3584]); }
            const bf16x8 wf = __builtin_bit_cast(bf16x8, wp);
            const f32x4 bias = *(const f32x4*)(p.gla_gate_b + dir * 512 + col0 + 4 * g);
            f32x4 carry = (f32x4){0.f, 0.f, 0.f, 0.f};
            v2u kk4[4], qq4[4];
#pragma unroll
            for (int tt = 0; tt < 4; ++tt) { const bf16* pr = PG + (size_t)(rowA + rstep * (16 * tt + c16)) * GIN + col0 + 4 * g;
                kk4[tt] = *(const v2u*)(pr + GQR); qq4[tt] = (v2u){0u, 0u}; if (c >= 4) qq4[tt] = *(const v2u*)pr; }
            asm volatile("" : "+v"(kk4[0]), "+v"(kk4[1]), "+v"(kk4[2]), "+v"(kk4[3]), "+v"(qq4[0]), "+v"(qq4[1]), "+v"(qq4[2]), "+v"(qq4[3]) :: "memory");
#pragma unroll
            for (int tt = 0; tt < 4; ++tt) {
                const int tok = 16 * tt + c16;
                const v2u kk = kk4[tt], qq = qq4[tt];
                const f32x4 z = mfma16(wf, lrf[tt], bias);
                f32x4 ls;
#pragma unroll
                for (int r = 0; r < 4; ++r) ls[r] = (fminf(z[r], 0.f) - flog(1.f + fexp(-fabsf(z[r])))) * (1.f / 16.f);
#pragma unroll
                for (int r = 0; r < 4; ++r) { ls[r] += dpp_shr<1>(ls[r]); ls[r] += dpp_shr<2>(ls[r]); ls[r] += dpp_shr<4>(ls[r]); ls[r] += dpp_shr<8>(ls[r]); }
                f32x4 bs = carry + ls;
#pragma unroll
                for (int r = 0; r < 4; ++r) carry[r] += __shfl(ls[r], 15, 16);
                const float k0 = __uint_as_float(kk.x << 16), k1 = __uint_as_float(kk.x & 0xffff0000u), k2 = __uint_as_float(kk.y << 16), k3 = __uint_as_float(kk.y & 0xffff0000u);
                v2u ko; ko.x = pk2(k0 * fexp(-bs[0]), k1 * fexp(-bs[1])); ko.y = pk2(k2 * fexp(-bs[2]), k3 * fexp(-bs[3]));
                *(v2u*)(KT + obase + (size_t)tok * 512 + col0 + 4 * g) = ko;
                if (c >= 4) { const float q0 = __uint_as_float(qq.x << 16), q1 = __uint_as_float(qq.x & 0xffff0000u), q2 = __uint_as_float(qq.y << 16), q3 = __uint_as_float(qq.y & 0xffff0000u);
                    v2u qo; qo.x = pk2(q0 * GLA_QS * fexp(bs[0]), q1 * GLA_QS * fexp(bs[1])); qo.y = pk2(q2 * GLA_QS * fexp(bs[2]), q3 * GLA_QS * fexp(bs[3]));
                    *(v2u*)(QT + obase + (size_t)tok * 512 + col0 + 4 * g) = qo; }
            }
            if (c16 == 15) { f32x4 dv; dv[0] = fexp(carry[0]); dv[1] = fexp(carry[1]); dv[2] = fexp(carry[2]); dv[3] = fexp(carry[3]);
                *(f32x4*)(DEC + ((size_t)(dir * NB + b) * 36 + c) * 512 + col0 + 4 * g) = dv; }
        }
    }
}
__device__ __forceinline__ void ph_glascan(const P& p, Frame& F) {
    const bf16* PG = WSP(bf16, WS_PG); const bf16* QT = WSP(bf16, WS_QT); const bf16* KT = WSP(bf16, WS_KT); const float* DEC = WSP(float, WS_DEC);
    const int lane = F.lane, w = F.wave, g = lane >> 4, c16 = lane & 15, qrow = c16 >> 2, pp = c16 & 3;
    constexpr int BUF = 49152, QOFF = 0, KOFF = 16384, VOFF = 32768, AM = 98304, DCO = 106496;
    LAS unsigned char* L = F.lds; LAS unsigned char* stg = L + DCO + 1024 + w * 2048;
    for (int u = F.vcu; u < 256; u += F.G) {
        const int dvh = u & 1, dir = (u >> 1) & 1, h = (u >> 2) & 3, b = u >> 4;
        bf16* OUT = WSP(bf16, WS_OF) + (dir ? (size_t)(WS_OB - WS_OF) / 2 : 0);
        const size_t seqbase = (size_t)(dir * NB + b) * 2304;
#define GLA_STAGE(c, bufi) do { _Pragma("unroll") for (int pc = 0; pc < 2; ++pc) { const int piece = w + 8 * pc, row = piece * 4 + g, chs = c16 ^ (row & 15); \
            const size_t srow = seqbase + 64 * (c) + row; const unsigned ldst = (bufi) * BUF + piece * 1024; \
            if ((c) >= 4) __builtin_amdgcn_global_load_lds((const unsigned*)((const char*)(QT + srow * 512 + h * 128) + chs * 16), (LAS unsigned*)(L + QOFF + ldst), 16, 0, 0); \
            __builtin_amdgcn_global_load_lds((const unsigned*)((const char*)(KT + srow * 512 + h * 128) + chs * 16), (LAS unsigned*)(L + KOFF + ldst), 16, 0, 0); \
            __builtin_amdgcn_global_load_lds((const unsigned*)((const char*)(PG + (size_t)gla_rowmap(b, dir, 64 * (c) + row) * GIN + GQR + GQK + h * 256 + dvh * 128) + chs * 16), (LAS unsigned*)(L + VOFF + ldst), 16, 0, 0); } \
            if (w == 0 && lane < 32) __builtin_amdgcn_global_load_lds((const unsigned*)((const char*)(DEC + ((size_t)(dir * NB + b) * 36 + (c)) * 512 + h * 128) + lane * 16), (LAS unsigned*)(L + DCO + (bufi) * 512), 16, 0, 0); } while (0)
        f32x4 S[8];
#pragma unroll
        for (int t = 0; t < 8; ++t) S[t] = (f32x4){0.f, 0.f, 0.f, 0.f};
        GLA_STAGE(0, 0);
        asm volatile("s_waitcnt vmcnt(0)" ::: "memory"); __builtin_amdgcn_s_barrier(); asm volatile("" ::: "memory");
#pragma clang loop unroll(disable)
        for (int c = 0; c < 36; ++c) {
            const int bi = c & 1; LAS unsigned char* Qs = L + bi * BUF + QOFF; LAS unsigned char* Ksm = L + bi * BUF + KOFF; LAS unsigned char* Vsm = L + bi * BUF + VOFF; LAS unsigned char* Am = L + AM;
            if (c + 1 < 36) GLA_STAGE(c + 1, bi ^ 1);
            if (c >= 4) {
#pragma unroll
                for (int q2 = 0; q2 < 2; ++q2) { const int id = 2 * w + q2, ti = id >> 2, tj = id & 3; f32x4 a = (f32x4){0.f, 0.f, 0.f, 0.f};
                    if (tj <= ti) {
#pragma unroll
                        for (int ks = 0; ks < 4; ++ks) { const int co = ((4 * ks + g) ^ c16) * 16;
                            const bf16x8 qa = *(const LAS bf16x8*)(Qs + (16 * ti + c16) * 256 + co), kb = *(const LAS bf16x8*)(Ksm + (16 * tj + c16) * 256 + co);
                            a = mfma16(qa, kb, a); }
                        asm volatile("s_nop 7\n\ts_nop 7" : "+v"(a));
                        if (tj == ti) {
#pragma unroll
                            for (int r = 0; r < 4; ++r) a[r] = c16 > 4 * g + r ? 0.f : a[r]; } }
#pragma unroll
                    for (int r = 0; r < 4; ++r) { const int i = 16 * ti + 4 * g + r; *(LAS bf16*)(Am + i * 128 + (((2 * tj + (c16 >> 3)) ^ (i & 7)) * 16) + (c16 & 7) * 2) = (bf16)f2bf(a[r]); } }
            }
            asm volatile("s_waitcnt lgkmcnt(0)" ::: "memory"); __builtin_amdgcn_s_barrier(); asm volatile("" ::: "memory");
            bf16x8 vf[2];
            { s16x4 t0, t1, t2, t3; const int ch = 2 * w + (pp >> 1), bo = (pp & 1) * 8, rl = 8 * g + qrow;
              TR_RD(t0, Vsm + rl * 256 + ((ch ^ (rl & 15)) * 16) + bo); TR_RD(t1, Vsm + (rl + 4) * 256 + ((ch ^ ((rl + 4) & 15)) * 16) + bo);
              TR_RD(t2, Vsm + (rl + 32) * 256 + ((ch ^ (rl & 15)) * 16) + bo); TR_RD(t3, Vsm + (rl + 36) * 256 + ((ch ^ ((rl + 4) & 15)) * 16) + bo);
              TR_WAIT4(t0, t1, t2, t3);
              vf[0] = (bf16x8){t0[0], t0[1], t0[2], t0[3], t1[0], t1[1], t1[2], t1[3]}; vf[1] = (bf16x8){t2[0], t2[1], t2[2], t2[3], t3[0], t3[1], t3[2], t3[3]}; }
            if (c >= 4) {
                bf16x8 sf[4];
#pragma unroll
                for (int ks = 0; ks < 4; ++ks) { v4u t4; t4.x = pk2(S[2 * ks][0], S[2 * ks][1]); t4.y = pk2(S[2 * ks][2], S[2 * ks][3]); t4.z = pk2(S[2 * ks + 1][0], S[2 * ks + 1][1]); t4.w = pk2(S[2 * ks + 1][2], S[2 * ks + 1][3]); sf[ks] = __builtin_bit_cast(bf16x8, t4); }
#pragma unroll
                for (int tt = 0; tt < 4; ++tt) { f32x4 o = (f32x4){0.f, 0.f, 0.f, 0.f}; const int row = 16 * tt + c16;
#pragma unroll
                    for (int ks = 0; ks < 4; ++ks) { const int ch0 = 4 * ks + (g >> 1), bo = (g & 1) * 8;
                        const s16x4 alo = *(const LAS s16x4*)(Qs + row * 256 + ((ch0 ^ c16) * 16) + bo), ahi = *(const LAS s16x4*)(Qs + row * 256 + (((ch0 + 2) ^ c16) * 16) + bo);
                        o = mfma16((bf16x8){alo[0], alo[1], alo[2], alo[3], ahi[0], ahi[1], ahi[2], ahi[3]}, sf[ks], o); }
#pragma unroll
                    for (int ks2 = 0; ks2 < 2; ++ks2) { const bf16x8 am = *(const LAS bf16x8*)(Am + row * 128 + (((4 * ks2 + g) ^ (row & 7)) * 16)); o = mfma16(am, vf[ks2], o); }
#pragma unroll
                    for (int r = 0; r < 4; ++r) *(LAS bf16*)(stg + (16 * tt + 4 * g + r) * 32 + c16 * 2) = (bf16)f2bf(o[r]); }
#pragma unroll
                for (int pc = 0; pc < 2; ++pc) { const int pi = lane + 64 * pc, tok = pi >> 1; const v4u ov = *(const LAS v4u*)(stg + pi * 16);
                    *(v4u*)(OUT + (size_t)gla_rowmap(b, dir, 64 * c + tok) * GV + h * 256 + dvh * 128 + 16 * w + (pi & 1) * 8) = ov; }
            }
#pragma unroll
            for (int t = 0; t < 8; ++t) { f32x4 acc = S[t];
                { s16x4 t0, t1, t2, t3; const int ch = 2 * t + (pp >> 1), bo = (pp & 1) * 8, rl = 8 * g + qrow;
                  TR_RD(t0, Ksm + rl * 256 + ((ch ^ (rl & 15)) * 16) + bo); TR_RD(t1, Ksm + (rl + 4) * 256 + ((ch ^ ((rl + 4) & 15)) * 16) + bo);
                  TR_RD(t2, Ksm + (rl + 32) * 256 + ((ch ^ (rl & 15)) * 16) + bo); TR_RD(t3, Ksm + (rl + 36) * 256 + ((ch ^ ((rl + 4) & 15)) * 16) + bo);
                  TR_WAIT4(t0, t1, t2, t3);
                  acc = mfma16((bf16x8){t0[0], t0[1], t0[2], t0[3], t1[0], t1[1], t1[2], t1[3]}, vf[0], acc);
                  acc = mfma16((bf16x8){t2[0], t2[1], t2[2], t2[3], t3[0], t3[1], t3[2], t3[3]}, vf[1], acc); }
                const f32x4 d4 = *(const LAS f32x4*)(L + DCO + bi * 512 + (16 * t + 4 * g) * 4);
                S[t] = acc * d4; }
            if (c >= 4) asm volatile("s_waitcnt vmcnt(2) lgkmcnt(0)" ::: "memory"); else asm volatile("s_waitcnt vmcnt(0) lgkmcnt(0)" ::: "memory");
            __builtin_amdgcn_s_barrier(); asm volatile("" ::: "memory");
        }
#undef GLA_STAGE
    }
}
__device__ __forceinline__ void ph_scan_naive(const P& p, Frame& F) {
    const bf16* PG = WSP(bf16, WS_PG);
    LAS float* sq = (LAS float*)F.lds; LAS float* sk = sq + 128; LAS float* sa = sk + 128; LAS float* sv = sa + 128; LAS float* so = sv + 64;
    const int tid = F.tid, e = tid & 63, w = tid >> 6;
    for (int u = F.vcu; u < 512; u += F.G) {
        const int sl = u & 3, dir = (u >> 2) & 1, h = (u >> 3) & 3, b = u >> 5;
        float S[16];
#pragma unroll
        for (int i = 0; i < 16; ++i) S[i] = 0.f;
        bf16* OUT = WSP(bf16, WS_OF) + (dir ? (size_t)(WS_OB - WS_OF) / 2 : 0);
        for (int step = 0; step < CTX + SEQ; ++step) {
            int row; if (step < CTX) row = NL + b * CTX + (dir ? CTX - 1 - step : step); else { const int t = step - CTX; row = b * SEQ + (dir ? SEQ - 1 - t : t); }
            const bf16* pr = PG + (size_t)row * GIN;
            if (tid < 128) { const int col = h * 128 + tid; float z = p.gla_gate_b[dir * 512 + col];
#pragma unroll
                for (int r = 0; r < 16; ++r) z += bf2f(pr[3072 + dir * 16 + r]) * p.gla_gate_w2[(size_t)(dir * 16 + r) * 512 + col];
                const float ls = fminf(z, 0.f) - log1pf(expf(-fabsf(z)));
                sq[tid] = bf2f(pr[col]) * GLA_QS; sk[tid] = bf2f(pr[GQR + col]); sa[tid] = expf(ls * (1.f / 16.f)); }
            else if (tid < 192) sv[tid - 128] = bf2f(pr[GQR + GQK + h * 256 + sl * 64 + tid - 128]);
            __syncthreads();
            const float v = sv[e]; float o = 0.f;
#pragma unroll
            for (int i = 0; i < 16; ++i) { const int d = 16 * w + i; S[i] = sa[d] * S[i] + sk[d] * v; o += sq[d] * S[i]; }
            so[w * 64 + e] = o;
            __syncthreads();
            if (step >= CTX && tid < 64) { float s = 0.f;
#pragma unroll
                for (int q = 0; q < 8; ++q) s += so[q * 64 + tid];
                OUT[(size_t)row * GV + h * 256 + sl * 64 + tid] = (bf16)f2bf(s); }
        }
        __syncthreads();
    }
}

enum Phase { PH_PRO = 0, PH_NORM1_0, PH_QKV, PH_ATTN, PH_OUT0, PH_N2R0, PH_TOPK0, PH_UP0, PH_DN0, PH_COMB0, PH_GLAIN, PH_PREP, PH_SCAN, PH_READ, PH_OUT1, PH_N2R1, PH_TOPK1, PH_UP1, PH_DN1, PH_COMB1, PH_END };

__global__ void __launch_bounds__(NWAVES * 64, 2) k_fwd(P p) {
    extern __shared__ __attribute__((aligned(16))) unsigned char lds[];
    Frame F;
    F.lds = (LAS unsigned char*)lds;
    F.tid = threadIdx.x; F.lane = F.tid & 63; F.wave = __builtin_amdgcn_readfirstlane(F.tid >> 6);
    F.G = gridDim.x; { const int bx = blockIdx.x; F.vcu = (F.G % 8 == 0) ? (bx % 8) * (F.G / 8) + bx / 8 : bx; }
    F.ws = p.ws;
    volatile LAS unsigned* MISC = (volatile LAS unsigned*)(F.lds + MISC_OFF);
    for (int u = F.tid; u < (LDS_BYTES - LDSCTL_OFF) / 4; u += NWAVES * 64) ((LAS unsigned*)(F.lds + LDSCTL_OFF))[u] = 0u;
    __syncthreads();
    const int lo = p.lo, hi = p.hi;
    XcdBarrier bar; bar.bar = (unsigned*)(F.ws + WS_CTL) + CW_BAR; bar.x = 0; bar.st = nullptr;
    if (hi - lo > 1) bar = xcd_barrier_post((unsigned*)(F.ws + WS_CTL) + CW_BAR, MISC + 8);
#define IN(k) (lo <= (k) && (k) < hi)
#define SEAM(k) do { if (IN(k) && IN((k) + 1)) xcd_barrier(bar, F.tid == 0); } while (0)
#define PHASE(k, ...) do { if (IN(k)) { F.lane = (int)__builtin_amdgcn_mbcnt_hi(~0u, __builtin_amdgcn_mbcnt_lo(~0u, 0u)); F.tid = F.wave * 64 + F.lane; __VA_ARGS__; if ((PROBE_MASK >> (k)) & 1) { xcd_barrier(bar, F.tid == 0); __VA_ARGS__; } } SEAM(k); } while (0)
    PHASE(PH_PRO, ph_pro(p, F, (OPT_MASK & 0xff) != 0));
    PHASE(PH_NORM1_0, ph_norm1(p, F, 0));
    PHASE(PH_QKV, {
        pg8::Gemm g{WSP(bf16, WS_H), WSP(bf16, WS_WQKV), D * 2, nullptr}; pg8::TileOrder S; S.init(1, NT / 256, ATT_N / 256, NT / 256, F.G, (int)blockIdx.x);
        pg8::EpiQKV E{WSP(bf16, WS_Q), WSP(bf16, WS_K), WSP(bf16, WS_V), WSP(float, WS_ROPE)};
        pg8::gemm_phase<pg8::EpiQKV, pg8::TileOrder>(F.lds, g, S, E, F.tid);
        BG_SLOT(96, CVT_SPLIT0, CVT_Q1); });
    PHASE(PH_ATTN, { if (OPT_MASK & 256) ph_attn(p, F); else ph_attn_naive(p, F); });
    PHASE(PH_OUT0, {
        pg8::Gemm g{WSP(bf16, WS_O), WSP(bf16, WS_WO0), D * 2, nullptr}; pg8::TileOrder S; S.init(1, NT / 256, D / 256, NT / 256, F.G, (int)blockIdx.x);
        pg8::EpiResid E{p.x, p.ctx, WSP(float, WS_XA), WSP(float, WS_MOD) + 2048};
        pg8::gemm_phase<pg8::EpiResid, pg8::TileOrder>(F.lds, g, S, E, F.tid);
        BG_SLOT(64, CVT_Q1, CVT_Q2); });
    PHASE(PH_N2R0, ph_norm2r(p, F, 0));
    PHASE(PH_TOPK0, ph_topkg(p, F, 0));
    PHASE(PH_UP0, {
        pg8::Gemm g{MOE_FP8 ? (const void*)WSP(unsigned char, WS_H8) : (const void*)WSP(bf16, WS_H), WSP(unsigned char, WS_WUP), D * EB, WSP(int, WS_ROWIDX)}; pg8::TileOrder S; S.init(NE, ESLOTS / 256, FF / 128, ESLOTS / 256, F.G, (int)blockIdx.x);
        pg8::EpiSwiglu E{WSP(unsigned char, WS_ACT)};
        pg8::gemm_phase<pg8::EpiSwiglu, pg8::TileOrder, MOE_FP8 != 0, true, true>(F.lds, g, S, E, F.tid);
        BG_SLOT(192, CVT_Q2, CVT_Q3); });
    PHASE(PH_DN0, {
        pg8::Gemm g{WSP(unsigned char, WS_ACT), WSP(unsigned char, WS_WDN), FF * EB, nullptr}; pg8::TileOrder S; S.init(NE, ESLOTS / 256, D / 256, ESLOTS / 256, F.G, (int)blockIdx.x);
        pg8::EpiDown E{WSP(bf16, WS_YS), WSP(float, WS_ROWG)};
        pg8::gemm_phase<pg8::EpiDown, pg8::TileOrder, MOE_FP8 != 0>(F.lds, g, S, E, F.tid);
        BG_SLOT(128, CVT_Q3, NPAIR_ALL); });
    PHASE(PH_COMB0, ph_combine(p, F, 0));
    PHASE(PH_GLAIN, {
        pg8::Gemm g{WSP(bf16, WS_H), WSP(bf16, WS_WGIN), D * 2, nullptr}; pg8::GlaInOrder S{F.G, (int)blockIdx.x};
        pg8::EpiGlaIn E{WSP(bf16, WS_PG)};
        pg8::gemm_phase<pg8::EpiGlaIn, pg8::GlaInOrder>(F.lds, g, S, E, F.tid); });
    PHASE(PH_PREP, { if (OPT_MASK & 512) ph_glaprep(p, F); });
    PHASE(PH_SCAN, { if (OPT_MASK & 512) ph_glascan(p, F); else ph_scan_naive(p, F); });
    PHASE(PH_READ, ph_readout(p, F));
    PHASE(PH_OUT1, {
        pg8::Gemm g{WSP(bf16, WS_H), WSP(bf16, WS_WO1), D * 2, nullptr}; pg8::TileOrder S; S.init(1, NL / 256, D / 256, NL / 256, F.G, (int)blockIdx.x);
        pg8::EpiResid E{WSP(float, WS_XA), WSP(float, WS_XA), WSP(float, WS_XA), WSP(float, WS_MOD) + 17 * 6144 + 2048};
        pg8::gemm_phase<pg8::EpiResid, pg8::TileOrder>(F.lds, g, S, E, F.tid); });
    PHASE(PH_N2R1, ph_norm2r(p, F, 1));
    PHASE(PH_TOPK1, ph_topkg(p, F, 1));
    PHASE(PH_UP1, {
        pg8::Gemm g{MOE_FP8 ? (const void*)WSP(unsigned char, WS_H8) : (const void*)WSP(bf16, WS_H), WSP(unsigned char, WS_WUP) + (size_t)NE * 5632 * D * EB, D * EB, WSP(int, WS_ROWIDX)}; pg8::TileOrder S; S.init(NE, NB * CAPL / 256, FF / 128, ESLOTS / 256, F.G, (int)blockIdx.x);
        pg8::EpiSwiglu E{WSP(unsigned char, WS_ACT)};
        pg8::gemm_phase<pg8::EpiSwiglu, pg8::TileOrder, MOE_FP8 != 0, true, true>(F.lds, g, S, E, F.tid); });
    PHASE(PH_DN1, {
        pg8::Gemm g{WSP(unsigned char, WS_ACT), WSP(unsigned char, WS_WDN) + (size_t)NE * D * FF * EB, FF * EB, nullptr}; pg8::TileOrder S; S.init(NE, NB * CAPL / 256, D / 256, ESLOTS / 256, F.G, (int)blockIdx.x);
        pg8::EpiDown E{WSP(bf16, WS_YS), WSP(float, WS_ROWG)};
        pg8::gemm_phase<pg8::EpiDown, pg8::TileOrder, MOE_FP8 != 0>(F.lds, g, S, E, F.tid); });
    PHASE(PH_COMB1, ph_combine(p, F, 1));
#undef PHASE
#undef IN
#undef SEAM
}

__global__ void __launch_bounds__(256) n_gemm(const bf16* A, int lda, const float* W, int ldw, float* C, int ldc, int M, int N, int K) {
    __shared__ float As[16][65], Bs[16][64];
    const int t = threadIdx.x, tx = t & 15, ty = t >> 4, m0 = blockIdx.y * 64, n0 = blockIdx.x * 64;
    float acc[4][4];
#pragma unroll
    for (int i = 0; i < 4; ++i)
#pragma unroll
        for (int j = 0; j < 4; ++j) acc[i][j] = 0.f;
    for (int k0 = 0; k0 < K; k0 += 16) {
        { const int r = t >> 2, kq = (t & 3) * 4; const v2u w = *(const v2u*)(A + (size_t)(m0 + r) * lda + k0 + kq);
          As[kq + 0][r] = __uint_as_float(w.x << 16); As[kq + 1][r] = __uint_as_float(w.x & 0xffff0000u); As[kq + 2][r] = __uint_as_float(w.y << 16); As[kq + 3][r] = __uint_as_float(w.y & 0xffff0000u); }
        { const int k = t >> 4, n = (t & 15) * 4;
#pragma unroll
          for (int j = 0; j < 4; ++j) Bs[k][n + j] = (n0 + n + j < N) ? W[(size_t)(k0 + k) * ldw + n0 + n + j] : 0.f; }
        __syncthreads();
#pragma unroll
        for (int kk = 0; kk < 16; ++kk) { float a[4], b[4];
#pragma unroll
            for (int i = 0; i < 4; ++i) { a[i] = As[kk][ty * 4 + i]; b[i] = Bs[kk][tx * 4 + i]; }
#pragma unroll
            for (int i = 0; i < 4; ++i)
#pragma unroll
                for (int j = 0; j < 4; ++j) acc[i][j] += a[i] * b[j]; }
        __syncthreads();
    }
#pragma unroll
    for (int i = 0; i < 4; ++i)
#pragma unroll
        for (int j = 0; j < 4; ++j) if (n0 + tx * 4 + j < N) C[(size_t)(m0 + ty * 4 + i) * ldc + n0 + tx * 4 + j] = acc[i][j];
}
__global__ void n_post_qkv(const float* T, int r0, int rows, bf16* Q, bf16* Kb, bf16* Vb) {
    const size_t i = (size_t)blockIdx.x * blockDim.x + threadIdx.x; if (i >= (size_t)rows * ATT_N) return;
    const int rl = (int)(i / ATT_N), c = (int)(i % ATT_N), r = r0 + rl; float val = T[i];
    if (c < 1280 && r < NL) { const int d = c & 63, a = d >> 5, s = (d >> 4) & 1, f = d & 15, t = r & (SEQ - 1); const float xp = T[(size_t)rl * ATT_N + (s ? c - 16 : c + 16)];
        const float inv = powf(10000.f, -(float)f / 16.f), ang = (float)(a ? (t & 63) : (t >> 6)) * inv, cs = cosf(ang), sn = sinf(ang);
        val = s == 0 ? val * cs - xp * sn : val * cs + xp * sn; }
    if (c < 1024) Q[(size_t)r * 1024 + c] = (bf16)f2bf(val * QSCALE); else if (c < 1280) Kb[(size_t)r * 256 + c - 1024] = (bf16)f2bf(val); else Vb[(size_t)r * 256 + c - 1280] = (bf16)f2bf(val);
}
__global__ void n_post_resid(const float* T, int r0, int rows, const float* xlat, const float* xctx, float* XA, const float* mod_g) {
    const size_t i = (size_t)blockIdx.x * blockDim.x + threadIdx.x; if (i >= (size_t)rows * D) return;
    const int rl = (int)(i / D), c = (int)(i % D), r = r0 + rl; const int j = r < NL ? r / SEQ : 16;
    const float xs = r < NL ? xlat[(size_t)r * D + c] : xctx[(size_t)(r - NL) * D + c];
    XA[(size_t)r * D + c] = xs + mod_g[(size_t)j * 6144 + c] * T[i];
}
__global__ void n_post_swiglu(const float* T, int rows, bf16* ACTrow0) {
    const size_t i = (size_t)blockIdx.x * blockDim.x + threadIdx.x; if (i >= (size_t)rows * FF) return;
    const int rl = (int)(i / FF), f = (int)(i % FF); const float g = T[(size_t)rl * 5632 + f], u = T[(size_t)rl * 5632 + FF + f];
    ACTrow0[(size_t)rl * FF + f] = (bf16)f2bf(silu_f(g) * u);
}
__global__ void n_post_down(const float* T, int rows, bf16* YSrow0, const float* rowg0) {
    const size_t i = (size_t)blockIdx.x * blockDim.x + threadIdx.x; if (i >= (size_t)rows * D) return;
    const int rl = (int)(i / D); YSrow0[i] = (bf16)f2bf(rowg0[rl] * T[i]);
}
__global__ void n_post_cast(const float* T, size_t n, bf16* O) { const size_t i = (size_t)blockIdx.x * blockDim.x + threadIdx.x; if (i < n) O[i] = (bf16)f2bf(T[i]); }
__global__ void __launch_bounds__(256) n_attn(const bf16* Q, const bf16* Kb, const bf16* Vb, const float* sink, bf16* O) {
    const int i = blockIdx.x * blockDim.x + threadIdx.x; if (i >= NT * NQH) return;
    const int r = i >> 4, hq = i & 15, hk = hq >> 2;
    float q[64], acc[64];
#pragma unroll
    for (int d = 0; d < 64; ++d) { q[d] = bf2f(Q[(size_t)r * 1024 + hq * 64 + d]); acc[d] = 0.f; }
    float m = sink[hq] * LOG2E, l = 1.f;
    const bool lat = r < NL; const int b = lat ? r / SEQ : (r - NL) / CTX, t = r & (SEQ - 1);
    const int nlat = lat ? (min(SEQ - 1, t + 128) - max(0, t - 128) + 1) : 0, klo = max(0, t - 128);
    for (int kk = 0; kk < CTX + nlat; ++kk) {
        const int kr = kk < CTX ? NL + b * CTX + kk : b * SEQ + klo + (kk - CTX);
        const bf16* kp = Kb + (size_t)kr * 256 + hk * 64; const bf16* vp = Vb + (size_t)kr * 256 + hk * 64;
        float s = 0.f;
#pragma unroll
        for (int d = 0; d < 64; ++d) s += q[d] * bf2f(kp[d]);
        const float mn = fmaxf(m, s), sc = exp2f(m - mn), pe = exp2f(s - mn);
        l = l * sc + pe; m = mn;
#pragma unroll
        for (int d = 0; d < 64; ++d) acc[d] = acc[d] * sc + pe * bf2f(vp[d]);
    }
    const float il = 1.f / l;
#pragma unroll
    for (int d = 0; d < 64; ++d) O[(size_t)r * 1024 + hq * 64 + d] = (bf16)f2bf(acc[d] * il);
}
__global__ void __launch_bounds__(512) n_glascan(const bf16* PG, const float* w2, const float* gb, bf16* OF, bf16* OB) {
    const int u = blockIdx.x, sl = u & 3, dir = (u >> 2) & 1, h = (u >> 3) & 3, b = u >> 5;
    __shared__ float sq[128], sk[128], sa[128], sv[64], so[8][64];
    const int tid = threadIdx.x, e = tid & 63, w = tid >> 6;
    float S[16];
#pragma unroll
    for (int i = 0; i < 16; ++i) S[i] = 0.f;
    bf16* OUT = dir ? OB : OF;
    for (int step = 0; step < CTX + SEQ; ++step) {
        int row; if (step < CTX) row = NL + b * CTX + (dir ? CTX - 1 - step : step); else { const int t = step - CTX; row = b * SEQ + (dir ? SEQ - 1 - t : t); }
        const bf16* pr = PG + (size_t)row * GIN;
        if (tid < 128) { const int col = h * 128 + tid; float z = gb[dir * 512 + col];
#pragma unroll
            for (int r = 0; r < 16; ++r) z += bf2f(pr[3072 + dir * 16 + r]) * w2[(size_t)(dir * 16 + r) * 512 + col];
            const float ls = fminf(z, 0.f) - log1pf(expf(-fabsf(z)));
            sq[tid] = bf2f(pr[col]) * GLA_QS; sk[tid] = bf2f(pr[GQR + col]); sa[tid] = expf(ls * (1.f / 16.f)); }
        else if (tid < 192) sv[tid - 128] = bf2f(pr[GQR + GQK + h * 256 + sl * 64 + tid - 128]);
        __syncthreads();
        const float v = sv[e]; float o = 0.f;
#pragma unroll
        for (int i = 0; i < 16; ++i) { const int d = 16 * w + i; S[i] = sa[d] * S[i] + sk[d] * v; o += sq[d] * S[i]; }
        so[w][e] = o;
        __syncthreads();
        if (step >= CTX && tid < 64) { float s = 0.f;
#pragma unroll
            for (int q = 0; q < 8; ++q) s += so[q][tid];
            OUT[(size_t)row * GV + h * 256 + sl * 64 + tid] = (bf16)f2bf(s); }
    }
}

static void launch_phase(P p, int lo, int hi, int grid, hipStream_t stream) { p.lo = lo; p.hi = hi; hipLaunchKernelGGL(k_fwd, dim3(grid), dim3(NWAVES * 64), LDS_BYTES, stream, p); }
static void naive_gemm(const bf16* A, int lda, const float* W, int ldw, float* C, int ldc, int M, int N, int K, hipStream_t s) {
    hipLaunchKernelGGL(n_gemm, dim3((N + 63) / 64, M / 64), dim3(256), 0, s, A, lda, W, ldw, C, ldc, M, N, K);
}
#define EW_GRID(n) dim3((unsigned)(((size_t)(n) + 255) / 256)), dim3(256), 0, stream

extern "C" void kernel_launch(void* const* d_in, const int* in_sizes, int n_in, void* d_out, int out_size, void* d_ws, size_t ws_size, hipStream_t stream) {
    static int grid = 0;
    if (grid == 0) {
        if (n_in != 21 || out_size != NL * D || ws_size < WS_END) { fprintf(stderr, "kernel_launch: unexpected shapes (n_in %d out %d ws %zu need %zu)\n", n_in, out_size, ws_size, (size_t)WS_END); grid = -1; return; }
        int dev = 0, cus = 0;
        if (hipGetDevice(&dev) != hipSuccess || hipDeviceGetAttribute(&cus, hipDeviceAttributeMultiprocessorCount, dev) != hipSuccess) { grid = -1; return; }
        if (hipFuncSetAttribute((const void*)k_fwd, hipFuncAttributeMaxDynamicSharedMemorySize, LDS_BYTES) != hipSuccess) { fprintf(stderr, "kernel_launch: hipFuncSetAttribute failed\n"); grid = -1; return; }
        int per_cu = 0;
        if (hipOccupancyMaxActiveBlocksPerMultiprocessor(&per_cu, (const void*)k_fwd, NWAVES * 64, LDS_BYTES) != hipSuccess || per_cu < 1) fprintf(stderr, "kernel_launch: occupancy query says %d\n", per_cu);
        (void)hipGetLastError();
        grid = cus;
    }
    if (grid < 0) return;
    hipMemsetAsync((char*)d_ws + WS_CTL, 0, CTL_ZERO_BYTES, stream);
    P p{};
    const float** pp = (const float**)&p;
    for (int i = 0; i < 21; ++i) pp[i] = (const float*)d_in[i];
    p.out = (float*)d_out; p.ws = (unsigned char*)d_ws; p.lo = 0; p.hi = 0;
    unsigned char* ws = (unsigned char*)d_ws;
#define WS(T, off) ((T*)(ws + (off)))
#if ONE_LAUNCH
    launch_phase(p, 0, PH_END, grid, stream);
#else
    float* TMP = WS(float, WS_TMP);
    launch_phase(p, PH_PRO, PH_PRO + 1, grid, stream);
    launch_phase(p, PH_NORM1_0, PH_NORM1_0 + 1, grid, stream);
    if (OPT_MASK & 1) launch_phase(p, PH_QKV, PH_QKV + 1, grid, stream);
    else for (int ch = 0; ch < NT / 2048; ++ch) { const int r0 = ch * 2048;
        naive_gemm(WS(bf16, WS_H) + (size_t)r0 * D, D, p.attn_w_in, ATT_N, TMP, ATT_N, 2048, ATT_N, D, stream);
        hipLaunchKernelGGL(n_post_qkv, EW_GRID((size_t)2048 * ATT_N), TMP, r0, 2048, WS(bf16, WS_Q), WS(bf16, WS_K), WS(bf16, WS_V)); }
    if (OPT_MASK & 256) launch_phase(p, PH_ATTN, PH_ATTN + 1, grid, stream);
    else hipLaunchKernelGGL(n_attn, dim3(NT * NQH / 256), dim3(256), 0, stream, WS(bf16, WS_Q), WS(bf16, WS_K), WS(bf16, WS_V), p.attn_sink, WS(bf16, WS_O));
    if (OPT_MASK & 2) launch_phase(p, PH_OUT0, PH_OUT0 + 1, grid, stream);
    else for (int ch = 0; ch < NT / 2048; ++ch) { const int r0 = ch * 2048;
        naive_gemm(WS(bf16, WS_O) + (size_t)r0 * D, D, p.attn_w_out, D, TMP, D, 2048, D, D, stream);
        hipLaunchKernelGGL(n_post_resid, EW_GRID((size_t)2048 * D), TMP, r0, 2048, p.x, p.ctx, WS(float, WS_XA), WS(float, WS_MOD) + 2048); }
    launch_phase(p, PH_N2R0, PH_N2R0 + 1, grid, stream);
    launch_phase(p, PH_TOPK0, PH_TOPK0 + 1, grid, stream);
    for (int l = 0; l < 2; ++l) {
        if (l == 1) {
            if (OPT_MASK & 16) launch_phase(p, PH_GLAIN, PH_GLAIN + 1, grid, stream);
            else for (int ch = 0; ch < NT / 2048; ++ch) { const int r0 = ch * 2048;
                naive_gemm(WS(bf16, WS_H) + (size_t)r0 * D, D, p.gla_w_in, GIN, TMP, GIN, 2048, GIN, D, stream);
                hipLaunchKernelGGL(n_post_cast, EW_GRID((size_t)2048 * GIN), TMP, (size_t)2048 * GIN, WS(bf16, WS_PG) + (size_t)r0 * GIN); }
            if (OPT_MASK & 512) launch_phase(p, PH_SCAN, PH_SCAN + 1, grid, stream);
            else hipLaunchKernelGGL(n_glascan, dim3(512), dim3(512), 0, stream, WS(bf16, WS_PG), p.gla_gate_w2, p.gla_gate_b, WS(bf16, WS_OF), WS(bf16, WS_OB));
            launch_phase(p, PH_READ, PH_READ + 1, grid, stream);
            if (OPT_MASK & 32) launch_phase(p, PH_OUT1, PH_OUT1 + 1, grid, stream);
            else for (int ch = 0; ch < NL / 2048; ++ch) { const int r0 = ch * 2048;
                naive_gemm(WS(bf16, WS_H) + (size_t)r0 * D, D, p.gla_w_out, D, TMP, D, 2048, D, D, stream);
                hipLaunchKernelGGL(n_post_resid, EW_GRID((size_t)2048 * D), TMP, r0, 2048, WS(float, WS_XA), WS(float, WS_XA), WS(float, WS_XA), WS(float, WS_MOD) + 17 * 6144 + 2048); }
            launch_phase(p, PH_N2R1, PH_N2R1 + 1, grid, stream);
            launch_phase(p, PH_TOPK1, PH_TOPK1 + 1, grid, stream);
        }
        const int rows_e = l == 0 ? ESLOTS : NB * CAPL, chunk = l == 0 ? 2304 : 2048;
        const bool up_opt = OPT_MASK & (l == 0 ? 4 : 64), dn_opt = OPT_MASK & (l == 0 ? 8 : 128);
        if (up_opt && dn_opt) { launch_phase(p, l == 0 ? PH_UP0 : PH_UP1, (l == 0 ? PH_UP0 : PH_UP1) + 1, grid, stream); launch_phase(p, l == 0 ? PH_DN0 : PH_DN1, (l == 0 ? PH_DN0 : PH_DN1) + 1, grid, stream); }
        else {
            if (up_opt) launch_phase(p, l == 0 ? PH_UP0 : PH_UP1, (l == 0 ? PH_UP0 : PH_UP1) + 1, grid, stream);
            else for (int e = 0; e < NE; ++e) for (int r0 = 0; r0 < rows_e; r0 += chunk) {
                const size_t row = (size_t)e * ESLOTS + r0; const size_t le = (size_t)(l * NE + e);
                naive_gemm(WS(bf16, WS_XG) + row * D, D, p.exp_w_gate + le * D * FF, FF, TMP, 5632, chunk, FF, D, stream);
                naive_gemm(WS(bf16, WS_XG) + row * D, D, p.exp_w_up + le * D * FF, FF, TMP + FF, 5632, chunk, FF, D, stream);
                hipLaunchKernelGGL(n_post_swiglu, EW_GRID((size_t)chunk * FF), TMP, chunk, WS(bf16, WS_ACT) + row * FF); }
            if (dn_opt) launch_phase(p, l == 0 ? PH_DN0 : PH_DN1, (l == 0 ? PH_DN0 : PH_DN1) + 1, grid, stream);
            else for (int e = 0; e < NE; ++e) for (int r0 = 0; r0 < rows_e; r0 += chunk) {
                const size_t row = (size_t)e * ESLOTS + r0; const size_t le = (size_t)(l * NE + e);
                naive_gemm(WS(bf16, WS_ACT) + row * FF, FF, p.exp_w_down + le * FF * D, D, TMP, D, chunk, D, FF, stream);
                hipLaunchKernelGGL(n_post_down, EW_GRID((size_t)chunk * D), TMP, chunk, WS(bf16, WS_YS) + row * D, WS(float, WS_ROWG) + row); }
        }
        launch_phase(p, l == 0 ? PH_COMB0 : PH_COMB1, (l == 0 ? PH_COMB0 : PH_COMB1) + 1, grid, stream);
    }
#endif
}
```

```cpp
#include <hip/hip_runtime.h>
#include <cstdio>
#include <cstdint>

#ifndef OPT_MASK
#define OPT_MASK 0x3FF
#endif
#ifndef MOE_FP8
#define MOE_FP8 1
#endif
#ifndef PROBE_MASK
#define PROBE_MASK 0
#endif
#ifndef ONE_LAUNCH
#define ONE_LAUNCH 1
#endif

#define GAS __attribute__((address_space(1)))
#define LAS __attribute__((address_space(3)))
typedef unsigned short bf16;
typedef unsigned v4u __attribute__((ext_vector_type(4)));
typedef unsigned v2u __attribute__((ext_vector_type(2)));
typedef float f32x4 __attribute__((ext_vector_type(4)));
typedef float f32x2 __attribute__((ext_vector_type(2)));
typedef short bf16x8 __attribute__((ext_vector_type(8)));

constexpr int D = 1024, NB = 16, SEQ = 2048, CTX = 256;
constexpr int NL = NB * SEQ, NC = NB * CTX, NT = NL + NC;
constexpr int NQH = 16, NKV = 4, HD = 64, ATT_N = 1536;
constexpr int GH = 4, GDK = 128, GDV = 256, GQK = 512, GV = 1024, GQR = 1536, GIN = 3104, GIN_PAD = 3328;
constexpr int NE = 16, FF = 2816, CAPL = 256, CAPC = 32, ESLOTS = NB * CAPL + NB * CAPC;
constexpr float EPS = 1e-6f;
constexpr float LOG2E = 1.4426950408889634f;
constexpr float QSCALE = 0.125f * LOG2E;
constexpr float GLA_QS = 0.08838834764831845f;
constexpr int EB = MOE_FP8 ? 1 : 2;
constexpr float F8_ACT = 16.f, F8_W = 256.f, F8_INV = 1.f / (16.f * 256.f);

constexpr size_t MiB = 1ull << 20;
constexpr size_t WS_CTL = 0, CTL_ZERO_BYTES = 1 * MiB;
constexpr size_t WS_MOD = 1 * MiB;
constexpr size_t WS_ROPE = WS_MOD + 896 * 1024;
constexpr size_t WS_WQKV = 2 * MiB;
constexpr size_t WS_WO0 = 5 * MiB;
constexpr size_t WS_WGIN = 7 * MiB;
constexpr size_t WS_WO1 = 14 * MiB;
constexpr size_t WS_AFF = 16 * MiB;
constexpr size_t WS_SLOT = 19 * MiB;
constexpr size_t WS_ROWIDX = 22 * MiB;
constexpr size_t WS_ROWG = 22 * MiB + 512 * 1024;
constexpr size_t WS_WUP = 24 * MiB;
constexpr size_t WS_WDN = WS_WUP + 352 * MiB;
constexpr size_t WS_XA = WS_WDN + 176 * MiB;
constexpr size_t WS_H = WS_XA + 144 * MiB;
constexpr size_t WS_E = WS_H + 72 * MiB;
constexpr size_t WS_Q = WS_E, WS_K = WS_E + 72 * MiB, WS_V = WS_E + 90 * MiB, WS_O = WS_E + 108 * MiB;
constexpr size_t WS_PG = WS_E, WS_OF = WS_E + 220 * MiB, WS_OB = WS_E + 284 * MiB;
constexpr size_t WS_QT = WS_E + 348 * MiB, WS_KT = WS_E + 420 * MiB, WS_DEC = WS_E + 492 * MiB;
constexpr size_t WS_XG = WS_E, WS_YS = WS_E, WS_ACT = WS_E + 144 * MiB;
constexpr size_t WS_H8 = WS_E;
constexpr size_t WS_TMP = WS_E + 540 * MiB;
constexpr size_t WS_END = WS_TMP + 50 * MiB;
constexpr int CW_BAR = 4096;

constexpr int RING_BYTES = 131072;
constexpr int LDS_BYTES = 147456;
constexpr int LDSCTL_OFF = LDS_BYTES - 1024, MISC_OFF = LDSCTL_OFF + 320;
constexpr int NWAVES = 8;

__device__ __forceinline__ float bf2f(bf16 v) { return __uint_as_float(((unsigned)v) << 16); }
typedef __bf16 hwbf16x2 __attribute__((ext_vector_type(2)));
__device__ __forceinline__ unsigned pk2(float lo, float hi) { const f32x2 v = {lo, hi}; return __builtin_bit_cast(unsigned, __builtin_convertvector(v, hwbf16x2)); }
__device__ __forceinline__ unsigned f2bf(float f) { return pk2(f, 0.f) & 0xffffu; }
__device__ __forceinline__ float clamp448(float v) { return __builtin_fminf(__builtin_fmaxf(v, -448.f), 448.f); }
__device__ __forceinline__ unsigned pk4_fp8(float a, float b, float c, float d) { int w = 0; w = __builtin_amdgcn_cvt_pk_fp8_f32(clamp448(a), clamp448(b), w, false); w = __builtin_amdgcn_cvt_pk_fp8_f32(clamp448(c), clamp448(d), w, true); return (unsigned)w; }
template <int CTRL, int RMASK> __device__ __forceinline__ float dpp_add(float x) { return x + __builtin_bit_cast(float, __builtin_amdgcn_update_dpp(0, __builtin_bit_cast(int, x), CTRL, RMASK, 0xf, false)); }
__device__ __forceinline__ float wave_sum(float v) {
    v = dpp_add<0xB1, 0xf>(v);
    v = dpp_add<0x4E, 0xf>(v);
    v = dpp_add<0x141, 0xf>(v);
    v = dpp_add<0x140, 0xf>(v);
    v = dpp_add<0x142, 0xa>(v);
    v = dpp_add<0x143, 0xc>(v);
    return __builtin_bit_cast(float, __builtin_amdgcn_readlane(__builtin_bit_cast(int, v), 63));
}
__device__ __forceinline__ float silu_f(float v) { return v / (1.f + expf(-v)); }
__device__ __forceinline__ float fexp(float x) { return __builtin_amdgcn_exp2f(x * LOG2E); }
__device__ __forceinline__ float flog(float x) { return __builtin_amdgcn_logf(x) * 0.6931471805599453f; }
__device__ __forceinline__ float fsilu(float v) { return v * __builtin_amdgcn_rcpf(1.f + fexp(-v)); }
template <int d> __device__ __forceinline__ float dpp_shr(float x) { return __builtin_bit_cast(float, __builtin_amdgcn_update_dpp(0, __builtin_bit_cast(int, x), 0x110 + d, 0xf, 0xf, true)); }
#define LDS_WAIT() asm volatile("s_waitcnt lgkmcnt(0)" ::: "memory")
#define LDS_SYNC() asm volatile("s_waitcnt lgkmcnt(0)\n\ts_barrier" ::: "memory")
#define VM_WAIT() asm volatile("s_waitcnt vmcnt(0)" ::: "memory")

struct P {
    const float *x, *c, *ctx, *c_ctx, *ada_w, *ada_b, *norm1_g, *norm2_g, *attn_w_in, *attn_w_out, *attn_sink,
        *gla_w_in, *gla_gate_w2, *gla_gate_b, *gla_norm_g, *gla_w_out, *router_w, *exp_w_gate, *exp_w_up, *exp_w_down, *final_norm_g;
    float* out; unsigned char* ws;
    int lo, hi;
};

namespace pg8 {
#define PG8_LAS __attribute__((address_space(3)))
typedef unsigned short bf16_t;
typedef unsigned u32x4 __attribute__((ext_vector_type(4)));
typedef unsigned u32x2 __attribute__((ext_vector_type(2)));
constexpr int BM = 256, BK = 64, HALF = 128, HTB = HALF * BK * 2, STAGE_BYTES = 8 * HTB, NXCD = 8, WGM = 8;
__host__ __device__ __forceinline__ int lds_byte(int r, int c) { const int st = (r >> 4) * 2 + (c >> 5), rr = r & 15, cc = c & 31, ob = rr * 64 + cc * 2; return st * 1024 + (ob ^ (((ob >> 9) & 1) << 5)); }
__host__ __device__ __forceinline__ void stage_rc(int b, int& R, int& C) { const int st = b / 1024, sb = b % 1024, swz = sb ^ (((sb >> 9) & 1) << 5); R = (st >> 1) * 16 + swz / 64; C = (st & 1) * 32 + (swz % 64) / 2; }
__host__ __device__ __forceinline__ int perm32(int rho) { const int n = rho >> 4, i = rho & 15; return 8 * (i >> 2) + 4 * n + (i & 3); }
struct Unit { int pm, pn; };
struct Gemm { const void* A; const void* Bt; int KB; const int* gidx; };
struct TileOrder {
    int nG, nM, nN, sM, G, c, per, nwg;
    __device__ __forceinline__ void init(int nG_, int nM_, int nN_, int sM_, int G_, int c_) { nG = nG_; nM = nM_; nN = nN_; sM = sM_; G = G_; c = c_; per = nM * nN; nwg = nG * per; }
    __device__ __forceinline__ bool next(int i, Unit& u) const {
        const long L = (long)i * G + c; if (L >= nwg) return false;
        int wgid = (int)L; { const int q = nwg / NXCD, r = nwg % NXCD, xcd = wgid % NXCD, off = wgid / NXCD; wgid = (xcd < r ? xcd * (q + 1) : r * (q + 1) + (xcd - r) * q) + off; }
        const int g = wgid / per, rem = wgid % per;
        const int nig = WGM * nN, gid = rem / nig, fm = gid * WGM, gsz = (nM - fm) < WGM ? (nM - fm) : WGM;
        u.pm = g * sM + fm + ((rem % nig) % gsz); u.pn = g * nN + (rem % nig) / gsz; return true;
    }
};
struct GlaInOrder {
    int G, c;
    __device__ __forceinline__ bool next(int i, Unit& u) const {
        constexpr int NLAT = (NL / BM) * 13, NALL = NLAT + (NC / BM) * 7;
        const long L = (long)i * G + c; if (L >= NALL) return false;
        int wgid = (int)L; { const int q = NALL / NXCD, xcd = wgid % NXCD, off = wgid / NXCD; wgid = xcd * q + off; }
        if (wgid < NLAT) { const int nig = WGM * 13, gid = wgid / nig, fm = gid * WGM; u.pm = fm + ((wgid % nig) % WGM); u.pn = (wgid % nig) / WGM; }
        else { const int r = wgid - NLAT; u.pm = NL / BM + (r & 15); u.pn = 6 + (r >> 4); }
        return true;
    }
};
__device__ __forceinline__ unsigned cvt_pk_bf16(float lo, float hi) { unsigned r; asm volatile("v_cvt_pk_bf16_f32 %0, %1, %2" : "=v"(r) : "v"(lo), "v"(hi)); return r; }

struct EpiQKV {
    static constexpr bool PERM = false;
    bf16_t *Q, *Kb, *Vb; const float* rope;
    __device__ __forceinline__ void operator()(const f32x4 (&acc)[2][2][4][2], const Unit& u, int wr, int wc, int fr, int fq) const {
        const int row0 = u.pm * BM + wr * 64 + fr; const bool latent = u.pm < (NL / BM);
        const int kind = u.pn < 4 ? 0 : (u.pn == 4 ? 1 : 2);
        const size_t boff = (kind >= 1 ? (size_t)(WS_K - WS_Q) / 2 : 0) + (kind == 2 ? (size_t)(WS_V - WS_K) / 2 : 0);
        bf16_t* base = Q + boff; const int ldc = kind == 0 ? 1024 : 256; const int colt = kind == 0 ? u.pn * BM : 0;
        const float sc = kind == 0 ? QSCALE : 1.f;
        f32x4 rc0[2][4], rc1[2][4];
#pragma unroll
        for (int ai = 0; ai < 2; ++ai)
#pragma unroll
            for (int m = 0; m < 4; ++m) { const int t = (row0 + ai * HALF + m * 16) & (SEQ - 1);
                rc0[ai][m] = (f32x4){1.f, 0.f, 1.f, 0.f}; rc1[ai][m] = rc0[ai][m];
                if (latent && kind != 2) { const int pos = (wc & 1) ? (t & 63) : (t >> 6); const f32x4* tp = (const f32x4*)(rope + (size_t)(pos * 16 + 4 * fq) * 2); rc0[ai][m] = tp[0]; rc1[ai][m] = tp[1]; } }
#pragma unroll
        for (int ai = 0; ai < 2; ++ai)
#pragma unroll
            for (int m = 0; m < 4; ++m) {
                const int r = row0 + ai * HALF + m * 16;
                const f32x4 cs0 = rc0[ai][m], cs1 = rc1[ai][m];
                const float cs[4] = {cs0[0], cs0[2], cs1[0], cs1[2]}, sn[4] = {cs0[1], cs0[3], cs1[1], cs1[3]};
                bf16_t* rowp = base + (size_t)r * ldc + colt + wc * 32 + 4 * fq;
#pragma unroll
                for (int bj = 0; bj < 2; ++bj) {
                    const f32x4 x0 = acc[ai][bj][m][0], x1 = acc[ai][bj][m][1]; float o0[4], o1[4];
#pragma unroll
                    for (int j = 0; j < 4; ++j) { o0[j] = (x0[j] * cs[j] - x1[j] * sn[j]) * sc; o1[j] = (x1[j] * cs[j] + x0[j] * sn[j]) * sc; }
                    u32x2 w0, w1; w0.x = cvt_pk_bf16(o0[0], o0[1]); w0.y = cvt_pk_bf16(o0[2], o0[3]); w1.x = cvt_pk_bf16(o1[0], o1[1]); w1.y = cvt_pk_bf16(o1[2], o1[3]);
                    *(u32x2*)(rowp + bj * HALF) = w0; *(u32x2*)(rowp + bj * HALF + 16) = w1;
                }
            }
    }
};
struct EpiResid {
    static constexpr bool PERM = false;
    const float *xlat, *xctx; float* XA; const float* mod_g;
    __device__ __forceinline__ void operator()(const f32x4 (&acc)[2][2][4][2], const Unit& u, int wr, int wc, int fr, int fq) const {
        const int row0 = u.pm * BM + wr * 64 + fr, col0 = u.pn * BM + wc * 32 + 4 * fq; const bool latent = u.pm < (NL / BM);
        const float* src = latent ? xlat : xctx - (size_t)NL * D; const int j = latent ? (u.pm >> 3) : 16;
        f32x4 gv[2][2];
#pragma unroll
        for (int bj = 0; bj < 2; ++bj)
#pragma unroll
            for (int n = 0; n < 2; ++n) gv[bj][n] = *(const f32x4*)(mod_g + (size_t)j * 6144 + col0 + bj * HALF + n * 16);
#pragma unroll
        for (int ai = 0; ai < 2; ++ai)
#pragma unroll
            for (int mp = 0; mp < 2; ++mp) { f32x4 xs[2][2][2];
#pragma unroll
                for (int mm = 0; mm < 2; ++mm) { const size_t off = (size_t)(row0 + ai * HALF + (2 * mp + mm) * 16) * D + col0;
#pragma unroll
                    for (int bj = 0; bj < 2; ++bj)
#pragma unroll
                        for (int n = 0; n < 2; ++n) xs[mm][bj][n] = *(const f32x4*)(src + off + bj * HALF + n * 16); }
                asm volatile("" : "+v"(xs[0][0][0]), "+v"(xs[0][0][1]), "+v"(xs[0][1][0]), "+v"(xs[0][1][1]), "+v"(xs[1][0][0]), "+v"(xs[1][0][1]), "+v"(xs[1][1][0]), "+v"(xs[1][1][1]) :: "memory");
#pragma unroll
                for (int mm = 0; mm < 2; ++mm) { const size_t off = (size_t)(row0 + ai * HALF + (2 * mp + mm) * 16) * D + col0;
#pragma unroll
                    for (int bj = 0; bj < 2; ++bj)
#pragma unroll
                        for (int n = 0; n < 2; ++n) *(f32x4*)(XA + off + bj * HALF + n * 16) = xs[mm][bj][n] + gv[bj][n] * acc[ai][bj][2 * mp + mm][n]; }
                asm volatile("" ::: "memory"); }
    }
};
struct EpiSwiglu {
    static constexpr bool PERM = true;
    unsigned char* ACT;
    __device__ __forceinline__ void operator()(const f32x4 (&acc)[2][2][4][2], const Unit& u, int wr, int wc, int fr, int fq) const {
        const int row0 = u.pm * BM + wr * 64 + fr, nl = u.pn % (FF / 128), col0 = nl * 128 + wc * 32 + 8 * fq;
        const float sin_ = MOE_FP8 ? F8_INV : 1.f, sout = MOE_FP8 ? F8_ACT : 1.f;
#pragma unroll
        for (int ai = 0; ai < 2; ++ai)
#pragma unroll
            for (int m = 0; m < 4; ++m) { float o[8];
#pragma unroll
                for (int n = 0; n < 2; ++n)
#pragma unroll
                    for (int j = 0; j < 4; ++j) { const float g = acc[ai][0][m][n][j] * sin_, up = acc[ai][1][m][n][j] * sin_; o[n * 4 + j] = g * __builtin_amdgcn_rcpf(1.f + __builtin_amdgcn_exp2f(g * -1.4426950408889634f)) * (up * sout); }
                unsigned char* dst = ACT + ((size_t)(row0 + ai * HALF + m * 16) * FF + col0) * EB;
                if (MOE_FP8) { u32x2 w; w.x = pk4_fp8(o[0], o[1], o[2], o[3]); w.y = pk4_fp8(o[4], o[5], o[6], o[7]); *(u32x2*)dst = w; }
                else { u32x4 w; w.x = cvt_pk_bf16(o[0], o[1]); w.y = cvt_pk_bf16(o[2], o[3]); w.z = cvt_pk_bf16(o[4], o[5]); w.w = cvt_pk_bf16(o[6], o[7]); *(u32x4*)dst = w; } }
    }
};
struct EpiDown {
    static constexpr bool PERM = true;
    bf16_t* YS; const float* rowg;
    __device__ __forceinline__ void operator()(const f32x4 (&acc)[2][2][4][2], const Unit& u, int wr, int wc, int fr, int fq) const {
        const int row0 = u.pm * BM + wr * 64 + fr, col0 = (u.pn & 3) * BM + wc * 32 + 8 * fq;
        float gr[2][4];
#pragma unroll
        for (int ai = 0; ai < 2; ++ai)
#pragma unroll
            for (int m = 0; m < 4; ++m) gr[ai][m] = rowg[row0 + ai * HALF + m * 16];
#pragma unroll
        for (int ai = 0; ai < 2; ++ai)
#pragma unroll
            for (int m = 0; m < 4; ++m) { const int r = row0 + ai * HALF + m * 16; const float g = gr[ai][m] * (MOE_FP8 ? F8_INV : 1.f);
#pragma unroll
                for (int bj = 0; bj < 2; ++bj) { const f32x4 v0 = acc[ai][bj][m][0] * g, v1 = acc[ai][bj][m][1] * g;
                    u32x4 w; w.x = cvt_pk_bf16(v0[0], v0[1]); w.y = cvt_pk_bf16(v0[2], v0[3]); w.z = cvt_pk_bf16(v1[0], v1[1]); w.w = cvt_pk_bf16(v1[2], v1[3]);
                    *(u32x4*)(YS + (size_t)r * D + col0 + bj * HALF) = w; } }
    }
};
struct EpiGlaIn {
    static constexpr bool PERM = true;
    bf16_t* PG;
    __device__ __forceinline__ void operator()(const f32x4 (&acc)[2][2][4][2], const Unit& u, int wr, int wc, int fr, int fq) const {
        const int row0 = u.pm * BM + wr * 64 + fr, col0 = u.pn * BM + wc * 32 + 8 * fq;
#pragma unroll
        for (int ai = 0; ai < 2; ++ai)
#pragma unroll
            for (int m = 0; m < 4; ++m) { const int r = row0 + ai * HALF + m * 16;
#pragma unroll
                for (int bj = 0; bj < 2; ++bj) { const f32x4 v0 = acc[ai][bj][m][0], v1 = acc[ai][bj][m][1];
                    u32x4 w; w.x = cvt_pk_bf16(v0[0], v0[1]); w.y = cvt_pk_bf16(v0[2], v0[3]); w.z = cvt_pk_bf16(v1[0], v1[1]); w.w = cvt_pk_bf16(v1[2], v1[3]);
                    if (col0 + bj * HALF < GIN) *(u32x4*)(PG + (size_t)r * GIN + col0 + bj * HALF) = w; } }
    }
};

typedef int v8i __attribute__((ext_vector_type(8)));
typedef int v4i __attribute__((ext_vector_type(4)));
__device__ __forceinline__ v8i cat8(bf16x8 lo, bf16x8 hi) { return __builtin_shufflevector(__builtin_bit_cast(v4i, lo), __builtin_bit_cast(v4i, hi), 0, 1, 2, 3, 4, 5, 6, 7); }
template <class Epi, class Sched, bool FP8 = false, bool ALIGN_EPI = true, bool GATHER = false>
__device__ __forceinline__ void gemm_phase(PG8_LAS unsigned char* lds, const Gemm g, const Sched& S, const Epi& E, const int tid) {
    const int wid = __builtin_amdgcn_readfirstlane(tid >> 6), lane = tid & 63, wr = wid >> 2, wc = wid & 3, fr = lane & 15, fq = lane >> 4;
    const int KB = g.KB, nt = KB / 128;
    unsigned voffA, voffB; int Rl, Cb;
    { int R, C; stage_rc(tid * 16, R, C); const int Rb = Epi::PERM ? ((R & ~31) + perm32(R & 31)) : R; voffA = (unsigned)(R * KB + C * 2); voffB = (unsigned)(Rb * KB + C * 2); Rl = R; Cb = C * 2; }
    unsigned gA[2][2], gN[2][2]; constexpr int GOFF = STAGE_BYTES;
    const unsigned r64 = 64u * (unsigned)KB;
    const unsigned kstep = 128u;
    const unsigned hstep = (unsigned)(HALF * KB);
    const unsigned tstep = 2u * hstep;
    const __amdgpu_buffer_rsrc_t rsA = __builtin_amdgcn_make_buffer_rsrc(const_cast<void*>(g.A), 0, 0x7fffffff, 0x00020000), rsB = __builtin_amdgcn_make_buffer_rsrc(const_cast<void*>(g.Bt), 0, 0x7fffffff, 0x00020000);
    const unsigned ldsw = (unsigned)wid * 1024u;
    const int aoff = lds_byte(wr * 64 + fr, fq * 8), boff = lds_byte(wc * 32 + fr, fq * 8);
    const int sw8 = (fr * 64 + (fq & 1) * 32) ^ (((fr >> 3) & 1) << 5);
    const int a8off = (wr * 8 + (fq >> 1)) * 1024 + sw8, b8off = (wc * 4 + (fq >> 1)) * 1024 + sw8;
#define PG8_SA(b, h) (((b) * 2 + (h)) * HTB)
#define PG8_SB(b, h) ((4 + (b) * 2 + (h)) * HTB)
#define PG8_STAGE(bufoff, rs, soff, voff) do { _Pragma("unroll") for (int _i = 0; _i < 2; ++_i) \
        __builtin_amdgcn_raw_ptr_buffer_load_lds(rs, (PG8_LAS void*)(lds + (bufoff) + ldsw + _i * 8192), 16, (int)(voff), (int)((soff) + _i * r64), 0, 0); } while (0)
#define PG8_STAGE_A(bufoff, h, soff, kofs, gsel) do { if constexpr (GATHER) { _Pragma("unroll") for (int _i = 0; _i < 2; ++_i) \
        __builtin_amdgcn_raw_ptr_buffer_load_lds(rsA, (PG8_LAS void*)(lds + (bufoff) + ldsw + _i * 8192), 16, (int)(gsel)[h][_i], (int)(kofs), 0, 0); } else PG8_STAGE(bufoff, rsA, soff, voffA); } while (0)
#define PG8_LDA(dst, b, h) do { _Pragma("unroll") for (int m = 0; m < 4; ++m) { if constexpr (FP8) dst##8[m] = cat8(*(const PG8_LAS bf16x8*)(lds + PG8_SA(b, h) + aoff + m * 2048), *(const PG8_LAS bf16x8*)(lds + PG8_SA(b, h) + aoff + m * 2048 + 1024)); \
        else { _Pragma("unroll") for (int k = 0; k < 2; ++k) dst[m][k] = *(const PG8_LAS bf16x8*)(lds + PG8_SA(b, h) + aoff + m * 2048 + k * 1024); } } } while (0)
#define PG8_LDB(dst, b, h) do { _Pragma("unroll") for (int n = 0; n < 2; ++n) { if constexpr (FP8) dst##8[n] = cat8(*(const PG8_LAS bf16x8*)(lds + PG8_SB(b, h) + boff + n * 2048), *(const PG8_LAS bf16x8*)(lds + PG8_SB(b, h) + boff + n * 2048 + 1024)); \
        else { _Pragma("unroll") for (int k = 0; k < 2; ++k) dst[n][k] = *(const PG8_LAS bf16x8*)(lds + PG8_SB(b, h) + boff + n * 2048 + k * 1024); } } } while (0)
#define PG8_MMA8(ai, bj, At, Bt) asm volatile("s_nop 1\n\t" \
        "v_mfma_scale_f32_16x16x128_f8f6f4 %0, %8, %10, %0, %14, %14 op_sel_hi:[0,0,0]\n\t" "v_mfma_scale_f32_16x16x128_f8f6f4 %1, %9, %10, %1, %14, %14 op_sel_hi:[0,0,0]\n\t" \
        "v_mfma_scale_f32_16x16x128_f8f6f4 %2, %8, %11, %2, %14, %14 op_sel_hi:[0,0,0]\n\t" "v_mfma_scale_f32_16x16x128_f8f6f4 %3, %9, %11, %3, %14, %14 op_sel_hi:[0,0,0]\n\t" \
        "v_mfma_scale_f32_16x16x128_f8f6f4 %4, %8, %12, %4, %14, %14 op_sel_hi:[0,0,0]\n\t" "v_mfma_scale_f32_16x16x128_f8f6f4 %5, %9, %12, %5, %14, %14 op_sel_hi:[0,0,0]\n\t" \
        "v_mfma_scale_f32_16x16x128_f8f6f4 %6, %8, %13, %6, %14, %14 op_sel_hi:[0,0,0]\n\t" "v_mfma_scale_f32_16x16x128_f8f6f4 %7, %9, %13, %7, %14, %14 op_sel_hi:[0,0,0]" \
        : "+v"(acc[ai][bj][0][0]), "+v"(acc[ai][bj][0][1]), "+v"(acc[ai][bj][1][0]), "+v"(acc[ai][bj][1][1]), "+v"(acc[ai][bj][2][0]), "+v"(acc[ai][bj][2][1]), "+v"(acc[ai][bj][3][0]), "+v"(acc[ai][bj][3][1]) \
        : "v"(Bt##8[0]), "v"(Bt##8[1]), "v"(At##8[0]), "v"(At##8[1]), "v"(At##8[2]), "v"(At##8[3]), "v"(scl8))
#define PG8_MMA(ai, bj, At, Bt) do { __builtin_amdgcn_s_setprio(1); if constexpr (FP8) { PG8_MMA8(ai, bj, At, Bt); } else { \
        _Pragma("unroll") for (int m = 0; m < 4; ++m) _Pragma("unroll") for (int n = 0; n < 2; ++n) _Pragma("unroll") for (int k = 0; k < 2; ++k) \
        acc[ai][bj][m][n] = __builtin_amdgcn_mfma_f32_16x16x32_bf16(Bt[n][k], At[m][k], acc[ai][bj][m][n], 0, 0, 0); } __builtin_amdgcn_s_setprio(0); } while (0)
#define PG8_WAIT_V(n) asm volatile("s_waitcnt vmcnt(" #n ")" ::: "memory")
#define PG8_WAIT_L(n) asm volatile("s_waitcnt lgkmcnt(" #n ")" ::: "memory")
#define PG8_BAR __builtin_amdgcn_s_barrier()
#define PG8_SCHED __builtin_amdgcn_sched_barrier(0)
    Unit cur, nxt; int ui = 0;
    if (!S.next(0, cur)) return;
    f32x4 acc[2][2][4][2];
#pragma unroll
    for (int a = 0; a < 2; ++a)
#pragma unroll
        for (int b = 0; b < 2; ++b)
#pragma unroll
            for (int m = 0; m < 4; ++m)
#pragma unroll
                for (int n = 0; n < 2; ++n) acc[a][b][m][n] = (f32x4){0.f, 0.f, 0.f, 0.f};
    int scl8 = 0x7f7f7f7f; asm volatile("" : "+v"(scl8));
    bf16x8 At[4][2], B0[2][2], B1[2][2]; v8i At8[4], B08[2], B18[2];
    unsigned cA = (unsigned)cur.pm * tstep, cB = (unsigned)cur.pn * tstep;
    if constexpr (GATHER) {
#pragma unroll
        for (int h = 0; h < 2; ++h)
#pragma unroll
            for (int i = 0; i < 2; ++i) { gA[h][i] = (unsigned)g.gidx[cur.pm * 256 + h * 128 + Rl + 64 * i] * (unsigned)KB + (unsigned)Cb; gN[h][i] = gA[h][i]; } }
    {
        PG8_STAGE(PG8_SB(0, 0), rsB, cB, voffB); PG8_STAGE(PG8_SB(0, 1), rsB, cB + hstep, voffB); PG8_STAGE_A(PG8_SA(0, 0), 0, cA, 0, gA); PG8_STAGE_A(PG8_SA(0, 1), 1, cA + hstep, 0, gA);
        if (wr == 1) PG8_BAR;
        PG8_WAIT_V(2); PG8_BAR;
        PG8_STAGE(PG8_SB(1, 0), rsB, cB + kstep, voffB); PG8_STAGE_A(PG8_SA(1, 0), 0, cA + kstep, kstep, gA); PG8_STAGE(PG8_SB(1, 1), rsB, cB + hstep + kstep, voffB);
        PG8_WAIT_V(6); PG8_BAR;
    }
    for (;;) {
        const bool has_next = S.next(ui + 1, nxt);
        const unsigned nA = has_next ? (unsigned)nxt.pm * tstep : cA, nB = has_next ? (unsigned)nxt.pn * tstep : cB;
        for (int t = 0; t < nt; t += 2) {
            const bool last = (t == nt - 2);
            const unsigned a1 = cA + (unsigned)(t + 1) * kstep;
            const unsigned a2 = last ? nA : cA + (unsigned)(t + 2) * kstep, b2 = last ? nB : cB + (unsigned)(t + 2) * kstep;
            const unsigned a3 = a2 + kstep, b3 = b2 + kstep;
            const unsigned k1 = (unsigned)(t + 1) * kstep, k2 = last ? 0u : (unsigned)(t + 2) * kstep, k3 = k2 + kstep;
            if constexpr (GATHER) {
                if (t == 0 && has_next && wid == 0) __builtin_amdgcn_global_load_lds((const unsigned*)(g.gidx + nxt.pm * 256 + lane * 4), (PG8_LAS unsigned*)(lds + GOFF + ((ui + 1) & 1) * 1024), 16, 0, 0);
                if (last && has_next) {
#pragma unroll
                    for (int h = 0; h < 2; ++h)
#pragma unroll
                        for (int i = 0; i < 2; ++i) gN[h][i] = (unsigned)*(const PG8_LAS int*)(lds + GOFF + ((ui + 1) & 1) * 1024 + (h * 128 + Rl + 64 * i) * 4) * (unsigned)KB + (unsigned)Cb; } }
            unsigned gS[2][2];
#pragma unroll
            for (int h = 0; h < 2; ++h)
#pragma unroll
                for (int i = 0; i < 2; ++i) gS[h][i] = last ? gN[h][i] : gA[h][i];
            PG8_LDB(B0, 0, 0); PG8_LDB(B1, 0, 1); PG8_SCHED; PG8_LDA(At, 0, 0); PG8_STAGE_A(PG8_SA(1, 1), 1, a1 + hstep, k1, gA);
            PG8_WAIT_V(8); PG8_WAIT_L(0); PG8_BAR; PG8_MMA(0, 0, At, B0); PG8_MMA(0, 1, At, B1); PG8_BAR; PG8_SCHED;
            PG8_LDA(At, 0, 1); PG8_STAGE(PG8_SB(0, 0), rsB, b2, voffB); PG8_STAGE(PG8_SB(0, 1), rsB, b2 + hstep, voffB); PG8_STAGE_A(PG8_SA(0, 0), 0, a2, k2, gS);
            PG8_WAIT_V(8); PG8_WAIT_L(0); PG8_BAR; PG8_MMA(1, 0, At, B0); PG8_MMA(1, 1, At, B1); PG8_BAR; PG8_SCHED;
            PG8_LDB(B0, 1, 0); PG8_LDB(B1, 1, 1); PG8_SCHED; PG8_LDA(At, 1, 0); PG8_STAGE_A(PG8_SA(0, 1), 1, a2 + hstep, k2, gS);
            PG8_WAIT_V(8); PG8_WAIT_L(0); PG8_BAR; PG8_MMA(0, 0, At, B0); PG8_MMA(0, 1, At, B1); PG8_BAR; PG8_SCHED;
            PG8_LDA(At, 1, 1); PG8_STAGE(PG8_SB(1, 0), rsB, b3, voffB); PG8_STAGE(PG8_SB(1, 1), rsB, b3 + hstep, voffB); PG8_STAGE_A(PG8_SA(1, 0), 0, a3, k3, gS);
            PG8_WAIT_V(8); PG8_WAIT_L(0); PG8_BAR; PG8_MMA(1, 0, At, B0); PG8_MMA(1, 1, At, B1); PG8_BAR; PG8_SCHED;
        }
        if constexpr (ALIGN_EPI) { if (wr == 0) PG8_BAR; }
        if constexpr (FP8) asm volatile("s_nop 15\n\ts_nop 15" ::: "memory");
        E(acc, cur, wr, wc, fr, fq);
        if (!has_next) break;
#pragma unroll
        for (int a = 0; a < 2; ++a)
#pragma unroll
            for (int b = 0; b < 2; ++b)
#pragma unroll
                for (int m = 0; m < 4; ++m)
#pragma unroll
                    for (int n = 0; n < 2; ++n) acc[a][b][m][n] = (f32x4){0.f, 0.f, 0.f, 0.f};
        cur = nxt; cA = nA; cB = nB; ++ui;
        if constexpr (GATHER) {
#pragma unroll
            for (int h = 0; h < 2; ++h)
#pragma unroll
                for (int i = 0; i < 2; ++i) gA[h][i] = gN[h][i]; }
        if constexpr (ALIGN_EPI) { if (wr == 1) PG8_BAR; }
    }
    PG8_WAIT_V(0);
    if constexpr (!ALIGN_EPI) { if (wr == 0) PG8_BAR; }
    PG8_BAR;
#undef PG8_STAGE_A
#undef PG8_SA
#undef PG8_SB
#undef PG8_STAGE
#undef PG8_LDA
#undef PG8_LDB
#undef PG8_MMA
#undef PG8_WAIT_V
#undef PG8_WAIT_L
#undef PG8_BAR
#undef PG8_SCHED
}
}

#define XB_TMO      128
#define XB_XCNT(j)  (256  + 64 * (j))
#define XB_XSUB(j)  (1280 + 64 * (j))
#define XB_XGEN(j)  (2304 + 64 * (j))
#define XB_TOP      3328
#define XB_TOPGEN   3392
#define XCD_BAR_WORDS 3456
#define XB_SPIN_CAP (1u << 18)
__device__ __forceinline__ unsigned xb_ld(unsigned* p)              { return __hip_atomic_load(p, __ATOMIC_RELAXED, __HIP_MEMORY_SCOPE_AGENT); }
__device__ __forceinline__ unsigned xb_add(unsigned* p, unsigned v) { return __hip_atomic_fetch_add(p, v, __ATOMIC_RELAXED, __HIP_MEMORY_SCOPE_AGENT); }
__device__ __forceinline__ unsigned xb_xcc_id() { return (unsigned)__builtin_amdgcn_s_getreg((3 << 11) | 20) & 0xFu; }
#define XB_SPIN(cond, bar) do { unsigned _sp = 0; while (cond) { __builtin_amdgcn_s_sleep(1); \
    if ((++_sp & 255u) == 0u) { if (xb_ld(&(bar)[XB_TMO])) break; if (_sp > XB_SPIN_CAP) { atomicAdd(&(bar)[XB_TMO], 1u); break; } } } } while (0)
struct XcdBarrier { unsigned* bar; unsigned x; volatile LAS unsigned* st; };
__device__ __forceinline__ XcdBarrier xcd_barrier_post(unsigned* bar, volatile LAS unsigned* st) {
    XcdBarrier b; b.bar = bar; b.x = xb_xcc_id(); b.st = st;
    if (threadIdx.x == 0) (void)xb_add(&bar[XB_XCNT(b.x)], 1u);
    return b;
}
__device__ __forceinline__ void xcd_barrier_complete(unsigned* bar, unsigned x, unsigned& nloc, unsigned& nx) {
    const unsigned G = gridDim.x * gridDim.y * gridDim.z;
    unsigned sum, cnt, mine, sp = 0u;
    for (;;) {
        sum = 0u; cnt = 0u; mine = 0u;
#pragma unroll
        for (unsigned j = 0; j < 16; ++j) { const unsigned c = xb_ld(&bar[XB_XCNT(j)]); sum += c; cnt += (c > 0u) ? 1u : 0u; mine = (j == x) ? c : mine; }
        if (sum == G) break;
        __builtin_amdgcn_s_sleep(1);
        if ((++sp & 255u) == 0u) { if (xb_ld(&bar[XB_TMO])) break; if (sp > XB_SPIN_CAP) { atomicAdd(&bar[XB_TMO], 1u); break; } }
    }
    nloc = mine > 0u ? mine : 1u; nx = cnt > 0u ? cnt : 1u;
}
__device__ __forceinline__ void xcd_barrier(const XcdBarrier& b, const bool thread0) {
    asm volatile("s_waitcnt vmcnt(0)" ::: "memory");
    __syncthreads();
    if (thread0) {
        unsigned* bar = b.bar;
        __builtin_amdgcn_s_waitcnt(0);
        unsigned nloc = b.st[0], nx = b.st[1];
        if (nloc == 0u) { xcd_barrier_complete(bar, b.x, nloc, nx); b.st[0] = nloc; b.st[1] = nx; }
        const unsigned old = xb_add(&bar[XB_XSUB(b.x)], 1u);
        const unsigned gen = old / nloc;
        if (old + 1u == (gen + 1u) * nloc) {
            __builtin_amdgcn_fence(__ATOMIC_RELEASE, "agent");
            asm volatile("s_waitcnt vmcnt(0)" ::: "memory");
            const unsigned og = xb_add(&bar[XB_TOP], 1u);
            const unsigned tg = og / nx;
            if (og + 1u == (tg + 1u) * nx) xb_add(&bar[XB_TOPGEN], 1u);
            else XB_SPIN(xb_ld(&bar[XB_TOPGEN]) == tg, bar);
            __builtin_amdgcn_fence(__ATOMIC_ACQUIRE, "agent");
            xb_add(&bar[XB_XGEN(b.x)], 1u);
            asm volatile("s_waitcnt vmcnt(0)" ::: "memory");
        } else {
            XB_SPIN(xb_ld(&bar[XB_XGEN(b.x)]) == gen, bar);
            __builtin_amdgcn_fence(__ATOMIC_ACQUIRE, "agent");
            asm volatile("s_waitcnt vmcnt(0)" ::: "memory");
        }
    }
    __syncthreads();
}

struct Frame {
    LAS unsigned char* lds;
    int tid, lane, wave, vcu, G;
    unsigned char* ws;
};
#define WSP(T, off) ((T*)(F.ws + (off)))

__device__ __forceinline__ void cvt_item(const float* W, int ldw, int nvalid, int k0, int n0, bf16* WT, int ldt, int drow0, LAS float* scr, int lane) {
    const int c4 = lane & 15, kr = lane >> 4;
    f32x4 v[16];
#pragma unroll
    for (int i = 0; i < 16; ++i) { const int r = 4 * i + kr; v[i] = (4 * c4 < nvalid) ? *(const GAS f32x4*)(W + (size_t)(k0 + r) * ldw + n0 + 4 * c4) : (f32x4){0.f, 0.f, 0.f, 0.f}; }
#pragma unroll
    for (int i = 0; i < 16; ++i) { const int r = 4 * i + kr; LAS float* s = scr + r * 65 + 4 * c4; s[0] = v[i][0]; s[1] = v[i][1]; s[2] = v[i][2]; s[3] = v[i][3]; }
    LDS_WAIT(); asm volatile("" ::: "memory");
    const int c = lane & 7;
#pragma unroll
    for (int j = 0; j < 8; ++j) { const int n = (lane >> 3) + 8 * j; const LAS float* s = scr + (8 * c) * 65 + n;
        v4u o; o.x = pk2(s[0 * 65], s[1 * 65]); o.y = pk2(s[2 * 65], s[3 * 65]); o.z = pk2(s[4 * 65], s[5 * 65]); o.w = pk2(s[6 * 65], s[7 * 65]);
        if (n < nvalid) *(GAS v4u*)(WT + (size_t)(drow0 + n) * ldt + k0 + 8 * c) = o; }
    LDS_WAIT(); asm volatile("" ::: "memory");
}

__device__ __forceinline__ void cvt8_load(const float* W, int ldw, int k0, int n0, f32x4 (&v)[16], int lane) {
    const int c4 = lane & 15, kr = lane >> 4;
#pragma unroll
    for (int i = 0; i < 16; ++i) v[i] = __builtin_nontemporal_load((const GAS f32x4*)(W + (size_t)(k0 + 4 * i + kr) * ldw + n0 + 4 * c4));
}
__device__ __forceinline__ void cvt8_finish(const f32x4 (&v)[16], int k0, unsigned char* WT, int ldt, int drow0, float scale, LAS float* scr, int lane) {
    const int c4 = lane & 15, kr = lane >> 4;
#pragma unroll
    for (int i = 0; i < 16; ++i) { const int r = 4 * i + kr; LAS float* s = scr + r * 65 + 4 * c4; s[0] = v[i][0]; s[1] = v[i][1]; s[2] = v[i][2]; s[3] = v[i][3]; }
    LDS_WAIT(); asm volatile("" ::: "memory");
    const int c = lane & 3;
#pragma unroll
    for (int j = 0; j < 4; ++j) { const int n = (lane >> 2) + 16 * j; const LAS float* s = scr + (16 * c) * 65 + n;
        v4u o;
        o.x = pk4_fp8(s[0 * 65] * scale, s[1 * 65] * scale, s[2 * 65] * scale, s[3 * 65] * scale); o.y = pk4_fp8(s[4 * 65] * scale, s[5 * 65] * scale, s[6 * 65] * scale, s[7 * 65] * scale);
        o.z = pk4_fp8(s[8 * 65] * scale, s[9 * 65] * scale, s[10 * 65] * scale, s[11 * 65] * scale); o.w = pk4_fp8(s[12 * 65] * scale, s[13 * 65] * scale, s[14 * 65] * scale, s[15 * 65] * scale);
        *(GAS v4u*)(WT + (size_t)(drow0 + n) * ldt + k0 + 16 * c) = o; }
    LDS_WAIT(); asm volatile("" ::: "memory");
}
struct ExpItem { const float* W; int ldw, k0, n0, ldt, drow0; unsigned char* WT; };
__device__ __forceinline__ ExpItem exp_item(const P& p, unsigned char* ws, int q, int half) {
    ExpItem e; const int le = q / 1056, rr = q % 1056, mk = rr / 352, ii = rr % 352;
    if (mk < 2) { const int kb2 = ii / 44, nb = ii % 44; e.n0 = 64 * nb; e.k0 = 64 * (2 * kb2 + half); e.W = (mk == 0 ? p.exp_w_gate : p.exp_w_up) + (size_t)le * D * FF; e.ldw = FF; e.ldt = D; e.drow0 = (e.n0 >> 7) * 256 + mk * 128 + (e.n0 & 127); e.WT = ws + WS_WUP + (size_t)le * 5632 * D; }
    else { const int kb2 = ii / 16, nb = ii % 16; e.n0 = 64 * nb; e.k0 = 64 * (2 * kb2 + half); e.W = p.exp_w_down + (size_t)le * FF * D; e.ldw = D; e.ldt = FF; e.drow0 = e.n0; e.WT = ws + WS_WDN + (size_t)le * D * FF; }
    return e;
}
constexpr int NPAIR_ALL = 32 * 1056;
__device__ __forceinline__ void cvt_pairs(const P& p, unsigned char* ws, LAS float* scr, int qfirst, int qstep, int qend, int lane) {
    f32x4 va[16], vb[16]; int q = qfirst;
    if (q < qend) { const ExpItem e = exp_item(p, ws, q, 0); cvt8_load(e.W, e.ldw, e.k0, e.n0, va, lane); }
    while (q < qend) {
        const ExpItem e0 = exp_item(p, ws, q, 0), e1 = exp_item(p, ws, q, 1);
        cvt8_load(e1.W, e1.ldw, e1.k0, e1.n0, vb, lane);
        cvt8_finish(va, e0.k0, e0.WT, e0.ldt, e0.drow0, F8_W, scr, lane);
        const int q2 = q + qstep;
        if (q2 < qend) { const ExpItem e2 = exp_item(p, ws, q2, 0); cvt8_load(e2.W, e2.ldw, e2.k0, e2.n0, va, lane); }
        cvt8_finish(vb, e1.k0, e1.WT, e1.ldt, e1.drow0, F8_W, scr, lane);
        q = q2;
    }
}
#ifndef BG_QKV
#define BG_QKV 2560
#define BG_OUT0 6144
#define BG_UP0 512
#define BG_DN0 4096
#endif
constexpr int CVT_Q3 = NPAIR_ALL - BG_DN0, CVT_Q2 = CVT_Q3 - BG_UP0, CVT_Q1 = CVT_Q2 - BG_OUT0, CVT_SPLIT0 = CVT_Q1 - BG_QKV;
static_assert(CVT_Q2 >= NPAIR_ALL / 2 && CVT_SPLIT0 >= 0, "the slices behind the layer-0 MoE must stay inside layer 1");
#define BG_SLOT(first, qb, qe) do { if (MOE_FP8 && F.G == 256 && (int)blockIdx.x >= (first) && (qb) < (qe)) { __syncthreads(); \
    cvt_pairs(p, F.ws, (LAS float*)(F.lds + F.wave * 16640), (qb) + ((int)blockIdx.x - (first)) * 8 + F.wave, (256 - (first)) * 8, (qe), F.lane); } } while (0)
__device__ __forceinline__ void ph_pro(const P& p, Frame& F, bool do_cvt) {
    float* MOD = WSP(float, WS_MOD); float* ROPE = WSP(float, WS_ROPE);
    if (F.vcu == 255 % F.G) {
        for (int i = F.tid; i < 1024; i += 512) { const int pos = i >> 4, f = i & 15; const float inv = powf(10000.f, -(float)f / 16.f); const float ang = (float)pos * inv; ROPE[2 * i] = cosf(ang); ROPE[2 * i + 1] = sinf(ang); }
    }
    if (F.vcu < 192) {
        LAS float* ssrc = (LAS float*)F.lds; LAS float* red = (LAS float*)(F.lds + 69632);
        for (int i = F.tid; i < 17 * 1024; i += 512) { const int j = i >> 10, k = i & 1023; const float v = (j < 16) ? p.c[j * 1024 + k] : p.c_ctx[k]; ssrc[i] = silu_f(v); }
        __syncthreads();
        for (int u = F.vcu; u < 192; u += F.G) {
            const int l = u / 96, c0 = (u % 96) * 64, col = c0 + (F.tid & 63), ks = F.tid >> 6;
            const float* w = p.ada_w + ((size_t)l * 1024 + ks * 128) * 6144 + col;
            float acc[17];
#pragma unroll
            for (int j = 0; j < 17; ++j) acc[j] = 0.f;
            for (int k = 0; k < 128; k += 4) {
                const float w0 = w[(size_t)(k + 0) * 6144], w1 = w[(size_t)(k + 1) * 6144], w2 = w[(size_t)(k + 2) * 6144], w3 = w[(size_t)(k + 3) * 6144];
#pragma unroll
                for (int j = 0; j < 17; ++j) { const f32x4 s = *(const LAS f32x4*)(ssrc + j * 1024 + ks * 128 + k); acc[j] += s[0] * w0 + s[1] * w1 + s[2] * w2 + s[3] * w3; }
            }
#pragma unroll
            for (int j = 0; j < 17; ++j) red[(ks * 17 + j) * 64 + (F.tid & 63)] = acc[j];
            __syncthreads();
            for (int i = F.tid; i < 17 * 64; i += 512) { const int j = i >> 6, c = i & 63; float s = p.ada_b[l * 6144 + c0 + c];
#pragma unroll
                for (int q = 0; q < 8; ++q) s += red[(q * 17 + j) * 64 + c];
                MOD[(size_t)(l * 17 + j) * 6144 + c0 + c] = s; }
            __syncthreads();
        }
    }
    if (do_cvt) {
        __syncthreads();
        LAS float* scr = (LAS float*)(F.lds + F.wave * 16640);
        const int gw = F.vcu * NWAVES + F.wave, NGW = F.G * NWAVES;
        constexpr int I_QKV = 16 * 24, I_O = 16 * 16, I_GIN = 16 * 49, I_SMALL = I_QKV + I_O + I_GIN + I_O, I_E = 704, I_LE = 3 * I_E, NITEMS = I_SMALL + 32 * I_LE;
        for (int it = gw; it < I_SMALL; it += NGW) {
            int r = it;
            if (r < I_QKV) { cvt_item(p.attn_w_in, ATT_N, 64, 64 * (r / 24), 64 * (r % 24), WSP(bf16, WS_WQKV), D, 64 * (r % 24), scr, F.lane); continue; } r -= I_QKV;
            if (r < I_O) { cvt_item(p.attn_w_out, D, 64, 64 * (r / 16), 64 * (r % 16), WSP(bf16, WS_WO0), D, 64 * (r % 16), scr, F.lane); continue; } r -= I_O;
            if (r < I_GIN) { const int nb = r % 49; cvt_item(p.gla_w_in, GIN, nb == 48 ? 32 : 64, 64 * (r / 49), 64 * nb, WSP(bf16, WS_WGIN), D, 64 * nb, scr, F.lane); continue; } r -= I_GIN;
            cvt_item(p.gla_w_out, D, 64, 64 * (r / 16), 64 * (r % 16), WSP(bf16, WS_WO1), D, 64 * (r % 16), scr, F.lane);
        }
        constexpr int NEXP = 32 * I_LE;
        if (MOE_FP8) {
            cvt_pairs(p, F.ws, scr, gw, NGW, F.G == 256 ? CVT_SPLIT0 : NPAIR_ALL, F.lane);
        } else {
            for (int r = gw; r < NEXP; r += NGW) {
                const int le = r / I_LE, rr = r % I_LE, mk = rr / I_E, ii = rr % I_E;
                if (mk < 2) { const int kb = ii / 44, nb = ii % 44, n0 = 64 * nb; const float* W = (mk == 0 ? p.exp_w_gate : p.exp_w_up) + (size_t)le * D * FF; const int dr = (n0 >> 7) * 256 + mk * 128 + (n0 & 127);
                    cvt_item(W, FF, 64, 64 * kb, n0, WSP(bf16, WS_WUP) + (size_t)le * 5632 * D, D, dr, scr, F.lane); }
                else { const int kb = ii / 16, nb = ii % 16; cvt_item(p.exp_w_down + (size_t)le * FF * D, D, 64, 64 * kb, 64 * nb, WSP(bf16, WS_WDN) + (size_t)le * D * FF, FF, 64 * nb, scr, F.lane); }
            }
        }
        { v4u* z = (v4u*)(WSP(bf16, WS_WGIN) + (size_t)GIN * D); const int n16 = (GIN_PAD - GIN) * D * 2 / 16;
          for (int i = F.vcu * 512 + F.tid; i < n16; i += F.G * 512) z[i] = (v4u){0u, 0u, 0u, 0u}; }
    }
}

__device__ __forceinline__ void norm_mod_store(const f32x4 (&v)[4], float rstd, const float* g, const float* sh, const float* sc, bf16* orow, int lane) {
    f32x4 gv[4], shv[4], scv[4];
#pragma unroll
    for (int j = 0; j < 4; ++j) { const int c = 4 * (lane + 64 * j); gv[j] = *(const f32x4*)(g + c); shv[j] = *(const f32x4*)(sh + c); scv[j] = *(const f32x4*)(sc + c); }
#pragma unroll
    for (int j = 0; j < 4; ++j) { const int c = 4 * (lane + 64 * j);
        const f32x4 y = (v[j] * rstd * gv[j]) * (scv[j] + 1.f) + shv[j]; v2u o; o.x = pk2(y[0], y[1]); o.y = pk2(y[2], y[3]); *(v2u*)(orow + c) = o; }
}
__device__ __forceinline__ void ph_norm1(const P& p, Frame& F, int l) {
    const float* MOD = WSP(float, WS_MOD); bf16* H = WSP(bf16, WS_H); const float* XA = WSP(float, WS_XA);
    const int gw = F.vcu * NWAVES + F.wave, NGW = F.G * NWAVES; constexpr int RW = 3;
    f32x4 gv[4];
#pragma unroll
    for (int q = 0; q < 4; ++q) gv[q] = *(const f32x4*)(p.norm1_g + l * D + 4 * (F.lane + 64 * q));
    for (int r0 = gw; r0 < NT; r0 += RW * NGW) {
        f32x4 v[RW][4], shv[RW][4], scv[RW][4];
#pragma unroll
        for (int h = 0; h < RW; ++h) { const int r = r0 + h * NGW < NT ? r0 + h * NGW : r0;
            const float* xr = (l == 0) ? (r < NL ? p.x + (size_t)r * D : p.ctx + (size_t)(r - NL) * D) : XA + (size_t)r * D;
            const int j = r < NL ? r / SEQ : 16; const float* mr = MOD + (size_t)(l * 17 + j) * 6144;
#pragma unroll
            for (int q = 0; q < 4; ++q) { const int c = 4 * (F.lane + 64 * q); v[h][q] = *(const f32x4*)(xr + c); shv[h][q] = *(const f32x4*)(mr + c); scv[h][q] = *(const f32x4*)(mr + 1024 + c); } }
#pragma unroll
        for (int h = 0; h < RW; ++h) { const int r = r0 + h * NGW; if (r >= NT) break; float s = 0.f;
#pragma unroll
            for (int q = 0; q < 4; ++q) s += (v[h][q][0] * v[h][q][0] + v[h][q][1] * v[h][q][1]) + (v[h][q][2] * v[h][q][2] + v[h][q][3] * v[h][q][3]);
            const float rstd = 1.f / sqrtf(wave_sum(s) * (1.f / D) + EPS);
            bf16* orow = H + (size_t)r * D;
#pragma unroll
            for (int q = 0; q < 4; ++q) { const f32x4 y = (v[h][q] * rstd * gv[q]) * (scv[h][q] + 1.f) + shv[h][q]; v2u o; o.x = pk2(y[0], y[1]); o.y = pk2(y[2], y[3]); *(v2u*)(orow + 4 * (F.lane + 64 * q)) = o; } }
    }
}
__device__ __forceinline__ void ph_norm2r(const P& p, Frame& F, int l) {
    const float* MOD = WSP(float, WS_MOD); bf16* H = WSP(bf16, WS_H); const float* XA = WSP(float, WS_XA); float* AFF = WSP(float, WS_AFF);
    constexpr int HT = 1028;
    LAS float* rw = (LAS float*)F.lds; LAS float* h2t = (LAS float*)(F.lds + 65536); LAS float* part = (LAS float*)(F.lds + 65536 + 16 * HT * 4);
    for (int i = F.tid; i < D * NE / 4; i += 512) ((LAS f32x4*)rw)[i] = ((const f32x4*)(p.router_w + (size_t)l * D * NE))[i];
    const int ntile = (l == 0 ? NT : NL) / 16, lane = F.lane, w = F.wave;
    const float *g = p.norm2_g + l * D;
    f32x4 v[2][4], gq[4];
#pragma unroll
    for (int q = 0; q < 4; ++q) gq[q] = *(const f32x4*)(g + 4 * (lane + 64 * q));
    if (F.vcu < ntile) {
#pragma unroll
        for (int h = 0; h < 2; ++h)
#pragma unroll
            for (int q = 0; q < 4; ++q) v[h][q] = *(const f32x4*)(XA + (size_t)(F.vcu * 16 + 2 * w + h) * D + 4 * (lane + 64 * q)); }
    __syncthreads();
    for (int tile = F.vcu; tile < ntile; tile += F.G) {
        const int r0 = tile * 16;
        f32x4 shq[4], scq[4];
        { const int j = r0 < NL ? r0 / SEQ : 16; const float* mr = MOD + (size_t)(l * 17 + j) * 6144;
#pragma unroll
          for (int q = 0; q < 4; ++q) { shq[q] = *(const f32x4*)(mr + 3072 + 4 * (lane + 64 * q)); scq[q] = *(const f32x4*)(mr + 4096 + 4 * (lane + 64 * q)); } }
#pragma unroll
        for (int h = 0; h < 2; ++h) { const int r = r0 + 2 * w + h; float s = 0.f;
#pragma unroll
            for (int q = 0; q < 4; ++q) s += (v[h][q][0] * v[h][q][0] + v[h][q][1] * v[h][q][1]) + (v[h][q][2] * v[h][q][2] + v[h][q][3] * v[h][q][3]);
            const float rstd = 1.f / sqrtf(wave_sum(s) * (1.f / D) + EPS);
            bf16* orow = H + (size_t)r * D;
#pragma unroll
            for (int q = 0; q < 4; ++q) { const int c = 4 * (lane + 64 * q); const f32x4 gv = gq[q], shv = shq[q], scv = scq[q];
                const f32x4 y = (v[h][q] * rstd * gv) * (scv + 1.f) + shv;
                if (MOE_FP8) *(unsigned*)(WSP(unsigned char, WS_H8) + (size_t)r * D + c) = pk4_fp8(y[0] * F8_ACT, y[1] * F8_ACT, y[2] * F8_ACT, y[3] * F8_ACT);
                else { v2u o; o.x = pk2(y[0], y[1]); o.y = pk2(y[2], y[3]); *(v2u*)(orow + c) = o; }
                *(LAS f32x4*)(h2t + (2 * w + h) * HT + c) = y; } }
        if (tile + F.G < ntile) {
#pragma unroll
            for (int h = 0; h < 2; ++h)
#pragma unroll
                for (int q = 0; q < 4; ++q) v[h][q] = *(const f32x4*)(XA + (size_t)((tile + F.G) * 16 + 2 * w + h) * D + 4 * (lane + 64 * q)); }
        LDS_SYNC();
        { f32x4 acc = (f32x4){0.f, 0.f, 0.f, 0.f}; const int i16 = lane & 15, kq = lane >> 4;
#pragma unroll 8
          for (int it = 0; it < 32; ++it) { const int k = 128 * w + 4 * it + kq; acc = __builtin_amdgcn_mfma_f32_16x16x4f32(h2t[i16 * HT + k], rw[k * 16 + i16], acc, 0, 0, 0); }
#pragma unroll
          for (int r = 0; r < 4; ++r) part[(w * 16 + 4 * kq + r) * 16 + i16] = acc[r]; }
        LDS_SYNC();
        if (F.tid < 256) { const int i = F.tid >> 4, e = F.tid & 15; float a = 0.f;
#pragma unroll
            for (int w2 = 0; w2 < 8; ++w2) a += part[(w2 * 16 + i) * 16 + e];
            float m = a;
#pragma unroll
            for (int o = 1; o < 16; o <<= 1) m = fmaxf(m, __shfl_xor(m, o));
            const float pe = expf(a - m); float ssum = pe;
#pragma unroll
            for (int o = 1; o < 16; o <<= 1) ssum += __shfl_xor(ssum, o);
            AFF[(size_t)(r0 + i) * 16 + e] = pe / ssum; }
    }
    __syncthreads();
}
__device__ __forceinline__ void ph_topkg(const P& p, Frame& F, int l) {
    const float* AFF = WSP(float, WS_AFF); int* SLOT = WSP(int, WS_SLOT); int* ROWIDX = WSP(int, WS_ROWIDX); float* ROWG = WSP(float, WS_ROWG);
    const bf16* H = WSP(bf16, WS_H); bf16* XG = WSP(bf16, WS_XG);
    LAS int* hist = (LAS int*)F.lds;
    LAS int* sel = hist + 256;
    LAS int* wtot = sel + 256;
    LAS int* shr = wtot + 8;
    const int nunits = l == 0 ? 512 : 256, tid = F.tid, lane = F.lane;
    for (int u = F.vcu; u < nunits; u += F.G) {
        const bool lat = u < 256; const int b = (u & 255) >> 4, e = u & 15;
        const int L = lat ? SEQ : CTX, cap = lat ? CAPL : CAPC, row0 = lat ? b * SEQ : NL + b * CTX, s0 = lat ? b * CAPL : NB * CAPL + b * CAPC;
        unsigned key[4]; const bool act = 4 * tid < L;
#pragma unroll
        for (int q = 0; q < 4; ++q) key[q] = act ? __float_as_uint(AFF[(size_t)(row0 + 4 * tid + q) * 16 + e]) : 0u;
        unsigned prefix = 0u; int kk = cap;
#pragma unroll
        for (int pass = 0; pass < 4; ++pass) { const int shift = 24 - 8 * pass;
            if (tid < 256) hist[tid] = 0;
            LDS_SYNC();
            if (act) {
#pragma unroll
                for (int q = 0; q < 4; ++q) { const bool cand = pass == 0 ? true : ((key[q] >> (shift + 8)) == (prefix >> (shift + 8))); if (cand) __hip_atomic_fetch_add(&hist[(key[q] >> shift) & 255u], 1, __ATOMIC_RELAXED, __HIP_MEMORY_SCOPE_WORKGROUP); } }
            LDS_SYNC();
            if (F.wave == 0) { const int h0 = hist[4 * lane], h1 = hist[4 * lane + 1], h2 = hist[4 * lane + 2], h3 = hist[4 * lane + 3]; const int tot = h0 + h1 + h2 + h3;
                int suf = tot;
#pragma unroll
                for (int o = 1; o < 64; o <<= 1) { const int t = __shfl_down(suf, o); if (lane + o < 64) suf += t; }
                int above = suf - tot;
                if (above < kk && kk <= above + h3) { shr[0] = 4 * lane + 3; shr[1] = above; } above += h3;
                if (above < kk && kk <= above + h2) { shr[0] = 4 * lane + 2; shr[1] = above; } above += h2;
                if (above < kk && kk <= above + h1) { shr[0] = 4 * lane + 1; shr[1] = above; } above += h1;
                if (above < kk && kk <= above + h0) { shr[0] = 4 * lane + 0; shr[1] = above; } }
            LDS_SYNC();
            prefix |= (unsigned)shr[0] << shift; kk -= shr[1];
        }
        const int n_gt = cap - kk;
        int cg = 0, ce = 0;
#pragma unroll
        for (int q = 0; q < 4; ++q) { cg += (act && key[q] > prefix) ? 1 : 0; ce += (act && key[q] == prefix) ? 1 : 0; }
        int pk = cg | (ce << 16), inc = pk;
#pragma unroll
        for (int o = 1; o < 64; o <<= 1) { const int t = __shfl_up(inc, o); if (lane >= o) inc += t; }
        if (lane == 63) wtot[F.wave] = inc;
        LDS_SYNC();
        int base = 0;
#pragma unroll
        for (int w2 = 0; w2 < 8; ++w2) base += (w2 < F.wave) ? wtot[w2] : 0;
        int ex = base + inc - pk; int rg = ex & 0xffff, re = ex >> 16;
        if (act) {
#pragma unroll
            for (int q = 0; q < 4; ++q) { const int row = row0 + 4 * tid + q; int s = -1;
                if (key[q] > prefix) { s = rg; ++rg; } else if (key[q] == prefix) { if (re < kk) s = n_gt + re; ++re; }
                if (s >= 0) { ROWIDX[e * ESLOTS + s0 + s] = row; ROWG[e * ESLOTS + s0 + s] = __uint_as_float(key[q]); sel[s] = row; s += s0; }
                SLOT[(size_t)row * 16 + e] = s; } }
        LDS_SYNC();
    }
}
__device__ __forceinline__ void ph_combine(const P& p, Frame& F, int l) {
    const float* MOD = WSP(float, WS_MOD); bf16* H = WSP(bf16, WS_H); float* XA = WSP(float, WS_XA); const int* SLOT = WSP(int, WS_SLOT); const bf16* YS = WSP(bf16, WS_YS);
    const int gw = F.vcu * NWAVES + F.wave, NGW = F.G * NWAVES; const int nrows = l == 0 ? NT : NL;
    f32x4 gn[4];
#pragma unroll
    for (int q = 0; q < 4; ++q) gn[q] = *(const f32x4*)((l == 0 ? p.norm1_g + D : p.final_norm_g) + 4 * (F.lane + 64 * q));
    for (int r0 = gw; r0 < nrows; r0 += 2 * NGW) {
        int sv[2]; f32x4 v[2][4], acc[2][4];
#pragma unroll
        for (int h = 0; h < 2; ++h) { const int r = r0 + h * NGW; sv[h] = F.lane < 16 ? SLOT[(size_t)r * 16 + F.lane] : -1;
#pragma unroll
            for (int q = 0; q < 4; ++q) { v[h][q] = *(const f32x4*)(XA + (size_t)r * D + 4 * (F.lane + 64 * q)); acc[h][q] = (f32x4){0.f, 0.f, 0.f, 0.f}; } }
        unsigned mk[2]; v2u yv[2][4][4];
#pragma unroll
        for (int h = 0; h < 2; ++h) { mk[h] = (unsigned)(__ballot(sv[h] >= 0) & 0xffffull); unsigned m2 = mk[h];
#pragma unroll
            for (int i = 0; i < 4; ++i) {
                if (m2) { const int e = __builtin_ctz(m2); m2 &= m2 - 1; const int sl = __builtin_amdgcn_readlane(sv[h], e); const bf16* yr = YS + (size_t)(e * ESLOTS + sl) * D;
#pragma unroll
                    for (int q = 0; q < 4; ++q) yv[h][i][q] = *(const v2u*)(yr + 4 * (F.lane + 64 * q)); }
                else {
#pragma unroll
                    for (int q = 0; q < 4; ++q) yv[h][i][q] = (v2u){0u, 0u}; } }
            mk[h] = m2; }
        f32x4 g2v[2][4], shn[2][4], scn[2][4];
#pragma unroll
        for (int h = 0; h < 2; ++h) { const int r = r0 + h * NGW; const int j = r < NL ? r / SEQ : 16; const float* g2 = MOD + (size_t)(l * 17 + j) * 6144 + 5120; const float* m1 = MOD + (size_t)(17 + j) * 6144;
#pragma unroll
            for (int q = 0; q < 4; ++q) { const int c = 4 * (F.lane + 64 * q); g2v[h][q] = *(const f32x4*)(g2 + c); if (l == 0) { shn[h][q] = *(const f32x4*)(m1 + c); scn[h][q] = *(const f32x4*)(m1 + 1024 + c); } } }
#pragma unroll
        for (int h = 0; h < 2; ++h) {
#pragma unroll
            for (int i = 0; i < 4; ++i)
#pragma unroll
                for (int q = 0; q < 4; ++q) { const v2u w = yv[h][i][q]; acc[h][q][0] += __uint_as_float(w.x << 16); acc[h][q][1] += __uint_as_float(w.x & 0xffff0000u); acc[h][q][2] += __uint_as_float(w.y << 16); acc[h][q][3] += __uint_as_float(w.y & 0xffff0000u); }
            unsigned m2 = mk[h];
            while (m2) { const int e = __builtin_ctz(m2); m2 &= m2 - 1; const int sl = __builtin_amdgcn_readlane(sv[h], e); const bf16* yr = YS + (size_t)(e * ESLOTS + sl) * D;
#pragma unroll
                for (int q = 0; q < 4; ++q) { const v2u w = *(const v2u*)(yr + 4 * (F.lane + 64 * q)); acc[h][q][0] += __uint_as_float(w.x << 16); acc[h][q][1] += __uint_as_float(w.x & 0xffff0000u); acc[h][q][2] += __uint_as_float(w.y << 16); acc[h][q][3] += __uint_as_float(w.y & 0xffff0000u); } } }
#pragma unroll
        for (int h = 0; h < 2; ++h) { const int r = r0 + h * NGW;
            float* xr = XA + (size_t)r * D; float s = 0.f;
#pragma unroll
            for (int q = 0; q < 4; ++q) { v[h][q] = v[h][q] + g2v[h][q] * acc[h][q]; s += (v[h][q][0] * v[h][q][0] + v[h][q][1] * v[h][q][1]) + (v[h][q][2] * v[h][q][2] + v[h][q][3] * v[h][q][3]); }
            const float rstd = 1.f / sqrtf(wave_sum(s) * (1.f / D) + EPS);
            if (l == 0) {
#pragma unroll
                for (int q = 0; q < 4; ++q) *(f32x4*)(xr + 4 * (F.lane + 64 * q)) = v[h][q];
                bf16* orow = H + (size_t)r * D;
#pragma unroll
                for (int q = 0; q < 4; ++q) { const f32x4 y = (v[h][q] * rstd * gn[q]) * (scn[h][q] + 1.f) + shn[h][q]; v2u o; o.x = pk2(y[0], y[1]); o.y = pk2(y[2], y[3]); *(v2u*)(orow + 4 * (F.lane + 64 * q)) = o; }
            } else {
                float* orow = p.out + (size_t)r * D;
#pragma unroll
                for (int q = 0; q < 4; ++q) { const int c = 4 * (F.lane + 64 * q); *(f32x4*)(orow + c) = v[h][q] * rstd * gn[q]; }
            } }
    }
}
__device__ __forceinline__ void ph_readout(const P& p, Frame& F) {
    bf16* H = WSP(bf16, WS_H); const bf16* OF = WSP(bf16, WS_OF); const bf16* OB = WSP(bf16, WS_OB); const bf16* PG = WSP(bf16, WS_PG);
    const int gw = F.vcu * NWAVES + F.wave, NGW = F.G * NWAVES;
    f32x4 gnv[4];
#pragma unroll
    for (int q = 0; q < 4; ++q) gnv[q] = *(const f32x4*)(p.gla_norm_g + 4 * (F.lane + 64 * q));
    for (int r0 = gw; r0 < NL; r0 += 2 * NGW) {
        v2u a[2][4], b[2][4], rr[2][4];
#pragma unroll
        for (int h = 0; h < 2; ++h) { const int r = r0 + h * NGW;
#pragma unroll
            for (int q = 0; q < 4; ++q) { const int c = 4 * (F.lane + 64 * q); a[h][q] = *(const v2u*)(OF + (size_t)r * GV + c); b[h][q] = *(const v2u*)(OB + (size_t)r * GV + c); rr[h][q] = *(const v2u*)(PG + (size_t)r * GIN + GQK + c); } }
#pragma unroll
        for (int h = 0; h < 2; ++h) { const int r = r0 + h * NGW;
#pragma unroll
            for (int q = 0; q < 4; ++q) { const int c = 4 * (F.lane + 64 * q);
                f32x4 o; o[0] = __uint_as_float(a[h][q].x << 16) + __uint_as_float(b[h][q].x << 16); o[1] = __uint_as_float(a[h][q].x & 0xffff0000u) + __uint_as_float(b[h][q].x & 0xffff0000u);
                o[2] = __uint_as_float(a[h][q].y << 16) + __uint_as_float(b[h][q].y << 16); o[3] = __uint_as_float(a[h][q].y & 0xffff0000u) + __uint_as_float(b[h][q].y & 0xffff0000u);
                const float ss = wave_sum((o[0] * o[0] + o[1] * o[1]) + (o[2] * o[2] + o[3] * o[3]));
                const float rstd = 1.f / sqrtf(ss * (1.f / GDV) + EPS);
                const f32x4 gv = gnv[q];
                const float q0 = __uint_as_float(rr[h][q].x << 16), q1 = __uint_as_float(rr[h][q].x & 0xffff0000u), q2 = __uint_as_float(rr[h][q].y << 16), q3 = __uint_as_float(rr[h][q].y & 0xffff0000u);
                const float y0 = o[0] * rstd * gv[0] * fsilu(q0), y1 = o[1] * rstd * gv[1] * fsilu(q1), y2 = o[2] * rstd * gv[2] * fsilu(q2), y3 = o[3] * rstd * gv[3] * fsilu(q3);
                v2u w; w.x = pk2(y0, y1); w.y = pk2(y2, y3); *(v2u*)(H + (size_t)r * D + c) = w; } }
    }
}

typedef float f32x16 __attribute__((ext_vector_type(16)));
typedef short s16x4 __attribute__((ext_vector_type(4)));
__device__ __forceinline__ s16x4 lds_tr16(const LAS unsigned char* p) { return __builtin_bit_cast(s16x4, __builtin_amdgcn_ds_read_tr16_b64_v4i16((LAS s16x4*)p)); }
__device__ __forceinline__ int crow(int r, int hi) { return (r & 3) + 8 * (r >> 2) + 4 * hi; }
#define TR_RD(dst, ptr) asm volatile("ds_read_b64_tr_b16 %0, %1" : "=v"(dst) : "v"((unsigned)(uintptr_t)(ptr)) : "memory")
#define TR_WAIT4(a, b, c, d) asm volatile("s_waitcnt lgkmcnt(0)" : "+v"(a), "+v"(b), "+v"(c), "+v"(d) :: "memory")
__device__ __forceinline__ void ph_attn(const P& p, Frame& F) {
    const bf16* Q = WSP(bf16, WS_Q); const bf16* Kb = WSP(bf16, WS_K); const bf16* Vb = WSP(bf16, WS_V); bf16* O = WSP(bf16, WS_O);
    const int lane = F.lane, r32 = lane & 31, hi = lane >> 5, w = F.wave, gq = w >> 1, th = w & 1;
    LAS unsigned char* Ks = F.lds; LAS unsigned char* Vs = F.lds + 3 * 8192;
    const int kl = lane >> 3, chp = lane & 7;
    const int dgrp = (lane >> 4) & 1, qrow = (lane & 15) >> 2, pp = lane & 3;
    for (int u = F.vcu; u < 2048 + 256; u += F.G) {
        const bool lat = u < 2048; int b, hk, t0, qrow0;
        if (lat) { b = u >> 7; hk = (u >> 5) & 3; t0 = 64 * (u & 31); qrow0 = b * SEQ + t0; }
        else { const int uc = u - 2048; b = uc >> 4; hk = (uc >> 2) & 3; t0 = 64 * (uc & 3); qrow0 = NL + b * CTX + t0; }
        int jlo = 0, jhi = -1;
        if (lat) { jlo = t0 >= 128 ? 0 : (128 - t0) / 64; jhi = (SEQ - 64 - (t0 - 128)) / 64; if (jhi > 4) jhi = 4; }
        const int nt = 4 + (jhi - jlo + 1);
        const int hq = hk * 4 + gq; const int qr_row = qrow0 + 32 * th + r32;
#define ATT_KROW(it) ((it) < 4 ? NL + b * CTX + 64 * (it) : b * SEQ + t0 - 128 + 64 * (jlo + (it) - 4))
#define ATT_DMA(it, sl) do { const size_t so_ = ((size_t)(ATT_KROW(it) + 8 * w + kl) * 256 + hk * 64) * 2 + (size_t)((chp ^ kl) * 16); \
        __builtin_amdgcn_global_load_lds((const unsigned*)((const char*)Kb + so_), (LAS unsigned*)(Ks + (sl) * 8192 + w * 1024), 16, 0, 0); \
        __builtin_amdgcn_global_load_lds((const unsigned*)((const char*)Vb + so_), (LAS unsigned*)(Vs + (sl) * 8192 + w * 1024), 16, 0, 0); } while (0)
        bf16x8 qr[4];
#pragma unroll
        for (int d0 = 0; d0 < 4; ++d0) qr[d0] = *(const bf16x8*)(Q + (size_t)qr_row * 1024 + hq * 64 + d0 * 16 + hi * 8);
        ATT_DMA(0, 0); ATT_DMA(1, 1);
        float m = p.attn_sink[hq] * LOG2E, l = hi == 0 ? 1.f : 0.f;
        f32x16 o[2];
#pragma unroll
        for (int r = 0; r < 16; ++r) { o[0][r] = 0.f; o[1][r] = 0.f; }
        int sc = 0, sn2 = 2;
        for (int it = 0; it < nt; ++it) {
            if (it + 1 < nt) asm volatile("s_waitcnt vmcnt(2)" ::: "memory"); else asm volatile("s_waitcnt vmcnt(0)" ::: "memory");
            __builtin_amdgcn_s_barrier(); asm volatile("" ::: "memory");
            if (it + 2 < nt) ATT_DMA(it + 2, sn2);
            const int slot = sc * 8192;
            f32x16 p0, p1;
#pragma unroll
            for (int r = 0; r < 16; ++r) { p0[r] = 0.f; p1[r] = 0.f; }
#pragma unroll
            for (int d0 = 0; d0 < 4; ++d0) {
                const int off = r32 * 128 + (((2 * d0 + hi) ^ (r32 & 7)) * 16);
                const bf16x8 k0 = *(const LAS bf16x8*)(Ks + slot + off), k1 = *(const LAS bf16x8*)(Ks + slot + off + 32 * 128);
                p0 = __builtin_amdgcn_mfma_f32_32x32x16_bf16(k0, qr[d0], p0, 0, 0, 0);
                p1 = __builtin_amdgcn_mfma_f32_32x32x16_bf16(k1, qr[d0], p1, 0, 0, 0);
            }
            s16x4 vt[2][4][2];
#pragma unroll
            for (int dblk = 0; dblk < 2; ++dblk)
#pragma unroll
                for (int ks = 0; ks < 4; ++ks) { const int klo = 16 * ks + 4 * hi + qrow, khi = klo + 8, ch = 4 * dblk + 2 * dgrp + (pp >> 1), bo = (pp & 1) * 8;
                    TR_RD(vt[dblk][ks][0], Vs + slot + klo * 128 + ((ch ^ (klo & 7)) * 16) + bo); TR_RD(vt[dblk][ks][1], Vs + slot + khi * 128 + ((ch ^ (khi & 7)) * 16) + bo); }
            asm volatile("s_nop 7\n\ts_nop 7" : "+v"(p0), "+v"(p1));
            if (it >= 4) { const int j = jlo + it - 4;
                if (j == 0 || j == 4) { const int dq = 32 * th + r32;
                    const int sg = j == 0 ? 1 : -1;
#pragma unroll
                    for (int r = 0; r < 16; ++r) { const int kk = crow(r, hi);
                        p0[r] = sg * (dq - kk) > 0 ? -1e30f : p0[r]; p1[r] = sg * (dq - (kk + 32)) > 0 ? -1e30f : p1[r]; } } }
            float mx = p0[0];
#pragma unroll
            for (int r = 1; r < 16; ++r) mx = fmaxf(mx, p0[r]);
#pragma unroll
            for (int r = 0; r < 16; ++r) mx = fmaxf(mx, p1[r]);
            mx = fmaxf(mx, __shfl_xor(mx, 32));
            const float mn = fmaxf(m, mx);
            if (__any(mn > m)) { const float f = __builtin_amdgcn_exp2f(m - mn); l *= f;
#pragma unroll
                for (int r = 0; r < 16; ++r) { o[0][r] *= f; o[1][r] *= f; }
                m = mn; }
            float ls = 0.f;
#pragma unroll
            for (int r = 0; r < 16; ++r) { p0[r] = __builtin_amdgcn_exp2f(p0[r] - m); p1[r] = __builtin_amdgcn_exp2f(p1[r] - m); ls += p0[r] + p1[r]; }
            l += ls;
            v4u pw[4];
#pragma unroll
            for (int q4 = 0; q4 < 4; ++q4) { pw[0][q4] = pk2(p0[2 * q4], p0[2 * q4 + 1]); pw[1][q4] = pk2(p0[8 + 2 * q4], p0[9 + 2 * q4]); pw[2][q4] = pk2(p1[2 * q4], p1[2 * q4 + 1]); pw[3][q4] = pk2(p1[8 + 2 * q4], p1[9 + 2 * q4]); }
            asm volatile("s_waitcnt lgkmcnt(0)" : "+v"(vt[0][0][0]), "+v"(vt[0][0][1]), "+v"(vt[0][1][0]), "+v"(vt[0][1][1]), "+v"(vt[0][2][0]), "+v"(vt[0][2][1]), "+v"(vt[0][3][0]), "+v"(vt[0][3][1]),
                         "+v"(vt[1][0][0]), "+v"(vt[1][0][1]), "+v"(vt[1][1][0]), "+v"(vt[1][1][1]), "+v"(vt[1][2][0]), "+v"(vt[1][2][1]), "+v"(vt[1][3][0]), "+v"(vt[1][3][1]) :: "memory");
#pragma unroll
            for (int dblk = 0; dblk < 2; ++dblk)
#pragma unroll
                for (int ks = 0; ks < 4; ++ks) { const s16x4 vlo = vt[dblk][ks][0], vhi = vt[dblk][ks][1];
                    const bf16x8 vf = (bf16x8){vlo[0], vlo[1], vlo[2], vlo[3], vhi[0], vhi[1], vhi[2], vhi[3]};
                    o[dblk] = __builtin_amdgcn_mfma_f32_32x32x16_bf16(vf, __builtin_bit_cast(bf16x8, pw[ks]), o[dblk], 0, 0, 0); }
            sc = sc == 2 ? 0 : sc + 1; sn2 = sn2 == 2 ? 0 : sn2 + 1;
        }
#undef ATT_KROW
#undef ATT_DMA
        const float il = 1.f / (l + __shfl_xor(l, 32));
        bf16* orow = O + (size_t)qr_row * 1024 + hq * 64;
#pragma unroll
        for (int dblk = 0; dblk < 2; ++dblk)
#pragma unroll
            for (int rq = 0; rq < 4; ++rq) { v2u wv; wv.x = pk2(o[dblk][4 * rq] * il, o[dblk][4 * rq + 1] * il); wv.y = pk2(o[dblk][4 * rq + 2] * il, o[dblk][4 * rq + 3] * il);
                *(v2u*)(orow + 32 * dblk + 8 * rq + 4 * hi) = wv; }
        __builtin_amdgcn_s_barrier(); asm volatile("" ::: "memory");
    }
}
__device__ __forceinline__ void ph_attn_naive(const P& p, Frame& F) {
    const bf16* Q = WSP(bf16, WS_Q); const bf16* Kb = WSP(bf16, WS_K); const bf16* Vb = WSP(bf16, WS_V); bf16* O = WSP(bf16, WS_O);
    for (int i = F.vcu * 512 + F.tid; i < NT * NQH; i += F.G * 512) {
        const int r = i >> 4, hq = i & 15, hk = hq >> 2;
        float q[64], acc[64];
#pragma unroll
        for (int d = 0; d < 64; ++d) { q[d] = bf2f(Q[(size_t)r * 1024 + hq * 64 + d]); acc[d] = 0.f; }
        float m = p.attn_sink[hq] * LOG2E, l = 1.f;
        const bool lat = r < NL; const int b = lat ? r / SEQ : (r - NL) / CTX, t = r & (SEQ - 1);
        const int nlat = lat ? (min(SEQ - 1, t + 128) - max(0, t - 128) + 1) : 0, klo = max(0, t - 128);
        for (int kk = 0; kk < CTX + nlat; ++kk) {
            const int kr = kk < CTX ? NL + b * CTX + kk : b * SEQ + klo + (kk - CTX);
            const bf16* kp = Kb + (size_t)kr * 256 + hk * 64; const bf16* vp = Vb + (size_t)kr * 256 + hk * 64;
            float s = 0.f;
#pragma unroll
            for (int d = 0; d < 64; ++d) s += q[d] * bf2f(kp[d]);
            const float mn = fmaxf(m, s), sc = exp2f(m - mn), pe = exp2f(s - mn);
            l = l * sc + pe; m = mn;
#pragma unroll
            for (int d = 0; d < 64; ++d) acc[d] = acc[d] * sc + pe * bf2f(vp[d]);
        }
        const float il = 1.f / l;
#pragma unroll
        for (int d = 0; d < 64; ++d) O[(size_t)r * 1024 + hq * 64 + d] = (bf16)f2bf(acc[d] * il);
    }
}
__device__ __forceinline__ f32x4 mfma16(bf16x8 a, bf16x8 b, f32x4 c) { return __builtin_amdgcn_mfma_f32_16x16x32_bf16(a, b, c, 0, 0, 0); }
__device__ __forceinline__ int gla_rowmap(int b, int dir, int s) { return s < CTX ? NL + b * CTX + (dir ? CTX - 1 - s : s) : b * SEQ + (dir ? SEQ - 1 - (s - CTX) : s - CTX); }
__device__ __forceinline__ void ph_glaprep(const P& p, Frame& F) {
    const bf16* PG = WSP(bf16, WS_PG); bf16* QT = WSP(bf16, WS_QT); bf16* KT = WSP(bf16, WS_KT); float* DEC = WSP(float, WS_DEC);
    const int lane = F.lane, w = F.wave, c16 = lane & 15, g = lane >> 4;
    for (int uu = F.vcu; uu < NB * 2 * 36 * 2; uu += F.G) {
        const int hf = uu & 1, u = uu >> 1, c = u % 36, dir = (u / 36) & 1, b = u / 72;
        const int rowA = gla_rowmap(b, dir, 64 * c), rstep = dir ? -1 : 1;
        const size_t obase = ((size_t)(dir * NB + b) * 2304 + 64 * c) * 512;
        bf16x8 lrf[4];
#pragma unroll
        for (int tt = 0; tt < 4; ++tt) { lrf[tt] = (bf16x8){0, 0, 0, 0, 0, 0, 0, 0};
            if (g < 2) lrf[tt] = *(const bf16x8*)(PG + (size_t)(rowA + rstep * (16 * tt + c16)) * GIN + 3072 + 16 * dir + 8 * g); }
#pragma unroll 1
        for (int ctl = 0; ctl < 2; ++ctl) { const int col0 = 256 * hf + 16 * (2 * w + ctl);
            v4u wp = (v4u){0u, 0u, 0u, 0u};
            if (g < 2) { const float* wsrc = p.gla_gate_w2 + (size_t)(dir * 16 + 8 * g) * 512 + col0 + c16;
                wp.x = pk2(wsrc[0], wsrc[512]); wp.y = pk2(wsrc[1024], wsrc[1536]); wp.z = pk2(wsrc[2048], wsrc[2560]); wp.w = pk2(wsrc[3072], wsrc[3584]); }
            const bf16x8 wf = __builtin_bit_cast(bf16x8, wp);
            const f32x4 bias = *(const f32x4*)(p.gla_gate_b + dir * 512 + col0 + 4 * g);
            f32x4 carry = (f32x4){0.f, 0.f, 0.f, 0.f};
            v2u kk4[4], qq4[4];
#pragma unroll
            for (int tt = 0; tt < 4; ++tt) { const bf16* pr = PG + (size_t)(rowA + rstep * (16 * tt + c16)) * GIN + col0 + 4 * g;
                kk4[tt] = *(const v2u*)(pr + GQR); qq4[tt] = (v2u){0u, 0u}; if (c >= 4) qq4[tt] = *(const v2u*)pr; }
            asm volatile("" : "+v"(kk4[0]), "+v"(kk4[1]), "+v"(kk4[2]), "+v"(kk4[3]), "+v"(qq4[0]), "+v"(qq4[1]), "+v"(qq4[2]), "+v"(qq4[3]) :: "memory");
#pragma unroll
            for (int tt = 0; tt < 4; ++tt) {
                const int tok = 16 * tt + c16;
                const v2u kk = kk4[tt], qq = qq4[tt];
                const f32x4 z = mfma16(wf, lrf[tt], bias);
                f32x4 ls;
#pragma unroll
                for (int r = 0; r < 4; ++r) ls[r] = (fminf(z[r], 0.f) - flog(1.f + fexp(-fabsf(z[r])))) * (1.f / 16.f);
#pragma unroll
                for (int r = 0; r < 4; ++r) { ls[r] += dpp_shr<1>(ls[r]); ls[r] += dpp_shr<2>(ls[r]); ls[r] += dpp_shr<4>(ls[r]); ls[r] += dpp_shr<8>(ls[r]); }
                f32x4 bs = carry + ls;
#pragma unroll
                for (int r = 0; r < 4; ++r) carry[r] += __shfl(ls[r], 15, 16);
                const float k0 = __uint_as_float(kk.x << 16), k1 = __uint_as_float(kk.x & 0xffff0000u), k2 = __uint_as_float(kk.y << 16), k3 = __uint_as_float(kk.y & 0xffff0000u);
                v2u ko; ko.x = pk2(k0 * fexp(-bs[0]), k1 * fexp(-bs[1])); ko.y = pk2(k2 * fexp(-bs[2]), k3 * fexp(-bs[3]));
                *(v2u*)(KT + obase + (size_t)tok * 512 + col0 + 4 * g) = ko;
                if (c >= 4) { const float q0 = __uint_as_float(qq.x << 16), q1 = __uint_as_float(qq.x & 0xffff0000u), q2 = __uint_as_float(qq.y << 16), q3 = __uint_as_float(qq.y & 0xffff0000u);
                    v2u qo; qo.x = pk2(q0 * GLA_QS * fexp(bs[0]), q1 * GLA_QS * fexp(bs[1])); qo.y = pk2(q2 * GLA_QS * fexp(bs[2]), q3 * GLA_QS * fexp(bs[3]));
                    *(v2u*)(QT + obase + (size_t)tok * 512 + col0 + 4 * g) = qo; }
            }
            if (c16 == 15) { f32x4 dv; dv[0] = fexp(carry[0]); dv[1] = fexp(carry[1]); dv[2] = fexp(carry[2]); dv[3] = fexp(carry[3]);
                *(f32x4*)(DEC + ((size_t)(dir * NB + b) * 36 + c) * 512 + col0 + 4 * g) = dv; }
        }
    }
}
__device__ __forceinline__ void ph_glascan(const P& p, Frame& F) {
    const bf16* PG = WSP(bf16, WS_PG); const bf16* QT = WSP(bf16, WS_QT); const bf16* KT = WSP(bf16, WS_KT); const float* DEC = WSP(float, WS_DEC);
    const int lane = F.lane, w = F.wave, g = lane >> 4, c16 = lane & 15, qrow = c16 >> 2, pp = c16 & 3;
    constexpr int BUF = 49152, QOFF = 0, KOFF = 16384, VOFF = 32768, AM = 98304, DCO = 106496;
    LAS unsigned char* L = F.lds; LAS unsigned char* stg = L + DCO + 1024 + w * 2048;
    for (int u = F.vcu; u < 256; u += F.G) {
        const int dvh = u & 1, dir = (u >> 1) & 1, h = (u >> 2) & 3, b = u >> 4;
        bf16* OUT = WSP(bf16, WS_OF) + (dir ? (size_t)(WS_OB - WS_OF) / 2 : 0);
        const size_t seqbase = (size_t)(dir * NB + b) * 2304;
#define GLA_STAGE(c, bufi) do { _Pragma("unroll") for (int pc = 0; pc < 2; ++pc) { const int piece = w + 8 * pc, row = piece * 4 + g, chs = c16 ^ (row & 15); \
            const size_t srow = seqbase + 64 * (c) + row; const unsigned ldst = (bufi) * BUF + piece * 1024; \
            if ((c) >= 4) __builtin_amdgcn_global_load_lds((const unsigned*)((const char*)(QT + srow * 512 + h * 128) + chs * 16), (LAS unsigned*)(L + QOFF + ldst), 16, 0, 0); \
            __builtin_amdgcn_global_load_lds((const unsigned*)((const char*)(KT + srow * 512 + h * 128) + chs * 16), (LAS unsigned*)(L + KOFF + ldst), 16, 0, 0); \
            __builtin_amdgcn_global_load_lds((const unsigned*)((const char*)(PG + (size_t)gla_rowmap(b, dir, 64 * (c) + row) * GIN + GQR + GQK + h * 256 + dvh * 128) + chs * 16), (LAS unsigned*)(L + VOFF + ldst), 16, 0, 0); } \
            if (w == 0 && lane < 32) __builtin_amdgcn_global_load_lds((const unsigned*)((const char*)(DEC + ((size_t)(dir * NB + b) * 36 + (c)) * 512 + h * 128) + lane * 16), (LAS unsigned*)(L + DCO + (bufi) * 512), 16, 0, 0); } while (0)
        f32x4 S[8];
#pragma unroll
        for (int t = 0; t < 8; ++t) S[t] = (f32x4){0.f, 0.f, 0.f, 0.f};
        GLA_STAGE(0, 0);
        asm volatile("s_waitcnt vmcnt(0)" ::: "memory"); __builtin_amdgcn_s_barrier(); asm volatile("" ::: "memory");
#pragma clang loop unroll(disable)
        for (int c = 0; c < 36; ++c) {
            const int bi = c & 1; LAS unsigned char* Qs = L + bi * BUF + QOFF; LAS unsigned char* Ksm = L + bi * BUF + KOFF; LAS unsigned char* Vsm = L + bi * BUF + VOFF; LAS unsigned char* Am = L + AM;
            if (c + 1 < 36) GLA_STAGE(c + 1, bi ^ 1);
            if (c >= 4) {
#pragma unroll
                for (int q2 = 0; q2 < 2; ++q2) { const int id = 2 * w + q2, ti = id >> 2, tj = id & 3; f32x4 a = (f32x4){0.f, 0.f, 0.f, 0.f};
                    if (tj <= ti) {
#pragma unroll
                        for (int ks = 0; ks < 4; ++ks) { const int co = ((4 * ks + g) ^ c16) * 16;
                            const bf16x8 qa = *(const LAS bf16x8*)(Qs + (16 * ti + c16) * 256 + co), kb = *(const LAS bf16x8*)(Ksm + (16 * tj + c16) * 256 + co);
                            a = mfma16(qa, kb, a); }
                        asm volatile("s_nop 7\n\ts_nop 7" : "+v"(a));
                        if (tj == ti) {
#pragma unroll
                            for (int r = 0; r < 4; ++r) a[r] = c16 > 4 * g + r ? 0.f : a[r]; } }
#pragma unroll
                    for (int r = 0; r < 4; ++r) { const int i = 16 * ti + 4 * g + r; *(LAS bf16*)(Am + i * 128 + (((2 * tj + (c16 >> 3)) ^ (i & 7)) * 16) + (c16 & 7) * 2) = (bf16)f2bf(a[r]); } }
            }
            asm volatile("s_waitcnt lgkmcnt(0)" ::: "memory"); __builtin_amdgcn_s_barrier(); asm volatile("" ::: "memory");
            bf16x8 vf[2];
            { s16x4 t0, t1, t2, t3; const int ch = 2 * w + (pp >> 1), bo = (pp & 1) * 8, rl = 8 * g + qrow;
              TR_RD(t0, Vsm + rl * 256 + ((ch ^ (rl & 15)) * 16) + bo); TR_RD(t1, Vsm + (rl + 4) * 256 + ((ch ^ ((rl + 4) & 15)) * 16) + bo);
              TR_RD(t2, Vsm + (rl + 32) * 256 + ((ch ^ (rl & 15)) * 16) + bo); TR_RD(t3, Vsm + (rl + 36) * 256 + ((ch ^ ((rl + 4) & 15)) * 16) + bo);
              TR_WAIT4(t0, t1, t2, t3);
              vf[0] = (bf16x8){t0[0], t0[1], t0[2], t0[3], t1[0], t1[1], t1[2], t1[3]}; vf[1] = (bf16x8){t2[0], t2[1], t2[2], t2[3], t3[0], t3[1], t3[2], t3[3]}; }
            if (c >= 4) {
                bf16x8 sf[4];
#pragma unroll
                for (int ks = 0; ks < 4; ++ks) { v4u t4; t4.x = pk2(S[2 * ks][0], S[2 * ks][1]); t4.y = pk2(S[2 * ks][2], S[2 * ks][3]); t4.z = pk2(S[2 * ks + 1][0], S[2 * ks + 1][1]); t4.w = pk2(S[2 * ks + 1][2], S[2 * ks + 1][3]); sf[ks] = __builtin_bit_cast(bf16x8, t4); }
#pragma unroll
                for (int tt = 0; tt < 4; ++tt) { f32x4 o = (f32x4){0.f, 0.f, 0.f, 0.f}; const int row = 16 * tt + c16;
#pragma unroll
                    for (int ks = 0; ks < 4; ++ks) { const int ch0 = 4 * ks + (g >> 1), bo = (g & 1) * 8;
                        const s16x4 alo = *(const LAS s16x4*)(Qs + row * 256 + ((ch0 ^ c16) * 16) + bo), ahi = *(const LAS s16x4*)(Qs + row * 256 + (((ch0 + 2) ^ c16) * 16) + bo);
                        o = mfma16((bf16x8){alo[0], alo[1], alo[2], alo[3], ahi[0], ahi[1], ahi[2], ahi[3]}, sf[ks], o); }
#pragma unroll
                    for (int ks2 = 0; ks2 < 2; ++ks2) { const bf16x8 am = *(const LAS bf16x8*)(Am + row * 128 + (((4 * ks2 + g) ^ (row & 7)) * 16)); o = mfma16(am, vf[ks2], o); }
#pragma unroll
                    for (int r = 0; r < 4; ++r) *(LAS bf16*)(stg + (16 * tt + 4 * g + r) * 32 + c16 * 2) = (bf16)f2bf(o[r]); }
#pragma unroll
                for (int pc = 0; pc < 2; ++pc) { const int pi = lane + 64 * pc, tok = pi >> 1; const v4u ov = *(const LAS v4u*)(stg + pi * 16);
                    *(v4u*)(OUT + (size_t)gla_rowmap(b, dir, 64 * c + tok) * GV + h * 256 + dvh * 128 + 16 * w + (pi & 1) * 8) = ov; }
            }
#pragma unroll
            for (int t = 0; t < 8; ++t) { f32x4 acc = S[t];
                { s16x4 t0, t1, t2, t3; const int ch = 2 * t + (pp >> 1), bo = (pp & 1) * 8, rl = 8 * g + qrow;
                  TR_RD(t0, Ksm + rl * 256 + ((ch ^ (rl & 15)) * 16) + bo); TR_RD(t1, Ksm + (rl + 4) * 256 + ((ch ^ ((rl + 4) & 15)) * 16) + bo);
                  TR_RD(t2, Ksm + (rl + 32) * 256 + ((ch ^ (rl & 15)) * 16) + bo); TR_RD(t3, Ksm + (rl + 36) * 256 + ((ch ^ ((rl + 4) & 15)) * 16) + bo);
                  TR_WAIT4(t0, t1, t2, t3);
                  acc = mfma16((bf16x8){t0[0], t0[1], t0[2], t0[3], t1[0], t1[1], t1[2], t1[3]}, vf[0], acc);
                  acc = mfma16((bf16x8){t2[0], t2[1], t2[2], t2[3], t3[0], t3[1], t3[2], t3[3]}, vf[1], acc); }
                const f32x4 d4 = *(const LAS f32x4*)(L + DCO + bi * 512 + (16 * t + 4 * g) * 4);
                S[t] = acc * d4; }
            if (c >= 4) asm volatile("s_waitcnt vmcnt(2) lgkmcnt(0)" ::: "memory"); else asm volatile("s_waitcnt vmcnt(0) lgkmcnt(0)" ::: "memory");
            __builtin_amdgcn_s_barrier(); asm volatile("" ::: "memory");
        }
#undef GLA_STAGE
    }
}
__device__ __forceinline__ void ph_scan_naive(const P& p, Frame& F) {
    const bf16* PG = WSP(bf16, WS_PG);
    LAS float* sq = (LAS float*)F.lds; LAS float* sk = sq + 128; LAS float* sa = sk + 128; LAS float* sv = sa + 128; LAS float* so = sv + 64;
    const int tid = F.tid, e = tid & 63, w = tid >> 6;
    for (int u = F.vcu; u < 512; u += F.G) {
        const int sl = u & 3, dir = (u >> 2) & 1, h = (u >> 3) & 3, b = u >> 5;
        float S[16];
#pragma unroll
        for (int i = 0; i < 16; ++i) S[i] = 0.f;
        bf16* OUT = WSP(bf16, WS_OF) + (dir ? (size_t)(WS_OB - WS_OF) / 2 : 0);
        for (int step = 0; step < CTX + SEQ; ++step) {
            int row; if (step < CTX) row = NL + b * CTX + (dir ? CTX - 1 - step : step); else { const int t = step - CTX; row = b * SEQ + (dir ? SEQ - 1 - t : t); }
            const bf16* pr = PG + (size_t)row * GIN;
            if (tid < 128) { const int col = h * 128 + tid; float z = p.gla_gate_b[dir * 512 + col];
#pragma unroll
                for (int r = 0; r < 16; ++r) z += bf2f(pr[3072 + dir * 16 + r]) * p.gla_gate_w2[(size_t)(dir * 16 + r) * 512 + col];
                const float ls = fminf(z, 0.f) - log1pf(expf(-fabsf(z)));
                sq[tid] = bf2f(pr[col]) * GLA_QS; sk[tid] = bf2f(pr[GQR + col]); sa[tid] = expf(ls * (1.f / 16.f)); }
            else if (tid < 192) sv[tid - 128] = bf2f(pr[GQR + GQK + h * 256 + sl * 64 + tid - 128]);
            __syncthreads();
            const float v = sv[e]; float o = 0.f;
#pragma unroll
            for (int i = 0; i < 16; ++i) { const int d = 16 * w + i; S[i] = sa[d] * S[i] + sk[d] * v; o += sq[d] * S[i]; }
            so[w * 64 + e] = o;
            __syncthreads();
            if (step >= CTX && tid < 64) { float s = 0.f;
#pragma unroll
                for (int q = 0; q < 8; ++q) s += so[q * 64 + tid];
                OUT[(size_t)row * GV + h * 256 + sl * 64 + tid] = (bf16)f2bf(s); }
        }
        __syncthreads();
    }
}

enum Phase { PH_PRO = 0, PH_NORM1_0, PH_QKV, PH_ATTN, PH_OUT0, PH_N2R0, PH_TOPK0, PH_UP0, PH_DN0, PH_COMB0, PH_GLAIN, PH_PREP, PH_SCAN, PH_READ, PH_OUT1, PH_N2R1, PH_TOPK1, PH_UP1, PH_DN1, PH_COMB1, PH_END };

__global__ void __launch_bounds__(NWAVES * 64, 2) k_fwd(P p) {
    extern __shared__ __attribute__((aligned(16))) unsigned char lds[];
    Frame F;
    F.lds = (LAS unsigned char*)lds;
    F.tid = threadIdx.x; F.lane = F.tid & 63; F.wave = __builtin_amdgcn_readfirstlane(F.tid >> 6);
    F.G = gridDim.x; { const int bx = blockIdx.x; F.vcu = (F.G % 8 == 0) ? (bx % 8) * (F.G / 8) + bx / 8 : bx; }
    F.ws = p.ws;
    volatile LAS unsigned* MISC = (volatile LAS unsigned*)(F.lds + MISC_OFF);
    for (int u = F.tid; u < (LDS_BYTES - LDSCTL_OFF) / 4; u += NWAVES * 64) ((LAS unsigned*)(F.lds + LDSCTL_OFF))[u] = 0u;
    __syncthreads();
    const int lo = p.lo, hi = p.hi;
    XcdBarrier bar; bar.bar = (unsigned*)(F.ws + WS_CTL) + CW_BAR; bar.x = 0; bar.st = nullptr;
    if (hi - lo > 1) bar = xcd_barrier_post((unsigned*)(F.ws + WS_CTL) + CW_BAR, MISC + 8);
#define IN(k) (lo <= (k) && (k) < hi)
#define SEAM(k) do { if (IN(k) && IN((k) + 1)) xcd_barrier(bar, F.tid == 0); } while (0)
#define PHASE(k, ...) do { if (IN(k)) { F.lane = (int)__builtin_amdgcn_mbcnt_hi(~0u, __builtin_amdgcn_mbcnt_lo(~0u, 0u)); F.tid = F.wave * 64 + F.lane; __VA_ARGS__; if ((PROBE_MASK >> (k)) & 1) { xcd_barrier(bar, F.tid == 0); __VA_ARGS__; } } SEAM(k); } while (0)
    PHASE(PH_PRO, ph_pro(p, F, (OPT_MASK & 0xff) != 0));
    PHASE(PH_NORM1_0, ph_norm1(p, F, 0));
    PHASE(PH_QKV, {
        pg8::Gemm g{WSP(bf16, WS_H), WSP(bf16, WS_WQKV), D * 2, nullptr}; pg8::TileOrder S; S.init(1, NT / 256, ATT_N / 256, NT / 256, F.G, (int)blockIdx.x);
        pg8::EpiQKV E{WSP(bf16, WS_Q), WSP(bf16, WS_K), WSP(bf16, WS_V), WSP(float, WS_ROPE)};
        pg8::gemm_phase<pg8::EpiQKV, pg8::TileOrder>(F.lds, g, S, E, F.tid);
        BG_SLOT(96, CVT_SPLIT0, CVT_Q1); });
    PHASE(PH_ATTN, { if (OPT_MASK & 256) ph_attn(p, F); else ph_attn_naive(p, F); });
    PHASE(PH_OUT0, {
        pg8::Gemm g{WSP(bf16, WS_O), WSP(bf16, WS_WO0), D * 2, nullptr}; pg8::TileOrder S; S.init(1, NT / 256, D / 256, NT / 256, F.G, (int)blockIdx.x);
        pg8::EpiResid E{p.x, p.ctx, WSP(float, WS_XA), WSP(float, WS_MOD) + 2048};
        pg8::gemm_phase<pg8::EpiResid, pg8::TileOrder>(F.lds, g, S, E, F.tid);
        BG_SLOT(64, CVT_Q1, CVT_Q2); });
    PHASE(PH_N2R0, ph_norm2r(p, F, 0));
    PHASE(PH_TOPK0, ph_topkg(p, F, 0));
    PHASE(PH_UP0, {
        pg8::Gemm g{MOE_FP8 ? (const void*)WSP(unsigned char, WS_H8) : (const void*)WSP(bf16, WS_H), WSP(unsigned char, WS_WUP), D * EB, WSP(int, WS_ROWIDX)}; pg8::TileOrder S; S.init(NE, ESLOTS / 256, FF / 128, ESLOTS / 256, F.G, (int)blockIdx.x);
        pg8::EpiSwiglu E{WSP(unsigned char, WS_ACT)};
        pg8::gemm_phase<pg8::EpiSwiglu, pg8::TileOrder, MOE_FP8 != 0, true, true>(F.lds, g, S, E, F.tid);
        BG_SLOT(192, CVT_Q2, CVT_Q3); });
    PHASE(PH_DN0, {
        pg8::Gemm g{WSP(unsigned char, WS_ACT), WSP(unsigned char, WS_WDN), FF * EB, nullptr}; pg8::TileOrder S; S.init(NE, ESLOTS / 256, D / 256, ESLOTS / 256, F.G, (int)blockIdx.x);
        pg8::EpiDown E{WSP(bf16, WS_YS), WSP(float, WS_ROWG)};
        pg8::gemm_phase<pg8::EpiDown, pg8::TileOrder, MOE_FP8 != 0>(F.lds, g, S, E, F.tid);
        BG_SLOT(128, CVT_Q3, NPAIR_ALL); });
    PHASE(PH_COMB0, ph_combine(p, F, 0));
    PHASE(PH_GLAIN, {
        pg8::Gemm g{WSP(bf16, WS_H), WSP(bf16, WS_WGIN), D * 2, nullptr}; pg8::GlaInOrder S{F.G, (int)blockIdx.x};
        pg8::EpiGlaIn E{WSP(bf16, WS_PG)};
        pg8::gemm_phase<pg8::EpiGlaIn, pg8::GlaInOrder>(F.lds, g, S, E, F.tid); });
    PHASE(PH_PREP, { if (OPT_MASK & 512) ph_glaprep(p, F); });
    PHASE(PH_SCAN, { if (OPT_MASK & 512) ph_glascan(p, F); else ph_scan_naive(p, F); });
    PHASE(PH_READ, ph_readout(p, F));
    PHASE(PH_OUT1, {
        pg8::Gemm g{WSP(bf16, WS_H), WSP(bf16, WS_WO1), D * 2, nullptr}; pg8::TileOrder S; S.init(1, NL / 256, D / 256, NL / 256, F.G, (int)blockIdx.x);
        pg8::EpiResid E{WSP(float, WS_XA), WSP(float, WS_XA), WSP(float, WS_XA), WSP(float, WS_MOD) + 17 * 6144 + 2048};
        pg8::gemm_phase<pg8::EpiResid, pg8::TileOrder>(F.lds, g, S, E, F.tid); });
    PHASE(PH_N2R1, ph_norm2r(p, F, 1));
    PHASE(PH_TOPK1, ph_topkg(p, F, 1));
    PHASE(PH_UP1, {
        pg8::Gemm g{MOE_FP8 ? (const void*)WSP(unsigned char, WS_H8) : (const void*)WSP(bf16, WS_H), WSP(unsigned char, WS_WUP) + (size_t)NE * 5632 * D * EB, D * EB, WSP(int, WS_ROWIDX)}; pg8::TileOrder S; S.init(NE, NB * CAPL / 256, FF / 128, ESLOTS / 256, F.G, (int)blockIdx.x);
        pg8::EpiSwiglu E{WSP(unsigned char, WS_ACT)};
        pg8::gemm_phase<pg8::EpiSwiglu, pg8::TileOrder, MOE_FP8 != 0, true, true>(F.lds, g, S, E, F.tid); });
    PHASE(PH_DN1, {
        pg8::Gemm g{WSP(unsigned char, WS_ACT), WSP(unsigned char, WS_WDN) + (size_t)NE * D * FF * EB, FF * EB, nullptr}; pg8::TileOrder S; S.init(NE, NB * CAPL / 256, D / 256, ESLOTS / 256, F.G, (int)blockIdx.x);
        pg8::EpiDown E{WSP(bf16, WS_YS), WSP(float, WS_ROWG)};
        pg8::gemm_phase<pg8::EpiDown, pg8::TileOrder, MOE_FP8 != 0>(F.lds, g, S, E, F.tid); });
    PHASE(PH_COMB1, ph_combine(p, F, 1));
#undef PHASE
#undef IN
#undef SEAM
}

__global__ void __launch_bounds__(256) n_gemm(const bf16* A, int lda, const float* W, int ldw, float* C, int ldc, int M, int N, int K) {
    __shared__ float As[16][65], Bs[16][64];
    const int t = threadIdx.x, tx = t & 15, ty = t >> 4, m0 = blockIdx.y * 64, n0 = blockIdx.x * 64;
    float acc[4][4];
#pragma unroll
    for (int i = 0; i < 4; ++i)
#pragma unroll
        for (int j = 0; j < 4; ++j) acc[i][j] = 0.f;
    for (int k0 = 0; k0 < K; k0 += 16) {
        { const int r = t >> 2, kq = (t & 3) * 4; const v2u w = *(const v2u*)(A + (size_t)(m0 + r) * lda + k0 + kq);
          As[kq + 0][r] = __uint_as_float(w.x << 16); As[kq + 1][r] = __uint_as_float(w.x & 0xffff0000u); As[kq + 2][r] = __uint_as_float(w.y << 16); As[kq + 3][r] = __uint_as_float(w.y & 0xffff0000u); }
        { const int k = t >> 4, n = (t & 15) * 4;
#pragma unroll
          for (int j = 0; j < 4; ++j) Bs[k][n + j] = (n0 + n + j < N) ? W[(size_t)(k0 + k) * ldw + n0 + n + j] : 0.f; }
        __syncthreads();
#pragma unroll
        for (int kk = 0; kk < 16; ++kk) { float a[4], b[4];
#pragma unroll
            for (int i = 0; i < 4; ++i) { a[i] = As[kk][ty * 4 + i]; b[i] = Bs[kk][tx * 4 + i]; }
#pragma unroll
            for (int i = 0; i < 4; ++i)
#pragma unroll
                for (int j = 0; j < 4; ++j) acc[i][j] += a[i] * b[j]; }
        __syncthreads();
    }
#pragma unroll
    for (int i = 0; i < 4; ++i)
#pragma unroll
        for (int j = 0; j < 4; ++j) if (n0 + tx * 4 + j < N) C[(size_t)(m0 + ty * 4 + i) * ldc + n0 + tx * 4 + j] = acc[i][j];
}
__global__ void n_post_qkv(const float* T, int r0, int rows, bf16* Q, bf16* Kb, bf16* Vb) {
    const size_t i = (size_t)blockIdx.x * blockDim.x + threadIdx.x; if (i >= (size_t)rows * ATT_N) return;
    const int rl = (int)(i / ATT_N), c = (int)(i % ATT_N), r = r0 + rl; float val = T[i];
    if (c < 1280 && r < NL) { const int d = c & 63, a = d >> 5, s = (d >> 4) & 1, f = d & 15, t = r & (SEQ - 1); const float xp = T[(size_t)rl * ATT_N + (s ? c - 16 : c + 16)];
        const float inv = powf(10000.f, -(float)f / 16.f), ang = (float)(a ? (t & 63) : (t >> 6)) * inv, cs = cosf(ang), sn = sinf(ang);
        val = s == 0 ? val * cs - xp * sn : val * cs + xp * sn; }
    if (c < 1024) Q[(size_t)r * 1024 + c] = (bf16)f2bf(val * QSCALE); else if (c < 1280) Kb[(size_t)r * 256 + c - 1024] = (bf16)f2bf(val); else Vb[(size_t)r * 256 + c - 1280] = (bf16)f2bf(val);
}
__global__ void n_post_resid(const float* T, int r0, int rows, const float* xlat, const float* xctx, float* XA, const float* mod_g) {
    const size_t i = (size_t)blockIdx.x * blockDim.x + threadIdx.x; if (i >= (size_t)rows * D) return;
    const int rl = (int)(i / D), c = (int)(i % D), r = r0 + rl; const int j = r < NL ? r / SEQ : 16;
    const float xs = r < NL ? xlat[(size_t)r * D + c] : xctx[(size_t)(r - NL) * D + c];
    XA[(size_t)r * D + c] = xs + mod_g[(size_t)j * 6144 + c] * T[i];
}
__global__ void n_post_swiglu(const float* T, int rows, bf16* ACTrow0) {
    const size_t i = (size_t)blockIdx.x * blockDim.x + threadIdx.x; if (i >= (size_t)rows * FF) return;
    const int rl = (int)(i / FF), f = (int)(i % FF); const float g = T[(size_t)rl * 5632 + f], u = T[(size_t)rl * 5632 + FF + f];
    ACTrow0[(size_t)rl * FF + f] = (bf16)f2bf(silu_f(g) * u);
}
__global__ void n_post_down(const float* T, int rows, bf16* YSrow0, const float* rowg0) {
    const size_t i = (size_t)blockIdx.x * blockDim.x + threadIdx.x; if (i >= (size_t)rows * D) return;
    const int rl = (int)(i / D); YSrow0[i] = (bf16)f2bf(rowg0[rl] * T[i]);
}
__global__ void n_post_cast(const float* T, size_t n, bf16* O) { const size_t i = (size_t)blockIdx.x * blockDim.x + threadIdx.x; if (i < n) O[i] = (bf16)f2bf(T[i]); }
__global__ void __launch_bounds__(256) n_attn(const bf16* Q, const bf16* Kb, const bf16* Vb, const float* sink, bf16* O) {
    const int i = blockIdx.x * blockDim.x + threadIdx.x; if (i >= NT * NQH) return;
    const int r = i >> 4, hq = i & 15, hk = hq >> 2;
    float q[64], acc[64];
#pragma unroll
    for (int d = 0; d < 64; ++d) { q[d] = bf2f(Q[(size_t)r * 1024 + hq * 64 + d]); acc[d] = 0.f; }
    float m = sink[hq] * LOG2E, l = 1.f;
    const bool lat = r < NL; const int b = lat ? r / SEQ : (r - NL) / CTX, t = r & (SEQ - 1);
    const int nlat = lat ? (min(SEQ - 1, t + 128) - max(0, t - 128) + 1) : 0, klo = max(0, t - 128);
    for (int kk = 0; kk < CTX + nlat; ++kk) {
        const int kr = kk < CTX ? NL + b * CTX + kk : b * SEQ + klo + (kk - CTX);
        const bf16* kp = Kb + (size_t)kr * 256 + hk * 64; const bf16* vp = Vb + (size_t)kr * 256 + hk * 64;
        float s = 0.f;
#pragma unroll
        for (int d = 0; d < 64; ++d) s += q[d] * bf2f(kp[d]);
        const float mn = fmaxf(m, s), sc = exp2f(m - mn), pe = exp2f(s - mn);
        l = l * sc + pe; m = mn;
#pragma unroll
        for (int d = 0; d < 64; ++d) acc[d] = acc[d] * sc + pe * bf2f(vp[d]);
    }
    const float il = 1.f / l;
#pragma unroll
    for (int d = 0; d < 64; ++d) O[(size_t)r * 1024 + hq * 64 + d] = (bf16)f2bf(acc[d] * il);
}
__global__ void __launch_bounds__(512) n_glascan(const bf16* PG, const float* w2, const float* gb, bf16* OF, bf16* OB) {
    const int u = blockIdx.x, sl = u & 3, dir = (u >> 2) & 1, h = (u >> 3) & 3, b = u >> 5;
    __shared__ float sq[128], sk[128], sa[128], sv[64], so[8][64];
    const int tid = threadIdx.x, e = tid & 63, w = tid >> 6;
    float S[16];
#pragma unroll
    for (int i = 0; i < 16; ++i) S[i] = 0.f;
    bf16* OUT = dir ? OB : OF;
    for (int step = 0; step < CTX + SEQ; ++step) {
        int row; if (step < CTX) row = NL + b * CTX + (dir ? CTX - 1 - step : step); else { const int t = step - CTX; row = b * SEQ + (dir ? SEQ - 1 - t : t); }
        const bf16* pr = PG + (size_t)row * GIN;
        if (tid < 128) { const int col = h * 128 + tid; float z = gb[dir * 512 + col];
#pragma unroll
            for (int r = 0; r < 16; ++r) z += bf2f(pr[3072 + dir * 16 + r]) * w2[(size_t)(dir * 16 + r) * 512 + col];
            const float ls = fminf(z, 0.f) - log1pf(expf(-fabsf(z)));
            sq[tid] = bf2f(pr[col]) * GLA_QS; sk[tid] = bf2f(pr[GQR + col]); sa[tid] = expf(ls * (1.f / 16.f)); }
        else if (tid < 192) sv[tid - 128] = bf2f(pr[GQR + GQK + h * 256 + sl * 64 + tid - 128]);
        __syncthreads();
        const float v = sv[e]; float o = 0.f;
#pragma unroll
        for (int i = 0; i < 16; ++i) { const int d = 16 * w + i; S[i] = sa[d] * S[i] + sk[d] * v; o += sq[d] * S[i]; }
        so[w][e] = o;
        __syncthreads();
        if (step >= CTX && tid < 64) { float s = 0.f;
#pragma unroll
            for (int q = 0; q < 8; ++q) s += so[q][tid];
            OUT[(size_t)row * GV + h * 256 + sl * 64 + tid] = (bf16)f2bf(s); }
    }
}

static void launch_phase(P p, int lo, int hi, int grid, hipStream_t stream) { p.lo = lo; p.hi = hi; hipLaunchKernelGGL(k_fwd, dim3(grid), dim3(NWAVES * 64), LDS_BYTES, stream, p); }
static void naive_gemm(const bf16* A, int lda, const float* W, int ldw, float* C, int ldc, int M, int N, int K, hipStream_t s) {
    hipLaunchKernelGGL(n_gemm, dim3((N + 63) / 64, M / 64), dim3(256), 0, s, A, lda, W, ldw, C, ldc, M, N, K);
}
#define EW_GRID(n) dim3((unsigned)(((size_t)(n) + 255) / 256)), dim3(256), 0, stream

extern "C" void kernel_launch(void* const* d_in, const int* in_sizes, int n_in, void* d_out, int out_size, void* d_ws, size_t ws_size, hipStream_t stream) {
    static int grid = 0;
    if (grid == 0) {
        if (n_in != 21 || out_size != NL * D || ws_size < WS_END) { fprintf(stderr, "kernel_launch: unexpected shapes (n_in %d out %d ws %zu need %zu)\n", n_in, out_size, ws_size, (size_t)WS_END); grid = -1; return; }
        int dev = 0, cus = 0;
        if (hipGetDevice(&dev) != hipSuccess || hipDeviceGetAttribute(&cus, hipDeviceAttributeMultiprocessorCount, dev) != hipSuccess) { grid = -1; return; }
        if (hipFuncSetAttribute((const void*)k_fwd, hipFuncAttributeMaxDynamicSharedMemorySize, LDS_BYTES) != hipSuccess) { fprintf(stderr, "kernel_launch: hipFuncSetAttribute failed\n"); grid = -1; return; }
        int per_cu = 0;
        if (hipOccupancyMaxActiveBlocksPerMultiprocessor(&per_cu, (const void*)k_fwd, NWAVES * 64, LDS_BYTES) != hipSuccess || per_cu < 1) fprintf(stderr, "kernel_launch: occupancy query says %d\n", per_cu);
        (void)hipGetLastError();
        grid = cus;
    }
    if (grid < 0) return;
    hipMemsetAsync((char*)d_ws + WS_CTL, 0, CTL_ZERO_BYTES, stream);
    P p{};
    const float** pp = (const float**)&p;
    for (int i = 0; i < 21; ++i) pp[i] = (const float*)d_in[i];
    p.out = (float*)d_out; p.ws = (unsigned char*)d_ws; p.lo = 0; p.hi = 0;
    unsigned char* ws = (unsigned char*)d_ws;
#define WS(T, off) ((T*)(ws + (off)))
#if ONE_LAUNCH
    launch_phase(p, 0, PH_END, grid, stream);
#else
    float* TMP = WS(float, WS_TMP);
    launch_phase(p, PH_PRO, PH_PRO + 1, grid, stream);
    launch_phase(p, PH_NORM1_0, PH_NORM1_0 + 1, grid, stream);
    if (OPT_MASK & 1) launch_phase(p, PH_QKV, PH_QKV + 1, grid, stream);
    else for (int ch = 0; ch < NT / 2048; ++ch) { const int r0 = ch * 2048;
        naive_gemm(WS(bf16, WS_H) + (size_t)r0 * D, D, p.attn_w_in, ATT_N, TMP, ATT_N, 2048, ATT_N, D, stream);
        hipLaunchKernelGGL(n_post_qkv, EW_GRID((size_t)2048 * ATT_N), TMP, r0, 2048, WS(bf16, WS_Q), WS(bf16, WS_K), WS(bf16, WS_V)); }
    if (OPT_MASK & 256) launch_phase(p, PH_ATTN, PH_ATTN + 1, grid, stream);
    else hipLaunchKernelGGL(n_attn, dim3(NT * NQH / 256), dim3(256), 0, stream, WS(bf16, WS_Q), WS(bf16, WS_K), WS(bf16, WS_V), p.attn_sink, WS(bf16, WS_O));
    if (OPT_MASK & 2) launch_phase(p, PH_OUT0, PH_OUT0 + 1, grid, stream);
    else for (int ch = 0; ch < NT / 2048; ++ch) { const int r0 = ch * 2048;
        naive_gemm(WS(bf16, WS_O) + (size_t)r0 * D, D, p.attn_w_out, D, TMP, D, 2048, D, D, stream);
        hipLaunchKernelGGL(n_post_resid, EW_GRID((size_t)2048 * D), TMP, r0, 2048, p.x, p.ctx, WS(float, WS_XA), WS(float, WS_MOD) + 2048); }
    launch_phase(p, PH_N2R0, PH_N2R0 + 1, grid, stream);
    launch_phase(p, PH_TOPK0, PH_TOPK0 + 1, grid, stream);
    for (int l = 0; l < 2; ++l) {
        if (l == 1) {
            if (OPT_MASK & 16) launch_phase(p, PH_GLAIN, PH_GLAIN + 1, grid, stream);
            else for (int ch = 0; ch < NT / 2048; ++ch) { const int r0 = ch * 2048;
                naive_gemm(WS(bf16, WS_H) + (size_t)r0 * D, D, p.gla_w_in, GIN, TMP, GIN, 2048, GIN, D, stream);
                hipLaunchKernelGGL(n_post_cast, EW_GRID((size_t)2048 * GIN), TMP, (size_t)2048 * GIN, WS(bf16, WS_PG) + (size_t)r0 * GIN); }
            if (OPT_MASK & 512) launch_phase(p, PH_SCAN, PH_SCAN + 1, grid, stream);
            else hipLaunchKernelGGL(n_glascan, dim3(512), dim3(512), 0, stream, WS(bf16, WS_PG), p.gla_gate_w2, p.gla_gate_b, WS(bf16, WS_OF), WS(bf16, WS_OB));
            launch_phase(p, PH_READ, PH_READ + 1, grid, stream);
            if (OPT_MASK & 32) launch_phase(p, PH_OUT1, PH_OUT1 + 1, grid, stream);
            else for (int ch = 0; ch < NL / 2048; ++ch) { const int r0 = ch * 2048;
                naive_gemm(WS(bf16, WS_H) + (size_t)r0 * D, D, p.gla_w_out, D, TMP, D, 2048, D, D, stream);
                hipLaunchKernelGGL(n_post_resid, EW_GRID((size_t)2048 * D), TMP, r0, 2048, WS(float, WS_XA), WS(float, WS_XA), WS(float, WS_XA), WS(float, WS_MOD) + 17 * 6144 + 2048); }
            launch_phase(p, PH_N2R1, PH_N2R1 + 1, grid, stream);
            launch_phase(p, PH_TOPK1, PH_TOPK1 + 1, grid, stream);
        }
        const int rows_e = l == 0 ? ESLOTS : NB * CAPL, chunk = l == 0 ? 2304 : 2048;
        const bool up_opt = OPT_MASK & (l == 0 ? 4 : 64), dn_opt = OPT_MASK & (l == 0 ? 8 : 128);
        if (up_opt && dn_opt) { launch_phase(p, l == 0 ? PH_UP0 : PH_UP1, (l == 0 ? PH_UP0 : PH_UP1) + 1, grid, stream); launch_phase(p, l == 0 ? PH_DN0 : PH_DN1, (l == 0 ? PH_DN0 : PH_DN1) + 1, grid, stream); }
        else {
            if (up_opt) launch_phase(p, l == 0 ? PH_UP0 : PH_UP1, (l == 0 ? PH_UP0 : PH_UP1) + 1, grid, stream);
            else for (int e = 0; e < NE; ++e) for (int r0 = 0; r0 < rows_e; r0 += chunk) {
                const size_t row = (size_t)e * ESLOTS + r0; const size_t le = (size_t)(l * NE + e);
                naive_gemm(WS(bf16, WS_XG) + row * D, D, p.exp_w_gate + le * D * FF, FF, TMP, 5632, chunk, FF, D, stream);
                naive_gemm(WS(bf16, WS_XG) + row * D, D, p.exp_w_up + le * D * FF, FF, TMP + FF, 5632, chunk, FF, D, stream);
                hipLaunchKernelGGL(n_post_swiglu, EW_GRID((size_t)chunk * FF), TMP, chunk, WS(bf16, WS_ACT) + row * FF); }
            if (dn_opt) launch_phase(p, l == 0 ? PH_DN0 : PH_DN1, (l == 0 ? PH_DN0 : PH_DN1) + 1, grid, stream);
            else for (int e = 0; e < NE; ++e) for (int r0 = 0; r0 < rows_e; r0 += chunk) {
                const size_t row = (size_t)e * ESLOTS + r0; const size_t le = (size_t)(l * NE + e);
                naive_gemm(WS(bf16, WS_ACT) + row * FF, FF, p.exp_w_down + le * FF * D, D, TMP, D, chunk, D, FF, stream);
                hipLaunchKernelGGL(n_post_down, EW_GRID((size_t)chunk * D), TMP, chunk, WS(bf16, WS_YS) + row * D, WS(float, WS_ROWG) + row); }
        }
        launch_phase(p, l == 0 ? PH_COMB0 : PH_COMB1, (l == 0 ? PH_COMB0 : PH_COMB1) + 1, grid, stream);
    }
#endif
}
```

```cpp
#include <hip/hip_runtime.h>
#include <cstdio>
#include <cstdint>

#ifndef OPT_MASK
#define OPT_MASK 0x3FF
#endif
#ifndef MOE_FP8
#define MOE_FP8 1
#endif
#ifndef PROBE_MASK
#define PROBE_MASK 0
#endif
#ifndef ONE_LAUNCH
#define ONE_LAUNCH 1
#endif

#define GAS __attribute__((address_space(1)))
#define LAS __attribute__((address_space(3)))
typedef unsigned short bf16;
typedef unsigned v4u __attribute__((ext_vector_type(4)));
typedef unsigned v2u __attribute__((ext_vector_type(2)));
typedef float f32x4 __attribute__((ext_vector_type(4)));
typedef float f32x2 __attribute__((ext_vector_type(2)));
typedef short bf16x8 __attribute__((ext_vector_type(8)));

constexpr int D = 1024, NB = 16, SEQ = 2048, CTX = 256;
constexpr int NL = NB * SEQ, NC = NB * CTX, NT = NL + NC;
constexpr int NQH = 16, NKV = 4, HD = 64, ATT_N = 1536;
constexpr int GH = 4, GDK = 128, GDV = 256, GQK = 512, GV = 1024, GQR = 1536, GIN = 3104, GIN_PAD = 3328;
constexpr int NE = 16, FF = 2816, CAPL = 256, CAPC = 32, ESLOTS = NB * CAPL + NB * CAPC;
constexpr float EPS = 1e-6f;
constexpr float LOG2E = 1.4426950408889634f;
constexpr float QSCALE = 0.125f * LOG2E;
constexpr float GLA_QS = 0.08838834764831845f;
constexpr int EB = MOE_FP8 ? 1 : 2;
constexpr float F8_ACT = 16.f, F8_W = 256.f, F8_INV = 1.f / (16.f * 256.f);

constexpr size_t MiB = 1ull << 20;
constexpr size_t WS_CTL = 0, CTL_ZERO_BYTES = 1 * MiB;
constexpr size_t WS_MOD = 1 * MiB;
constexpr size_t WS_ROPE = WS_MOD + 896 * 1024;
constexpr size_t WS_WQKV = 2 * MiB;
constexpr size_t WS_WO0 = 5 * MiB;
constexpr size_t WS_WGIN = 7 * MiB;
constexpr size_t WS_WO1 = 14 * MiB;
constexpr size_t WS_AFF = 16 * MiB;
constexpr size_t WS_SLOT = 19 * MiB;
constexpr size_t WS_ROWIDX = 22 * MiB;
constexpr size_t WS_ROWG = 22 * MiB + 512 * 1024;
constexpr size_t WS_WUP = 24 * MiB;
constexpr size_t WS_WDN = WS_WUP + 352 * MiB;
constexpr size_t WS_XA = WS_WDN + 176 * MiB;
constexpr size_t WS_H = WS_XA + 144 * MiB;
constexpr size_t WS_E = WS_H + 72 * MiB;
constexpr size_t WS_Q = WS_E, WS_K = WS_E + 72 * MiB, WS_V = WS_E + 90 * MiB, WS_O = WS_E + 108 * MiB;
constexpr size_t WS_PG = WS_E, WS_OF = WS_E + 220 * MiB, WS_OB = WS_E + 284 * MiB;
constexpr size_t WS_QT = WS_E + 348 * MiB, WS_KT = WS_E + 420 * MiB, WS_DEC = WS_E + 492 * MiB;
constexpr size_t WS_XG = WS_E, WS_YS = WS_E, WS_ACT = WS_E + 144 * MiB;
constexpr size_t WS_H8 = WS_E;
constexpr size_t WS_TMP = WS_E + 540 * MiB;
constexpr size_t WS_END = WS_TMP + 50 * MiB;
constexpr int CW_BAR = 4096;

constexpr int RING_BYTES = 131072;
constexpr int LDS_BYTES = 147456;
constexpr int LDSCTL_OFF = LDS_BYTES - 1024, MISC_OFF = LDSCTL_OFF + 320;
constexpr int NWAVES = 8;

__device__ __forceinline__ float bf2f(bf16 v) { return __uint_as_float(((unsigned)v) << 16); }
typedef __bf16 hwbf16x2 __attribute__((ext_vector_type(2)));
__device__ __forceinline__ unsigned pk2(float lo, float hi) { const f32x2 v = {lo, hi}; return __builtin_bit_cast(unsigned, __builtin_convertvector(v, hwbf16x2)); }
__device__ __forceinline__ unsigned f2bf(float f) { return pk2(f, 0.f) & 0xffffu; }
__device__ __forceinline__ float clamp448(float v) { return __builtin_fminf(__builtin_fmaxf(v, -448.f), 448.f); }
__device__ __forceinline__ unsigned pk4_fp8(float a, float b, float c, float d) { int w = 0; w = __builtin_amdgcn_cvt_pk_fp8_f32(clamp448(a), clamp448(b), w, false); w = __builtin_amdgcn_cvt_pk_fp8_f32(clamp448(c), clamp448(d), w, true); return (unsigned)w; }
template <int CTRL, int RMASK> __device__ __forceinline__ float dpp_add(float x) { return x + __builtin_bit_cast(float, __builtin_amdgcn_update_dpp(0, __builtin_bit_cast(int, x), CTRL, RMASK, 0xf, false)); }
__device__ __forceinline__ float wave_sum(float v) {
    v = dpp_add<0xB1, 0xf>(v);
    v = dpp_add<0x4E, 0xf>(v);
    v = dpp_add<0x141, 0xf>(v);
    v = dpp_add<0x140, 0xf>(v);
    v = dpp_add<0x142, 0xa>(v);
    v = dpp_add<0x143, 0xc>(v);
    return __builtin_bit_cast(float, __builtin_amdgcn_readlane(__builtin_bit_cast(int, v), 63));
}
__device__ __forceinline__ float silu_f(float v) { return v / (1.f + expf(-v)); }
__device__ __forceinline__ float fexp(float x) { return __builtin_amdgcn_exp2f(x * LOG2E); }
__device__ __forceinline__ float flog(float x) { return __builtin_amdgcn_logf(x) * 0.6931471805599453f; }
__device__ __forceinline__ float fsilu(float v) { return v * __builtin_amdgcn_rcpf(1.f + fexp(-v)); }
template <int d> __device__ __forceinline__ float dpp_shr(float x) { return __builtin_bit_cast(float, __builtin_amdgcn_update_dpp(0, __builtin_bit_cast(int, x), 0x110 + d, 0xf, 0xf, true)); }
#define LDS_WAIT() asm volatile("s_waitcnt lgkmcnt(0)" ::: "memory")
#define LDS_SYNC() asm volatile("s_waitcnt lgkmcnt(0)\n\ts_barrier" ::: "memory")
#define VM_WAIT() asm volatile("s_waitcnt vmcnt(0)" ::: "memory")

struct P {
    const float *x, *c, *ctx, *c_ctx, *ada_w, *ada_b, *norm1_g, *norm2_g, *attn_w_in, *attn_w_out, *attn_sink,
        *gla_w_in, *gla_gate_w2, *gla_gate_b, *gla_norm_g, *gla_w_out, *router_w, *exp_w_gate, *exp_w_up, *exp_w_down, *final_norm_g;
    float* out; unsigned char* ws;
    int lo, hi;
};

namespace pg8 {
#define PG8_LAS __attribute__((address_space(3)))
typedef unsigned short bf16_t;
typedef unsigned u32x4 __attribute__((ext_vector_type(4)));
typedef unsigned u32x2 __attribute__((ext_vector_type(2)));
constexpr int BM = 256, BK = 64, HALF = 128, HTB = HALF * BK * 2, STAGE_BYTES = 8 * HTB, NXCD = 8, WGM = 8;
__host__ __device__ __forceinline__ int lds_byte(int r, int c) { const int st = (r >> 4) * 2 + (c >> 5), rr = r & 15, cc = c & 31, ob = rr * 64 + cc * 2; return st * 1024 + (ob ^ (((ob >> 9) & 1) << 5)); }
__host__ __device__ __forceinline__ void stage_rc(int b, int& R, int& C) { const int st = b / 1024, sb = b % 1024, swz = sb ^ (((sb >> 9) & 1) << 5); R = (st >> 1) * 16 + swz / 64; C = (st & 1) * 32 + (swz % 64) / 2; }
__host__ __device__ __forceinline__ int perm32(int rho) { const int n = rho >> 4, i = rho & 15; return 8 * (i >> 2) + 4 * n + (i & 3); }
struct Unit { int pm, pn; };
struct Gemm { const void* A; const void* Bt; int KB; const int* gidx; };
struct TileOrder {
    int nG, nM, nN, sM, G, c, per, nwg;
    __device__ __forceinline__ void init(int nG_, int nM_, int nN_, int sM_, int G_, int c_) { nG = nG_; nM = nM_; nN = nN_; sM = sM_; G = G_; c = c_; per = nM * nN; nwg = nG * per; }
    __device__ __forceinline__ bool next(int i, Unit& u) const {
        const long L = (long)i * G + c; if (L >= nwg) return false;
        int wgid = (int)L; { const int q = nwg / NXCD, r = nwg % NXCD, xcd = wgid % NXCD, off = wgid / NXCD; wgid = (xcd < r ? xcd * (q + 1) : r * (q + 1) + (xcd - r) * q) + off; }
        const int g = wgid / per, rem = wgid % per;
        const int nig = WGM * nN, gid = rem / nig, fm = gid * WGM, gsz = (nM - fm) < WGM ? (nM - fm) : WGM;
        u.pm = g * sM + fm + ((rem % nig) % gsz); u.pn = g * nN + (rem % nig) / gsz; return true;
    }
};
struct GlaInOrder {
    int G, c;
    __device__ __forceinline__ bool next(int i, Unit& u) const {
        constexpr int NLAT = (NL / BM) * 13, NALL = NLAT + (NC / BM) * 7;
        const long L = (long)i * G + c; if (L >= NALL) return false;
        int wgid = (int)L; { const int q = NALL / NXCD, xcd = wgid % NXCD, off = wgid / NXCD; wgid = xcd * q + off; }
        if (wgid < NLAT) { const int nig = WGM * 13, gid = wgid / nig, fm = gid * WGM; u.pm = fm + ((wgid % nig) % WGM); u.pn = (wgid % nig) / WGM; }
        else { const int r = wgid - NLAT; u.pm = NL / BM + (r & 15); u.pn = 6 + (r >> 4); }
        return true;
    }
};
__device__ __forceinline__ unsigned cvt_pk_bf16(float lo, float hi) { unsigned r; asm volatile("v_cvt_pk_bf16_f32 %0, %1, %2" : "=v"(r) : "v"(lo), "v"(hi)); return r; }

struct EpiQKV {
    static constexpr bool PERM = false;
    bf16_t *Q, *Kb, *Vb; const float* rope;
    __device__ __forceinline__ void operator()(const f32x4 (&acc)[2][2][4][2], const Unit& u, int wr, int wc, int fr, int fq) const {
        const int row0 = u.pm * BM + wr * 64 + fr; const bool latent = u.pm < (NL / BM);
        const int kind = u.pn < 4 ? 0 : (u.pn == 4 ? 1 : 2);
        const size_t boff = (kind >= 1 ? (size_t)(WS_K - WS_Q) / 2 : 0) + (kind == 2 ? (size_t)(WS_V - WS_K) / 2 : 0);
        bf16_t* base = Q + boff; const int ldc = kind == 0 ? 1024 : 256; const int colt = kind == 0 ? u.pn * BM : 0;
        const float sc = kind == 0 ? QSCALE : 1.f;
        f32x4 rc0[2][4], rc1[2][4];
#pragma unroll
        for (int ai = 0; ai < 2; ++ai)
#pragma unroll
            for (int m = 0; m < 4; ++m) { const int t = (row0 + ai * HALF + m * 16) & (SEQ - 1);
                rc0[ai][m] = (f32x4){1.f, 0.f, 1.f, 0.f}; rc1[ai][m] = rc0[ai][m];
                if (latent && kind != 2) { const int pos = (wc & 1) ? (t & 63) : (t >> 6); const f32x4* tp = (const f32x4*)(rope + (size_t)(pos * 16 + 4 * fq) * 2); rc0[ai][m] = tp[0]; rc1[ai][m] = tp[1]; } }
#pragma unroll
        for (int ai = 0; ai < 2; ++ai)
#pragma unroll
            for (int m = 0; m < 4; ++m) {
                const int r = row0 + ai * HALF + m * 16;
                const f32x4 cs0 = rc0[ai][m], cs1 = rc1[ai][m];
                const float cs[4] = {cs0[0], cs0[2], cs1[0], cs1[2]}, sn[4] = {cs0[1], cs0[3], cs1[1], cs1[3]};
                bf16_t* rowp = base + (size_t)r * ldc + colt + wc * 32 + 4 * fq;
#pragma unroll
                for (int bj = 0; bj < 2; ++bj) {
                    const f32x4 x0 = acc[ai][bj][m][0], x1 = acc[ai][bj][m][1]; float o0[4], o1[4];
#pragma unroll
                    for (int j = 0; j < 4; ++j) { o0[j] = (x0[j] * cs[j] - x1[j] * sn[j]) * sc; o1[j] = (x1[j] * cs[j] + x0[j] * sn[j]) * sc; }
                    u32x2 w0, w1; w0.x = cvt_pk_bf16(o0[0], o0[1]); w0.y = cvt_pk_bf16(o0[2], o0[3]); w1.x = cvt_pk_bf16(o1[0], o1[1]); w1.y = cvt_pk_bf16(o1[2], o1[3]);
                    *(u32x2*)(rowp + bj * HALF) = w0; *(u32x2*)(rowp + bj * HALF + 16) = w1;
                }
            }
    }
};
struct EpiResid {
    static constexpr bool PERM = false;
    const float *xlat, *xctx; float* XA; const float* mod_g;
    __device__ __forceinline__ void operator()(const f32x4 (&acc)[2][2][4][2], const Unit& u, int wr, int wc, int fr, int fq) const {
        const int row0 = u.pm * BM + wr * 64 + fr, col0 = u.pn * BM + wc * 32 + 4 * fq; const bool latent = u.pm < (NL / BM);
        const float* src = latent ? xlat : xctx - (size_t)NL * D; const int j = latent ? (u.pm >> 3) : 16;
        f32x4 gv[2][2];
#pragma unroll
        for (int bj = 0; bj < 2; ++bj)
#pragma unroll
            for (int n = 0; n < 2; ++n) gv[bj][n] = *(const f32x4*)(mod_g + (size_t)j * 6144 + col0 + bj * HALF + n * 16);
#pragma unroll
        for (int ai = 0; ai < 2; ++ai)
#pragma unroll
            for (int mp = 0; mp < 2; ++mp) { f32x4 xs[2][2][2];
#pragma unroll
                for (int mm = 0; mm < 2; ++mm) { const size_t off = (size_t)(row0 + ai * HALF + (2 * mp + mm) * 16) * D + col0;
#pragma unroll
                    for (int bj = 0; bj < 2; ++bj)
#pragma unroll
                        for (int n = 0; n < 2; ++n) xs[mm][bj][n] = *(const f32x4*)(src + off + bj * HALF + n * 16); }
                asm volatile("" : "+v"(xs[0][0][0]), "+v"(xs[0][0][1]), "+v"(xs[0][1][0]), "+v"(xs[0][1][1]), "+v"(xs[1][0][0]), "+v"(xs[1][0][1]), "+v"(xs[1][1][0]), "+v"(xs[1][1][1]) :: "memory");
#pragma unroll
                for (int mm = 0; mm < 2; ++mm) { const size_t off = (size_t)(row0 + ai * HALF + (2 * mp + mm) * 16) * D + col0;
#pragma unroll
                    for (int bj = 0; bj < 2; ++bj)
#pragma unroll
                        for (int n = 0; n < 2; ++n) *(f32x4*)(XA + off + bj * HALF + n * 16) = xs[mm][bj][n] + gv[bj][n] * acc[ai][bj][2 * mp + mm][n]; }
                asm volatile("" ::: "memory"); }
    }
};
struct EpiSwiglu {
    static constexpr bool PERM = true;
    unsigned char* ACT;
    __device__ __forceinline__ void operator()(const f32x4 (&acc)[2][2][4][2], const Unit& u, int wr, int wc, int fr, int fq) const {
        const int row0 = u.pm * BM + wr * 64 + fr, nl = u.pn % (FF / 128), col0 = nl * 128 + wc * 32 + 8 * fq;
        const float sin_ = MOE_FP8 ? F8_INV : 1.f, sout = MOE_FP8 ? F8_ACT : 1.f;
#pragma unroll
        for (int ai = 0; ai < 2; ++ai)
#pragma unroll
            for (int m = 0; m < 4; ++m) { float o[8];
#pragma unroll
                for (int n = 0; n < 2; ++n)
#pragma unroll
                    for (int j = 0; j < 4; ++j) { const float g = acc[ai][0][m][n][j] * sin_, up = acc[ai][1][m][n][j] * sin_; o[n * 4 + j] = g * __builtin_amdgcn_rcpf(1.f + __builtin_amdgcn_exp2f(g * -1.4426950408889634f)) * (up * sout); }
                unsigned char* dst = ACT + ((size_t)(row0 + ai * HALF + m * 16) * FF + col0) * EB;
                if (MOE_FP8) { u32x2 w; w.x = pk4_fp8(o[0], o[1], o[2], o[3]); w.y = pk4_fp8(o[4], o[5], o[6], o[7]); *(u32x2*)dst = w; }
                else { u32x4 w; w.x = cvt_pk_bf16(o[0], o[1]); w.y = cvt_pk_bf16(o[2], o[3]); w.z = cvt_pk_bf16(o[4], o[5]); w.w = cvt_pk_bf16(o[6], o[7]); *(u32x4*)dst = w; } }
    }
};
struct EpiDown {
    static constexpr bool PERM = true;
    bf16_t* YS; const float* rowg;
    __device__ __forceinline__ void operator()(const f32x4 (&acc)[2][2][4][2], const Unit& u, int wr, int wc, int fr, int fq) const {
        const int row0 = u.pm * BM + wr * 64 + fr, col0 = (u.pn & 3) * BM + wc * 32 + 8 * fq;
        float gr[2][4];
#pragma unroll
        for (int ai = 0; ai < 2; ++ai)
#pragma unroll
            for (int m = 0; m < 4; ++m) gr[ai][m] = rowg[row0 + ai * HALF + m * 16];
#pragma unroll
        for (int ai = 0; ai < 2; ++ai)
#pragma unroll
            for (int m = 0; m < 4; ++m) { const int r = row0 + ai * HALF + m * 16; const float g = gr[ai][m] * (MOE_FP8 ? F8_INV : 1.f);
#pragma unroll
                for (int bj = 0; bj < 2; ++bj) { const f32x4 v0 = acc[ai][bj][m][0] * g, v1 = acc[ai][bj][m][1] * g;
                    u32x4 w; w.x = cvt_pk_bf16(v0[0], v0[1]); w.y = cvt_pk_bf16(v0[2], v0[3]); w.z = cvt_pk_bf16(v1[0], v1[1]); w.w = cvt_pk_bf16(v1[2], v1[3]);
                    *(u32x4*)(YS + (size_t)r * D + col0 + bj * HALF) = w; } }
    }
};
struct EpiGlaIn {
    static constexpr bool PERM = true;
    bf16_t* PG;
    __device__ __forceinline__ void operator()(const f32x4 (&acc)[2][2][4][2], const Unit& u, int wr, int wc, int fr, int fq) const {
        const int row0 = u.pm * BM + wr * 64 + fr, col0 = u.pn * BM + wc * 32 + 8 * fq;
#pragma unroll
        for (int ai = 0; ai < 2; ++ai)
#pragma unroll
            for (int m = 0; m < 4; ++m) { const int r = row0 + ai * HALF + m * 16;
#pragma unroll
                for (int bj = 0; bj < 2; ++bj) { const f32x4 v0 = acc[ai][bj][m][0], v1 = acc[ai][bj][m][1];
                    u32x4 w; w.x = cvt_pk_bf16(v0[0], v0[1]); w.y = cvt_pk_bf16(v0[2], v0[3]); w.z = cvt_pk_bf16(v1[0], v1[1]); w.w = cvt_pk_bf16(v1[2], v1[3]);
                    if (col0 + bj * HALF < GIN) *(u32x4*)(PG + (size_t)r * GIN + col0 + bj * HALF) = w; } }
    }
};

typedef int v8i __attribute__((ext_vector_type(8)));
typedef int v4i __attribute__((ext_vector_type(4)));
__device__ __forceinline__ v8i cat8(bf16x8 lo, bf16x8 hi) { return __builtin_shufflevector(__builtin_bit_cast(v4i, lo), __builtin_bit_cast(v4i, hi), 0, 1, 2, 3, 4, 5, 6, 7); }
template <class Epi, class Sched, bool FP8 = false, bool ALIGN_EPI = true, bool GATHER = false>
__device__ __forceinline__ void gemm_phase(PG8_LAS unsigned char* lds, const Gemm g, const Sched& S, const Epi& E, const int tid) {
    const int wid = __builtin_amdgcn_readfirstlane(tid >> 6), lane = tid & 63, wr = wid >> 2, wc = wid & 3, fr = lane & 15, fq = lane >> 4;
    const int KB = g.KB, nt = KB / 128;
    unsigned voffA, voffB; int Rl, Cb;
    { int R, C; stage_rc(tid * 16, R, C); const int Rb = Epi::PERM ? ((R & ~31) + perm32(R & 31)) : R; voffA = (unsigned)(R * KB + C * 2); voffB = (unsigned)(Rb * KB + C * 2); Rl = R; Cb = C * 2; }
    unsigned gA[2][2], gN[2][2]; constexpr int GOFF = STAGE_BYTES;
    const unsigned r64 = 64u * (unsigned)KB;
    const unsigned kstep = 128u;
    const unsigned hstep = (unsigned)(HALF * KB);
    const unsigned tstep = 2u * hstep;
    const __amdgpu_buffer_rsrc_t rsA = __builtin_amdgcn_make_buffer_rsrc(const_cast<void*>(g.A), 0, 0x7fffffff, 0x00020000), rsB = __builtin_amdgcn_make_buffer_rsrc(const_cast<void*>(g.Bt), 0, 0x7fffffff, 0x00020000);
    const unsigned ldsw = (unsigned)wid * 1024u;
    const int aoff = lds_byte(wr * 64 + fr, fq * 8), boff = lds_byte(wc * 32 + fr, fq * 8);
    const int sw8 = (fr * 64 + (fq & 1) * 32) ^ (((fr >> 3) & 1) << 5);
    const int a8off = (wr * 8 + (fq >> 1)) * 1024 + sw8, b8off = (wc * 4 + (fq >> 1)) * 1024 + sw8;
#define PG8_SA(b, h) (((b) * 2 + (h)) * HTB)
#define PG8_SB(b, h) ((4 + (b) * 2 + (h)) * HTB)
#define PG8_STAGE(bufoff, rs, soff, voff) do { _Pragma("unroll") for (int _i = 0; _i < 2; ++_i) \
        __builtin_amdgcn_raw_ptr_buffer_load_lds(rs, (PG8_LAS void*)(lds + (bufoff) + ldsw + _i * 8192), 16, (int)(voff), (int)((soff) + _i * r64), 0, 0); } while (0)
#define PG8_STAGE_A(bufoff, h, soff, kofs, gsel) do { if constexpr (GATHER) { _Pragma("unroll") for (int _i = 0; _i < 2; ++_i) \
        __builtin_amdgcn_raw_ptr_buffer_load_lds(rsA, (PG8_LAS void*)(lds + (bufoff) + ldsw + _i * 8192), 16, (int)(gsel)[h][_i], (int)(kofs), 0, 0); } else PG8_STAGE(bufoff, rsA, soff, voffA); } while (0)
#define PG8_LDA(dst, b, h) do { _Pragma("unroll") for (int m = 0; m < 4; ++m) { if constexpr (FP8) dst##8[m] = cat8(*(const PG8_LAS bf16x8*)(lds + PG8_SA(b, h) + aoff + m * 2048), *(const PG8_LAS bf16x8*)(lds + PG8_SA(b, h) + aoff + m * 2048 + 1024)); \
        else { _Pragma("unroll") for (int k = 0; k < 2; ++k) dst[m][k] = *(const PG8_LAS bf16x8*)(lds + PG8_SA(b, h) + aoff + m * 2048 + k * 1024); } } } while (0)
#define PG8_LDB(dst, b, h) do { _Pragma("unroll") for (int n = 0; n < 2; ++n) { if constexpr (FP8) dst##8[n] = cat8(*(const PG8_LAS bf16x8*)(lds + PG8_SB(b, h) + boff + n * 2048), *(const PG8_LAS bf16x8*)(lds + PG8_SB(b, h) + boff + n * 2048 + 1024)); \
        else { _Pragma("unroll") for (int k = 0; k < 2; ++k) dst[n][k] = *(const PG8_LAS bf16x8*)(lds + PG8_SB(b, h) + boff + n * 2048 + k * 1024); } } } while (0)
#define PG8_MMA8(ai, bj, At, Bt) asm volatile("s_nop 1\n\t" \
        "v_mfma_scale_f32_16x16x128_f8f6f4 %0, %8, %10, %0, %14, %14 op_sel_hi:[0,0,0]\n\t" "v_mfma_scale_f32_16x16x128_f8f6f4 %1, %9, %10, %1, %14, %14 op_sel_hi:[0,0,0]\n\t" \
        "v_mfma_scale_f32_16x16x128_f8f6f4 %2, %8, %11, %2, %14, %14 op_sel_hi:[0,0,0]\n\t" "v_mfma_scale_f32_16x16x128_f8f6f4 %3, %9, %11, %3, %14, %14 op_sel_hi:[0,0,0]\n\t" \
        "v_mfma_scale_f32_16x16x128_f8f6f4 %4, %8, %12, %4, %14, %14 op_sel_hi:[0,0,0]\n\t" "v_mfma_scale_f32_16x16x128_f8f6f4 %5, %9, %12, %5, %14, %14 op_sel_hi:[0,0,0]\n\t" \
        "v_mfma_scale_f32_16x16x128_f8f6f4 %6, %8, %13, %6, %14, %14 op_sel_hi:[0,0,0]\n\t" "v_mfma_scale_f32_16x16x128_f8f6f4 %7, %9, %13, %7, %14, %14 op_sel_hi:[0,0,0]" \
        : "+v"(acc[ai][bj][0][0]), "+v"(acc[ai][bj][0][1]), "+v"(acc[ai][bj][1][0]), "+v"(acc[ai][bj][1][1]), "+v"(acc[ai][bj][2][0]), "+v"(acc[ai][bj][2][1]), "+v"(acc[ai][bj][3][0]), "+v"(acc[ai][bj][3][1]) \
        : "v"(Bt##8[0]), "v"(Bt##8[1]), "v"(At##8[0]), "v"(At##8[1]), "v"(At##8[2]), "v"(At##8[3]), "v"(scl8))
#define PG8_MMA(ai, bj, At, Bt) do { __builtin_amdgcn_s_setprio(1); if constexpr (FP8) { PG8_MMA8(ai, bj, At, Bt); } else { \
        _Pragma("unroll") for (int m = 0; m < 4; ++m) _Pragma("unroll") for (int n = 0; n < 2; ++n) _Pragma("unroll") for (int k = 0; k < 2; ++k) \
        acc[ai][bj][m][n] = __builtin_amdgcn_mfma_f32_16x16x32_bf16(Bt[n][k], At[m][k], acc[ai][bj][m][n], 0, 0, 0); } __builtin_amdgcn_s_setprio(0); } while (0)
#define PG8_WAIT_V(n) asm volatile("s_waitcnt vmcnt(" #n ")" ::: "memory")
#define PG8_WAIT_L(n) asm volatile("s_waitcnt lgkmcnt(" #n ")" ::: "memory")
#define PG8_BAR __builtin_amdgcn_s_barrier()
#define PG8_SCHED __builtin_amdgcn_sched_barrier(0)
    Unit cur, nxt; int ui = 0;
    if (!S.next(0, cur)) return;
    f32x4 acc[2][2][4][2];
#pragma unroll
    for (int a = 0; a < 2; ++a)
#pragma unroll
        for (int b = 0; b < 2; ++b)
#pragma unroll
            for (int m = 0; m < 4; ++m)
#pragma unroll
                for (int n = 0; n < 2; ++n) acc[a][b][m][n] = (f32x4){0.f, 0.f, 0.f, 0.f};
    int scl8 = 0x7f7f7f7f; asm volatile("" : "+v"(scl8));
    bf16x8 At[4][2], B0[2][2], B1[2][2]; v8i At8[4], B08[2], B18[2];
    unsigned cA = (unsigned)cur.pm * tstep, cB = (unsigned)cur.pn * tstep;
    if constexpr (GATHER) {
#pragma unroll
        for (int h = 0; h < 2; ++h)
#pragma unroll
            for (int i = 0; i < 2; ++i) { gA[h][i] = (unsigned)g.gidx[cur.pm * 256 + h * 128 + Rl + 64 * i] * (unsigned)KB + (unsigned)Cb; gN[h][i] = gA[h][i]; } }
    {
        PG8_STAGE(PG8_SB(0, 0), rsB, cB, voffB); PG8_STAGE(PG8_SB(0, 1), rsB, cB + hstep, voffB); PG8_STAGE_A(PG8_SA(0, 0), 0, cA, 0, gA); PG8_STAGE_A(PG8_SA(0, 1), 1, cA + hstep, 0, gA);
        if (wr == 1) PG8_BAR;
        PG8_WAIT_V(2); PG8_BAR;
        PG8_STAGE(PG8_SB(1, 0), rsB, cB + kstep, voffB); PG8_STAGE_A(PG8_SA(1, 0), 0, cA + kstep, kstep, gA); PG8_STAGE(PG8_SB(1, 1), rsB, cB + hstep + kstep, voffB);
        PG8_WAIT_V(6); PG8_BAR;
    }
    for (;;) {
        const bool has_next = S.next(ui + 1, nxt);
        const unsigned nA = has_next ? (unsigned)nxt.pm * tstep : cA, nB = has_next ? (unsigned)nxt.pn * tstep : cB;
        for (int t = 0; t < nt; t += 2) {
            const bool last = (t == nt - 2);
            const unsigned a1 = cA + (unsigned)(t + 1) * kstep;
            const unsigned a2 = last ? nA : cA + (unsigned)(t + 2) * kstep, b2 = last ? nB : cB + (unsigned)(t + 2) * kstep;
            const unsigned a3 = a2 + kstep, b3 = b2 + kstep;
            const unsigned k1 = (unsigned)(t + 1) * kstep, k2 = last ? 0u : (unsigned)(t + 2) * kstep, k3 = k2 + kstep;
            if constexpr (GATHER) {
                if (t == 0 && has_next && wid == 0) __builtin_amdgcn_global_load_lds((const unsigned*)(g.gidx + nxt.pm * 256 + lane * 4), (PG8_LAS unsigned*)(lds + GOFF + ((ui + 1) & 1) * 1024), 16, 0, 0);
                if (last && has_next) {
#pragma unroll
                    for (int h = 0; h < 2; ++h)
#pragma unroll
                        for (int i = 0; i < 2; ++i) gN[h][i] = (unsigned)*(const PG8_LAS int*)(lds + GOFF + ((ui + 1) & 1) * 1024 + (h * 128 + Rl + 64 * i) * 4) * (unsigned)KB + (unsigned)Cb; } }
            unsigned gS[2][2];
#pragma unroll
            for (int h = 0; h < 2; ++h)
#pragma unroll
                for (int i = 0; i < 2; ++i) gS[h][i] = last ? gN[h][i] : gA[h][i];
            PG8_LDB(B0, 0, 0); PG8_LDB(B1, 0, 1); PG8_SCHED; PG8_LDA(At, 0, 0); PG8_STAGE_A(PG8_SA(1, 1), 1, a1 + hstep, k1, gA);
            PG8_WAIT_V(8); PG8_WAIT_L(0); PG8_BAR; PG8_MMA(0, 0, At, B0); PG8_MMA(0, 1, At, B1); PG8_BAR; PG8_SCHED;
            PG8_LDA(At, 0, 1); PG8_STAGE(PG8_SB(0, 0), rsB, b2, voffB); PG8_STAGE(PG8_SB(0, 1), rsB, b2 + hstep, voffB); PG8_STAGE_A(PG8_SA(0, 0), 0, a2, k2, gS);
            PG8_WAIT_V(8); PG8_WAIT_L(0); PG8_BAR; PG8_MMA(1, 0, At, B0); PG8_MMA(1, 1, At, B1); PG8_BAR; PG8_SCHED;
            PG8_LDB(B0, 1, 0); PG8_LDB(B1, 1, 1); PG8_SCHED; PG8_LDA(At, 1, 0); PG8_STAGE_A(PG8_SA(0, 1), 1, a2 + hstep, k2, gS);
            PG8_WAIT_V(8); PG8_WAIT_L(0); PG8_BAR; PG8_MMA(0, 0, At, B0); PG8_MMA(0, 1, At, B1); PG8_BAR; PG8_SCHED;
            PG8_LDA(At, 1, 1); PG8_STAGE(PG8_SB(1, 0), rsB, b3, voffB); PG8_STAGE(PG8_SB(1, 1), rsB, b3 + hstep, voffB); PG8_STAGE_A(PG8_SA(1, 0), 0, a3, k3, gS);
            PG8_WAIT_V(8); PG8_WAIT_L(0); PG8_BAR; PG8_MMA(1, 0, At, B0); PG8_MMA(1, 1, At, B1); PG8_BAR; PG8_SCHED;
        }
        if constexpr (ALIGN_EPI) { if (wr == 0) PG8_BAR; }
        if constexpr (FP8) asm volatile("s_nop 15\n\ts_nop 15" ::: "memory");
        E(acc, cur, wr, wc, fr, fq);
        if (!has_next) break;
#pragma unroll
        for (int a = 0; a < 2; ++a)
#pragma unroll
            for (int b = 0; b < 2; ++b)
#pragma unroll
                for (int m = 0; m < 4; ++m)
#pragma unroll
                    for (int n = 0; n < 2; ++n) acc[a][b][m][n] = (f32x4){0.f, 0.f, 0.f, 0.f};
        cur = nxt; cA = nA; cB = nB; ++ui;
        if constexpr (GATHER) {
#pragma unroll
            for (int h = 0; h < 2; ++h)
#pragma unroll
                for (int i = 0; i < 2; ++i) gA[h][i] = gN[h][i]; }
        if constexpr (ALIGN_EPI) { if (wr == 1) PG8_BAR; }
    }
    PG8_WAIT_V(0);
    if constexpr (!ALIGN_EPI) { if (wr == 0) PG8_BAR; }
    PG8_BAR;
#undef PG8_STAGE_A
#undef PG8_SA
#undef PG8_SB
#undef PG8_STAGE
#undef PG8_LDA
#undef PG8_LDB
#undef PG8_MMA
#undef PG8_WAIT_V
#undef PG8_WAIT_L
#undef PG8_BAR
#undef PG8_SCHED
}
}

#define XB_TMO      128
#define XB_XCNT(j)  (256  + 64 * (j))
#define XB_XSUB(j)  (1280 + 64 * (j))
#define XB_XGEN(j)  (2304 + 64 * (j))
#define XB_TOP      3328
#define XB_TOPGEN   3392
#define XCD_BAR_WORDS 3456
#define XB_SPIN_CAP (1u << 18)
__device__ __forceinline__ unsigned xb_ld(unsigned* p)              { return __hip_atomic_load(p, __ATOMIC_RELAXED, __HIP_MEMORY_SCOPE_AGENT); }
__device__ __forceinline__ unsigned xb_add(unsigned* p, unsigned v) { return __hip_atomic_fetch_add(p, v, __ATOMIC_RELAXED, __HIP_MEMORY_SCOPE_AGENT); }
__device__ __forceinline__ unsigned xb_xcc_id() { return (unsigned)__builtin_amdgcn_s_getreg((3 << 11) | 20) & 0xFu; }
#define XB_SPIN(cond, bar) do { unsigned _sp = 0; while (cond) { __builtin_amdgcn_s_sleep(1); \
    if ((++_sp & 255u) == 0u) { if (xb_ld(&(bar)[XB_TMO])) break; if (_sp > XB_SPIN_CAP) { atomicAdd(&(bar)[XB_TMO], 1u); break; } } } } while (0)
struct XcdBarrier { unsigned* bar; unsigned x; volatile LAS unsigned* st; };
__device__ __forceinline__ XcdBarrier xcd_barrier_post(unsigned* bar, volatile LAS unsigned* st) {
    XcdBarrier b; b.bar = bar; b.x = xb_xcc_id(); b.st = st;
    if (threadIdx.x == 0) (void)xb_add(&bar[XB_XCNT(b.x)], 1u);
    return b;
}
__device__ __forceinline__ void xcd_barrier_complete(unsigned* bar, unsigned x, unsigned& nloc, unsigned& nx) {
    const unsigned G = gridDim.x * gridDim.y * gridDim.z;
    unsigned sum, cnt, mine, sp = 0u;
    for (;;) {
        sum = 0u; cnt = 0u; mine = 0u;
#pragma unroll
        for (unsigned j = 0; j < 16; ++j) { const unsigned c = xb_ld(&bar[XB_XCNT(j)]); sum += c; cnt += (c > 0u) ? 1u : 0u; mine = (j == x) ? c : mine; }
        if (sum == G) break;
        __builtin_amdgcn_s_sleep(1);
        if ((++sp & 255u) == 0u) { if (xb_ld(&bar[XB_TMO])) break; if (sp > XB_SPIN_CAP) { atomicAdd(&bar[XB_TMO], 1u); break; } }
    }
    nloc = mine > 0u ? mine : 1u; nx = cnt > 0u ? cnt : 1u;
}
__device__ __forceinline__ void xcd_barrier(const XcdBarrier& b, const bool thread0) {
    asm volatile("s_waitcnt vmcnt(0)" ::: "memory");
    __syncthreads();
    if (thread0) {
        unsigned* bar = b.bar;
        __builtin_amdgcn_s_waitcnt(0);
        unsigned nloc = b.st[0], nx = b.st[1];
        if (nloc == 0u) { xcd_barrier_complete(bar, b.x, nloc, nx); b.st[0] = nloc; b.st[1] = nx; }
        const unsigned old = xb_add(&bar[XB_XSUB(b.x)], 1u);
        const unsigned gen = old / nloc;
        if (old + 1u == (gen + 1u) * nloc) {
            __builtin_amdgcn_fence(__ATOMIC_RELEASE, "agent");
            asm volatile("s_waitcnt vmcnt(0)" ::: "memory");
            const unsigned og = xb_add(&bar[XB_TOP], 1u);
            const unsigned tg = og / nx;
            if (og + 1u == (tg + 1u) * nx) xb_add(&bar[XB_TOPGEN], 1u);
            else XB_SPIN(xb_ld(&bar[XB_TOPGEN]) == tg, bar);
            __builtin_amdgcn_fence(__ATOMIC_ACQUIRE, "agent");
            xb_add(&bar[XB_XGEN(b.x)], 1u);
            asm volatile("s_waitcnt vmcnt(0)" ::: "memory");
        } else {
            XB_SPIN(xb_ld(&bar[XB_XGEN(b.x)]) == gen, bar);
            __builtin_amdgcn_fence(__ATOMIC_ACQUIRE, "agent");
            asm volatile("s_waitcnt vmcnt(0)" ::: "memory");
        }
    }
    __syncthreads();
}

struct Frame {
    LAS unsigned char* lds;
    int tid, lane, wave, vcu, G;
    unsigned char* ws;
};
#define WSP(T, off) ((T*)(F.ws + (off)))

__device__ __forceinline__ void cvt_item(const float* W, int ldw, int nvalid, int k0, int n0, bf16* WT, int ldt, int drow0, LAS float* scr, int lane) {
    const int c4 = lane & 15, kr = lane >> 4;
    f32x4 v[16];
#pragma unroll
    for (int i = 0; i < 16; ++i) { const int r = 4 * i + kr; v[i] = (4 * c4 < nvalid) ? *(const GAS f32x4*)(W + (size_t)(k0 + r) * ldw + n0 + 4 * c4) : (f32x4){0.f, 0.f, 0.f, 0.f}; }
#pragma unroll
    for (int i = 0; i < 16; ++i) { const int r = 4 * i + kr; LAS float* s = scr + r * 65 + 4 * c4; s[0] = v[i][0]; s[1] = v[i][1]; s[2] = v[i][2]; s[3] = v[i][3]; }
    LDS_WAIT(); asm volatile("" ::: "memory");
    const int c = lane & 7;
#pragma unroll
    for (int j = 0; j < 8; ++j) { const int n = (lane >> 3) + 8 * j; const LAS float* s = scr + (8 * c) * 65 + n;
        v4u o; o.x = pk2(s[0 * 65], s[1 * 65]); o.y = pk2(s[2 * 65], s[3 * 65]); o.z = pk2(s[4 * 65], s[5 * 65]); o.w = pk2(s[6 * 65], s[7 * 65]);
        if (n < nvalid) *(GAS v4u*)(WT + (size_t)(drow0 + n) * ldt + k0 + 8 * c) = o; }
    LDS_WAIT(); asm volatile("" ::: "memory");
}

__device__ __forceinline__ void cvt8_load(const float* W, int ldw, int k0, int n0, f32x4 (&v)[16], int lane) {
    const int c4 = lane & 15, kr = lane >> 4;
#pragma unroll
    for (int i = 0; i < 16; ++i) v[i] = __builtin_nontemporal_load((const GAS f32x4*)(W + (size_t)(k0 + 4 * i + kr) * ldw + n0 + 4 * c4));
}
__device__ __forceinline__ void cvt8_finish(const f32x4 (&v)[16], int k0, unsigned char* WT, int ldt, int drow0, float scale, LAS float* scr, int lane) {
    const int c4 = lane & 15, kr = lane >> 4;
#pragma unroll
    for (int i = 0; i < 16; ++i) { const int r = 4 * i + kr; LAS float* s = scr + r * 65 + 4 * c4; s[0] = v[i][0]; s[1] = v[i][1]; s[2] = v[i][2]; s[3] = v[i][3]; }
    LDS_WAIT(); asm volatile("" ::: "memory");
    const int c = lane & 3;
#pragma unroll
    for (int j = 0; j < 4; ++j) { const int n = (lane >> 2) + 16 * j; const LAS float* s = scr + (16 * c) * 65 + n;
        v4u o;
        o.x = pk4_fp8(s[0 * 65] * scale, s[1 * 65] * scale, s[2 * 65] * scale, s[3 * 65] * scale); o.y = pk4_fp8(s[4 * 65] * scale, s[5 * 65] * scale, s[6 * 65] * scale, s[7 * 65] * scale);
        o.z = pk4_fp8(s[8 * 65] * scale, s[9 * 65] * scale, s[10 * 65] * scale, s[11 * 65] * scale); o.w = pk4_fp8(s[12 * 65] * scale, s[13 * 65] * scale, s[14 * 65] * scale, s[15 * 65] * scale);
        *(GAS v4u*)(WT + (size_t)(drow0 + n) * ldt + k0 + 16 * c) = o; }
    LDS_WAIT(); asm volatile("" ::: "memory");
}
struct ExpItem { const float* W; int ldw, k0, n0, ldt, drow0; unsigned char* WT; };
__device__ __forceinline__ ExpItem exp_item(const P& p, unsigned char* ws, int q, int half) {
    ExpItem e; const int le = q / 1056, rr = q % 1056, mk = rr / 352, ii = rr % 352;
    if (mk < 2) { const int kb2 = ii / 44, nb = ii % 44; e.n0 = 64 * nb; e.k0 = 64 * (2 * kb2 + half); e.W = (mk == 0 ? p.exp_w_gate : p.exp_w_up) + (size_t)le * D * FF; e.ldw = FF; e.ldt = D; e.drow0 = (e.n0 >> 7) * 256 + mk * 128 + (e.n0 & 127); e.WT = ws + WS_WUP + (size_t)le * 5632 * D; }
    else { const int kb2 = ii / 16, nb = ii % 16; e.n0 = 64 * nb; e.k0 = 64 * (2 * kb2 + half); e.W = p.exp_w_down + (size_t)le * FF * D; e.ldw = D; e.ldt = FF; e.drow0 = e.n0; e.WT = ws + WS_WDN + (size_t)le * D * FF; }
    return e;
}
constexpr int NPAIR_ALL = 32 * 1056;
__device__ __forceinline__ void cvt_pairs(const P& p, unsigned char* ws, LAS float* scr, int qfirst, int qstep, int qend, int lane) {
    f32x4 va[16], vb[16]; int q = qfirst;
    if (q < qend) { const ExpItem e = exp_item(p, ws, q, 0); cvt8_load(e.W, e.ldw, e.k0, e.n0, va, lane); }
    while (q < qend) {
        const ExpItem e0 = exp_item(p, ws, q, 0), e1 = exp_item(p, ws, q, 1);
        cvt8_load(e1.W, e1.ldw, e1.k0, e1.n0, vb, lane);
        cvt8_finish(va, e0.k0, e0.WT, e0.ldt, e0.drow0, F8_W, scr, lane);
        const int q2 = q + qstep;
        if (q2 < qend) { const ExpItem e2 = exp_item(p, ws, q2, 0); cvt8_load(e2.W, e2.ldw, e2.k0, e2.n0, va, lane); }
        cvt8_finish(vb, e1.k0, e1.WT, e1.ldt, e1.drow0, F8_W, scr, lane);
        q = q2;
    }
}
#ifndef BG_QKV
#define BG_QKV 2560
#define BG_OUT0 6144
#define BG_UP0 512
#define BG_DN0 4096
#endif
constexpr int CVT_Q3 = NPAIR_ALL - BG_DN0, CVT_Q2 = CVT_Q3 - BG_UP0, CVT_Q1 = CVT_Q2 - BG_OUT0, CVT_SPLIT0 = CVT_Q1 - BG_QKV;
static_assert(CVT_Q2 >= NPAIR_ALL / 2 && CVT_SPLIT0 >= 0, "the slices behind the layer-0 MoE must stay inside layer 1");
#define BG_SLOT(first, qb, qe) do { if (MOE_FP8 && F.G == 256 && (int)blockIdx.x >= (first) && (qb) < (qe)) { __syncthreads(); \
    cvt_pairs(p, F.ws, (LAS float*)(F.lds + F.wave * 16640), (qb) + ((int)blockIdx.x - (first)) * 8 + F.wave, (256 - (first)) * 8, (qe), F.lane); } } while (0)
__device__ __forceinline__ void ph_pro(const P& p, Frame& F, bool do_cvt) {
    float* MOD = WSP(float, WS_MOD); float* ROPE = WSP(float, WS_ROPE);
    if (F.vcu == 255 % F.G) {
        for (int i = F.tid; i < 1024; i += 512) { const int pos = i >> 4, f = i & 15; const float inv = powf(10000.f, -(float)f / 16.f); const float ang = (float)pos * inv; ROPE[2 * i] = cosf(ang); ROPE[2 * i + 1] = sinf(ang); }
    }
    if (F.vcu < 192) {
        LAS float* ssrc = (LAS float*)F.lds; LAS float* red = (LAS float*)(F.lds + 69632);
        for (int i = F.tid; i < 17 * 1024; i += 512) { const int j = i >> 10, k = i & 1023; const float v = (j < 16) ? p.c[j * 1024 + k] : p.c_ctx[k]; ssrc[i] = silu_f(v); }
        __syncthreads();
        for (int u = F.vcu; u < 192; u += F.G) {
            const int l = u / 96, c0 = (u % 96) * 64, col = c0 + (F.tid & 63), ks = F.tid >> 6;
            const float* w = p.ada_w + ((size_t)l * 1024 + ks * 128) * 6144 + col;
            float acc[17];
#pragma unroll
            for (int j = 0; j < 17; ++j) acc[j] = 0.f;
            for (int k = 0; k < 128; k += 4) {
                const float w0 = w[(size_t)(k + 0) * 6144], w1 = w[(size_t)(k + 1) * 6144], w2 = w[(size_t)(k + 2) * 6144], w3 = w[(size_t)(k + 3) * 6144];
#pragma unroll
                for (int j = 0; j < 17; ++j) { const f32x4 s = *(const LAS f32x4*)(ssrc + j * 1024 + ks * 128 + k); acc[j] += s[0] * w0 + s[1] * w1 + s[2] * w2 + s[3] * w3; }
            }
#pragma unroll
            for (int j = 0; j < 17; ++j) red[(ks * 17 + j) * 64 + (F.tid & 63)] = acc[j];
            __syncthreads();
            for (int i = F.tid; i < 17 * 64; i += 512) { const int j = i >> 6, c = i & 63; float s = p.ada_b[l * 6144 + c0 + c];
#pragma unroll
                for (int q = 0; q < 8; ++q) s += red[(q * 17 + j) * 64 + c];
                MOD[(size_t)(l * 17 + j) * 6144 + c0 + c] = s; }
            __syncthreads();
        }
    }
    if (do_cvt) {
        __syncthreads();
        LAS float* scr = (LAS float*)(F.lds + F.wave * 16640);
        const int gw = F.vcu * NWAVES + F.wave, NGW = F.G * NWAVES;
        constexpr int I_QKV = 16 * 24, I_O = 16 * 16, I_GIN = 16 * 49, I_SMALL = I_QKV + I_O + I_GIN + I_O, I_E = 704, I_LE = 3 * I_E, NITEMS = I_SMALL + 32 * I_LE;
        for (int it = gw; it < I_SMALL; it += NGW) {
            int r = it;
            if (r < I_QKV) { cvt_item(p.attn_w_in, ATT_N, 64, 64 * (r / 24), 64 * (r % 24), WSP(bf16, WS_WQKV), D, 64 * (r % 24), scr, F.lane); continue; } r -= I_QKV;
            if (r < I_O) { cvt_item(p.attn_w_out, D, 64, 64 * (r / 16), 64 * (r % 16), WSP(bf16, WS_WO0), D, 64 * (r % 16), scr, F.lane); continue; } r -= I_O;
            if (r < I_GIN) { const int nb = r % 49; cvt_item(p.gla_w_in, GIN, nb == 48 ? 32 : 64, 64 * (r / 49), 64 * nb, WSP(bf16, WS_WGIN), D, 64 * nb, scr, F.lane); continue; } r -= I_GIN;
            cvt_item(p.gla_w_out, D, 64, 64 * (r / 16), 64 * (r % 16), WSP(bf16, WS_WO1), D, 64 * (r % 16), scr, F.lane);
        }
        constexpr int NEXP = 32 * I_LE;
        if (MOE_FP8) {
            cvt_pairs(p, F.ws, scr, gw, NGW, F.G == 256 ? CVT_SPLIT0 : NPAIR_ALL, F.lane);
        } else {
            for (int r = gw; r < NEXP; r += NGW) {
                const int le = r / I_LE, rr = r % I_LE, mk = rr / I_E, ii = rr % I_E;
                if (mk < 2) { const int kb = ii / 44, nb = ii % 44, n0 = 64 * nb; const float* W = (mk == 0 ? p.exp_w_gate : p.exp_w_up) + (size_t)le * D * FF; const int dr = (n0 >> 7) * 256 + mk * 128 + (n0 & 127);
                    cvt_item(W, FF, 64, 64 * kb, n0, WSP(bf16, WS_WUP) + (size_t)le * 5632 * D, D, dr, scr, F.lane); }
                else { const int kb = ii / 16, nb = ii % 16; cvt_item(p.exp_w_down + (size_t)le * FF * D, D, 64, 64 * kb, 64 * nb, WSP(bf16, WS_WDN) + (size_t)le * D * FF, FF, 64 * nb, scr, F.lane); }
            }
        }
        { v4u* z = (v4u*)(WSP(bf16, WS_WGIN) + (size_t)GIN * D); const int n16 = (GIN_PAD - GIN) * D * 2 / 16;
          for (int i = F.vcu * 512 + F.tid; i < n16; i += F.G * 512) z[i] = (v4u){0u, 0u, 0u, 0u}; }
    }
}

__device__ __forceinline__ void norm_mod_store(const f32x4 (&v)[4], float rstd, const float* g, const float* sh, const float* sc, bf16* orow, int lane) {
    f32x4 gv[4], shv[4], scv[4];
#pragma unroll
    for (int j = 0; j < 4; ++j) { const int c = 4 * (lane + 64 * j); gv[j] = *(const f32x4*)(g + c); shv[j] = *(const f32x4*)(sh + c); scv[j] = *(const f32x4*)(sc + c); }
#pragma unroll
    for (int j = 0; j < 4; ++j) { const int c = 4 * (lane + 64 * j);
        const f32x4 y = (v[j] * rstd * gv[j]) * (scv[j] + 1.f) + shv[j]; v2u o; o.x = pk2(y[0], y[1]); o.y = pk2(y[2], y[3]); *(v2u*)(orow + c) = o; }
}
__device__ __forceinline__ void ph_norm1(const P& p, Frame& F, int l) {
    const float* MOD = WSP(float, WS_MOD); bf16* H = WSP(bf16, WS_H); const float* XA = WSP(float, WS_XA);
    const int gw = F.vcu * NWAVES + F.wave, NGW = F.G * NWAVES; constexpr int RW = 3;
    f32x4 gv[4];
#pragma unroll
    for (int q = 0; q < 4; ++q) gv[q] = *(const f32x4*)(p.norm1_g + l * D + 4 * (F.lane + 64 * q));
    for (int r0 = gw; r0 < NT; r0 += RW * NGW) {
        f32x4 v[RW][4], shv[RW][4], scv[RW][4];
#pragma unroll
        for (int h = 0; h < RW; ++h) { const int r = r0 + h * NGW < NT ? r0 + h * NGW : r0;
            const float* xr = (l == 0) ? (r < NL ? p.x + (size_t)r * D : p.ctx + (size_t)(r - NL) * D) : XA + (size_t)r * D;
            const int j = r < NL ? r / SEQ : 16; const float* mr = MOD + (size_t)(l * 17 + j) * 6144;
#pragma unroll
            for (int q = 0; q < 4; ++q) { const int c = 4 * (F.lane + 64 * q); v[h][q] = *(const f32x4*)(xr + c); shv[h][q] = *(const f32x4*)(mr + c); scv[h][q] = *(const f32x4*)(mr + 1024 + c); } }
#pragma unroll
        for (int h = 0; h < RW; ++h) { const int r = r0 + h * NGW; if (r >= NT) break; float s = 0.f;
#pragma unroll
            for (int q = 0; q < 4; ++q) s += (v[h][q][0] * v[h][q][0] + v[h][q][1] * v[h][q][1]) + (v[h][q][2] * v[h][q][2] + v[h][q][3] * v[h][q][3]);
            const float rstd = 1.f / sqrtf(wave_sum(s) * (1.f / D) + EPS);
            bf16* orow = H + (size_t)r * D;
#pragma unroll
            for (int q = 0; q < 4; ++q) { const f32x4 y = (v[h][q] * rstd * gv[q]) * (scv[h][q] + 1.f) + shv[h][q]; v2u o; o.x = pk2(y[0], y[1]); o.y = pk2(y[2], y[3]); *(v2u*)(orow + 4 * (F.lane + 64 * q)) = o; } }
    }
}
__device__ __forceinline__ void ph_norm2r(const P& p, Frame& F, int l) {
    const float* MOD = WSP(float, WS_MOD); bf16* H = WSP(bf16, WS_H); const float* XA = WSP(float, WS_XA); float* AFF = WSP(float, WS_AFF);
    constexpr int HT = 1028;
    LAS float* rw = (LAS float*)F.lds; LAS float* h2t = (LAS float*)(F.lds + 65536); LAS float* part = (LAS float*)(F.lds + 65536 + 16 * HT * 4);
    for (int i = F.tid; i < D * NE / 4; i += 512) ((LAS f32x4*)rw)[i] = ((const f32x4*)(p.router_w + (size_t)l * D * NE))[i];
    const int ntile = (l == 0 ? NT : NL) / 16, lane = F.lane, w = F.wave;
    const float *g = p.norm2_g + l * D;
    f32x4 v[2][4], gq[4];
#pragma unroll
    for (int q = 0; q < 4; ++q) gq[q] = *(const f32x4*)(g + 4 * (lane + 64 * q));
    if (F.vcu < ntile) {
#pragma unroll
        for (int h = 0; h < 2; ++h)
#pragma unroll
            for (int q = 0; q < 4; ++q) v[h][q] = *(const f32x4*)(XA + (size_t)(F.vcu * 16 + 2 * w + h) * D + 4 * (lane + 64 * q)); }
    __syncthreads();
    for (int tile = F.vcu; tile < ntile; tile += F.G) {
        const int r0 = tile * 16;
        f32x4 shq[4], scq[4];
        { const int j = r0 < NL ? r0 / SEQ : 16; const float* mr = MOD + (size_t)(l * 17 + j) * 6144;
#pragma unroll
          for (int q = 0; q < 4; ++q) { shq[q] = *(const f32x4*)(mr + 3072 + 4 * (lane + 64 * q)); scq[q] = *(const f32x4*)(mr + 4096 + 4 * (lane + 64 * q)); } }
#pragma unroll
        for (int h = 0; h < 2; ++h) { const int r = r0 + 2 * w + h; float s = 0.f;
#pragma unroll
            for (int q = 0; q < 4; ++q) s += (v[h][q][0] * v[h][q][0] + v[h][q][1] * v[h][q][1]) + (v[h][q][2] * v[h][q][2] + v[h][q][3] * v[h][q][3]);
            const float rstd = 1.f / sqrtf(wave_sum(s) * (1.f / D) + EPS);
            bf16* orow = H + (size_t)r * D;
#pragma unroll
            for (int q = 0; q < 4; ++q) { const int c = 4 * (lane + 64 * q); const f32x4 gv = gq[q], shv = shq[q], scv = scq[q];
                const f32x4 y = (v[h][q] * rstd * gv) * (scv + 1.f) + shv;
                if (MOE_FP8) *(unsigned*)(WSP(unsigned char, WS_H8) + (size_t)r * D + c) = pk4_fp8(y[0] * F8_ACT, y[1] * F8_ACT, y[2] * F8_ACT, y[3] * F8_ACT);
                else { v2u o; o.x = pk2(y[0], y[1]); o.y = pk2(y[2], y[3]); *(v2u*)(orow + c) = o; }
                *(LAS f32x4*)(h2t + (2 * w + h) * HT + c) = y; } }
        if (tile + F.G < ntile) {
#pragma unroll
            for (int h = 0; h < 2; ++h)
#pragma unroll
                for (int q = 0; q < 4; ++q) v[h][q] = *(const f32x4*)(XA + (size_t)((tile + F.G) * 16 + 2 * w + h) * D + 4 * (lane + 64 * q)); }
        LDS_SYNC();
        { f32x4 acc = (f32x4){0.f, 0.f, 0.f, 0.f}; const int i16 = lane & 15, kq = lane >> 4;
#pragma unroll 8
          for (int it = 0; it < 32; ++it) { const int k = 128 * w + 4 * it + kq; acc = __builtin_amdgcn_mfma_f32_16x16x4f32(h2t[i16 * HT + k], rw[k * 16 + i16], acc, 0, 0, 0); }
#pragma unroll
          for (int r = 0; r < 4; ++r) part[(w * 16 + 4 * kq + r) * 16 + i16] = acc[r]; }
        LDS_SYNC();
        if (F.tid < 256) { const int i = F.tid >> 4, e = F.tid & 15; float a = 0.f;
#pragma unroll
            for (int w2 = 0; w2 < 8; ++w2) a += part[(w2 * 16 + i) * 16 + e];
            float m = a;
#pragma unroll
            for (int o = 1; o < 16; o <<= 1) m = fmaxf(m, __shfl_xor(m, o));
            const float pe = expf(a - m); float ssum = pe;
#pragma unroll
            for (int o = 1; o < 16; o <<= 1) ssum += __shfl_xor(ssum, o);
            AFF[(size_t)(r0 + i) * 16 + e] = pe / ssum; }
    }
    __syncthreads();
}
__device__ __forceinline__ void ph_topkg(const P& p, Frame& F, int l) {
    const float* AFF = WSP(float, WS_AFF); int* SLOT = WSP(int, WS_SLOT); int* ROWIDX = WSP(int, WS_ROWIDX); float* ROWG = WSP(float, WS_ROWG);
    const bf16* H = WSP(bf16, WS_H); bf16* XG = WSP(bf16, WS_XG);
    LAS int* hist = (LAS int*)F.lds;
    LAS int* sel = hist + 256;
    LAS int* wtot = sel + 256;
    LAS int* shr = wtot + 8;
    const int nunits = l == 0 ? 512 : 256, tid = F.tid, lane = F.lane;
    for (int u = F.vcu; u < nunits; u += F.G) {
        const bool lat = u < 256; const int b = (u & 255) >> 4, e = u & 15;
        const int L = lat ? SEQ : CTX, cap = lat ? CAPL : CAPC, row0 = lat ? b * SEQ : NL + b * CTX, s0 = lat ? b * CAPL : NB * CAPL + b * CAPC;
        unsigned key[4]; const bool act = 4 * tid < L;
#pragma unroll
        for (int q = 0; q < 4; ++q) key[q] = act ? __float_as_uint(AFF[(size_t)(row0 + 4 * tid + q) * 16 + e]) : 0u;
        unsigned prefix = 0u; int kk = cap;
#pragma unroll
        for (int pass = 0; pass < 4; ++pass) { const int shift = 24 - 8 * pass;
            if (tid < 256) hist[tid] = 0;
            LDS_SYNC();
            if (act) {
#pragma unroll
                for (int q = 0; q < 4; ++q) { const bool cand = pass == 0 ? true : ((key[q] >> (shift + 8)) == (prefix >> (shift + 8))); if (cand) __hip_atomic_fetch_add(&hist[(key[q] >> shift) & 255u], 1, __ATOMIC_RELAXED, __HIP_MEMORY_SCOPE_WORKGROUP); } }
            LDS_SYNC();
            if (F.wave == 0) { const int h0 = hist[4 * lane], h1 = hist[4 * lane + 1], h2 = hist[4 * lane + 2], h3 = hist[4 * lane + 3]; const int tot = h0 + h1 + h2 + h3;
                int suf = tot;
#pragma unroll
                for (int o = 1; o < 64; o <<= 1) { const int t = __shfl_down(suf, o); if (lane + o < 64) suf += t; }
                int above = suf - tot;
                if (above < kk && kk <= above + h3) { shr[0] = 4 * lane + 3; shr[1] = above; } above += h3;
                if (above < kk && kk <= above + h2) { shr[0] = 4 * lane + 2; shr[1] = above; } above += h2;
                if (above < kk && kk <= above + h1) { shr[0] = 4 * lane + 1; shr[1] = above; } above += h1;
                if (above < kk && kk <= above + h0) { shr[0] = 4 * lane + 0; shr[1] = above; } }
            LDS_SYNC();
            prefix |= (unsigned)shr[0] << shift; kk -= shr[1];
        }
        const int n_gt = cap - kk;
        int cg = 0, ce = 0;
#pragma unroll
        for (int q = 0; q < 4; ++q) { cg += (act && key[q] > prefix) ? 1 : 0; ce += (act && key[q] == prefix) ? 1 : 0; }
        int pk = cg | (ce << 16), inc = pk;
#pragma unroll
        for (int o = 1; o < 64; o <<= 1) { const int t = __shfl_up(inc, o); if (lane >= o) inc += t; }
        if (lane == 63) wtot[F.wave] = inc;
        LDS_SYNC();
        int base = 0;
#pragma unroll
        for (int w2 = 0; w2 < 8; ++w2) base += (w2 < F.wave) ? wtot[w2] : 0;
        int ex = base + inc - pk; int rg = ex & 0xffff, re = ex >> 16;
        if (act) {
#pragma unroll
            for (int q = 0; q < 4; ++q) { const int row = row0 + 4 * tid + q; int s = -1;
                if (key[q] > prefix) { s = rg; ++rg; } else if (key[q] == prefix) { if (re < kk) s = n_gt + re; ++re; }
                if (s >= 0) { ROWIDX[e * ESLOTS + s0 + s] = row; ROWG[e * ESLOTS + s0 + s] = __uint_as_float(key[q]); sel[s] = row; s += s0; }
                SLOT[(size_t)row * 16 + e] = s; } }
        LDS_SYNC();
    }
}
__device__ __forceinline__ void ph_combine(const P& p, Frame& F, int l) {
    const float* MOD = WSP(float, WS_MOD); bf16* H = WSP(bf16, WS_H); float* XA = WSP(float, WS_XA); const int* SLOT = WSP(int, WS_SLOT); const bf16* YS = WSP(bf16, WS_YS);
    const int gw = F.vcu * NWAVES + F.wave, NGW = F.G * NWAVES; const int nrows = l == 0 ? NT : NL;
    f32x4 gn[4];
#pragma unroll
    for (int q = 0; q < 4; ++q) gn[q] = *(const f32x4*)((l == 0 ? p.norm1_g + D : p.final_norm_g) + 4 * (F.lane + 64 * q));
    for (int r0 = gw; r0 < nrows; r0 += 2 * NGW) {
        int sv[2]; f32x4 v[2][4], acc[2][4];
#pragma unroll
        for (int h = 0; h < 2; ++h) { const int r = r0 + h * NGW; sv[h] = F.lane < 16 ? SLOT[(size_t)r * 16 + F.lane] : -1;
#pragma unroll
            for (int q = 0; q < 4; ++q) { v[h][q] = *(const f32x4*)(XA + (size_t)r * D + 4 * (F.lane + 64 * q)); acc[h][q] = (f32x4){0.f, 0.f, 0.f, 0.f}; } }
        unsigned mk[2]; v2u yv[2][4][4];
#pragma unroll
        for (int h = 0; h < 2; ++h) { mk[h] = (unsigned)(__ballot(sv[h] >= 0) & 0xffffull); unsigned m2 = mk[h];
#pragma unroll
            for (int i = 0; i < 4; ++i) {
                if (m2) { const int e = __builtin_ctz(m2); m2 &= m2 - 1; const int sl = __builtin_amdgcn_readlane(sv[h], e); const bf16* yr = YS + (size_t)(e * ESLOTS + sl) * D;
#pragma unroll
                    for (int q = 0; q < 4; ++q) yv[h][i][q] = *(const v2u*)(yr + 4 * (F.lane + 64 * q)); }
                else {
#pragma unroll
                    for (int q = 0; q < 4; ++q) yv[h][i][q] = (v2u){0u, 0u}; } }
            mk[h] = m2; }
        f32x4 g2v[2][4], shn[2][4], scn[2][4];
#pragma unroll
        for (int h = 0; h < 2; ++h) { const int r = r0 + h * NGW; const int j = r < NL ? r / SEQ : 16; const float* g2 = MOD + (size_t)(l * 17 + j) * 6144 + 5120; const float* m1 = MOD + (size_t)(17 + j) * 6144;
#pragma unroll
            for (int q = 0; q < 4; ++q) { const int c = 4 * (F.lane + 64 * q); g2v[h][q] = *(const f32x4*)(g2 + c); if (l == 0) { shn[h][q] = *(const f32x4*)(m1 + c); scn[h][q] = *(const f32x4*)(m1 + 1024 + c); } } }
#pragma unroll
        for (int h = 0; h < 2; ++h) {
#pragma unroll
            for (int i = 0; i < 4; ++i)
#pragma unroll
                for (int q = 0; q < 4; ++q) { const v2u w = yv[h][i][q]; acc[h][q][0] += __uint_as_float(w.x << 16); acc[h][q][1] += __uint_as_float(w.x & 0xffff0000u); acc[h][q][2] += __uint_as_float(w.y << 16); acc[h][q][3] += __uint_as_float(w.y & 0xffff0000u); }
            unsigned m2 = mk[h];
            while (m2) { const int e = __builtin_ctz(m2); m2 &= m2 - 1; const int sl = __builtin_amdgcn_readlane(sv[h], e); const bf16* yr = YS + (size_t)(e * ESLOTS + sl) * D;
#pragma unroll
                for (int q = 0; q < 4; ++q) { const v2u w = *(const v2u*)(yr + 4 * (F.lane + 64 * q)); acc[h][q][0] += __uint_as_float(w.x << 16); acc[h][q][1] += __uint_as_float(w.x & 0xffff0000u); acc[h][q][2] += __uint_as_float(w.y << 16); acc[h][q][3] += __uint_as_float(w.y & 0xffff0000u); } } }
#pragma unroll
        for (int h = 0; h < 2; ++h) { const int r = r0 + h * NGW;
            float* xr = XA + (size_t)r * D; float s = 0.f;
#pragma unroll
            for (int q = 0; q < 4; ++q) { v[h][q] = v[h][q] + g2v[h][q] * acc[h][q]; s += (v[h][q][0] * v[h][q][0] + v[h][q][1] * v[h][q][1]) + (v[h][q][2] * v[h][q][2] + v[h][q][3] * v[h][q][3]); }
            const float rstd = 1.f / sqrtf(wave_sum(s) * (1.f / D) + EPS);
            if (l == 0) {
#pragma unroll
                for (int q = 0; q < 4; ++q) *(f32x4*)(xr + 4 * (F.lane + 64 * q)) = v[h][q];
                bf16* orow = H + (size_t)r * D;
#pragma unroll
                for (int q = 0; q < 4; ++q) { const f32x4 y = (v[h][q] * rstd * gn[q]) * (scn[h][q] + 1.f) + shn[h][q]; v2u o; o.x = pk2(y[0], y[1]); o.y = pk2(y[2], y[3]); *(v2u*)(orow + 4 * (F.lane + 64 * q)) = o; }
            } else {
                float* orow = p.out + (size_t)r * D;
#pragma unroll
                for (int q = 0; q < 4; ++q) { const int c = 4 * (F.lane + 64 * q); *(f32x4*)(orow + c) = v[h][q] * rstd * gn[q]; }
            } }
    }
}
__device__ __forceinline__ void ph_readout(const P& p, Frame& F) {
    bf16* H = WSP(bf16, WS_H); const bf16* OF = WSP(bf16, WS_OF); const bf16* OB = WSP(bf16, WS_OB); const bf16* PG = WSP(bf16, WS_PG);
    const int gw = F.vcu * NWAVES + F.wave, NGW = F.G * NWAVES;
    f32x4 gnv[4];
#pragma unroll
    for (int q = 0; q < 4; ++q) gnv[q] = *(const f32x4*)(p.gla_norm_g + 4 * (F.lane + 64 * q));
    for (int r0 = gw; r0 < NL; r0 += 2 * NGW) {
        v2u a[2][4], b[2][4], rr[2][4];
#pragma unroll
        for (int h = 0; h < 2; ++h) { const int r = r0 + h * NGW;
#pragma unroll
            for (int q = 0; q < 4; ++q) { const int c = 4 * (F.lane + 64 * q); a[h][q] = *(const v2u*)(OF + (size_t)r * GV + c); b[h][q] = *(const v2u*)(OB + (size_t)r * GV + c); rr[h][q] = *(const v2u*)(PG + (size_t)r * GIN + GQK + c); } }
#pragma unroll
        for (int h = 0; h < 2; ++h) { const int r = r0 + h * NGW;
#pragma unroll
            for (int q = 0; q < 4; ++q) { const int c = 4 * (F.lane + 64 * q);
                f32x4 o; o[0] = __uint_as_float(a[h][q].x << 16) + __uint_as_float(b[h][q].x << 16); o[1] = __uint_as_float(a[h][q].x & 0xffff0000u) + __uint_as_float(b[h][q].x & 0xffff0000u);
                o[2] = __uint_as_float(a[h][q].y << 16) + __uint_as_float(b[h][q].y << 16); o[3] = __uint_as_float(a[h][q].y & 0xffff0000u) + __uint_as_float(b[h][q].y & 0xffff0000u);
                const float ss = wave_sum((o[0] * o[0] + o[1] * o[1]) + (o[2] * o[2] + o[3] * o[3]));
                const float rstd = 1.f / sqrtf(ss * (1.f / GDV) + EPS);
                const f32x4 gv = gnv[q];
                const float q0 = __uint_as_float(rr[h][q].x << 16), q1 = __uint_as_float(rr[h][q].x & 0xffff0000u), q2 = __uint_as_float(rr[h][q].y << 16), q3 = __uint_as_float(rr[h][q].y & 0xffff0000u);
                const float y0 = o[0] * rstd * gv[0] * fsilu(q0), y1 = o[1] * rstd * gv[1] * fsilu(q1), y2 = o[2] * rstd * gv[2] * fsilu(q2), y3 = o[3] * rstd * gv[3] * fsilu(q3);
                v2u w; w.x = pk2(y0, y1); w.y = pk2(y2, y3); *(v2u*)(H + (size_t)r * D + c) = w; } }
    }
}

typedef float f32x16 __attribute__((ext_vector_type(16)));
typedef short s16x4 __attribute__((ext_vector_type(4)));
__device__ __forceinline__ s16x4 lds_tr16(const LAS unsigned char* p) { return __builtin_bit_cast(s16x4, __builtin_amdgcn_ds_read_tr16_b64_v4i16((LAS s16x4*)p)); }
__device__ __forceinline__ int crow(int r, int hi) { return (r & 3) + 8 * (r >> 2) + 4 * hi; }
#define TR_RD(dst, ptr) asm volatile("ds_read_b64_tr_b16 %0, %1" : "=v"(dst) : "v"((unsigned)(uintptr_t)(ptr)) : "memory")
#define TR_WAIT4(a, b, c, d) asm volatile("s_waitcnt lgkmcnt(0)" : "+v"(a), "+v"(b), "+v"(c), "+v"(d) :: "memory")
__device__ __forceinline__ void ph_attn(const P& p, Frame& F) {
    const bf16* Q = WSP(bf16, WS_Q); const bf16* Kb = WSP(bf16, WS_K); const bf16* Vb = WSP(bf16, WS_V); bf16* O = WSP(bf16, WS_O);
    const int lane = F.lane, r32 = lane & 31, hi = lane >> 5, w = F.wave, gq = w >> 1, th = w & 1;
    LAS unsigned char* Ks = F.lds; LAS unsigned char* Vs = F.lds + 3 * 8192;
    const int kl = lane >> 3, chp = lane & 7;
    const int dgrp = (lane >> 4) & 1, qrow = (lane & 15) >> 2, pp = lane & 3;
#define ATT_DEC(u_, lat_, b_, hk_, t0_, qrow0_, jlo_, nt_) do { lat_ = (u_) < 2048; \
        if (lat_) { b_ = (u_) >> 7; hk_ = ((u_) >> 5) & 3; t0_ = 64 * ((u_) & 31); qrow0_ = b_ * SEQ + t0_; } \
        else { const int uc_ = (u_) - 2048; b_ = uc_ >> 4; hk_ = (uc_ >> 2) & 3; t0_ = 64 * (uc_ & 3); qrow0_ = NL + b_ * CTX + t0_; } \
        int jhi_ = -1; jlo_ = 0; \
        if (lat_) { jlo_ = t0_ >= 128 ? 0 : (128 - t0_) / 64; jhi_ = (SEQ - 64 - (t0_ - 128)) / 64; if (jhi_ > 4) jhi_ = 4; } \
        nt_ = 4 + (jhi_ - jlo_ + 1); } while (0)
#define ATT_KROW(b_, t0_, jlo_, it) ((it) < 4 ? NL + (b_) * CTX + 64 * (it) : (b_) * SEQ + (t0_) - 128 + 64 * ((jlo_) + (it) - 4))
#define ATT_DMA(b_, hk_, t0_, jlo_, it, sl) do { const size_t so_ = ((size_t)(ATT_KROW(b_, t0_, jlo_, it) + 8 * w + kl) * 256 + (hk_) * 64) * 2 + (size_t)((chp ^ kl) * 16); \
        __builtin_amdgcn_global_load_lds((const unsigned*)((const char*)Kb + so_), (LAS unsigned*)(Ks + (sl) * 8192 + w * 1024), 16, 0, 0); \
        __builtin_amdgcn_global_load_lds((const unsigned*)((const char*)Vb + so_), (LAS unsigned*)(Vs + (sl) * 8192 + w * 1024), 16, 0, 0); } while (0)
    constexpr int NU = 2048 + 256;
    const float snk0 = p.attn_sink[gq], snk1 = p.attn_sink[4 + gq], snk2 = p.attn_sink[8 + gq], snk3 = p.attn_sink[12 + gq];
    int sc = 0, sn2 = 2;
    bool first = true;
    bf16x8 qr[4], qn[4];
    if (F.vcu < NU) { bool lat; int b, hk, t0, qrow0, jlo, nt; ATT_DEC(F.vcu, lat, b, hk, t0, qrow0, jlo, nt); (void)nt; (void)lat;
#pragma unroll
        for (int d0 = 0; d0 < 4; ++d0) qr[d0] = *(const bf16x8*)(Q + (size_t)(qrow0 + 32 * th + r32) * 1024 + (hk * 4 + gq) * 64 + d0 * 16 + hi * 8);
        ATT_DMA(b, hk, t0, jlo, 0, 0); ATT_DMA(b, hk, t0, jlo, 1, 1); }
    for (int u = F.vcu; u < NU; u += F.G) {
        bool lat; int b, hk, t0, qrow0, jlo, nt; ATT_DEC(u, lat, b, hk, t0, qrow0, jlo, nt);
        const bool has_next = u + F.G < NU;
        bool nlat; int nb, nhk, nt0, nqrow0, njlo, nnt; { const int un = has_next ? u + F.G : u; ATT_DEC(un, nlat, nb, nhk, nt0, nqrow0, njlo, nnt); (void)nnt; (void)nlat; }
        const int hq = hk * 4 + gq; const int qr_row = qrow0 + 32 * th + r32;
#pragma unroll
        for (int d0 = 0; d0 < 4; ++d0) { const bf16* qp = Q + (size_t)(nqrow0 + 32 * th + r32) * 1024 + (nhk * 4 + gq) * 64 + d0 * 16 + hi * 8;
            asm volatile("global_load_dwordx4 %0, %1, off" : "=v"(qn[d0]) : "v"(qp) : "memory"); }
        float m = (hk == 0 ? snk0 : hk == 1 ? snk1 : hk == 2 ? snk2 : snk3) * LOG2E, l = hi == 0 ? 1.f : 0.f;
        f32x16 o[2];
#pragma unroll
        for (int r = 0; r < 16; ++r) { o[0][r] = 0.f; o[1][r] = 0.f; }
#pragma clang loop unroll(disable)
        for (int it = 0; it < nt; ++it) {
            if (it == nt - 1) { if (has_next) asm volatile("s_waitcnt vmcnt(2)" ::: "memory"); else asm volatile("s_waitcnt vmcnt(0)" ::: "memory"); }
            else if (it < 2) { if (first) asm volatile("s_waitcnt vmcnt(6)" ::: "memory"); else asm volatile("s_waitcnt vmcnt(14)" ::: "memory"); }
            else asm volatile("s_waitcnt vmcnt(2)" ::: "memory");
            __builtin_amdgcn_s_barrier(); asm volatile("" ::: "memory");
            if (it + 2 < nt) ATT_DMA(b, hk, t0, jlo, it + 2, sn2);
            else if (has_next) ATT_DMA(nb, nhk, nt0, njlo, it + 2 - nt, sn2);
            const int slot = sc * 8192;
            f32x16 p0, p1;
#pragma unroll
            for (int r = 0; r < 16; ++r) { p0[r] = 0.f; p1[r] = 0.f; }
#pragma unroll
            for (int d0 = 0; d0 < 4; ++d0) {
                const int off = r32 * 128 + (((2 * d0 + hi) ^ (r32 & 7)) * 16);
                const bf16x8 k0 = *(const LAS bf16x8*)(Ks + slot + off), k1 = *(const LAS bf16x8*)(Ks + slot + off + 32 * 128);
                p0 = __builtin_amdgcn_mfma_f32_32x32x16_bf16(k0, qr[d0], p0, 0, 0, 0);
                p1 = __builtin_amdgcn_mfma_f32_32x32x16_bf16(k1, qr[d0], p1, 0, 0, 0);
            }
            s16x4 vt[2][4][2];
#pragma unroll
            for (int dblk = 0; dblk < 2; ++dblk)
#pragma unroll
                for (int ks = 0; ks < 4; ++ks) { const int klo = 16 * ks + 4 * hi + qrow, khi = klo + 8, ch = 4 * dblk + 2 * dgrp + (pp >> 1), bo = (pp & 1) * 8;
                    TR_RD(vt[dblk][ks][0], Vs + slot + klo * 128 + ((ch ^ (klo & 7)) * 16) + bo); TR_RD(vt[dblk][ks][1], Vs + slot + khi * 128 + ((ch ^ (khi & 7)) * 16) + bo); }
            asm volatile("s_nop 7\n\ts_nop 7" : "+v"(p0), "+v"(p1));
            if (it >= 4) { const int j = jlo + it - 4;
                if (j == 0 || j == 4) { const int dq = 32 * th + r32;
                    const int sg = j == 0 ? 1 : -1;
#pragma unroll
                    for (int r = 0; r < 16; ++r) { const int kk = crow(r, hi);
                        p0[r] = sg * (dq - kk) > 0 ? -1e30f : p0[r]; p1[r] = sg * (dq - (kk + 32)) > 0 ? -1e30f : p1[r]; } } }
            float mx = p0[0];
#pragma unroll
            for (int r = 1; r < 16; ++r) mx = fmaxf(mx, p0[r]);
#pragma unroll
            for (int r = 0; r < 16; ++r) mx = fmaxf(mx, p1[r]);
            mx = fmaxf(mx, __shfl_xor(mx, 32));
            const float mn = fmaxf(m, mx);
            if (__any(mn > m)) { const float f = __builtin_amdgcn_exp2f(m - mn); l *= f;
#pragma unroll
                for (int r = 0; r < 16; ++r) { o[0][r] *= f; o[1][r] *= f; }
                m = mn; }
            float ls = 0.f;
#pragma unroll
            for (int r = 0; r < 16; ++r) { p0[r] = __builtin_amdgcn_exp2f(p0[r] - m); p1[r] = __builtin_amdgcn_exp2f(p1[r] - m); ls += p0[r] + p1[r]; }
            l += ls;
            v4u pw[4];
#pragma unroll
            for (int q4 = 0; q4 < 4; ++q4) { pw[0][q4] = pk2(p0[2 * q4], p0[2 * q4 + 1]); pw[1][q4] = pk2(p0[8 + 2 * q4], p0[9 + 2 * q4]); pw[2][q4] = pk2(p1[2 * q4], p1[2 * q4 + 1]); pw[3][q4] = pk2(p1[8 + 2 * q4], p1[9 + 2 * q4]); }
            asm volatile("s_waitcnt lgkmcnt(0)" : "+v"(vt[0][0][0]), "+v"(vt[0][0][1]), "+v"(vt[0][1][0]), "+v"(vt[0][1][1]), "+v"(vt[0][2][0]), "+v"(vt[0][2][1]), "+v"(vt[0][3][0]), "+v"(vt[0][3][1]),
                         "+v"(vt[1][0][0]), "+v"(vt[1][0][1]), "+v"(vt[1][1][0]), "+v"(vt[1][1][1]), "+v"(vt[1][2][0]), "+v"(vt[1][2][1]), "+v"(vt[1][3][0]), "+v"(vt[1][3][1]) :: "memory");
#pragma unroll
            for (int dblk = 0; dblk < 2; ++dblk)
#pragma unroll
                for (int ks = 0; ks < 4; ++ks) { const s16x4 vlo = vt[dblk][ks][0], vhi = vt[dblk][ks][1];
                    const bf16x8 vf = (bf16x8){vlo[0], vlo[1], vlo[2], vlo[3], vhi[0], vhi[1], vhi[2], vhi[3]};
                    o[dblk] = __builtin_amdgcn_mfma_f32_32x32x16_bf16(vf, __builtin_bit_cast(bf16x8, pw[ks]), o[dblk], 0, 0, 0); }
            sc = sc == 2 ? 0 : sc + 1; sn2 = sn2 == 2 ? 0 : sn2 + 1;
        }
#undef ATT_KROW
#undef ATT_DMA
        const float il = 1.f / (l + __shfl_xor(l, 32));
        bf16* orow = O + (size_t)qr_row * 1024 + hq * 64;
#pragma unroll
        for (int dblk = 0; dblk < 2; ++dblk)
#pragma unroll
            for (int rq = 0; rq < 4; ++rq) { v2u wv; wv.x = pk2(o[dblk][4 * rq] * il, o[dblk][4 * rq + 1] * il); wv.y = pk2(o[dblk][4 * rq + 2] * il, o[dblk][4 * rq + 3] * il);
                *(v2u*)(orow + 32 * dblk + 8 * rq + 4 * hi) = wv; }
#pragma unroll
        for (int d0 = 0; d0 < 4; ++d0) qr[d0] = qn[d0];
        first = false;
    }
#undef ATT_DEC
}
__device__ __forceinline__ void ph_attn_naive(const P& p, Frame& F) {
    const bf16* Q = WSP(bf16, WS_Q); const bf16* Kb = WSP(bf16, WS_K); const bf16* Vb = WSP(bf16, WS_V); bf16* O = WSP(bf16, WS_O);
    for (int i = F.vcu * 512 + F.tid; i < NT * NQH; i += F.G * 512) {
        const int r = i >> 4, hq = i & 15, hk = hq >> 2;
        float q[64], acc[64];
#pragma unroll
        for (int d = 0; d < 64; ++d) { q[d] = bf2f(Q[(size_t)r * 1024 + hq * 64 + d]); acc[d] = 0.f; }
        float m = p.attn_sink[hq] * LOG2E, l = 1.f;
        const bool lat = r < NL; const int b = lat ? r / SEQ : (r - NL) / CTX, t = r & (SEQ - 1);
        const int nlat = lat ? (min(SEQ - 1, t + 128) - max(0, t - 128) + 1) : 0, klo = max(0, t - 128);
        for (int kk = 0; kk < CTX + nlat; ++kk) {
            const int kr = kk < CTX ? NL + b * CTX + kk : b * SEQ + klo + (kk - CTX);
            const bf16* kp = Kb + (size_t)kr * 256 + hk * 64; const bf16* vp = Vb + (size_t)kr * 256 + hk * 64;
            float s = 0.f;
#pragma unroll
            for (int d = 0; d < 64; ++d) s += q[d] * bf2f(kp[d]);
            const float mn = fmaxf(m, s), sc = exp2f(m - mn), pe = exp2f(s - mn);
            l = l * sc + pe; m = mn;
#pragma unroll
            for (int d = 0; d < 64; ++d) acc[d] = acc[d] * sc + pe * bf2f(vp[d]);
        }
        const float il = 1.f / l;
#pragma unroll
        for (int d = 0; d < 64; ++d) O[(size_t)r * 1024 + hq * 64 + d] = (bf16)f2bf(acc[d] * il);
    }
}
__device__ __forceinline__ f32x4 mfma16(bf16x8 a, bf16x8 b, f32x4 c) { return __builtin_amdgcn_mfma_f32_16x16x32_bf16(a, b, c, 0, 0, 0); }
__device__ __forceinline__ int gla_rowmap(int b, int dir, int s) { return s < CTX ? NL + b * CTX + (dir ? CTX - 1 - s : s) : b * SEQ + (dir ? SEQ - 1 - (s - CTX) : s - CTX); }
__device__ __forceinline__ void ph_glaprep(const P& p, Frame& F) {
    const bf16* PG = WSP(bf16, WS_PG); bf16* QT = WSP(bf16, WS_QT); bf16* KT = WSP(bf16, WS_KT); float* DEC = WSP(float, WS_DEC);
    const int lane = F.lane, w = F.wave, c16 = lane & 15, g = lane >> 4;
    for (int uu = F.vcu; uu < NB * 2 * 36 * 2; uu += F.G) {
        const int hf = uu & 1, u = uu >> 1, c = u % 36, dir = (u / 36) & 1, b = u / 72;
        const int rowA = gla_rowmap(b, dir, 64 * c), rstep = dir ? -1 : 1;
        const size_t obase = ((size_t)(dir * NB + b) * 2304 + 64 * c) * 512;
        bf16x8 lrf[4];
#pragma unroll
        for (int tt = 0; tt < 4; ++tt) { lrf[tt] = (bf16x8){0, 0, 0, 0, 0, 0, 0, 0};
            if (g < 2) lrf[tt] = *(const bf16x8*)(PG + (size_t)(rowA + rstep * (16 * tt + c16)) * GIN + 3072 + 16 * dir + 8 * g); }
#pragma unroll 1
        for (int ctl = 0; ctl < 2; ++ctl) { const int col0 = 256 * hf + 16 * (2 * w + ctl);
            v4u wp = (v4u){0u, 0u, 0u, 0u};
            if (g < 2) { const float* wsrc = p.gla_gate_w2 + (size_t)(dir * 16 + 8 * g) * 512 + col0 + c16;
                wp.x = pk2(wsrc[0], wsrc[512]); wp.y = pk2(wsrc[1024], wsrc[1536]); wp.z = pk2(wsrc[2048], wsrc[2560]); wp.w = pk2(wsrc[3072], wsrc[3584]); }
            const bf16x8 wf = __builtin_bit_cast(bf16x8, wp);
            const f32x4 bias = *(const f32x4*)(p.gla_gate_b + dir * 512 + col0 + 4 * g);
            f32x4 carry = (f32x4){0.f, 0.f, 0.f, 0.f};
            v2u kk4[4], qq4[4];
#pragma unroll
            for (int tt = 0; tt < 4; ++tt) { const bf16* pr = PG + (size_t)(rowA + rstep * (16 * tt + c16)) * GIN + col0 + 4 * g;
                kk4[tt] = *(const v2u*)(pr + GQR); qq4[tt] = (v2u){0u, 0u}; if (c >= 4) qq4[tt] = *(const v2u*)pr; }
            asm volatile("" : "+v"(kk4[0]), "+v"(kk4[1]), "+v"(kk4[2]), "+v"(kk4[3]), "+v"(qq4[0]), "+v"(qq4[1]), "+v"(qq4[2]), "+v"(qq4[3]) :: "memory");
#pragma unroll
            for (int tt = 0; tt < 4; ++tt) {
                const int tok = 16 * tt + c16;
                const v2u kk = kk4[tt], qq = qq4[tt];
                const f32x4 z = mfma16(wf, lrf[tt], bias);
                f32x4 ls;
#pragma unroll
                for (int r = 0; r < 4; ++r) ls[r] = (fminf(z[r], 0.f) - flog(1.f + fexp(-fabsf(z[r])))) * (1.f / 16.f);
#pragma unroll
                for (int r = 0; r < 4; ++r) { ls[r] += dpp_shr<1>(ls[r]); ls[r] += dpp_shr<2>(ls[r]); ls[r] += dpp_shr<4>(ls[r]); ls[r] += dpp_shr<8>(ls[r]); }
                f32x4 bs = carry + ls;
#pragma unroll
                for (int r = 0; r < 4; ++r) carry[r] += __shfl(ls[r], 15, 16);
                const float k0 = __uint_as_float(kk.x << 16), k1 = __uint_as_float(kk.x & 0xffff0000u), k2 = __uint_as_float(kk.y << 16), k3 = __uint_as_float(kk.y & 0xffff0000u);
                v2u ko; ko.x = pk2(k0 * fexp(-bs[0]), k1 * fexp(-bs[1])); ko.y = pk2(k2 * fexp(-bs[2]), k3 * fexp(-bs[3]));
                *(v2u*)(KT + obase + (size_t)tok * 512 + col0 + 4 * g) = ko;
                if (c >= 4) { const float q0 = __uint_as_float(qq.x << 16), q1 = __uint_as_float(qq.x & 0xffff0000u), q2 = __uint_as_float(qq.y << 16), q3 = __uint_as_float(qq.y & 0xffff0000u);
                    v2u qo; qo.x = pk2(q0 * GLA_QS * fexp(bs[0]), q1 * GLA_QS * fexp(bs[1])); qo.y = pk2(q2 * GLA_QS * fexp(bs[2]), q3 * GLA_QS * fexp(bs[3]));
                    *(v2u*)(QT + obase + (size_t)tok * 512 + col0 + 4 * g) = qo; }
            }
            if (c16 == 15) { f32x4 dv; dv[0] = fexp(carry[0]); dv[1] = fexp(carry[1]); dv[2] = fexp(carry[2]); dv[3] = fexp(carry[3]);
                *(f32x4*)(DEC + ((size_t)(dir * NB + b) * 36 + c) * 512 + col0 + 4 * g) = dv; }
        }
    }
}
__device__ __forceinline__ void ph_glascan(const P& p, Frame& F) {
    const bf16* PG = WSP(bf16, WS_PG); const bf16* QT = WSP(bf16, WS_QT); const bf16* KT = WSP(bf16, WS_KT); const float* DEC = WSP(float, WS_DEC);
    const int lane = F.lane, w = F.wave, g = lane >> 4, c16 = lane & 15, qrow = c16 >> 2, pp = c16 & 3;
    constexpr int BUF = 49152, QOFF = 0, KOFF = 16384, VOFF = 32768, AM = 98304, DCO = 106496;
    LAS unsigned char* L = F.lds; LAS unsigned char* stg = L + DCO + 1024 + w * 2048;
    for (int u = F.vcu; u < 256; u += F.G) {
        const int dvh = u & 1, dir = (u >> 1) & 1, h = (u >> 2) & 3, b = u >> 4;
        bf16* OUT = WSP(bf16, WS_OF) + (dir ? (size_t)(WS_OB - WS_OF) / 2 : 0);
        const size_t seqbase = (size_t)(dir * NB + b) * 2304;
#define GLA_STAGE(c, bufi) do { _Pragma("unroll") for (int pc = 0; pc < 2; ++pc) { const int piece = w + 8 * pc, row = piece * 4 + g, chs = c16 ^ (row & 15); \
            const size_t srow = seqbase + 64 * (c) + row; const unsigned ldst = (bufi) * BUF + piece * 1024; \
            if ((c) >= 4) __builtin_amdgcn_global_load_lds((const unsigned*)((const char*)(QT + srow * 512 + h * 128) + chs * 16), (LAS unsigned*)(L + QOFF + ldst), 16, 0, 0); \
            __builtin_amdgcn_global_load_lds((const unsigned*)((const char*)(KT + srow * 512 + h * 128) + chs * 16), (LAS unsigned*)(L + KOFF + ldst), 16, 0, 0); \
            __builtin_amdgcn_global_load_lds((const unsigned*)((const char*)(PG + (size_t)gla_rowmap(b, dir, 64 * (c) + row) * GIN + GQR + GQK + h * 256 + dvh * 128) + chs * 16), (LAS unsigned*)(L + VOFF + ldst), 16, 0, 0); } \
            if (w == 0 && lane < 32) __builtin_amdgcn_global_load_lds((const unsigned*)((const char*)(DEC + ((size_t)(dir * NB + b) * 36 + (c)) * 512 + h * 128) + lane * 16), (LAS unsigned*)(L + DCO + (bufi) * 512), 16, 0, 0); } while (0)
        f32x4 S[8];
#pragma unroll
        for (int t = 0; t < 8; ++t) S[t] = (f32x4){0.f, 0.f, 0.f, 0.f};
        GLA_STAGE(0, 0);
        asm volatile("s_waitcnt vmcnt(0)" ::: "memory"); __builtin_amdgcn_s_barrier(); asm volatile("" ::: "memory");
#pragma clang loop unroll(disable)
        for (int c = 0; c < 36; ++c) {
            const int bi = c & 1; LAS unsigned char* Qs = L + bi * BUF + QOFF; LAS unsigned char* Ksm = L + bi * BUF + KOFF; LAS unsigned char* Vsm = L + bi * BUF + VOFF; LAS unsigned char* Am = L + AM;
            if (c + 1 < 36) GLA_STAGE(c + 1, bi ^ 1);
            if (c >= 4) {
#pragma unroll
                for (int q2 = 0; q2 < 2; ++q2) { const int id = 2 * w + q2, ti = id >> 2, tj = id & 3; f32x4 a = (f32x4){0.f, 0.f, 0.f, 0.f};
                    if (tj <= ti) {
#pragma unroll
                        for (int ks = 0; ks < 4; ++ks) { const int co = ((4 * ks + g) ^ c16) * 16;
                            const bf16x8 qa = *(const LAS bf16x8*)(Qs + (16 * ti + c16) * 256 + co), kb = *(const LAS bf16x8*)(Ksm + (16 * tj + c16) * 256 + co);
                            a = mfma16(qa, kb, a); }
                        asm volatile("s_nop 7\n\ts_nop 7" : "+v"(a));
                        if (tj == ti) {
#pragma unroll
                            for (int r = 0; r < 4; ++r) a[r] = c16 > 4 * g + r ? 0.f : a[r]; } }
#pragma unroll
                    for (int r = 0; r < 4; ++r) { const int i = 16 * ti + 4 * g + r; *(LAS bf16*)(Am + i * 128 + (((2 * tj + (c16 >> 3)) ^ (i & 7)) * 16) + (c16 & 7) * 2) = (bf16)f2bf(a[r]); } }
            }
            asm volatile("s_waitcnt lgkmcnt(0)" ::: "memory"); __builtin_amdgcn_s_barrier(); asm volatile("" ::: "memory");
            bf16x8 vf[2];
            { s16x4 t0, t1, t2, t3; const int ch = 2 * w + (pp >> 1), bo = (pp & 1) * 8, rl = 8 * g + qrow;
              TR_RD(t0, Vsm + rl * 256 + ((ch ^ (rl & 15)) * 16) + bo); TR_RD(t1, Vsm + (rl + 4) * 256 + ((ch ^ ((rl + 4) & 15)) * 16) + bo);
              TR_RD(t2, Vsm + (rl + 32) * 256 + ((ch ^ (rl & 15)) * 16) + bo); TR_RD(t3, Vsm + (rl + 36) * 256 + ((ch ^ ((rl + 4) & 15)) * 16) + bo);
              TR_WAIT4(t0, t1, t2, t3);
              vf[0] = (bf16x8){t0[0], t0[1], t0[2], t0[3], t1[0], t1[1], t1[2], t1[3]}; vf[1] = (bf16x8){t2[0], t2[1], t2[2], t2[3], t3[0], t3[1], t3[2], t3[3]}; }
            if (c >= 4) {
                bf16x8 sf[4];
#pragma unroll
                for (int ks = 0; ks < 4; ++ks) { v4u t4; t4.x = pk2(S[2 * ks][0], S[2 * ks][1]); t4.y = pk2(S[2 * ks][2], S[2 * ks][3]); t4.z = pk2(S[2 * ks + 1][0], S[2 * ks + 1][1]); t4.w = pk2(S[2 * ks + 1][2], S[2 * ks + 1][3]); sf[ks] = __builtin_bit_cast(bf16x8, t4); }
#pragma unroll
                for (int tt = 0; tt < 4; ++tt) { f32x4 o = (f32x4){0.f, 0.f, 0.f, 0.f}; const int row = 16 * tt + c16;
#pragma unroll
                    for (int ks = 0; ks < 4; ++ks) { const int ch0 = 4 * ks + (g >> 1), bo = (g & 1) * 8;
                        const s16x4 alo = *(const LAS s16x4*)(Qs + row * 256 + ((ch0 ^ c16) * 16) + bo), ahi = *(const LAS s16x4*)(Qs + row * 256 + (((ch0 + 2) ^ c16) * 16) + bo);
                        o = mfma16((bf16x8){alo[0], alo[1], alo[2], alo[3], ahi[0], ahi[1], ahi[2], ahi[3]}, sf[ks], o); }
#pragma unroll
                    for (int ks2 = 0; ks2 < 2; ++ks2) { const bf16x8 am = *(const LAS bf16x8*)(Am + row * 128 + (((4 * ks2 + g) ^ (row & 7)) * 16)); o = mfma16(am, vf[ks2], o); }
#pragma unroll
                    for (int r = 0; r < 4; ++r) *(LAS bf16*)(stg + (16 * tt + 4 * g + r) * 32 + c16 * 2) = (bf16)f2bf(o[r]); }
#pragma unroll
                for (int pc = 0; pc < 2; ++pc) { const int pi = lane + 64 * pc, tok = pi >> 1; const v4u ov = *(const LAS v4u*)(stg + pi * 16);
                    *(v4u*)(OUT + (size_t)gla_rowmap(b, dir, 64 * c + tok) * GV + h * 256 + dvh * 128 + 16 * w + (pi & 1) * 8) = ov; }
            }
#pragma unroll
            for (int t = 0; t < 8; ++t) { f32x4 acc = S[t];
                { s16x4 t0, t1, t2, t3; const int ch = 2 * t + (pp >> 1), bo = (pp & 1) * 8, rl = 8 * g + qrow;
                  TR_RD(t0, Ksm + rl * 256 + ((ch ^ (rl & 15)) * 16) + bo); TR_RD(t1, Ksm + (rl + 4) * 256 + ((ch ^ ((rl + 4) & 15)) * 16) + bo);
                  TR_RD(t2, Ksm + (rl + 32) * 256 + ((ch ^ (rl & 15)) * 16) + bo); TR_RD(t3, Ksm + (rl + 36) * 256 + ((ch ^ ((rl + 4) & 15)) * 16) + bo);
                  TR_WAIT4(t0, t1, t2, t3);
                  acc = mfma16((bf16x8){t0[0], t0[1], t0[2], t0[3], t1[0], t1[1], t1[2], t1[3]}, vf[0], acc);
                  acc = mfma16((bf16x8){t2[0], t2[1], t2[2], t2[3], t3[0], t3[1], t3[2], t3[3]}, vf[1], acc); }
                const f32x4 d4 = *(const LAS f32x4*)(L + DCO + bi * 512 + (16 * t + 4 * g) * 4);
                S[t] = acc * d4; }
            if (c >= 4) asm volatile("s_waitcnt vmcnt(2) lgkmcnt(0)" ::: "memory"); else asm volatile("s_waitcnt vmcnt(0) lgkmcnt(0)" ::: "memory");
            __builtin_amdgcn_s_barrier(); asm volatile("" ::: "memory");
        }
#undef GLA_STAGE
    }
}
__device__ __forceinline__ void ph_scan_naive(const P& p, Frame& F) {
    const bf16* PG = WSP(bf16, WS_PG);
    LAS float* sq = (LAS float*)F.lds; LAS float* sk = sq + 128; LAS float* sa = sk + 128; LAS float* sv = sa + 128; LAS float* so = sv + 64;
    const int tid = F.tid, e = tid & 63, w = tid >> 6;
    for (int u = F.vcu; u < 512; u += F.G) {
        const int sl = u & 3, dir = (u >> 2) & 1, h = (u >> 3) & 3, b = u >> 5;
        float S[16];
#pragma unroll
        for (int i = 0; i < 16; ++i) S[i] = 0.f;
        bf16* OUT = WSP(bf16, WS_OF) + (dir ? (size_t)(WS_OB - WS_OF) / 2 : 0);
        for (int step = 0; step < CTX + SEQ; ++step) {
            int row; if (step < CTX) row = NL + b * CTX + (dir ? CTX - 1 - step : step); else { const int t = step - CTX; row = b * SEQ + (dir ? SEQ - 1 - t : t); }
            const bf16* pr = PG + (size_t)row * GIN;
            if (tid < 128) { const int col = h * 128 + tid; float z = p.gla_gate_b[dir * 512 + col];
#pragma unroll
                for (int r = 0; r < 16; ++r) z += bf2f(pr[3072 + dir * 16 + r]) * p.gla_gate_w2[(size_t)(dir * 16 + r) * 512 + col];
                const float ls = fminf(z, 0.f) - log1pf(expf(-fabsf(z)));
                sq[tid] = bf2f(pr[col]) * GLA_QS; sk[tid] = bf2f(pr[GQR + col]); sa[tid] = expf(ls * (1.f / 16.f)); }
            else if (tid < 192) sv[tid - 128] = bf2f(pr[GQR + GQK + h * 256 + sl * 64 + tid - 128]);
            __syncthreads();
            const float v = sv[e]; float o = 0.f;
#pragma unroll
            for (int i = 0; i < 16; ++i) { const int d = 16 * w + i; S[i] = sa[d] * S[i] + sk[d] * v; o += sq[d] * S[i]; }
            so[w * 64 + e] = o;
            __syncthreads();
            if (step >= CTX && tid < 64) { float s = 0.f;
#pragma unroll
                for (int q = 0; q < 8; ++q) s += so[q * 64 + tid];
                OUT[(size_t)row * GV + h * 256 + sl * 64 + tid] = (bf16)f2bf(s); }
        }
        __syncthreads();
    }
}

enum Phase { PH_PRO = 0, PH_NORM1_0, PH_QKV, PH_ATTN, PH_OUT0, PH_N2R0, PH_TOPK0, PH_UP0, PH_DN0, PH_COMB0, PH_GLAIN, PH_PREP, PH_SCAN, PH_READ, PH_OUT1, PH_N2R1, PH_TOPK1, PH_UP1, PH_DN1, PH_COMB1, PH_END };

__global__ void __launch_bounds__(NWAVES * 64, 2) k_fwd(P p) {
    extern __shared__ __attribute__((aligned(16))) unsigned char lds[];
    Frame F;
    F.lds = (LAS unsigned char*)lds;
    F.tid = threadIdx.x; F.lane = F.tid & 63; F.wave = __builtin_amdgcn_readfirstlane(F.tid >> 6);
    F.G = gridDim.x; { const int bx = blockIdx.x; F.vcu = (F.G % 8 == 0) ? (bx % 8) * (F.G / 8) + bx / 8 : bx; }
    F.ws = p.ws;
    volatile LAS unsigned* MISC = (volatile LAS unsigned*)(F.lds + MISC_OFF);
    for (int u = F.tid; u < (LDS_BYTES - LDSCTL_OFF) / 4; u += NWAVES * 64) ((LAS unsigned*)(F.lds + LDSCTL_OFF))[u] = 0u;
    __syncthreads();
    const int lo = p.lo, hi = p.hi;
    XcdBarrier bar; bar.bar = (unsigned*)(F.ws + WS_CTL) + CW_BAR; bar.x = 0; bar.st = nullptr;
    if (hi - lo > 1) bar = xcd_barrier_post((unsigned*)(F.ws + WS_CTL) + CW_BAR, MISC + 8);
#define IN(k) (lo <= (k) && (k) < hi)
#define SEAM(k) do { if (IN(k) && IN((k) + 1)) xcd_barrier(bar, F.tid == 0); } while (0)
#define PHASE(k, ...) do { if (IN(k)) { F.lane = (int)__builtin_amdgcn_mbcnt_hi(~0u, __builtin_amdgcn_mbcnt_lo(~0u, 0u)); F.tid = F.wave * 64 + F.lane; __VA_ARGS__; if ((PROBE_MASK >> (k)) & 1) { xcd_barrier(bar, F.tid == 0); __VA_ARGS__; } } SEAM(k); } while (0)
    PHASE(PH_PRO, ph_pro(p, F, (OPT_MASK & 0xff) != 0));
    PHASE(PH_NORM1_0, ph_norm1(p, F, 0));
    PHASE(PH_QKV, {
        pg8::Gemm g{WSP(bf16, WS_H), WSP(bf16, WS_WQKV), D * 2, nullptr}; pg8::TileOrder S; S.init(1, NT / 256, ATT_N / 256, NT / 256, F.G, (int)blockIdx.x);
        pg8::EpiQKV E{WSP(bf16, WS_Q), WSP(bf16, WS_K), WSP(bf16, WS_V), WSP(float, WS_ROPE)};
        pg8::gemm_phase<pg8::EpiQKV, pg8::TileOrder>(F.lds, g, S, E, F.tid);
        BG_SLOT(96, CVT_SPLIT0, CVT_Q1); });
    PHASE(PH_ATTN, { if (OPT_MASK & 256) ph_attn(p, F); else ph_attn_naive(p, F); });
    PHASE(PH_OUT0, {
        pg8::Gemm g{WSP(bf16, WS_O), WSP(bf16, WS_WO0), D * 2, nullptr}; pg8::TileOrder S; S.init(1, NT / 256, D / 256, NT / 256, F.G, (int)blockIdx.x);
        pg8::EpiResid E{p.x, p.ctx, WSP(float, WS_XA), WSP(float, WS_MOD) + 2048};
        pg8::gemm_phase<pg8::EpiResid, pg8::TileOrder>(F.lds, g, S, E, F.tid);
        BG_SLOT(64, CVT_Q1, CVT_Q2); });
    PHASE(PH_N2R0, ph_norm2r(p, F, 0));
    PHASE(PH_TOPK0, ph_topkg(p, F, 0));
    PHASE(PH_UP0, {
        pg8::Gemm g{MOE_FP8 ? (const void*)WSP(unsigned char, WS_H8) : (const void*)WSP(bf16, WS_H), WSP(unsigned char, WS_WUP), D * EB, WSP(int, WS_ROWIDX)}; pg8::TileOrder S; S.init(NE, ESLOTS / 256, FF / 128, ESLOTS / 256, F.G, (int)blockIdx.x);
        pg8::EpiSwiglu E{WSP(unsigned char, WS_ACT)};
        pg8::gemm_phase<pg8::EpiSwiglu, pg8::TileOrder, MOE_FP8 != 0, true, true>(F.lds, g, S, E, F.tid);
        BG_SLOT(192, CVT_Q2, CVT_Q3); });
    PHASE(PH_DN0, {
        pg8::Gemm g{WSP(unsigned char, WS_ACT), WSP(unsigned char, WS_WDN), FF * EB, nullptr}; pg8::TileOrder S; S.init(NE, ESLOTS / 256, D / 256, ESLOTS / 256, F.G, (int)blockIdx.x);
        pg8::EpiDown E{WSP(bf16, WS_YS), WSP(float, WS_ROWG)};
        pg8::gemm_phase<pg8::EpiDown, pg8::TileOrder, MOE_FP8 != 0>(F.lds, g, S, E, F.tid);
        BG_SLOT(128, CVT_Q3, NPAIR_ALL); });
    PHASE(PH_COMB0, ph_combine(p, F, 0));
    PHASE(PH_GLAIN, {
        pg8::Gemm g{WSP(bf16, WS_H), WSP(bf16, WS_WGIN), D * 2, nullptr}; pg8::GlaInOrder S{F.G, (int)blockIdx.x};
        pg8::EpiGlaIn E{WSP(bf16, WS_PG)};
        pg8::gemm_phase<pg8::EpiGlaIn, pg8::GlaInOrder>(F.lds, g, S, E, F.tid); });
    PHASE(PH_PREP, { if (OPT_MASK & 512) ph_glaprep(p, F); });
    PHASE(PH_SCAN, { if (OPT_MASK & 512) ph_glascan(p, F); else ph_scan_naive(p, F); });
    PHASE(PH_READ, ph_readout(p, F));
    PHASE(PH_OUT1, {
        pg8::Gemm g{WSP(bf16, WS_H), WSP(bf16, WS_WO1), D * 2, nullptr}; pg8::TileOrder S; S.init(1, NL / 256, D / 256, NL / 256, F.G, (int)blockIdx.x);
        pg8::EpiResid E{WSP(float, WS_XA), WSP(float, WS_XA), WSP(float, WS_XA), WSP(float, WS_MOD) + 17 * 6144 + 2048};
        pg8::gemm_phase<pg8::EpiResid, pg8::TileOrder>(F.lds, g, S, E, F.tid); });
    PHASE(PH_N2R1, ph_norm2r(p, F, 1));
    PHASE(PH_TOPK1, ph_topkg(p, F, 1));
    PHASE(PH_UP1, {
        pg8::Gemm g{MOE_FP8 ? (const void*)WSP(unsigned char, WS_H8) : (const void*)WSP(bf16, WS_H), WSP(unsigned char, WS_WUP) + (size_t)NE * 5632 * D * EB, D * EB, WSP(int, WS_ROWIDX)}; pg8::TileOrder S; S.init(NE, NB * CAPL / 256, FF / 128, ESLOTS / 256, F.G, (int)blockIdx.x);
        pg8::EpiSwiglu E{WSP(unsigned char, WS_ACT)};
        pg8::gemm_phase<pg8::EpiSwiglu, pg8::TileOrder, MOE_FP8 != 0, true, true>(F.lds, g, S, E, F.tid); });
    PHASE(PH_DN1, {
        pg8::Gemm g{WSP(unsigned char, WS_ACT), WSP(unsigned char, WS_WDN) + (size_t)NE * D * FF * EB, FF * EB, nullptr}; pg8::TileOrder S; S.init(NE, NB * CAPL / 256, D / 256, ESLOTS / 256, F.G, (int)blockIdx.x);
        pg8::EpiDown E{WSP(bf16, WS_YS), WSP(float, WS_ROWG)};
        pg8::gemm_phase<pg8::EpiDown, pg8::TileOrder, MOE_FP8 != 0>(F.lds, g, S, E, F.tid); });
    PHASE(PH_COMB1, ph_combine(p, F, 1));
#undef PHASE
#undef IN
#undef SEAM
}

__global__ void __launch_bounds__(256) n_gemm(const bf16* A, int lda, const float* W, int ldw, float* C, int ldc, int M, int N, int K) {
    __shared__ float As[16][65], Bs[16][64];
    const int t = threadIdx.x, tx = t & 15, ty = t >> 4, m0 = blockIdx.y * 64, n0 = blockIdx.x * 64;
    float acc[4][4];
#pragma unroll
    for (int i = 0; i < 4; ++i)
#pragma unroll
        for (int j = 0; j < 4; ++j) acc[i][j] = 0.f;
    for (int k0 = 0; k0 < K; k0 += 16) {
        { const int r = t >> 2, kq = (t & 3) * 4; const v2u w = *(const v2u*)(A + (size_t)(m0 + r) * lda + k0 + kq);
          As[kq + 0][r] = __uint_as_float(w.x << 16); As[kq + 1][r] = __uint_as_float(w.x & 0xffff0000u); As[kq + 2][r] = __uint_as_float(w.y << 16); As[kq + 3][r] = __uint_as_float(w.y & 0xffff0000u); }
        { const int k = t >> 4, n = (t & 15) * 4;
#pragma unroll
          for (int j = 0; j < 4; ++j) Bs[k][n + j] = (n0 + n + j < N) ? W[(size_t)(k0 + k) * ldw + n0 + n + j] : 0.f; }
        __syncthreads();
#pragma unroll
        for (int kk = 0; kk < 16; ++kk) { float a[4], b[4];
#pragma unroll
            for (int i = 0; i < 4; ++i) { a[i] = As[kk][ty * 4 + i]; b[i] = Bs[kk][tx * 4 + i]; }
#pragma unroll
            for (int i = 0; i < 4; ++i)
#pragma unroll
                for (int j = 0; j < 4; ++j) acc[i][j] += a[i] * b[j]; }
        __syncthreads();
    }
#pragma unroll
    for (int i = 0; i < 4; ++i)
#pragma unroll
        for (int j = 0; j < 4; ++j) if (n0 + tx * 4 + j < N) C[(size_t)(m0 + ty * 4 + i) * ldc + n0 + tx * 4 + j] = acc[i][j];
}
__global__ void n_post_qkv(const float* T, int r0, int rows, bf16* Q, bf16* Kb, bf16* Vb) {
    const size_t i = (size_t)blockIdx.x * blockDim.x + threadIdx.x; if (i >= (size_t)rows * ATT_N) return;
    const int rl = (int)(i / ATT_N), c = (int)(i % ATT_N), r = r0 + rl; float val = T[i];
    if (c < 1280 && r < NL) { const int d = c & 63, a = d >> 5, s = (d >> 4) & 1, f = d & 15, t = r & (SEQ - 1); const float xp = T[(size_t)rl * ATT_N + (s ? c - 16 : c + 16)];
        const float inv = powf(10000.f, -(float)f / 16.f), ang = (float)(a ? (t & 63) : (t >> 6)) * inv, cs = cosf(ang), sn = sinf(ang);
        val = s == 0 ? val * cs - xp * sn : val * cs + xp * sn; }
    if (c < 1024) Q[(size_t)r * 1024 + c] = (bf16)f2bf(val * QSCALE); else if (c < 1280) Kb[(size_t)r * 256 + c - 1024] = (bf16)f2bf(val); else Vb[(size_t)r * 256 + c - 1280] = (bf16)f2bf(val);
}
__global__ void n_post_resid(const float* T, int r0, int rows, const float* xlat, const float* xctx, float* XA, const float* mod_g) {
    const size_t i = (size_t)blockIdx.x * blockDim.x + threadIdx.x; if (i >= (size_t)rows * D) return;
    const int rl = (int)(i / D), c = (int)(i % D), r = r0 + rl; const int j = r < NL ? r / SEQ : 16;
    const float xs = r < NL ? xlat[(size_t)r * D + c] : xctx[(size_t)(r - NL) * D + c];
    XA[(size_t)r * D + c] = xs + mod_g[(size_t)j * 6144 + c] * T[i];
}
__global__ void n_post_swiglu(const float* T, int rows, bf16* ACTrow0) {
    const size_t i = (size_t)blockIdx.x * blockDim.x + threadIdx.x; if (i >= (size_t)rows * FF) return;
    const int rl = (int)(i / FF), f = (int)(i % FF); const float g = T[(size_t)rl * 5632 + f], u = T[(size_t)rl * 5632 + FF + f];
    ACTrow0[(size_t)rl * FF + f] = (bf16)f2bf(silu_f(g) * u);
}
__global__ void n_post_down(const float* T, int rows, bf16* YSrow0, const float* rowg0) {
    const size_t i = (size_t)blockIdx.x * blockDim.x + threadIdx.x; if (i >= (size_t)rows * D) return;
    const int rl = (int)(i / D); YSrow0[i] = (bf16)f2bf(rowg0[rl] * T[i]);
}
__global__ void n_post_cast(const float* T, size_t n, bf16* O) { const size_t i = (size_t)blockIdx.x * blockDim.x + threadIdx.x; if (i < n) O[i] = (bf16)f2bf(T[i]); }
__global__ void __launch_bounds__(256) n_attn(const bf16* Q, const bf16* Kb, const bf16* Vb, const float* sink, bf16* O) {
    const int i = blockIdx.x * blockDim.x + threadIdx.x; if (i >= NT * NQH) return;
    const int r = i >> 4, hq = i & 15, hk = hq >> 2;
    float q[64], acc[64];
#pragma unroll
    for (int d = 0; d < 64; ++d) { q[d] = bf2f(Q[(size_t)r * 1024 + hq * 64 + d]); acc[d] = 0.f; }
    float m = sink[hq] * LOG2E, l = 1.f;
    const bool lat = r < NL; const int b = lat ? r / SEQ : (r - NL) / CTX, t = r & (SEQ - 1);
    const int nlat = lat ? (min(SEQ - 1, t + 128) - max(0, t - 128) + 1) : 0, klo = max(0, t - 128);
    for (int kk = 0; kk < CTX + nlat; ++kk) {
        const int kr = kk < CTX ? NL + b * CTX + kk : b * SEQ + klo + (kk - CTX);
        const bf16* kp = Kb + (size_t)kr * 256 + hk * 64; const bf16* vp = Vb + (size_t)kr * 256 + hk * 64;
        float s = 0.f;
#pragma unroll
        for (int d = 0; d < 64; ++d) s += q[d] * bf2f(kp[d]);
        const float mn = fmaxf(m, s), sc = exp2f(m - mn), pe = exp2f(s - mn);
        l = l * sc + pe; m = mn;
#pragma unroll
        for (int d = 0; d < 64; ++d) acc[d] = acc[d] * sc + pe * bf2f(vp[d]);
    }
    const float il = 1.f / l;
#pragma unroll
    for (int d = 0; d < 64; ++d) O[(size_t)r * 1024 + hq * 64 + d] = (bf16)f2bf(acc[d] * il);
}
__global__ void __launch_bounds__(512) n_glascan(const bf16* PG, const float* w2, const float* gb, bf16* OF, bf16* OB) {
    const int u = blockIdx.x, sl = u & 3, dir = (u >> 2) & 1, h = (u >> 3) & 3, b = u >> 5;
    __shared__ float sq[128], sk[128], sa[128], sv[64], so[8][64];
    const int tid = threadIdx.x, e = tid & 63, w = tid >> 6;
    float S[16];
#pragma unroll
    for (int i = 0; i < 16; ++i) S[i] = 0.f;
    bf16* OUT = dir ? OB : OF;
    for (int step = 0; step < CTX + SEQ; ++step) {
        int row; if (step < CTX) row = NL + b * CTX + (dir ? CTX - 1 - step : step); else { const int t = step - CTX; row = b * SEQ + (dir ? SEQ - 1 - t : t); }
        const bf16* pr = PG + (size_t)row * GIN;
        if (tid < 128) { const int col = h * 128 + tid; float z = gb[dir * 512 + col];
#pragma unroll
            for (int r = 0; r < 16; ++r) z += bf2f(pr[3072 + dir * 16 + r]) * w2[(size_t)(dir * 16 + r) * 512 + col];
            const float ls = fminf(z, 0.f) - log1pf(expf(-fabsf(z)));
            sq[tid] = bf2f(pr[col]) * GLA_QS; sk[tid] = bf2f(pr[GQR + col]); sa[tid] = expf(ls * (1.f / 16.f)); }
        else if (tid < 192) sv[tid - 128] = bf2f(pr[GQR + GQK + h * 256 + sl * 64 + tid - 128]);
        __syncthreads();
        const float v = sv[e]; float o = 0.f;
#pragma unroll
        for (int i = 0; i < 16; ++i) { const int d = 16 * w + i; S[i] = sa[d] * S[i] + sk[d] * v; o += sq[d] * S[i]; }
        so[w][e] = o;
        __syncthreads();
        if (step >= CTX && tid < 64) { float s = 0.f;
#pragma unroll
            for (int q = 0; q < 8; ++q) s += so[q][tid];
            OUT[(size_t)row * GV + h * 256 + sl * 64 + tid] = (bf16)f2bf(s); }
    }
}

static void launch_phase(P p, int lo, int hi, int grid, hipStream_t stream) { p.lo = lo; p.hi = hi; hipLaunchKernelGGL(k_fwd, dim3(grid), dim3(NWAVES * 64), LDS_BYTES, stream, p); }
static void naive_gemm(const bf16* A, int lda, const float* W, int ldw, float* C, int ldc, int M, int N, int K, hipStream_t s) {
    hipLaunchKernelGGL(n_gemm, dim3((N + 63) / 64, M / 64), dim3(256), 0, s, A, lda, W, ldw, C, ldc, M, N, K);
}
#define EW_GRID(n) dim3((unsigned)(((size_t)(n) + 255) / 256)), dim3(256), 0, stream

extern "C" void kernel_launch(void* const* d_in, const int* in_sizes, int n_in, void* d_out, int out_size, void* d_ws, size_t ws_size, hipStream_t stream) {
    static int grid = 0;
    if (grid == 0) {
        if (n_in != 21 || out_size != NL * D || ws_size < WS_END) { fprintf(stderr, "kernel_launch: unexpected shapes (n_in %d out %d ws %zu need %zu)\n", n_in, out_size, ws_size, (size_t)WS_END); grid = -1; return; }
        int dev = 0, cus = 0;
        if (hipGetDevice(&dev) != hipSuccess || hipDeviceGetAttribute(&cus, hipDeviceAttributeMultiprocessorCount, dev) != hipSuccess) { grid = -1; return; }
        if (hipFuncSetAttribute((const void*)k_fwd, hipFuncAttributeMaxDynamicSharedMemorySize, LDS_BYTES) != hipSuccess) { fprintf(stderr, "kernel_launch: hipFuncSetAttribute failed\n"); grid = -1; return; }
        int per_cu = 0;
        if (hipOccupancyMaxActiveBlocksPerMultiprocessor(&per_cu, (const void*)k_fwd, NWAVES * 64, LDS_BYTES) != hipSuccess || per_cu < 1) fprintf(stderr, "kernel_launch: occupancy query says %d\n", per_cu);
        (void)hipGetLastError();
        grid = cus;
    }
    if (grid < 0) return;
    hipMemsetAsync((char*)d_ws + WS_CTL, 0, CTL_ZERO_BYTES, stream);
    P p{};
    const float** pp = (const float**)&p;
    for (int i = 0; i < 21; ++i) pp[i] = (const float*)d_in[i];
    p.out = (float*)d_out; p.ws = (unsigned char*)d_ws; p.lo = 0; p.hi = 0;
    unsigned char* ws = (unsigned char*)d_ws;
#define WS(T, off) ((T*)(ws + (off)))
#if ONE_LAUNCH
    launch_phase(p, 0, PH_END, grid, stream);
#else
    float* TMP = WS(float, WS_TMP);
    launch_phase(p, PH_PRO, PH_PRO + 1, grid, stream);
    launch_phase(p, PH_NORM1_0, PH_NORM1_0 + 1, grid, stream);
    if (OPT_MASK & 1) launch_phase(p, PH_QKV, PH_QKV + 1, grid, stream);
    else for (int ch = 0; ch < NT / 2048; ++ch) { const int r0 = ch * 2048;
        naive_gemm(WS(bf16, WS_H) + (size_t)r0 * D, D, p.attn_w_in, ATT_N, TMP, ATT_N, 2048, ATT_N, D, stream);
        hipLaunchKernelGGL(n_post_qkv, EW_GRID((size_t)2048 * ATT_N), TMP, r0, 2048, WS(bf16, WS_Q), WS(bf16, WS_K), WS(bf16, WS_V)); }
    if (OPT_MASK & 256) launch_phase(p, PH_ATTN, PH_ATTN + 1, grid, stream);
    else hipLaunchKernelGGL(n_attn, dim3(NT * NQH / 256), dim3(256), 0, stream, WS(bf16, WS_Q), WS(bf16, WS_K), WS(bf16, WS_V), p.attn_sink, WS(bf16, WS_O));
    if (OPT_MASK & 2) launch_phase(p, PH_OUT0, PH_OUT0 + 1, grid, stream);
    else for (int ch = 0; ch < NT / 2048; ++ch) { const int r0 = ch * 2048;
        naive_gemm(WS(bf16, WS_O) + (size_t)r0 * D, D, p.attn_w_out, D, TMP, D, 2048, D, D, stream);
        hipLaunchKernelGGL(n_post_resid, EW_GRID((size_t)2048 * D), TMP, r0, 2048, p.x, p.ctx, WS(float, WS_XA), WS(float, WS_MOD) + 2048); }
    launch_phase(p, PH_N2R0, PH_N2R0 + 1, grid, stream);
    launch_phase(p, PH_TOPK0, PH_TOPK0 + 1, grid, stream);
    for (int l = 0; l < 2; ++l) {
        if (l == 1) {
            if (OPT_MASK & 16) launch_phase(p, PH_GLAIN, PH_GLAIN + 1, grid, stream);
            else for (int ch = 0; ch < NT / 2048; ++ch) { const int r0 = ch * 2048;
                naive_gemm(WS(bf16, WS_H) + (size_t)r0 * D, D, p.gla_w_in, GIN, TMP, GIN, 2048, GIN, D, stream);
                hipLaunchKernelGGL(n_post_cast, EW_GRID((size_t)2048 * GIN), TMP, (size_t)2048 * GIN, WS(bf16, WS_PG) + (size_t)r0 * GIN); }
            if (OPT_MASK & 512) launch_phase(p, PH_SCAN, PH_SCAN + 1, grid, stream);
            else hipLaunchKernelGGL(n_glascan, dim3(512), dim3(512), 0, stream, WS(bf16, WS_PG), p.gla_gate_w2, p.gla_gate_b, WS(bf16, WS_OF), WS(bf16, WS_OB));
            launch_phase(p, PH_READ, PH_READ + 1, grid, stream);
            if (OPT_MASK & 32) launch_phase(p, PH_OUT1, PH_OUT1 + 1, grid, stream);
            else for (int ch = 0; ch < NL / 2048; ++ch) { const int r0 = ch * 2048;
                naive_gemm(WS(bf16, WS_H) + (size_t)r0 * D, D, p.gla_w_out, D, TMP, D, 2048, D, D, stream);
                hipLaunchKernelGGL(n_post_resid, EW_GRID((size_t)2048 * D), TMP, r0, 2048, WS(float, WS_XA), WS(float, WS_XA), WS(float, WS_XA), WS(float, WS_MOD) + 17 * 6144 + 2048); }
            launch_phase(p, PH_N2R1, PH_N2R1 + 1, grid, stream);
            launch_phase(p, PH_TOPK1, PH_TOPK1 + 1, grid, stream);
        }
        const int rows_e = l == 0 ? ESLOTS : NB * CAPL, chunk = l == 0 ? 2304 : 2048;
        const bool up_opt = OPT_MASK & (l == 0 ? 4 : 64), dn_opt = OPT_MASK & (l == 0 ? 8 : 128);
        if (up_opt && dn_opt) { launch_phase(p, l == 0 ? PH_UP0 : PH_UP1, (l == 0 ? PH_UP0 : PH_UP1) + 1, grid, stream); launch_phase(p, l == 0 ? PH_DN0 : PH_DN1, (l == 0 ? PH_DN0 : PH_DN1) + 1, grid, stream); }
        else {
            if (up_opt) launch_phase(p, l == 0 ? PH_UP0 : PH_UP1, (l == 0 ? PH_UP0 : PH_UP1) + 1, grid, stream);
            else for (int e = 0; e < NE; ++e) for (int r0 = 0; r0 < rows_e; r0 += chunk) {
                const size_t row = (size_t)e * ESLOTS + r0; const size_t le = (size_t)(l * NE + e);
                naive_gemm(WS(bf16, WS_XG) + row * D, D, p.exp_w_gate + le * D * FF, FF, TMP, 5632, chunk, FF, D, stream);
                naive_gemm(WS(bf16, WS_XG) + row * D, D, p.exp_w_up + le * D * FF, FF, TMP + FF, 5632, chunk, FF, D, stream);
                hipLaunchKernelGGL(n_post_swiglu, EW_GRID((size_t)chunk * FF), TMP, chunk, WS(bf16, WS_ACT) + row * FF); }
            if (dn_opt) launch_phase(p, l == 0 ? PH_DN0 : PH_DN1, (l == 0 ? PH_DN0 : PH_DN1) + 1, grid, stream);
            else for (int e = 0; e < NE; ++e) for (int r0 = 0; r0 < rows_e; r0 += chunk) {
                const size_t row = (size_t)e * ESLOTS + r0; const size_t le = (size_t)(l * NE + e);
                naive_gemm(WS(bf16, WS_ACT) + row * FF, FF, p.exp_w_down + le * FF * D, D, TMP, D, chunk, D, FF, stream);
                hipLaunchKernelGGL(n_post_down, EW_GRID((size_t)chunk * D), TMP, chunk, WS(bf16, WS_YS) + row * D, WS(float, WS_ROWG) + row); }
        }
        launch_phase(p, l == 0 ? PH_COMB0 : PH_COMB1, (l == 0 ? PH_COMB0 : PH_COMB1) + 1, grid, stream);
    }
#endif
}
```

```cpp
#include <hip/hip_runtime.h>
#include <cstdio>
#include <cstdint>

#ifndef OPT_MASK
#define OPT_MASK 0x3FF
#endif
#ifndef MOE_FP8
#define MOE_FP8 1
#endif
#ifndef PROBE_MASK
#define PROBE_MASK 0
#endif
#ifndef ONE_LAUNCH
#define ONE_LAUNCH 1
#endif

#define GAS __attribute__((address_space(1)))
#define LAS __attribute__((address_space(3)))
typedef unsigned short bf16;
typedef unsigned v4u __attribute__((ext_vector_type(4)));
typedef unsigned v2u __attribute__((ext_vector_type(2)));
typedef float f32x4 __attribute__((ext_vector_type(4)));
typedef float f32x2 __attribute__((ext_vector_type(2)));
typedef short bf16x8 __attribute__((ext_vector_type(8)));

constexpr int D = 1024, NB = 16, SEQ = 2048, CTX = 256;
constexpr int NL = NB * SEQ, NC = NB * CTX, NT = NL + NC;
constexpr int NQH = 16, NKV = 4, HD = 64, ATT_N = 1536;
constexpr int GH = 4, GDK = 128, GDV = 256, GQK = 512, GV = 1024, GQR = 1536, GIN = 3104, GIN_PAD = 3328;
constexpr int NE = 16, FF = 2816, CAPL = 256, CAPC = 32, ESLOTS = NB * CAPL + NB * CAPC;
constexpr float EPS = 1e-6f;
constexpr float LOG2E = 1.4426950408889634f;
constexpr float QSCALE = 0.125f * LOG2E;
constexpr float GLA_QS = 0.08838834764831845f;
constexpr int EB = MOE_FP8 ? 1 : 2;
constexpr float F8_ACT = 16.f, F8_W = 256.f, F8_INV = 1.f / (16.f * 256.f);

constexpr size_t MiB = 1ull << 20;
constexpr size_t WS_CTL = 0, CTL_ZERO_BYTES = 1 * MiB;
constexpr size_t WS_MOD = 1 * MiB;
constexpr size_t WS_ROPE = WS_MOD + 896 * 1024;
constexpr size_t WS_WQKV = 2 * MiB;
constexpr size_t WS_WO0 = 5 * MiB;
constexpr size_t WS_WGIN = 7 * MiB;
constexpr size_t WS_WO1 = 14 * MiB;
constexpr size_t WS_AFF = 16 * MiB;
constexpr size_t WS_SLOT = 19 * MiB;
constexpr size_t WS_ROWIDX = 22 * MiB;
constexpr size_t WS_ROWG = 22 * MiB + 512 * 1024;
constexpr size_t WS_WUP = 24 * MiB;
constexpr size_t WS_WDN = WS_WUP + 352 * MiB;
constexpr size_t WS_XA = WS_WDN + 176 * MiB;
constexpr size_t WS_H = WS_XA + 144 * MiB;
constexpr size_t WS_E = WS_H + 72 * MiB;
constexpr size_t WS_Q = WS_E, WS_K = WS_E + 72 * MiB, WS_V = WS_E + 90 * MiB, WS_O = WS_E + 108 * MiB;
constexpr size_t WS_PG = WS_E, WS_OF = WS_E + 220 * MiB, WS_OB = WS_E + 284 * MiB;
constexpr size_t WS_QT = WS_E + 348 * MiB, WS_KT = WS_E + 420 * MiB, WS_DEC = WS_E + 492 * MiB;
constexpr size_t WS_XG = WS_E, WS_YS = WS_E, WS_ACT = WS_E + 144 * MiB;
constexpr size_t WS_H8 = WS_E;
constexpr size_t WS_TMP = WS_E + 540 * MiB;
constexpr size_t WS_END = WS_TMP + 50 * MiB;
constexpr int CW_BAR = 4096;

constexpr int RING_BYTES = 131072;
constexpr int LDS_BYTES = 147456;
constexpr int LDSCTL_OFF = LDS_BYTES - 1024, MISC_OFF = LDSCTL_OFF + 320;
constexpr int NWAVES = 8;

__device__ __forceinline__ float bf2f(bf16 v) { return __uint_as_float(((unsigned)v) << 16); }
typedef __bf16 hwbf16x2 __attribute__((ext_vector_type(2)));
__device__ __forceinline__ unsigned pk2(float lo, float hi) { const f32x2 v = {lo, hi}; return __builtin_bit_cast(unsigned, __builtin_convertvector(v, hwbf16x2)); }
__device__ __forceinline__ unsigned f2bf(float f) { return pk2(f, 0.f) & 0xffffu; }
__device__ __forceinline__ float clamp448(float v) { return __builtin_fminf(__builtin_fmaxf(v, -448.f), 448.f); }
__device__ __forceinline__ unsigned pk4_fp8(float a, float b, float c, float d) { int w = 0; w = __builtin_amdgcn_cvt_pk_fp8_f32(clamp448(a), clamp448(b), w, false); w = __builtin_amdgcn_cvt_pk_fp8_f32(clamp448(c), clamp448(d), w, true); return (unsigned)w; }
typedef _Float16 f16x4 __attribute__((ext_vector_type(4)));
typedef unsigned short xa_t;
__device__ __forceinline__ v2u pack_h4(f32x4 v) { return __builtin_bit_cast(v2u, __builtin_convertvector(v, f16x4)); }
__device__ __forceinline__ f32x4 unpack_h4(v2u w) { return __builtin_convertvector(__builtin_bit_cast(f16x4, w), f32x4); }
template <int CTRL, int RMASK> __device__ __forceinline__ float dpp_add(float x) { return x + __builtin_bit_cast(float, __builtin_amdgcn_update_dpp(0, __builtin_bit_cast(int, x), CTRL, RMASK, 0xf, false)); }
__device__ __forceinline__ float wave_sum(float v) {
    v = dpp_add<0xB1, 0xf>(v);
    v = dpp_add<0x4E, 0xf>(v);
    v = dpp_add<0x141, 0xf>(v);
    v = dpp_add<0x140, 0xf>(v);
    v = dpp_add<0x142, 0xa>(v);
    v = dpp_add<0x143, 0xc>(v);
    return __builtin_bit_cast(float, __builtin_amdgcn_readlane(__builtin_bit_cast(int, v), 63));
}
__device__ __forceinline__ float silu_f(float v) { return v / (1.f + expf(-v)); }
__device__ __forceinline__ float fexp(float x) { return __builtin_amdgcn_exp2f(x * LOG2E); }
__device__ __forceinline__ float flog(float x) { return __builtin_amdgcn_logf(x) * 0.6931471805599453f; }
__device__ __forceinline__ float fsilu(float v) { return v * __builtin_amdgcn_rcpf(1.f + fexp(-v)); }
template <int d> __device__ __forceinline__ float dpp_shr(float x) { return __builtin_bit_cast(float, __builtin_amdgcn_update_dpp(0, __builtin_bit_cast(int, x), 0x110 + d, 0xf, 0xf, true)); }
#define LDS_WAIT() asm volatile("s_waitcnt lgkmcnt(0)" ::: "memory")
#define LDS_SYNC() asm volatile("s_waitcnt lgkmcnt(0)\n\ts_barrier" ::: "memory")
#define VM_WAIT() asm volatile("s_waitcnt vmcnt(0)" ::: "memory")

struct P {
    const float *x, *c, *ctx, *c_ctx, *ada_w, *ada_b, *norm1_g, *norm2_g, *attn_w_in, *attn_w_out, *attn_sink,
        *gla_w_in, *gla_gate_w2, *gla_gate_b, *gla_norm_g, *gla_w_out, *router_w, *exp_w_gate, *exp_w_up, *exp_w_down, *final_norm_g;
    float* out; unsigned char* ws;
    int lo, hi;
};

namespace pg8 {
#define PG8_LAS __attribute__((address_space(3)))
typedef unsigned short bf16_t;
typedef unsigned u32x4 __attribute__((ext_vector_type(4)));
typedef unsigned u32x2 __attribute__((ext_vector_type(2)));
constexpr int BM = 256, BK = 64, HALF = 128, HTB = HALF * BK * 2, STAGE_BYTES = 8 * HTB, NXCD = 8, WGM = 8;
__host__ __device__ __forceinline__ int lds_byte(int r, int c) { const int st = (r >> 4) * 2 + (c >> 5), rr = r & 15, cc = c & 31, ob = rr * 64 + cc * 2; return st * 1024 + (ob ^ (((ob >> 9) & 1) << 5)); }
__host__ __device__ __forceinline__ void stage_rc(int b, int& R, int& C) { const int st = b / 1024, sb = b % 1024, swz = sb ^ (((sb >> 9) & 1) << 5); R = (st >> 1) * 16 + swz / 64; C = (st & 1) * 32 + (swz % 64) / 2; }
__host__ __device__ __forceinline__ int perm32(int rho) { const int n = rho >> 4, i = rho & 15; return 8 * (i >> 2) + 4 * n + (i & 3); }
struct Unit { int pm, pn; };
struct Gemm { const void* A; const void* Bt; int KB; const int* gidx; };
struct TileOrder {
    int nG, nM, nN, sM, G, c, per, nwg;
    __device__ __forceinline__ void init(int nG_, int nM_, int nN_, int sM_, int G_, int c_) { nG = nG_; nM = nM_; nN = nN_; sM = sM_; G = G_; c = c_; per = nM * nN; nwg = nG * per; }
    __device__ __forceinline__ bool next(int i, Unit& u) const {
        const long L = (long)i * G + c; if (L >= nwg) return false;
        int wgid = (int)L; { const int q = nwg / NXCD, r = nwg % NXCD, xcd = wgid % NXCD, off = wgid / NXCD; wgid = (xcd < r ? xcd * (q + 1) : r * (q + 1) + (xcd - r) * q) + off; }
        const int g = wgid / per, rem = wgid % per;
        const int nig = WGM * nN, gid = rem / nig, fm = gid * WGM, gsz = (nM - fm) < WGM ? (nM - fm) : WGM;
        u.pm = g * sM + fm + ((rem % nig) % gsz); u.pn = g * nN + (rem % nig) / gsz; return true;
    }
};
struct GlaInOrder {
    int G, c;
    __device__ __forceinline__ bool next(int i, Unit& u) const {
        constexpr int NLAT = (NL / BM) * 13, NALL = NLAT + (NC / BM) * 7;
        const long L = (long)i * G + c; if (L >= NALL) return false;
        int wgid = (int)L; { const int q = NALL / NXCD, xcd = wgid % NXCD, off = wgid / NXCD; wgid = xcd * q + off; }
        if (wgid < NLAT) { const int nig = WGM * 13, gid = wgid / nig, fm = gid * WGM; u.pm = fm + ((wgid % nig) % WGM); u.pn = (wgid % nig) / WGM; }
        else { const int r = wgid - NLAT; u.pm = NL / BM + (r & 15); u.pn = 6 + (r >> 4); }
        return true;
    }
};
__device__ __forceinline__ unsigned cvt_pk_bf16(float lo, float hi) { unsigned r; asm volatile("v_cvt_pk_bf16_f32 %0, %1, %2" : "=v"(r) : "v"(lo), "v"(hi)); return r; }

struct EpiQKV {
    static constexpr bool PERM = false;
    bf16_t *Q, *Kb, *Vb; const float* rope;
    __device__ __forceinline__ void operator()(const f32x4 (&acc)[2][2][4][2], const Unit& u, int wr, int wc, int fr, int fq) const {
        const int row0 = u.pm * BM + wr * 64 + fr; const bool latent = u.pm < (NL / BM);
        const int kind = u.pn < 4 ? 0 : (u.pn == 4 ? 1 : 2);
        const size_t boff = (kind >= 1 ? (size_t)(WS_K - WS_Q) / 2 : 0) + (kind == 2 ? (size_t)(WS_V - WS_K) / 2 : 0);
        bf16_t* base = Q + boff; const int ldc = kind == 0 ? 1024 : 256; const int colt = kind == 0 ? u.pn * BM : 0;
        const float sc = kind == 0 ? QSCALE : 1.f;
        f32x4 rc0[2][4], rc1[2][4];
#pragma unroll
        for (int ai = 0; ai < 2; ++ai)
#pragma unroll
            for (int m = 0; m < 4; ++m) { const int t = (row0 + ai * HALF + m * 16) & (SEQ - 1);
                rc0[ai][m] = (f32x4){1.f, 0.f, 1.f, 0.f}; rc1[ai][m] = rc0[ai][m];
                if (latent && kind != 2) { const int pos = (wc & 1) ? (t & 63) : (t >> 6); const f32x4* tp = (const f32x4*)(rope + (size_t)(pos * 16 + 4 * fq) * 2); rc0[ai][m] = tp[0]; rc1[ai][m] = tp[1]; } }
#pragma unroll
        for (int ai = 0; ai < 2; ++ai)
#pragma unroll
            for (int m = 0; m < 4; ++m) {
                const int r = row0 + ai * HALF + m * 16;
                const f32x4 cs0 = rc0[ai][m], cs1 = rc1[ai][m];
                const float cs[4] = {cs0[0], cs0[2], cs1[0], cs1[2]}, sn[4] = {cs0[1], cs0[3], cs1[1], cs1[3]};
                bf16_t* rowp = base + (size_t)r * ldc + colt + wc * 32 + 4 * fq;
#pragma unroll
                for (int bj = 0; bj < 2; ++bj) {
                    const f32x4 x0 = acc[ai][bj][m][0], x1 = acc[ai][bj][m][1]; float o0[4], o1[4];
#pragma unroll
                    for (int j = 0; j < 4; ++j) { o0[j] = (x0[j] * cs[j] - x1[j] * sn[j]) * sc; o1[j] = (x1[j] * cs[j] + x0[j] * sn[j]) * sc; }
                    u32x2 w0, w1; w0.x = cvt_pk_bf16(o0[0], o0[1]); w0.y = cvt_pk_bf16(o0[2], o0[3]); w1.x = cvt_pk_bf16(o1[0], o1[1]); w1.y = cvt_pk_bf16(o1[2], o1[3]);
                    *(u32x2*)(rowp + bj * HALF) = w0; *(u32x2*)(rowp + bj * HALF + 16) = w1;
                }
            }
    }
};
template <bool SRC16>
struct EpiResidT {
    static constexpr bool PERM = false;
    const float *xlat, *xctx; xa_t* XA; const float* mod_g;
    __device__ __forceinline__ void operator()(const f32x4 (&acc)[2][2][4][2], const Unit& u, int wr, int wc, int fr, int fq) const {
        const int row0 = u.pm * BM + wr * 64 + fr, col0 = u.pn * BM + wc * 32 + 4 * fq; const bool latent = u.pm < (NL / BM);
        const float* src = latent ? xlat : xctx - (size_t)NL * D; const int j = latent ? (u.pm >> 3) : 16;
        f32x4 gv[2][2];
#pragma unroll
        for (int bj = 0; bj < 2; ++bj)
#pragma unroll
            for (int n = 0; n < 2; ++n) gv[bj][n] = *(const f32x4*)(mod_g + (size_t)j * 6144 + col0 + bj * HALF + n * 16);
#pragma unroll
        for (int ai = 0; ai < 2; ++ai)
#pragma unroll
            for (int mp = 0; mp < 2; ++mp) { f32x4 xs[2][2][2]; v2u xh[2][2][2];
#pragma unroll
                for (int mm = 0; mm < 2; ++mm) { const size_t off = (size_t)(row0 + ai * HALF + (2 * mp + mm) * 16) * D + col0;
#pragma unroll
                    for (int bj = 0; bj < 2; ++bj)
#pragma unroll
                        for (int n = 0; n < 2; ++n) { if constexpr (SRC16) xh[mm][bj][n] = *(const v2u*)(XA + off + bj * HALF + n * 16); else xs[mm][bj][n] = *(const f32x4*)(src + off + bj * HALF + n * 16); } }
                if constexpr (SRC16) asm volatile("" : "+v"(xh[0][0][0]), "+v"(xh[0][0][1]), "+v"(xh[0][1][0]), "+v"(xh[0][1][1]), "+v"(xh[1][0][0]), "+v"(xh[1][0][1]), "+v"(xh[1][1][0]), "+v"(xh[1][1][1]) :: "memory");
                else asm volatile("" : "+v"(xs[0][0][0]), "+v"(xs[0][0][1]), "+v"(xs[0][1][0]), "+v"(xs[0][1][1]), "+v"(xs[1][0][0]), "+v"(xs[1][0][1]), "+v"(xs[1][1][0]), "+v"(xs[1][1][1]) :: "memory");
#pragma unroll
                for (int mm = 0; mm < 2; ++mm) { const size_t off = (size_t)(row0 + ai * HALF + (2 * mp + mm) * 16) * D + col0;
#pragma unroll
                    for (int bj = 0; bj < 2; ++bj)
#pragma unroll
                        for (int n = 0; n < 2; ++n) { const f32x4 xin = SRC16 ? unpack_h4(xh[mm][bj][n]) : xs[mm][bj][n];
                            *(v2u*)(XA + off + bj * HALF + n * 16) = pack_h4(xin + gv[bj][n] * acc[ai][bj][2 * mp + mm][n]); } }
                asm volatile("" ::: "memory"); }
    }
};
struct EpiSwiglu {
    static constexpr bool PERM = true;
    unsigned char* ACT;
    __device__ __forceinline__ void operator()(const f32x4 (&acc)[2][2][4][2], const Unit& u, int wr, int wc, int fr, int fq) const {
        const int row0 = u.pm * BM + wr * 64 + fr, nl = u.pn % (FF / 128), col0 = nl * 128 + wc * 32 + 8 * fq;
        const float sin_ = MOE_FP8 ? F8_INV : 1.f, sout = MOE_FP8 ? F8_ACT : 1.f;
#pragma unroll
        for (int ai = 0; ai < 2; ++ai)
#pragma unroll
            for (int m = 0; m < 4; ++m) { float o[8];
#pragma unroll
                for (int n = 0; n < 2; ++n)
#pragma unroll
                    for (int j = 0; j < 4; ++j) { const float g = acc[ai][0][m][n][j] * sin_, up = acc[ai][1][m][n][j] * sin_; o[n * 4 + j] = g * __builtin_amdgcn_rcpf(1.f + __builtin_amdgcn_exp2f(g * -1.4426950408889634f)) * (up * sout); }
                unsigned char* dst = ACT + ((size_t)(row0 + ai * HALF + m * 16) * FF + col0) * EB;
                if (MOE_FP8) { u32x2 w; w.x = pk4_fp8(o[0], o[1], o[2], o[3]); w.y = pk4_fp8(o[4], o[5], o[6], o[7]); *(u32x2*)dst = w; }
                else { u32x4 w; w.x = cvt_pk_bf16(o[0], o[1]); w.y = cvt_pk_bf16(o[2], o[3]); w.z = cvt_pk_bf16(o[4], o[5]); w.w = cvt_pk_bf16(o[6], o[7]); *(u32x4*)dst = w; } }
    }
};
struct EpiDown {
    static constexpr bool PERM = true;
    bf16_t* YS; const float* rowg;
    __device__ __forceinline__ void operator()(const f32x4 (&acc)[2][2][4][2], const Unit& u, int wr, int wc, int fr, int fq) const {
        const int row0 = u.pm * BM + wr * 64 + fr, col0 = (u.pn & 3) * BM + wc * 32 + 8 * fq;
        float gr[2][4];
#pragma unroll
        for (int ai = 0; ai < 2; ++ai)
#pragma unroll
            for (int m = 0; m < 4; ++m) gr[ai][m] = rowg[row0 + ai * HALF + m * 16];
#pragma unroll
        for (int ai = 0; ai < 2; ++ai)
#pragma unroll
            for (int m = 0; m < 4; ++m) { const int r = row0 + ai * HALF + m * 16; const float g = gr[ai][m] * (MOE_FP8 ? F8_INV : 1.f);
#pragma unroll
                for (int bj = 0; bj < 2; ++bj) { const f32x4 v0 = acc[ai][bj][m][0] * g, v1 = acc[ai][bj][m][1] * g;
                    u32x4 w; w.x = cvt_pk_bf16(v0[0], v0[1]); w.y = cvt_pk_bf16(v0[2], v0[3]); w.z = cvt_pk_bf16(v1[0], v1[1]); w.w = cvt_pk_bf16(v1[2], v1[3]);
                    *(u32x4*)(YS + (size_t)r * D + col0 + bj * HALF) = w; } }
    }
};
struct EpiGlaIn {
    static constexpr bool PERM = true;
    bf16_t* PG;
    __device__ __forceinline__ void operator()(const f32x4 (&acc)[2][2][4][2], const Unit& u, int wr, int wc, int fr, int fq) const {
        const int row0 = u.pm * BM + wr * 64 + fr, col0 = u.pn * BM + wc * 32 + 8 * fq;
#pragma unroll
        for (int ai = 0; ai < 2; ++ai)
#pragma unroll
            for (int m = 0; m < 4; ++m) { const int r = row0 + ai * HALF + m * 16;
#pragma unroll
                for (int bj = 0; bj < 2; ++bj) { const f32x4 v0 = acc[ai][bj][m][0], v1 = acc[ai][bj][m][1];
                    u32x4 w; w.x = cvt_pk_bf16(v0[0], v0[1]); w.y = cvt_pk_bf16(v0[2], v0[3]); w.z = cvt_pk_bf16(v1[0], v1[1]); w.w = cvt_pk_bf16(v1[2], v1[3]);
                    if (col0 + bj * HALF < GIN) *(u32x4*)(PG + (size_t)r * GIN + col0 + bj * HALF) = w; } }
    }
};

typedef int v8i __attribute__((ext_vector_type(8)));
typedef int v4i __attribute__((ext_vector_type(4)));
__device__ __forceinline__ v8i cat8(bf16x8 lo, bf16x8 hi) { return __builtin_shufflevector(__builtin_bit_cast(v4i, lo), __builtin_bit_cast(v4i, hi), 0, 1, 2, 3, 4, 5, 6, 7); }
template <class Epi, class Sched, bool FP8 = false, bool ALIGN_EPI = true, bool GATHER = false>
__device__ __forceinline__ void gemm_phase(PG8_LAS unsigned char* lds, const Gemm g, const Sched& S, const Epi& E, const int tid) {
    const int wid = __builtin_amdgcn_readfirstlane(tid >> 6), lane = tid & 63, wr = wid >> 2, wc = wid & 3, fr = lane & 15, fq = lane >> 4;
    const int KB = g.KB, nt = KB / 128;
    unsigned voffA, voffB; int Rl, Cb;
    { int R, C; stage_rc(tid * 16, R, C); const int Rb = Epi::PERM ? ((R & ~31) + perm32(R & 31)) : R; voffA = (unsigned)(R * KB + C * 2); voffB = (unsigned)(Rb * KB + C * 2); Rl = R; Cb = C * 2; }
    unsigned gA[2][2], gN[2][2]; constexpr int GOFF = STAGE_BYTES;
    const unsigned r64 = 64u * (unsigned)KB;
    const unsigned kstep = 128u;
    const unsigned hstep = (unsigned)(HALF * KB);
    const unsigned tstep = 2u * hstep;
    const __amdgpu_buffer_rsrc_t rsA = __builtin_amdgcn_make_buffer_rsrc(const_cast<void*>(g.A), 0, 0x7fffffff, 0x00020000), rsB = __builtin_amdgcn_make_buffer_rsrc(const_cast<void*>(g.Bt), 0, 0x7fffffff, 0x00020000);
    const unsigned ldsw = (unsigned)wid * 1024u;
    const int aoff = lds_byte(wr * 64 + fr, fq * 8), boff = lds_byte(wc * 32 + fr, fq * 8);
    const int sw8 = (fr * 64 + (fq & 1) * 32) ^ (((fr >> 3) & 1) << 5);
    const int a8off = (wr * 8 + (fq >> 1)) * 1024 + sw8, b8off = (wc * 4 + (fq >> 1)) * 1024 + sw8;
#define PG8_SA(b, h) (((b) * 2 + (h)) * HTB)
#define PG8_SB(b, h) ((4 + (b) * 2 + (h)) * HTB)
#define PG8_STAGE(bufoff, rs, soff, voff) do { _Pragma("unroll") for (int _i = 0; _i < 2; ++_i) \
        __builtin_amdgcn_raw_ptr_buffer_load_lds(rs, (PG8_LAS void*)(lds + (bufoff) + ldsw + _i * 8192), 16, (int)(voff), (int)((soff) + _i * r64), 0, 0); } while (0)
#define PG8_STAGE_A(bufoff, h, soff, kofs, gsel) do { if constexpr (GATHER) { _Pragma("unroll") for (int _i = 0; _i < 2; ++_i) \
        __builtin_amdgcn_raw_ptr_buffer_load_lds(rsA, (PG8_LAS void*)(lds + (bufoff) + ldsw + _i * 8192), 16, (int)(gsel)[h][_i], (int)(kofs), 0, 0); } else PG8_STAGE(bufoff, rsA, soff, voffA); } while (0)
#define PG8_LDA(dst, b, h) do { _Pragma("unroll") for (int m = 0; m < 4; ++m) { if constexpr (FP8) dst##8[m] = cat8(*(const PG8_LAS bf16x8*)(lds + PG8_SA(b, h) + aoff + m * 2048), *(const PG8_LAS bf16x8*)(lds + PG8_SA(b, h) + aoff + m * 2048 + 1024)); \
        else { _Pragma("unroll") for (int k = 0; k < 2; ++k) dst[m][k] = *(const PG8_LAS bf16x8*)(lds + PG8_SA(b, h) + aoff + m * 2048 + k * 1024); } } } while (0)
#define PG8_LDB(dst, b, h) do { _Pragma("unroll") for (int n = 0; n < 2; ++n) { if constexpr (FP8) dst##8[n] = cat8(*(const PG8_LAS bf16x8*)(lds + PG8_SB(b, h) + boff + n * 2048), *(const PG8_LAS bf16x8*)(lds + PG8_SB(b, h) + boff + n * 2048 + 1024)); \
        else { _Pragma("unroll") for (int k = 0; k < 2; ++k) dst[n][k] = *(const PG8_LAS bf16x8*)(lds + PG8_SB(b, h) + boff + n * 2048 + k * 1024); } } } while (0)
#define PG8_MMA8(ai, bj, At, Bt) asm volatile("s_nop 1\n\t" \
        "v_mfma_scale_f32_16x16x128_f8f6f4 %0, %8, %10, %0, %14, %14 op_sel_hi:[0,0,0]\n\t" "v_mfma_scale_f32_16x16x128_f8f6f4 %1, %9, %10, %1, %14, %14 op_sel_hi:[0,0,0]\n\t" \
        "v_mfma_scale_f32_16x16x128_f8f6f4 %2, %8, %11, %2, %14, %14 op_sel_hi:[0,0,0]\n\t" "v_mfma_scale_f32_16x16x128_f8f6f4 %3, %9, %11, %3, %14, %14 op_sel_hi:[0,0,0]\n\t" \
        "v_mfma_scale_f32_16x16x128_f8f6f4 %4, %8, %12, %4, %14, %14 op_sel_hi:[0,0,0]\n\t" "v_mfma_scale_f32_16x16x128_f8f6f4 %5, %9, %12, %5, %14, %14 op_sel_hi:[0,0,0]\n\t" \
        "v_mfma_scale_f32_16x16x128_f8f6f4 %6, %8, %13, %6, %14, %14 op_sel_hi:[0,0,0]\n\t" "v_mfma_scale_f32_16x16x128_f8f6f4 %7, %9, %13, %7, %14, %14 op_sel_hi:[0,0,0]" \
        : "+v"(acc[ai][bj][0][0]), "+v"(acc[ai][bj][0][1]), "+v"(acc[ai][bj][1][0]), "+v"(acc[ai][bj][1][1]), "+v"(acc[ai][bj][2][0]), "+v"(acc[ai][bj][2][1]), "+v"(acc[ai][bj][3][0]), "+v"(acc[ai][bj][3][1]) \
        : "v"(Bt##8[0]), "v"(Bt##8[1]), "v"(At##8[0]), "v"(At##8[1]), "v"(At##8[2]), "v"(At##8[3]), "v"(scl8))
#define PG8_MMA(ai, bj, At, Bt) do { __builtin_amdgcn_s_setprio(1); if constexpr (FP8) { PG8_MMA8(ai, bj, At, Bt); } else { \
        _Pragma("unroll") for (int m = 0; m < 4; ++m) _Pragma("unroll") for (int n = 0; n < 2; ++n) _Pragma("unroll") for (int k = 0; k < 2; ++k) \
        acc[ai][bj][m][n] = __builtin_amdgcn_mfma_f32_16x16x32_bf16(Bt[n][k], At[m][k], acc[ai][bj][m][n], 0, 0, 0); } __builtin_amdgcn_s_setprio(0); } while (0)
#define PG8_WAIT_V(n) asm volatile("s_waitcnt vmcnt(" #n ")" ::: "memory")
#define PG8_WAIT_L(n) asm volatile("s_waitcnt lgkmcnt(" #n ")" ::: "memory")
#define PG8_BAR __builtin_amdgcn_s_barrier()
#define PG8_SCHED __builtin_amdgcn_sched_barrier(0)
    Unit cur, nxt; int ui = 0;
    if (!S.next(0, cur)) return;
    f32x4 acc[2][2][4][2];
#pragma unroll
    for (int a = 0; a < 2; ++a)
#pragma unroll
        for (int b = 0; b < 2; ++b)
#pragma unroll
            for (int m = 0; m < 4; ++m)
#pragma unroll
                for (int n = 0; n < 2; ++n) acc[a][b][m][n] = (f32x4){0.f, 0.f, 0.f, 0.f};
    int scl8 = 0x7f7f7f7f; asm volatile("" : "+v"(scl8));
    bf16x8 At[4][2], B0[2][2], B1[2][2]; v8i At8[4], B08[2], B18[2];
    unsigned cA = (unsigned)cur.pm * tstep, cB = (unsigned)cur.pn * tstep;
    if constexpr (GATHER) {
#pragma unroll
        for (int h = 0; h < 2; ++h)
#pragma unroll
            for (int i = 0; i < 2; ++i) { gA[h][i] = (unsigned)g.gidx[cur.pm * 256 + h * 128 + Rl + 64 * i] * (unsigned)KB + (unsigned)Cb; gN[h][i] = gA[h][i]; } }
    {
        PG8_STAGE(PG8_SB(0, 0), rsB, cB, voffB); PG8_STAGE(PG8_SB(0, 1), rsB, cB + hstep, voffB); PG8_STAGE_A(PG8_SA(0, 0), 0, cA, 0, gA); PG8_STAGE_A(PG8_SA(0, 1), 1, cA + hstep, 0, gA);
        if (wr == 1) PG8_BAR;
        PG8_WAIT_V(2); PG8_BAR;
        PG8_STAGE(PG8_SB(1, 0), rsB, cB + kstep, voffB); PG8_STAGE_A(PG8_SA(1, 0), 0, cA + kstep, kstep, gA); PG8_STAGE(PG8_SB(1, 1), rsB, cB + hstep + kstep, voffB);
        PG8_WAIT_V(6); PG8_BAR;
    }
    for (;;) {
        const bool has_next = S.next(ui + 1, nxt);
        const unsigned nA = has_next ? (unsigned)nxt.pm * tstep : cA, nB = has_next ? (unsigned)nxt.pn * tstep : cB;
        for (int t = 0; t < nt; t += 2) {
            const bool last = (t == nt - 2);
            const unsigned a1 = cA + (unsigned)(t + 1) * kstep;
            const unsigned a2 = last ? nA : cA + (unsigned)(t + 2) * kstep, b2 = last ? nB : cB + (unsigned)(t + 2) * kstep;
            const unsigned a3 = a2 + kstep, b3 = b2 + kstep;
            const unsigned k1 = (unsigned)(t + 1) * kstep, k2 = last ? 0u : (unsigned)(t + 2) * kstep, k3 = k2 + kstep;
            if constexpr (GATHER) {
                if (t == 0 && has_next && wid == 0) __builtin_amdgcn_global_load_lds((const unsigned*)(g.gidx + nxt.pm * 256 + lane * 4), (PG8_LAS unsigned*)(lds + GOFF + ((ui + 1) & 1) * 1024), 16, 0, 0);
                if (last && has_next) {
#pragma unroll
                    for (int h = 0; h < 2; ++h)
#pragma unroll
                        for (int i = 0; i < 2; ++i) gN[h][i] = (unsigned)*(const PG8_LAS int*)(lds + GOFF + ((ui + 1) & 1) * 1024 + (h * 128 + Rl + 64 * i) * 4) * (unsigned)KB + (unsigned)Cb; } }
            unsigned gS[2][2];
#pragma unroll
            for (int h = 0; h < 2; ++h)
#pragma unroll
                for (int i = 0; i < 2; ++i) gS[h][i] = last ? gN[h][i] : gA[h][i];
            PG8_LDB(B0, 0, 0); PG8_LDB(B1, 0, 1); PG8_SCHED; PG8_LDA(At, 0, 0); PG8_STAGE_A(PG8_SA(1, 1), 1, a1 + hstep, k1, gA);
            PG8_WAIT_V(8); PG8_WAIT_L(0); PG8_BAR; PG8_MMA(0, 0, At, B0); PG8_MMA(0, 1, At, B1); PG8_BAR; PG8_SCHED;
            PG8_LDA(At, 0, 1); PG8_STAGE(PG8_SB(0, 0), rsB, b2, voffB); PG8_STAGE(PG8_SB(0, 1), rsB, b2 + hstep, voffB); PG8_STAGE_A(PG8_SA(0, 0), 0, a2, k2, gS);
            PG8_WAIT_V(8); PG8_WAIT_L(0); PG8_BAR; PG8_MMA(1, 0, At, B0); PG8_MMA(1, 1, At, B1); PG8_BAR; PG8_SCHED;
            PG8_LDB(B0, 1, 0); PG8_LDB(B1, 1, 1); PG8_SCHED; PG8_LDA(At, 1, 0); PG8_STAGE_A(PG8_SA(0, 1), 1, a2 + hstep, k2, gS);
            PG8_WAIT_V(8); PG8_WAIT_L(0); PG8_BAR; PG8_MMA(0, 0, At, B0); PG8_MMA(0, 1, At, B1); PG8_BAR; PG8_SCHED;
            PG8_LDA(At, 1, 1); PG8_STAGE(PG8_SB(1, 0), rsB, b3, voffB); PG8_STAGE(PG8_SB(1, 1), rsB, b3 + hstep, voffB); PG8_STAGE_A(PG8_SA(1, 0), 0, a3, k3, gS);
            PG8_WAIT_V(8); PG8_WAIT_L(0); PG8_BAR; PG8_MMA(1, 0, At, B0); PG8_MMA(1, 1, At, B1); PG8_BAR; PG8_SCHED;
        }
        if constexpr (ALIGN_EPI) { if (wr == 0) PG8_BAR; }
        if constexpr (FP8) asm volatile("s_nop 15\n\ts_nop 15" ::: "memory");
        E(acc, cur, wr, wc, fr, fq);
        if (!has_next) break;
#pragma unroll
        for (int a = 0; a < 2; ++a)
#pragma unroll
            for (int b = 0; b < 2; ++b)
#pragma unroll
                for (int m = 0; m < 4; ++m)
#pragma unroll
                    for (int n = 0; n < 2; ++n) acc[a][b][m][n] = (f32x4){0.f, 0.f, 0.f, 0.f};
        cur = nxt; cA = nA; cB = nB; ++ui;
        if constexpr (GATHER) {
#pragma unroll
            for (int h = 0; h < 2; ++h)
#pragma unroll
                for (int i = 0; i < 2; ++i) gA[h][i] = gN[h][i]; }
        if constexpr (ALIGN_EPI) { if (wr == 1) PG8_BAR; }
    }
    PG8_WAIT_V(0);
    if constexpr (!ALIGN_EPI) { if (wr == 0) PG8_BAR; }
    PG8_BAR;
#undef PG8_STAGE_A
#undef PG8_SA
#undef PG8_SB
#undef PG8_STAGE
#undef PG8_LDA
#undef PG8_LDB
#undef PG8_MMA
#undef PG8_WAIT_V
#undef PG8_WAIT_L
#undef PG8_BAR
#undef PG8_SCHED
}
}

#define XB_TMO      128
#define XB_XCNT(j)  (256  + 64 * (j))
#define XB_XSUB(j)  (1280 + 64 * (j))
#define XB_XGEN(j)  (2304 + 64 * (j))
#define XB_TOP      3328
#define XB_TOPGEN   3392
#define XCD_BAR_WORDS 3456
#define XB_SPIN_CAP (1u << 18)
__device__ __forceinline__ unsigned xb_ld(unsigned* p)              { return __hip_atomic_load(p, __ATOMIC_RELAXED, __HIP_MEMORY_SCOPE_AGENT); }
__device__ __forceinline__ unsigned xb_add(unsigned* p, unsigned v) { return __hip_atomic_fetch_add(p, v, __ATOMIC_RELAXED, __HIP_MEMORY_SCOPE_AGENT); }
__device__ __forceinline__ unsigned xb_xcc_id() { return (unsigned)__builtin_amdgcn_s_getreg((3 << 11) | 20) & 0xFu; }
#define XB_SPIN(cond, bar) do { unsigned _sp = 0; while (cond) { __builtin_amdgcn_s_sleep(1); \
    if ((++_sp & 255u) == 0u) { if (xb_ld(&(bar)[XB_TMO])) break; if (_sp > XB_SPIN_CAP) { atomicAdd(&(bar)[XB_TMO], 1u); break; } } } } while (0)
struct XcdBarrier { unsigned* bar; unsigned x; volatile LAS unsigned* st; };
__device__ __forceinline__ XcdBarrier xcd_barrier_post(unsigned* bar, volatile LAS unsigned* st) {
    XcdBarrier b; b.bar = bar; b.x = xb_xcc_id(); b.st = st;
    if (threadIdx.x == 0) (void)xb_add(&bar[XB_XCNT(b.x)], 1u);
    return b;
}
__device__ __forceinline__ void xcd_barrier_complete(unsigned* bar, unsigned x, unsigned& nloc, unsigned& nx) {
    const unsigned G = gridDim.x * gridDim.y * gridDim.z;
    unsigned sum, cnt, mine, sp = 0u;
    for (;;) {
        sum = 0u; cnt = 0u; mine = 0u;
#pragma unroll
        for (unsigned j = 0; j < 16; ++j) { const unsigned c = xb_ld(&bar[XB_XCNT(j)]); sum += c; cnt += (c > 0u) ? 1u : 0u; mine = (j == x) ? c : mine; }
        if (sum == G) break;
        __builtin_amdgcn_s_sleep(1);
        if ((++sp & 255u) == 0u) { if (xb_ld(&bar[XB_TMO])) break; if (sp > XB_SPIN_CAP) { atomicAdd(&bar[XB_TMO], 1u); break; } }
    }
    nloc = mine > 0u ? mine : 1u; nx = cnt > 0u ? cnt : 1u;
}
__device__ __forceinline__ void xcd_barrier(const XcdBarrier& b, const bool thread0) {
    asm volatile("s_waitcnt vmcnt(0)" ::: "memory");
    __syncthreads();
    if (thread0) {
        unsigned* bar = b.bar;
        __builtin_amdgcn_s_waitcnt(0);
        unsigned nloc = b.st[0], nx = b.st[1];
        if (nloc == 0u) { xcd_barrier_complete(bar, b.x, nloc, nx); b.st[0] = nloc; b.st[1] = nx; }
        const unsigned old = xb_add(&bar[XB_XSUB(b.x)], 1u);
        const unsigned gen = old / nloc;
        if (old + 1u == (gen + 1u) * nloc) {
            __builtin_amdgcn_fence(__ATOMIC_RELEASE, "agent");
            asm volatile("s_waitcnt vmcnt(0)" ::: "memory");
            const unsigned og = xb_add(&bar[XB_TOP], 1u);
            const unsigned tg = og / nx;
            if (og + 1u == (tg + 1u) * nx) xb_add(&bar[XB_TOPGEN], 1u);
            else XB_SPIN(xb_ld(&bar[XB_TOPGEN]) == tg, bar);
            __builtin_amdgcn_fence(__ATOMIC_ACQUIRE, "agent");
            xb_add(&bar[XB_XGEN(b.x)], 1u);
            asm volatile("s_waitcnt vmcnt(0)" ::: "memory");
        } else {
            XB_SPIN(xb_ld(&bar[XB_XGEN(b.x)]) == gen, bar);
            __builtin_amdgcn_fence(__ATOMIC_ACQUIRE, "agent");
            asm volatile("s_waitcnt vmcnt(0)" ::: "memory");
        }
    }
    __syncthreads();
}

struct Frame {
    LAS unsigned char* lds;
    int tid, lane, wave, vcu, G;
    unsigned char* ws;
};
#define WSP(T, off) ((T*)(F.ws + (off)))

__device__ __forceinline__ void cvt_item(const float* W, int ldw, int nvalid, int k0, int n0, bf16* WT, int ldt, int drow0, LAS float* scr, int lane) {
    const int c4 = lane & 15, kr = lane >> 4;
    f32x4 v[16];
#pragma unroll
    for (int i = 0; i < 16; ++i) { const int r = 4 * i + kr; v[i] = (4 * c4 < nvalid) ? *(const GAS f32x4*)(W + (size_t)(k0 + r) * ldw + n0 + 4 * c4) : (f32x4){0.f, 0.f, 0.f, 0.f}; }
#pragma unroll
    for (int i = 0; i < 16; ++i) { const int r = 4 * i + kr; LAS float* s = scr + r * 65 + 4 * c4; s[0] = v[i][0]; s[1] = v[i][1]; s[2] = v[i][2]; s[3] = v[i][3]; }
    LDS_WAIT(); asm volatile("" ::: "memory");
    const int c = lane & 7;
#pragma unroll
    for (int j = 0; j < 8; ++j) { const int n = (lane >> 3) + 8 * j; const LAS float* s = scr + (8 * c) * 65 + n;
        v4u o; o.x = pk2(s[0 * 65], s[1 * 65]); o.y = pk2(s[2 * 65], s[3 * 65]); o.z = pk2(s[4 * 65], s[5 * 65]); o.w = pk2(s[6 * 65], s[7 * 65]);
        if (n < nvalid) *(GAS v4u*)(WT + (size_t)(drow0 + n) * ldt + k0 + 8 * c) = o; }
    LDS_WAIT(); asm volatile("" ::: "memory");
}

__device__ __forceinline__ void cvt8_load(const float* W, int ldw, int k0, int n0, f32x4 (&v)[16], int lane) {
    const int c4 = lane & 15, kr = lane >> 4;
#pragma unroll
    for (int i = 0; i < 16; ++i) v[i] = __builtin_nontemporal_load((const GAS f32x4*)(W + (size_t)(k0 + 4 * i + kr) * ldw + n0 + 4 * c4));
}
__device__ __forceinline__ void cvt8_finish(const f32x4 (&v)[16], int k0, unsigned char* WT, int ldt, int drow0, float scale, LAS float* scr, int lane) {
    const int c4 = lane & 15, kr = lane >> 4;
#pragma unroll
    for (int i = 0; i < 16; ++i) { const int r = 4 * i + kr; LAS float* s = scr + r * 65 + 4 * c4; s[0] = v[i][0]; s[1] = v[i][1]; s[2] = v[i][2]; s[3] = v[i][3]; }
    LDS_WAIT(); asm volatile("" ::: "memory");
    const int c = lane & 3;
#pragma unroll
    for (int j = 0; j < 4; ++j) { const int n = (lane >> 2) + 16 * j; const LAS float* s = scr + (16 * c) * 65 + n;
        v4u o;
        o.x = pk4_fp8(s[0 * 65] * scale, s[1 * 65] * scale, s[2 * 65] * scale, s[3 * 65] * scale); o.y = pk4_fp8(s[4 * 65] * scale, s[5 * 65] * scale, s[6 * 65] * scale, s[7 * 65] * scale);
        o.z = pk4_fp8(s[8 * 65] * scale, s[9 * 65] * scale, s[10 * 65] * scale, s[11 * 65] * scale); o.w = pk4_fp8(s[12 * 65] * scale, s[13 * 65] * scale, s[14 * 65] * scale, s[15 * 65] * scale);
        *(GAS v4u*)(WT + (size_t)(drow0 + n) * ldt + k0 + 16 * c) = o; }
    LDS_WAIT(); asm volatile("" ::: "memory");
}
struct ExpItem { const float* W; int ldw, k0, n0, ldt, drow0; unsigned char* WT; };
__device__ __forceinline__ ExpItem exp_item(const P& p, unsigned char* ws, int q, int half) {
    ExpItem e; const int le = q / 1056, rr = q % 1056, mk = rr / 352, ii = rr % 352;
    if (mk < 2) { const int kb2 = ii / 44, nb = ii % 44; e.n0 = 64 * nb; e.k0 = 64 * (2 * kb2 + half); e.W = (mk == 0 ? p.exp_w_gate : p.exp_w_up) + (size_t)le * D * FF; e.ldw = FF; e.ldt = D; e.drow0 = (e.n0 >> 7) * 256 + mk * 128 + (e.n0 & 127); e.WT = ws + WS_WUP + (size_t)le * 5632 * D; }
    else { const int kb2 = ii / 16, nb = ii % 16; e.n0 = 64 * nb; e.k0 = 64 * (2 * kb2 + half); e.W = p.exp_w_down + (size_t)le * FF * D; e.ldw = D; e.ldt = FF; e.drow0 = e.n0; e.WT = ws + WS_WDN + (size_t)le * D * FF; }
    return e;
}
constexpr int NPAIR_ALL = 32 * 1056;
__device__ __forceinline__ void cvt_pairs(const P& p, unsigned char* ws, LAS float* scr, int qfirst, int qstep, int qend, int lane) {
    f32x4 va[16], vb[16]; int q = qfirst;
    if (q < qend) { const ExpItem e = exp_item(p, ws, q, 0); cvt8_load(e.W, e.ldw, e.k0, e.n0, va, lane); }
    while (q < qend) {
        const ExpItem e0 = exp_item(p, ws, q, 0), e1 = exp_item(p, ws, q, 1);
        cvt8_load(e1.W, e1.ldw, e1.k0, e1.n0, vb, lane);
        cvt8_finish(va, e0.k0, e0.WT, e0.ldt, e0.drow0, F8_W, scr, lane);
        const int q2 = q + qstep;
        if (q2 < qend) { const ExpItem e2 = exp_item(p, ws, q2, 0); cvt8_load(e2.W, e2.ldw, e2.k0, e2.n0, va, lane); }
        cvt8_finish(vb, e1.k0, e1.WT, e1.ldt, e1.drow0, F8_W, scr, lane);
        q = q2;
    }
}
#ifndef BG_QKV
#define BG_QKV 2560
#define BG_OUT0 6144
#define BG_UP0 512
#define BG_DN0 4096
#endif
constexpr int CVT_Q3 = NPAIR_ALL - BG_DN0, CVT_Q2 = CVT_Q3 - BG_UP0, CVT_Q1 = CVT_Q2 - BG_OUT0, CVT_SPLIT0 = CVT_Q1 - BG_QKV;
static_assert(CVT_Q2 >= NPAIR_ALL / 2 && CVT_SPLIT0 >= 0, "the slices behind the layer-0 MoE must stay inside layer 1");
#define BG_SLOT(first, qb, qe) do { if (MOE_FP8 && F.G == 256 && (int)blockIdx.x >= (first) && (qb) < (qe)) { __syncthreads(); \
    cvt_pairs(p, F.ws, (LAS float*)(F.lds + F.wave * 16640), (qb) + ((int)blockIdx.x - (first)) * 8 + F.wave, (256 - (first)) * 8, (qe), F.lane); } } while (0)
__device__ __forceinline__ void ph_pro(const P& p, Frame& F, bool do_cvt) {
    float* MOD = WSP(float, WS_MOD); float* ROPE = WSP(float, WS_ROPE);
    if (F.vcu == 255 % F.G) {
        for (int i = F.tid; i < 1024; i += 512) { const int pos = i >> 4, f = i & 15; const float inv = powf(10000.f, -(float)f / 16.f); const float ang = (float)pos * inv; ROPE[2 * i] = cosf(ang); ROPE[2 * i + 1] = sinf(ang); }
    }
    if (F.vcu < 192) {
        LAS float* ssrc = (LAS float*)F.lds; LAS float* red = (LAS float*)(F.lds + 69632);
        for (int i = F.tid; i < 17 * 1024; i += 512) { const int j = i >> 10, k = i & 1023; const float v = (j < 16) ? p.c[j * 1024 + k] : p.c_ctx[k]; ssrc[i] = silu_f(v); }
        __syncthreads();
        for (int u = F.vcu; u < 192; u += F.G) {
            const int l = u / 96, c0 = (u % 96) * 64, col = c0 + (F.tid & 63), ks = F.tid >> 6;
            const float* w = p.ada_w + ((size_t)l * 1024 + ks * 128) * 6144 + col;
            float acc[17];
#pragma unroll
            for (int j = 0; j < 17; ++j) acc[j] = 0.f;
            for (int k = 0; k < 128; k += 4) {
                const float w0 = w[(size_t)(k + 0) * 6144], w1 = w[(size_t)(k + 1) * 6144], w2 = w[(size_t)(k + 2) * 6144], w3 = w[(size_t)(k + 3) * 6144];
#pragma unroll
                for (int j = 0; j < 17; ++j) { const f32x4 s = *(const LAS f32x4*)(ssrc + j * 1024 + ks * 128 + k); acc[j] += s[0] * w0 + s[1] * w1 + s[2] * w2 + s[3] * w3; }
            }
#pragma unroll
            for (int j = 0; j < 17; ++j) red[(ks * 17 + j) * 64 + (F.tid & 63)] = acc[j];
            __syncthreads();
            for (int i = F.tid; i < 17 * 64; i += 512) { const int j = i >> 6, c = i & 63; float s = p.ada_b[l * 6144 + c0 + c];
#pragma unroll
                for (int q = 0; q < 8; ++q) s += red[(q * 17 + j) * 64 + c];
                MOD[(size_t)(l * 17 + j) * 6144 + c0 + c] = s; }
            __syncthreads();
        }
    }
    if (do_cvt) {
        __syncthreads();
        LAS float* scr = (LAS float*)(F.lds + F.wave * 16640);
        const int gw = F.vcu * NWAVES + F.wave, NGW = F.G * NWAVES;
        constexpr int I_QKV = 16 * 24, I_O = 16 * 16, I_GIN = 16 * 49, I_SMALL = I_QKV + I_O + I_GIN + I_O, I_E = 704, I_LE = 3 * I_E, NITEMS = I_SMALL + 32 * I_LE;
        for (int it = gw; it < I_SMALL; it += NGW) {
            int r = it;
            if (r < I_QKV) { cvt_item(p.attn_w_in, ATT_N, 64, 64 * (r / 24), 64 * (r % 24), WSP(bf16, WS_WQKV), D, 64 * (r % 24), scr, F.lane); continue; } r -= I_QKV;
            if (r < I_O) { cvt_item(p.attn_w_out, D, 64, 64 * (r / 16), 64 * (r % 16), WSP(bf16, WS_WO0), D, 64 * (r % 16), scr, F.lane); continue; } r -= I_O;
            if (r < I_GIN) { const int nb = r % 49; cvt_item(p.gla_w_in, GIN, nb == 48 ? 32 : 64, 64 * (r / 49), 64 * nb, WSP(bf16, WS_WGIN), D, 64 * nb, scr, F.lane); continue; } r -= I_GIN;
            cvt_item(p.gla_w_out, D, 64, 64 * (r / 16), 64 * (r % 16), WSP(bf16, WS_WO1), D, 64 * (r % 16), scr, F.lane);
        }
        constexpr int NEXP = 32 * I_LE;
        if (MOE_FP8) {
            cvt_pairs(p, F.ws, scr, gw, NGW, F.G == 256 ? CVT_SPLIT0 : NPAIR_ALL, F.lane);
        } else {
            for (int r = gw; r < NEXP; r += NGW) {
                const int le = r / I_LE, rr = r % I_LE, mk = rr / I_E, ii = rr % I_E;
                if (mk < 2) { const int kb = ii / 44, nb = ii % 44, n0 = 64 * nb; const float* W = (mk == 0 ? p.exp_w_gate : p.exp_w_up) + (size_t)le * D * FF; const int dr = (n0 >> 7) * 256 + mk * 128 + (n0 & 127);
                    cvt_item(W, FF, 64, 64 * kb, n0, WSP(bf16, WS_WUP) + (size_t)le * 5632 * D, D, dr, scr, F.lane); }
                else { const int kb = ii / 16, nb = ii % 16; cvt_item(p.exp_w_down + (size_t)le * FF * D, D, 64, 64 * kb, 64 * nb, WSP(bf16, WS_WDN) + (size_t)le * D * FF, FF, 64 * nb, scr, F.lane); }
            }
        }
        { v4u* z = (v4u*)(WSP(bf16, WS_WGIN) + (size_t)GIN * D); const int n16 = (GIN_PAD - GIN) * D * 2 / 16;
          for (int i = F.vcu * 512 + F.tid; i < n16; i += F.G * 512) z[i] = (v4u){0u, 0u, 0u, 0u}; }
    }
}

__device__ __forceinline__ void norm_mod_store(const f32x4 (&v)[4], float rstd, const float* g, const float* sh, const float* sc, bf16* orow, int lane) {
    f32x4 gv[4], shv[4], scv[4];
#pragma unroll
    for (int j = 0; j < 4; ++j) { const int c = 4 * (lane + 64 * j); gv[j] = *(const f32x4*)(g + c); shv[j] = *(const f32x4*)(sh + c); scv[j] = *(const f32x4*)(sc + c); }
#pragma unroll
    for (int j = 0; j < 4; ++j) { const int c = 4 * (lane + 64 * j);
        const f32x4 y = (v[j] * rstd * gv[j]) * (scv[j] + 1.f) + shv[j]; v2u o; o.x = pk2(y[0], y[1]); o.y = pk2(y[2], y[3]); *(v2u*)(orow + c) = o; }
}
__device__ __forceinline__ void ph_norm1(const P& p, Frame& F, int l) {
    const float* MOD = WSP(float, WS_MOD); bf16* H = WSP(bf16, WS_H); const float* XA = WSP(float, WS_XA);
    const int gw = F.vcu * NWAVES + F.wave, NGW = F.G * NWAVES; constexpr int RW = 3;
    f32x4 gv[4];
#pragma unroll
    for (int q = 0; q < 4; ++q) gv[q] = *(const f32x4*)(p.norm1_g + l * D + 4 * (F.lane + 64 * q));
    for (int r0 = gw; r0 < NT; r0 += RW * NGW) {
        f32x4 v[RW][4], shv[RW][4], scv[RW][4];
#pragma unroll
        for (int h = 0; h < RW; ++h) { const int r = r0 + h * NGW < NT ? r0 + h * NGW : r0;
            const float* xr = (l == 0) ? (r < NL ? p.x + (size_t)r * D : p.ctx + (size_t)(r - NL) * D) : XA + (size_t)r * D;
            const int j = r < NL ? r / SEQ : 16; const float* mr = MOD + (size_t)(l * 17 + j) * 6144;
#pragma unroll
            for (int q = 0; q < 4; ++q) { const int c = 4 * (F.lane + 64 * q); v[h][q] = *(const f32x4*)(xr + c); shv[h][q] = *(const f32x4*)(mr + c); scv[h][q] = *(const f32x4*)(mr + 1024 + c); } }
#pragma unroll
        for (int h = 0; h < RW; ++h) { const int r = r0 + h * NGW; if (r >= NT) break; float s = 0.f;
#pragma unroll
            for (int q = 0; q < 4; ++q) s += (v[h][q][0] * v[h][q][0] + v[h][q][1] * v[h][q][1]) + (v[h][q][2] * v[h][q][2] + v[h][q][3] * v[h][q][3]);
            const float rstd = 1.f / sqrtf(wave_sum(s) * (1.f / D) + EPS);
            bf16* orow = H + (size_t)r * D;
#pragma unroll
            for (int q = 0; q < 4; ++q) { const f32x4 y = (v[h][q] * rstd * gv[q]) * (scv[h][q] + 1.f) + shv[h][q]; v2u o; o.x = pk2(y[0], y[1]); o.y = pk2(y[2], y[3]); *(v2u*)(orow + 4 * (F.lane + 64 * q)) = o; } }
    }
}
__device__ __forceinline__ void ph_norm2r(const P& p, Frame& F, int l) {
    const float* MOD = WSP(float, WS_MOD); bf16* H = WSP(bf16, WS_H); const xa_t* XA = WSP(xa_t, WS_XA); float* AFF = WSP(float, WS_AFF);
    constexpr int HT = 1028;
    LAS float* rw = (LAS float*)F.lds; LAS float* h2t = (LAS float*)(F.lds + 65536); LAS float* part = (LAS float*)(F.lds + 65536 + 16 * HT * 4);
    for (int i = F.tid; i < D * NE / 4; i += 512) ((LAS f32x4*)rw)[i] = ((const f32x4*)(p.router_w + (size_t)l * D * NE))[i];
    const int ntile = (l == 0 ? NT : NL) / 16, lane = F.lane, w = F.wave;
    const float *g = p.norm2_g + l * D;
    f32x4 v[2][4], gq[4]; v2u vr[2][4];
#pragma unroll
    for (int q = 0; q < 4; ++q) gq[q] = *(const f32x4*)(g + 4 * (lane + 64 * q));
    if (F.vcu < ntile) {
#pragma unroll
        for (int h = 0; h < 2; ++h)
#pragma unroll
            for (int q = 0; q < 4; ++q) vr[h][q] = *(const v2u*)(XA + (size_t)(F.vcu * 16 + 2 * w + h) * D + 4 * (lane + 64 * q)); }
    __syncthreads();
    for (int tile = F.vcu; tile < ntile; tile += F.G) {
        const int r0 = tile * 16;
        f32x4 shq[4], scq[4];
        { const int j = r0 < NL ? r0 / SEQ : 16; const float* mr = MOD + (size_t)(l * 17 + j) * 6144;
#pragma unroll
          for (int q = 0; q < 4; ++q) { shq[q] = *(const f32x4*)(mr + 3072 + 4 * (lane + 64 * q)); scq[q] = *(const f32x4*)(mr + 4096 + 4 * (lane + 64 * q)); } }
#pragma unroll
        for (int h = 0; h < 2; ++h)
#pragma unroll
            for (int q = 0; q < 4; ++q) v[h][q] = unpack_h4(vr[h][q]);
#pragma unroll
        for (int h = 0; h < 2; ++h) { const int r = r0 + 2 * w + h; float s = 0.f;
#pragma unroll
            for (int q = 0; q < 4; ++q) s += (v[h][q][0] * v[h][q][0] + v[h][q][1] * v[h][q][1]) + (v[h][q][2] * v[h][q][2] + v[h][q][3] * v[h][q][3]);
            const float rstd = 1.f / sqrtf(wave_sum(s) * (1.f / D) + EPS);
            bf16* orow = H + (size_t)r * D;
#pragma unroll
            for (int q = 0; q < 4; ++q) { const int c = 4 * (lane + 64 * q); const f32x4 gv = gq[q], shv = shq[q], scv = scq[q];
                const f32x4 y = (v[h][q] * rstd * gv) * (scv + 1.f) + shv;
                if (MOE_FP8) *(unsigned*)(WSP(unsigned char, WS_H8) + (size_t)r * D + c) = pk4_fp8(y[0] * F8_ACT, y[1] * F8_ACT, y[2] * F8_ACT, y[3] * F8_ACT);
                else { v2u o; o.x = pk2(y[0], y[1]); o.y = pk2(y[2], y[3]); *(v2u*)(orow + c) = o; }
                *(LAS f32x4*)(h2t + (2 * w + h) * HT + c) = y; } }
        if (tile + F.G < ntile) {
#pragma unroll
            for (int h = 0; h < 2; ++h)
#pragma unroll
                for (int q = 0; q < 4; ++q) vr[h][q] = *(const v2u*)(XA + (size_t)((tile + F.G) * 16 + 2 * w + h) * D + 4 * (lane + 64 * q)); }
        LDS_SYNC();
        { f32x4 acc = (f32x4){0.f, 0.f, 0.f, 0.f}; const int i16 = lane & 15, kq = lane >> 4;
#pragma unroll 8
          for (int it = 0; it < 32; ++it) { const int k = 128 * w + 4 * it + kq; acc = __builtin_amdgcn_mfma_f32_16x16x4f32(h2t[i16 * HT + k], rw[k * 16 + i16], acc, 0, 0, 0); }
#pragma unroll
          for (int r = 0; r < 4; ++r) part[(w * 16 + 4 * kq + r) * 16 + i16] = acc[r]; }
        LDS_SYNC();
        if (F.tid < 256) { const int i = F.tid >> 4, e = F.tid & 15; float a = 0.f;
#pragma unroll
            for (int w2 = 0; w2 < 8; ++w2) a += part[(w2 * 16 + i) * 16 + e];
            float m = a;
#pragma unroll
            for (int o = 1; o < 16; o <<= 1) m = fmaxf(m, __shfl_xor(m, o));
            const float pe = expf(a - m); float ssum = pe;
#pragma unroll
            for (int o = 1; o < 16; o <<= 1) ssum += __shfl_xor(ssum, o);
            AFF[(size_t)(r0 + i) * 16 + e] = pe / ssum; }
    }
    __syncthreads();
}
__device__ __forceinline__ void ph_topkg(const P& p, Frame& F, int l) {
    const float* AFF = WSP(float, WS_AFF); int* SLOT = WSP(int, WS_SLOT); int* ROWIDX = WSP(int, WS_ROWIDX); float* ROWG = WSP(float, WS_ROWG);
    const bf16* H = WSP(bf16, WS_H); bf16* XG = WSP(bf16, WS_XG);
    LAS int* hist = (LAS int*)F.lds;
    LAS int* sel = hist + 256;
    LAS int* wtot = sel + 256;
    LAS int* shr = wtot + 8;
    const int nunits = l == 0 ? 512 : 256, tid = F.tid, lane = F.lane;
    for (int u = F.vcu; u < nunits; u += F.G) {
        const bool lat = u < 256; const int b = (u & 255) >> 4, e = u & 15;
        const int L = lat ? SEQ : CTX, cap = lat ? CAPL : CAPC, row0 = lat ? b * SEQ : NL + b * CTX, s0 = lat ? b * CAPL : NB * CAPL + b * CAPC;
        unsigned key[4]; const bool act = 4 * tid < L;
#pragma unroll
        for (int q = 0; q < 4; ++q) key[q] = act ? __float_as_uint(AFF[(size_t)(row0 + 4 * tid + q) * 16 + e]) : 0u;
        unsigned prefix = 0u; int kk = cap;
#pragma unroll
        for (int pass = 0; pass < 4; ++pass) { const int shift = 24 - 8 * pass;
            if (tid < 256) hist[tid] = 0;
            LDS_SYNC();
            if (act) {
#pragma unroll
                for (int q = 0; q < 4; ++q) { const bool cand = pass == 0 ? true : ((key[q] >> (shift + 8)) == (prefix >> (shift + 8))); if (cand) __hip_atomic_fetch_add(&hist[(key[q] >> shift) & 255u], 1, __ATOMIC_RELAXED, __HIP_MEMORY_SCOPE_WORKGROUP); } }
            LDS_SYNC();
            if (F.wave == 0) { const int h0 = hist[4 * lane], h1 = hist[4 * lane + 1], h2 = hist[4 * lane + 2], h3 = hist[4 * lane + 3]; const int tot = h0 + h1 + h2 + h3;
                int suf = tot;
#pragma unroll
                for (int o = 1; o < 64; o <<= 1) { const int t = __shfl_down(suf, o); if (lane + o < 64) suf += t; }
                int above = suf - tot;
                if (above < kk && kk <= above + h3) { shr[0] = 4 * lane + 3; shr[1] = above; } above += h3;
                if (above < kk && kk <= above + h2) { shr[0] = 4 * lane + 2; shr[1] = above; } above += h2;
                if (above < kk && kk <= above + h1) { shr[0] = 4 * lane + 1; shr[1] = above; } above += h1;
                if (above < kk && kk <= above + h0) { shr[0] = 4 * lane + 0; shr[1] = above; } }
            LDS_SYNC();
            prefix |= (unsigned)shr[0] << shift; kk -= shr[1];
        }
        const int n_gt = cap - kk;
        int cg = 0, ce = 0;
#pragma unroll
        for (int q = 0; q < 4; ++q) { cg += (act && key[q] > prefix) ? 1 : 0; ce += (act && key[q] == prefix) ? 1 : 0; }
        int pk = cg | (ce << 16), inc = pk;
#pragma unroll
        for (int o = 1; o < 64; o <<= 1) { const int t = __shfl_up(inc, o); if (lane >= o) inc += t; }
        if (lane == 63) wtot[F.wave] = inc;
        LDS_SYNC();
        int base = 0;
#pragma unroll
        for (int w2 = 0; w2 < 8; ++w2) base += (w2 < F.wave) ? wtot[w2] : 0;
        int ex = base + inc - pk; int rg = ex & 0xffff, re = ex >> 16;
        if (act) {
#pragma unroll
            for (int q = 0; q < 4; ++q) { const int row = row0 + 4 * tid + q; int s = -1;
                if (key[q] > prefix) { s = rg; ++rg; } else if (key[q] == prefix) { if (re < kk) s = n_gt + re; ++re; }
                if (s >= 0) { ROWIDX[e * ESLOTS + s0 + s] = row; ROWG[e * ESLOTS + s0 + s] = __uint_as_float(key[q]); sel[s] = row; s += s0; }
                SLOT[(size_t)row * 16 + e] = s; } }
        LDS_SYNC();
    }
}
__device__ __forceinline__ void ph_combine(const P& p, Frame& F, int l) {
    const float* MOD = WSP(float, WS_MOD); bf16* H = WSP(bf16, WS_H); xa_t* XA = WSP(xa_t, WS_XA); const int* SLOT = WSP(int, WS_SLOT); const bf16* YS = WSP(bf16, WS_YS);
    const int gw = F.vcu * NWAVES + F.wave, NGW = F.G * NWAVES; const int nrows = l == 0 ? NT : NL;
    f32x4 gn[4];
#pragma unroll
    for (int q = 0; q < 4; ++q) gn[q] = *(const f32x4*)((l == 0 ? p.norm1_g + D : p.final_norm_g) + 4 * (F.lane + 64 * q));
    for (int r0 = gw; r0 < nrows; r0 += 2 * NGW) {
        int sv[2]; f32x4 v[2][4], acc[2][4];
#pragma unroll
        for (int h = 0; h < 2; ++h) { const int r = r0 + h * NGW; sv[h] = F.lane < 16 ? SLOT[(size_t)r * 16 + F.lane] : -1;
#pragma unroll
            for (int q = 0; q < 4; ++q) { v[h][q] = unpack_h4(*(const v2u*)(XA + (size_t)r * D + 4 * (F.lane + 64 * q))); acc[h][q] = (f32x4){0.f, 0.f, 0.f, 0.f}; } }
        unsigned mk[2]; v2u yv[2][4][4];
#pragma unroll
        for (int h = 0; h < 2; ++h) { mk[h] = (unsigned)(__ballot(sv[h] >= 0) & 0xffffull); unsigned m2 = mk[h];
#pragma unroll
            for (int i = 0; i < 4; ++i) {
                if (m2) { const int e = __builtin_ctz(m2); m2 &= m2 - 1; const int sl = __builtin_amdgcn_readlane(sv[h], e); const bf16* yr = YS + (size_t)(e * ESLOTS + sl) * D;
#pragma unroll
                    for (int q = 0; q < 4; ++q) yv[h][i][q] = *(const v2u*)(yr + 4 * (F.lane + 64 * q)); }
                else {
#pragma unroll
                    for (int q = 0; q < 4; ++q) yv[h][i][q] = (v2u){0u, 0u}; } }
            mk[h] = m2; }
        f32x4 g2v[2][4], shn[2][4], scn[2][4];
#pragma unroll
        for (int h = 0; h < 2; ++h) { const int r = r0 + h * NGW; const int j = r < NL ? r / SEQ : 16; const float* g2 = MOD + (size_t)(l * 17 + j) * 6144 + 5120; const float* m1 = MOD + (size_t)(17 + j) * 6144;
#pragma unroll
            for (int q = 0; q < 4; ++q) { const int c = 4 * (F.lane + 64 * q); g2v[h][q] = *(const f32x4*)(g2 + c); if (l == 0) { shn[h][q] = *(const f32x4*)(m1 + c); scn[h][q] = *(const f32x4*)(m1 + 1024 + c); } } }
#pragma unroll
        for (int h = 0; h < 2; ++h) {
#pragma unroll
            for (int i = 0; i < 4; ++i)
#pragma unroll
                for (int q = 0; q < 4; ++q) { const v2u w = yv[h][i][q]; acc[h][q][0] += __uint_as_float(w.x << 16); acc[h][q][1] += __uint_as_float(w.x & 0xffff0000u); acc[h][q][2] += __uint_as_float(w.y << 16); acc[h][q][3] += __uint_as_float(w.y & 0xffff0000u); }
            unsigned m2 = mk[h];
            while (m2) { const int e = __builtin_ctz(m2); m2 &= m2 - 1; const int sl = __builtin_amdgcn_readlane(sv[h], e); const bf16* yr = YS + (size_t)(e * ESLOTS + sl) * D;
#pragma unroll
                for (int q = 0; q < 4; ++q) { const v2u w = *(const v2u*)(yr + 4 * (F.lane + 64 * q)); acc[h][q][0] += __uint_as_float(w.x << 16); acc[h][q][1] += __uint_as_float(w.x & 0xffff0000u); acc[h][q][2] += __uint_as_float(w.y << 16); acc[h][q][3] += __uint_as_float(w.y & 0xffff0000u); } } }
#pragma unroll
        for (int h = 0; h < 2; ++h) { const int r = r0 + h * NGW;
            xa_t* xr = XA + (size_t)r * D; float s = 0.f;
#pragma unroll
            for (int q = 0; q < 4; ++q) { v[h][q] = v[h][q] + g2v[h][q] * acc[h][q]; s += (v[h][q][0] * v[h][q][0] + v[h][q][1] * v[h][q][1]) + (v[h][q][2] * v[h][q][2] + v[h][q][3] * v[h][q][3]); }
            const float rstd = 1.f / sqrtf(wave_sum(s) * (1.f / D) + EPS);
            if (l == 0) {
#pragma unroll
                for (int q = 0; q < 4; ++q) *(v2u*)(xr + 4 * (F.lane + 64 * q)) = pack_h4(v[h][q]);
                bf16* orow = H + (size_t)r * D;
#pragma unroll
                for (int q = 0; q < 4; ++q) { const f32x4 y = (v[h][q] * rstd * gn[q]) * (scn[h][q] + 1.f) + shn[h][q]; v2u o; o.x = pk2(y[0], y[1]); o.y = pk2(y[2], y[3]); *(v2u*)(orow + 4 * (F.lane + 64 * q)) = o; }
            } else {
                float* orow = p.out + (size_t)r * D;
#pragma unroll
                for (int q = 0; q < 4; ++q) { const int c = 4 * (F.lane + 64 * q); *(f32x4*)(orow + c) = v[h][q] * rstd * gn[q]; }
            } }
    }
}
__device__ __forceinline__ void ph_readout(const P& p, Frame& F) {
    bf16* H = WSP(bf16, WS_H); const bf16* OF = WSP(bf16, WS_OF); const bf16* OB = WSP(bf16, WS_OB); const bf16* PG = WSP(bf16, WS_PG);
    const int gw = F.vcu * NWAVES + F.wave, NGW = F.G * NWAVES;
    f32x4 gnv[4];
#pragma unroll
    for (int q = 0; q < 4; ++q) gnv[q] = *(const f32x4*)(p.gla_norm_g + 4 * (F.lane + 64 * q));
    for (int r0 = gw; r0 < NL; r0 += 2 * NGW) {
        v2u a[2][4], b[2][4], rr[2][4];
#pragma unroll
        for (int h = 0; h < 2; ++h) { const int r = r0 + h * NGW;
#pragma unroll
            for (int q = 0; q < 4; ++q) { const int c = 4 * (F.lane + 64 * q); a[h][q] = *(const v2u*)(OF + (size_t)r * GV + c); b[h][q] = *(const v2u*)(OB + (size_t)r * GV + c); rr[h][q] = *(const v2u*)(PG + (size_t)r * GIN + GQK + c); } }
#pragma unroll
        for (int h = 0; h < 2; ++h) { const int r = r0 + h * NGW;
#pragma unroll
            for (int q = 0; q < 4; ++q) { const int c = 4 * (F.lane + 64 * q);
                f32x4 o; o[0] = __uint_as_float(a[h][q].x << 16) + __uint_as_float(b[h][q].x << 16); o[1] = __uint_as_float(a[h][q].x & 0xffff0000u) + __uint_as_float(b[h][q].x & 0xffff0000u);
                o[2] = __uint_as_float(a[h][q].y << 16) + __uint_as_float(b[h][q].y << 16); o[3] = __uint_as_float(a[h][q].y & 0xffff0000u) + __uint_as_float(b[h][q].y & 0xffff0000u);
                const float ss = wave_sum((o[0] * o[0] + o[1] * o[1]) + (o[2] * o[2] + o[3] * o[3]));
                const float rstd = 1.f / sqrtf(ss * (1.f / GDV) + EPS);
                const f32x4 gv = gnv[q];
                const float q0 = __uint_as_float(rr[h][q].x << 16), q1 = __uint_as_float(rr[h][q].x & 0xffff0000u), q2 = __uint_as_float(rr[h][q].y << 16), q3 = __uint_as_float(rr[h][q].y & 0xffff0000u);
                const float y0 = o[0] * rstd * gv[0] * fsilu(q0), y1 = o[1] * rstd * gv[1] * fsilu(q1), y2 = o[2] * rstd * gv[2] * fsilu(q2), y3 = o[3] * rstd * gv[3] * fsilu(q3);
                v2u w; w.x = pk2(y0, y1); w.y = pk2(y2, y3); *(v2u*)(H + (size_t)r * D + c) = w; } }
    }
}

typedef float f32x16 __attribute__((ext_vector_type(16)));
typedef short s16x4 __attribute__((ext_vector_type(4)));
__device__ __forceinline__ s16x4 lds_tr16(const LAS unsigned char* p) { return __builtin_bit_cast(s16x4, __builtin_amdgcn_ds_read_tr16_b64_v4i16((LAS s16x4*)p)); }
__device__ __forceinline__ int crow(int r, int hi) { return (r & 3) + 8 * (r >> 2) + 4 * hi; }
#define TR_RD(dst, ptr) asm volatile("ds_read_b64_tr_b16 %0, %1" : "=v"(dst) : "v"((unsigned)(uintptr_t)(ptr)) : "memory")
#define TR_WAIT4(a, b, c, d) asm volatile("s_waitcnt lgkmcnt(0)" : "+v"(a), "+v"(b), "+v"(c), "+v"(d) :: "memory")
__device__ __forceinline__ void ph_attn(const P& p, Frame& F) {
    const bf16* Q = WSP(bf16, WS_Q); const bf16* Kb = WSP(bf16, WS_K); const bf16* Vb = WSP(bf16, WS_V); bf16* O = WSP(bf16, WS_O);
    const int lane = F.lane, r32 = lane & 31, hi = lane >> 5, w = F.wave, gq = w >> 1, th = w & 1;
    LAS unsigned char* Ks = F.lds; LAS unsigned char* Vs = F.lds + 3 * 8192;
    const int kl = lane >> 3, chp = lane & 7;
    const int dgrp = (lane >> 4) & 1, qrow = (lane & 15) >> 2, pp = lane & 3;
#define ATT_DEC(u_, lat_, b_, hk_, t0_, qrow0_, jlo_, nt_) do { lat_ = (u_) < 2048; \
        if (lat_) { b_ = (u_) >> 7; hk_ = ((u_) >> 5) & 3; t0_ = 64 * ((u_) & 31); qrow0_ = b_ * SEQ + t0_; } \
        else { const int uc_ = (u_) - 2048; b_ = uc_ >> 4; hk_ = (uc_ >> 2) & 3; t0_ = 64 * (uc_ & 3); qrow0_ = NL + b_ * CTX + t0_; } \
        int jhi_ = -1; jlo_ = 0; \
        if (lat_) { jlo_ = t0_ >= 128 ? 0 : (128 - t0_) / 64; jhi_ = (SEQ - 64 - (t0_ - 128)) / 64; if (jhi_ > 4) jhi_ = 4; } \
        nt_ = 4 + (jhi_ - jlo_ + 1); } while (0)
#define ATT_KROW(b_, t0_, jlo_, it) ((it) < 4 ? NL + (b_) * CTX + 64 * (it) : (b_) * SEQ + (t0_) - 128 + 64 * ((jlo_) + (it) - 4))
#define ATT_DMA(b_, hk_, t0_, jlo_, it, sl) do { const size_t so_ = ((size_t)(ATT_KROW(b_, t0_, jlo_, it) + 8 * w + kl) * 256 + (hk_) * 64) * 2 + (size_t)((chp ^ kl) * 16); \
        __builtin_amdgcn_global_load_lds((const unsigned*)((const char*)Kb + so_), (LAS unsigned*)(Ks + (sl) * 8192 + w * 1024), 16, 0, 0); \
        __builtin_amdgcn_global_load_lds((const unsigned*)((const char*)Vb + so_), (LAS unsigned*)(Vs + (sl) * 8192 + w * 1024), 16, 0, 0); } while (0)
    constexpr int NU = 2048 + 256;
    const float snk0 = p.attn_sink[gq], snk1 = p.attn_sink[4 + gq], snk2 = p.attn_sink[8 + gq], snk3 = p.attn_sink[12 + gq];
    int sc = 0, sn2 = 2;
    bool first = true;
    bf16x8 qr[4], qn[4];
    if (F.vcu < NU) { bool lat; int b, hk, t0, qrow0, jlo, nt; ATT_DEC(F.vcu, lat, b, hk, t0, qrow0, jlo, nt); (void)nt; (void)lat;
#pragma unroll
        for (int d0 = 0; d0 < 4; ++d0) qr[d0] = *(const bf16x8*)(Q + (size_t)(qrow0 + 32 * th + r32) * 1024 + (hk * 4 + gq) * 64 + d0 * 16 + hi * 8);
        ATT_DMA(b, hk, t0, jlo, 0, 0); ATT_DMA(b, hk, t0, jlo, 1, 1); }
    for (int u = F.vcu; u < NU; u += F.G) {
        bool lat; int b, hk, t0, qrow0, jlo, nt; ATT_DEC(u, lat, b, hk, t0, qrow0, jlo, nt);
        const bool has_next = u + F.G < NU;
        bool nlat; int nb, nhk, nt0, nqrow0, njlo, nnt; { const int un = has_next ? u + F.G : u; ATT_DEC(un, nlat, nb, nhk, nt0, nqrow0, njlo, nnt); (void)nnt; (void)nlat; }
        const int hq = hk * 4 + gq; const int qr_row = qrow0 + 32 * th + r32;
#pragma unroll
        for (int d0 = 0; d0 < 4; ++d0) { const bf16* qp = Q + (size_t)(nqrow0 + 32 * th + r32) * 1024 + (nhk * 4 + gq) * 64 + d0 * 16 + hi * 8;
            asm volatile("global_load_dwordx4 %0, %1, off" : "=v"(qn[d0]) : "v"(qp) : "memory"); }
        float m = (hk == 0 ? snk0 : hk == 1 ? snk1 : hk == 2 ? snk2 : snk3) * LOG2E, l = hi == 0 ? 1.f : 0.f;
        f32x16 o[2];
#pragma unroll
        for (int r = 0; r < 16; ++r) { o[0][r] = 0.f; o[1][r] = 0.f; }
#pragma clang loop unroll(disable)
        for (int it = 0; it < nt; ++it) {
            if (it == nt - 1) { if (has_next) asm volatile("s_waitcnt vmcnt(2)" ::: "memory"); else asm volatile("s_waitcnt vmcnt(0)" ::: "memory"); }
            else if (it < 2) { if (first) asm volatile("s_waitcnt vmcnt(6)" ::: "memory"); else asm volatile("s_waitcnt vmcnt(14)" ::: "memory"); }
            else asm volatile("s_waitcnt vmcnt(2)" ::: "memory");
            __builtin_amdgcn_s_barrier(); asm volatile("" ::: "memory");
            if (it + 2 < nt) ATT_DMA(b, hk, t0, jlo, it + 2, sn2);
            else if (has_next) ATT_DMA(nb, nhk, nt0, njlo, it + 2 - nt, sn2);
            const int slot = sc * 8192;
            f32x16 p0, p1;
#pragma unroll
            for (int r = 0; r < 16; ++r) { p0[r] = 0.f; p1[r] = 0.f; }
#pragma unroll
            for (int d0 = 0; d0 < 4; ++d0) {
                const int off = r32 * 128 + (((2 * d0 + hi) ^ (r32 & 7)) * 16);
                const bf16x8 k0 = *(const LAS bf16x8*)(Ks + slot + off), k1 = *(const LAS bf16x8*)(Ks + slot + off + 32 * 128);
                p0 = __builtin_amdgcn_mfma_f32_32x32x16_bf16(k0, qr[d0], p0, 0, 0, 0);
                p1 = __builtin_amdgcn_mfma_f32_32x32x16_bf16(k1, qr[d0], p1, 0, 0, 0);
            }
            s16x4 vt[2][4][2];
#pragma unroll
            for (int dblk = 0; dblk < 2; ++dblk)
#pragma unroll
                for (int ks = 0; ks < 4; ++ks) { const int klo = 16 * ks + 4 * hi + qrow, khi = klo + 8, ch = 4 * dblk + 2 * dgrp + (pp >> 1), bo = (pp & 1) * 8;
                    TR_RD(vt[dblk][ks][0], Vs + slot + klo * 128 + ((ch ^ (klo & 7)) * 16) + bo); TR_RD(vt[dblk][ks][1], Vs + slot + khi * 128 + ((ch ^ (khi & 7)) * 16) + bo); }
            asm volatile("s_nop 7\n\ts_nop 7" : "+v"(p0), "+v"(p1));
            if (it >= 4) { const int j = jlo + it - 4;
                if (j == 0 || j == 4) { const int dq = 32 * th + r32;
                    const int sg = j == 0 ? 1 : -1;
#pragma unroll
                    for (int r = 0; r < 16; ++r) { const int kk = crow(r, hi);
                        p0[r] = sg * (dq - kk) > 0 ? -1e30f : p0[r]; p1[r] = sg * (dq - (kk + 32)) > 0 ? -1e30f : p1[r]; } } }
            float mx = p0[0];
#pragma unroll
            for (int r = 1; r < 16; ++r) mx = fmaxf(mx, p0[r]);
#pragma unroll
            for (int r = 0; r < 16; ++r) mx = fmaxf(mx, p1[r]);
            mx = fmaxf(mx, __shfl_xor(mx, 32));
            const float mn = fmaxf(m, mx);
            if (__any(mn > m)) { const float f = __builtin_amdgcn_exp2f(m - mn); l *= f;
#pragma unroll
                for (int r = 0; r < 16; ++r) { o[0][r] *= f; o[1][r] *= f; }
                m = mn; }
            float ls = 0.f;
#pragma unroll
            for (int r = 0; r < 16; ++r) { p0[r] = __builtin_amdgcn_exp2f(p0[r] - m); p1[r] = __builtin_amdgcn_exp2f(p1[r] - m); ls += p0[r] + p1[r]; }
            l += ls;
            v4u pw[4];
#pragma unroll
            for (int q4 = 0; q4 < 4; ++q4) { pw[0][q4] = pk2(p0[2 * q4], p0[2 * q4 + 1]); pw[1][q4] = pk2(p0[8 + 2 * q4], p0[9 + 2 * q4]); pw[2][q4] = pk2(p1[2 * q4], p1[2 * q4 + 1]); pw[3][q4] = pk2(p1[8 + 2 * q4], p1[9 + 2 * q4]); }
            asm volatile("s_waitcnt lgkmcnt(0)" : "+v"(vt[0][0][0]), "+v"(vt[0][0][1]), "+v"(vt[0][1][0]), "+v"(vt[0][1][1]), "+v"(vt[0][2][0]), "+v"(vt[0][2][1]), "+v"(vt[0][3][0]), "+v"(vt[0][3][1]),
                         "+v"(vt[1][0][0]), "+v"(vt[1][0][1]), "+v"(vt[1][1][0]), "+v"(vt[1][1][1]), "+v"(vt[1][2][0]), "+v"(vt[1][2][1]), "+v"(vt[1][3][0]), "+v"(vt[1][3][1]) :: "memory");
#pragma unroll
            for (int dblk = 0; dblk < 2; ++dblk)
#pragma unroll
                for (int ks = 0; ks < 4; ++ks) { const s16x4 vlo = vt[dblk][ks][0], vhi = vt[dblk][ks][1];
                    const bf16x8 vf = (bf16x8){vlo[0], vlo[1], vlo[2], vlo[3], vhi[0], vhi[1], vhi[2], vhi[3]};
                    o[dblk] = __builtin_amdgcn_mfma_f32_32x32x16_bf16(vf, __builtin_bit_cast(bf16x8, pw[ks]), o[dblk], 0, 0, 0); }
            sc = sc == 2 ? 0 : sc + 1; sn2 = sn2 == 2 ? 0 : sn2 + 1;
        }
#undef ATT_KROW
#undef ATT_DMA
        const float il = 1.f / (l + __shfl_xor(l, 32));
        bf16* orow = O + (size_t)qr_row * 1024 + hq * 64;
#pragma unroll
        for (int dblk = 0; dblk < 2; ++dblk)
#pragma unroll
            for (int rq = 0; rq < 4; ++rq) { v2u wv; wv.x = pk2(o[dblk][4 * rq] * il, o[dblk][4 * rq + 1] * il); wv.y = pk2(o[dblk][4 * rq + 2] * il, o[dblk][4 * rq + 3] * il);
                *(v2u*)(orow + 32 * dblk + 8 * rq + 4 * hi) = wv; }
#pragma unroll
        for (int d0 = 0; d0 < 4; ++d0) qr[d0] = qn[d0];
        first = false;
    }
#undef ATT_DEC
}
__device__ __forceinline__ void ph_attn_naive(const P& p, Frame& F) {
    const bf16* Q = WSP(bf16, WS_Q); const bf16* Kb = WSP(bf16, WS_K); const bf16* Vb = WSP(bf16, WS_V); bf16* O = WSP(bf16, WS_O);
    for (int i = F.vcu * 512 + F.tid; i < NT * NQH; i += F.G * 512) {
        const int r = i >> 4, hq = i & 15, hk = hq >> 2;
        float q[64], acc[64];
#pragma unroll
        for (int d = 0; d < 64; ++d) { q[d] = bf2f(Q[(size_t)r * 1024 + hq * 64 + d]); acc[d] = 0.f; }
        float m = p.attn_sink[hq] * LOG2E, l = 1.f;
        const bool lat = r < NL; const int b = lat ? r / SEQ : (r - NL) / CTX, t = r & (SEQ - 1);
        const int nlat = lat ? (min(SEQ - 1, t + 128) - max(0, t - 128) + 1) : 0, klo = max(0, t - 128);
        for (int kk = 0; kk < CTX + nlat; ++kk) {
            const int kr = kk < CTX ? NL + b * CTX + kk : b * SEQ + klo + (kk - CTX);
            const bf16* kp = Kb + (size_t)kr * 256 + hk * 64; const bf16* vp = Vb + (size_t)kr * 256 + hk * 64;
            float s = 0.f;
#pragma unroll
            for (int d = 0; d < 64; ++d) s += q[d] * bf2f(kp[d]);
            const float mn = fmaxf(m, s), sc = exp2f(m - mn), pe = exp2f(s - mn);
            l = l * sc + pe; m = mn;
#pragma unroll
            for (int d = 0; d < 64; ++d) acc[d] = acc[d] * sc + pe * bf2f(vp[d]);
        }
        const float il = 1.f / l;
#pragma unroll
        for (int d = 0; d < 64; ++d) O[(size_t)r * 1024 + hq * 64 + d] = (bf16)f2bf(acc[d] * il);
    }
}
__device__ __forceinline__ f32x4 mfma16(bf16x8 a, bf16x8 b, f32x4 c) { return __builtin_amdgcn_mfma_f32_16x16x32_bf16(a, b, c, 0, 0, 0); }
__device__ __forceinline__ int gla_rowmap(int b, int dir, int s) { return s < CTX ? NL + b * CTX + (dir ? CTX - 1 - s : s) : b * SEQ + (dir ? SEQ - 1 - (s - CTX) : s - CTX); }
__device__ __forceinline__ void ph_glaprep(const P& p, Frame& F) {
    const bf16* PG = WSP(bf16, WS_PG); bf16* QT = WSP(bf16, WS_QT); bf16* KT = WSP(bf16, WS_KT); float* DEC = WSP(float, WS_DEC);
    const int lane = F.lane, w = F.wave, c16 = lane & 15, g = lane >> 4;
    for (int uu = F.vcu; uu < NB * 2 * 36 * 2; uu += F.G) {
        const int hf = uu & 1, u = uu >> 1, c = u % 36, dir = (u / 36) & 1, b = u / 72;
        const int rowA = gla_rowmap(b, dir, 64 * c), rstep = dir ? -1 : 1;
        const size_t obase = ((size_t)(dir * NB + b) * 2304 + 64 * c) * 512;
        bf16x8 lrf[4];
#pragma unroll
        for (int tt = 0; tt < 4; ++tt) { lrf[tt] = (bf16x8){0, 0, 0, 0, 0, 0, 0, 0};
            if (g < 2) lrf[tt] = *(const bf16x8*)(PG + (size_t)(rowA + rstep * (16 * tt + c16)) * GIN + 3072 + 16 * dir + 8 * g); }
#pragma unroll 1
        for (int ctl = 0; ctl < 2; ++ctl) { const int col0 = 256 * hf + 16 * (2 * w + ctl);
            v4u wp = (v4u){0u, 0u, 0u, 0u};
            if (g < 2) { const float* wsrc = p.gla_gate_w2 + (size_t)(dir * 16 + 8 * g) * 512 + col0 + c16;
                wp.x = pk2(wsrc[0], wsrc[512]); wp.y = pk2(wsrc[1024], wsrc[1536]); wp.z = pk2(wsrc[2048], wsrc[2560]); wp.w = pk2(wsrc[3072], wsrc[3584]); }
            const bf16x8 wf = __builtin_bit_cast(bf16x8, wp);
            const f32x4 bias = *(const f32x4*)(p.gla_gate_b + dir * 512 + col0 + 4 * g);
            f32x4 carry = (f32x4){0.f, 0.f, 0.f, 0.f};
            v2u kk4[4], qq4[4];
#pragma unroll
            for (int tt = 0; tt < 4; ++tt) { const bf16* pr = PG + (size_t)(rowA + rstep * (16 * tt + c16)) * GIN + col0 + 4 * g;
                kk4[tt] = *(const v2u*)(pr + GQR); qq4[tt] = (v2u){0u, 0u}; if (c >= 4) qq4[tt] = *(const v2u*)pr; }
            asm volatile("" : "+v"(kk4[0]), "+v"(kk4[1]), "+v"(kk4[2]), "+v"(kk4[3]), "+v"(qq4[0]), "+v"(qq4[1]), "+v"(qq4[2]), "+v"(qq4[3]) :: "memory");
#pragma unroll
            for (int tt = 0; tt < 4; ++tt) {
                const int tok = 16 * tt + c16;
                const v2u kk = kk4[tt], qq = qq4[tt];
                const f32x4 z = mfma16(wf, lrf[tt], bias);
                f32x4 ls;
#pragma unroll
                for (int r = 0; r < 4; ++r) ls[r] = (fminf(z[r], 0.f) - flog(1.f + fexp(-fabsf(z[r])))) * (1.f / 16.f);
#pragma unroll
                for (int r = 0; r < 4; ++r) { ls[r] += dpp_shr<1>(ls[r]); ls[r] += dpp_shr<2>(ls[r]); ls[r] += dpp_shr<4>(ls[r]); ls[r] += dpp_shr<8>(ls[r]); }
                f32x4 bs = carry + ls;
#pragma unroll
                for (int r = 0; r < 4; ++r) carry[r] += __shfl(ls[r], 15, 16);
                const float k0 = __uint_as_float(kk.x << 16), k1 = __uint_as_float(kk.x & 0xffff0000u), k2 = __uint_as_float(kk.y << 16), k3 = __uint_as_float(kk.y & 0xffff0000u);
                v2u ko; ko.x = pk2(k0 * fexp(-bs[0]), k1 * fexp(-bs[1])); ko.y = pk2(k2 * fexp(-bs[2]), k3 * fexp(-bs[3]));
                *(v2u*)(KT + obase + (size_t)tok * 512 + col0 + 4 * g) = ko;
                if (c >= 4) { const float q0 = __uint_as_float(qq.x << 16), q1 = __uint_as_float(qq.x & 0xffff0000u), q2 = __uint_as_float(qq.y << 16), q3 = __uint_as_float(qq.y & 0xffff0000u);
                    v2u qo; qo.x = pk2(q0 * GLA_QS * fexp(bs[0]), q1 * GLA_QS * fexp(bs[1])); qo.y = pk2(q2 * GLA_QS * fexp(bs[2]), q3 * GLA_QS * fexp(bs[3]));
                    *(v2u*)(QT + obase + (size_t)tok * 512 + col0 + 4 * g) = qo; }
            }
            if (c16 == 15) { f32x4 dv; dv[0] = fexp(carry[0]); dv[1] = fexp(carry[1]); dv[2] = fexp(carry[2]); dv[3] = fexp(carry[3]);
                *(f32x4*)(DEC + ((size_t)(dir * NB + b) * 36 + c) * 512 + col0 + 4 * g) = dv; }
        }
    }
}
__device__ __forceinline__ void ph_glascan(const P& p, Frame& F) {
    const bf16* PG = WSP(bf16, WS_PG); const bf16* QT = WSP(bf16, WS_QT); const bf16* KT = WSP(bf16, WS_KT); const float* DEC = WSP(float, WS_DEC);
    const int lane = F.lane, w = F.wave, g = lane >> 4, c16 = lane & 15, qrow = c16 >> 2, pp = c16 & 3;
    constexpr int BUF = 49152, QOFF = 0, KOFF = 16384, VOFF = 32768, AM = 98304, DCO = 106496;
    LAS unsigned char* L = F.lds; LAS unsigned char* stg = L + DCO + 1024 + w * 2048;
    for (int u = F.vcu; u < 256; u += F.G) {
        const int dvh = u & 1, dir = (u >> 1) & 1, h = (u >> 2) & 3, b = u >> 4;
        bf16* OUT = WSP(bf16, WS_OF) + (dir ? (size_t)(WS_OB - WS_OF) / 2 : 0);
        const size_t seqbase = (size_t)(dir * NB + b) * 2304;
#define GLA_STAGE(c, bufi) do { _Pragma("unroll") for (int pc = 0; pc < 2; ++pc) { const int piece = w + 8 * pc, row = piece * 4 + g, chs = c16 ^ (row & 15); \
            const size_t srow = seqbase + 64 * (c) + row; const unsigned ldst = (bufi) * BUF + piece * 1024; \
            if ((c) >= 4) __builtin_amdgcn_global_load_lds((const unsigned*)((const char*)(QT + srow * 512 + h * 128) + chs * 16), (LAS unsigned*)(L + QOFF + ldst), 16, 0, 0); \
            __builtin_amdgcn_global_load_lds((const unsigned*)((const char*)(KT + srow * 512 + h * 128) + chs * 16), (LAS unsigned*)(L + KOFF + ldst), 16, 0, 0); \
            __builtin_amdgcn_global_load_lds((const unsigned*)((const char*)(PG + (size_t)gla_rowmap(b, dir, 64 * (c) + row) * GIN + GQR + GQK + h * 256 + dvh * 128) + chs * 16), (LAS unsigned*)(L + VOFF + ldst), 16, 0, 0); } \
            if (w == 0 && lane < 32) __builtin_amdgcn_global_load_lds((const unsigned*)((const char*)(DEC + ((size_t)(dir * NB + b) * 36 + (c)) * 512 + h * 128) + lane * 16), (LAS unsigned*)(L + DCO + (bufi) * 512), 16, 0, 0); } while (0)
        f32x4 S[8];
#pragma unroll
        for (int t = 0; t < 8; ++t) S[t] = (f32x4){0.f, 0.f, 0.f, 0.f};
        GLA_STAGE(0, 0);
        asm volatile("s_waitcnt vmcnt(0)" ::: "memory"); __builtin_amdgcn_s_barrier(); asm volatile("" ::: "memory");
#pragma clang loop unroll(disable)
        for (int c = 0; c < 36; ++c) {
            const int bi = c & 1; LAS unsigned char* Qs = L + bi * BUF + QOFF; LAS unsigned char* Ksm = L + bi * BUF + KOFF; LAS unsigned char* Vsm = L + bi * BUF + VOFF; LAS unsigned char* Am = L + AM;
            if (c + 1 < 36) GLA_STAGE(c + 1, bi ^ 1);
            if (c >= 4) {
#pragma unroll
                for (int q2 = 0; q2 < 2; ++q2) { const int id = 2 * w + q2, ti = id >> 2, tj = id & 3; f32x4 a = (f32x4){0.f, 0.f, 0.f, 0.f};
                    if (tj <= ti) {
#pragma unroll
                        for (int ks = 0; ks < 4; ++ks) { const int co = ((4 * ks + g) ^ c16) * 16;
                            const bf16x8 qa = *(const LAS bf16x8*)(Qs + (16 * ti + c16) * 256 + co), kb = *(const LAS bf16x8*)(Ksm + (16 * tj + c16) * 256 + co);
                            a = mfma16(qa, kb, a); }
                        asm volatile("s_nop 7\n\ts_nop 7" : "+v"(a));
                        if (tj == ti) {
#pragma unroll
                            for (int r = 0; r < 4; ++r) a[r] = c16 > 4 * g + r ? 0.f : a[r]; } }
#pragma unroll
                    for (int r = 0; r < 4; ++r) { const int i = 16 * ti + 4 * g + r; *(LAS bf16*)(Am + i * 128 + (((2 * tj + (c16 >> 3)) ^ (i & 7)) * 16) + (c16 & 7) * 2) = (bf16)f2bf(a[r]); } }
            }
            asm volatile("s_waitcnt lgkmcnt(0)" ::: "memory"); __builtin_amdgcn_s_barrier(); asm volatile("" ::: "memory");
            bf16x8 vf[2];
            { s16x4 t0, t1, t2, t3; const int ch = 2 * w + (pp >> 1), bo = (pp & 1) * 8, rl = 8 * g + qrow;
              TR_RD(t0, Vsm + rl * 256 + ((ch ^ (rl & 15)) * 16) + bo); TR_RD(t1, Vsm + (rl + 4) * 256 + ((ch ^ ((rl + 4) & 15)) * 16) + bo);
              TR_RD(t2, Vsm + (rl + 32) * 256 + ((ch ^ (rl & 15)) * 16) + bo); TR_RD(t3, Vsm + (rl + 36) * 256 + ((ch ^ ((rl + 4) & 15)) * 16) + bo);
              TR_WAIT4(t0, t1, t2, t3);
              vf[0] = (bf16x8){t0[0], t0[1], t0[2], t0[3], t1[0], t1[1], t1[2], t1[3]}; vf[1] = (bf16x8){t2[0], t2[1], t2[2], t2[3], t3[0], t3[1], t3[2], t3[3]}; }
            if (c >= 4) {
                bf16x8 sf[4];
#pragma unroll
                for (int ks = 0; ks < 4; ++ks) { v4u t4; t4.x = pk2(S[2 * ks][0], S[2 * ks][1]); t4.y = pk2(S[2 * ks][2], S[2 * ks][3]); t4.z = pk2(S[2 * ks + 1][0], S[2 * ks + 1][1]); t4.w = pk2(S[2 * ks + 1][2], S[2 * ks + 1][3]); sf[ks] = __builtin_bit_cast(bf16x8, t4); }
#pragma unroll
                for (int tt = 0; tt < 4; ++tt) { f32x4 o = (f32x4){0.f, 0.f, 0.f, 0.f}; const int row = 16 * tt + c16;
#pragma unroll
                    for (int ks = 0; ks < 4; ++ks) { const int ch0 = 4 * ks + (g >> 1), bo = (g & 1) * 8;
                        const s16x4 alo = *(const LAS s16x4*)(Qs + row * 256 + ((ch0 ^ c16) * 16) + bo), ahi = *(const LAS s16x4*)(Qs + row * 256 + (((ch0 + 2) ^ c16) * 16) + bo);
                        o = mfma16((bf16x8){alo[0], alo[1], alo[2], alo[3], ahi[0], ahi[1], ahi[2], ahi[3]}, sf[ks], o); }
#pragma unroll
                    for (int ks2 = 0; ks2 < 2; ++ks2) { const bf16x8 am = *(const LAS bf16x8*)(Am + row * 128 + (((4 * ks2 + g) ^ (row & 7)) * 16)); o = mfma16(am, vf[ks2], o); }
#pragma unroll
                    for (int r = 0; r < 4; ++r) *(LAS bf16*)(stg + (16 * tt + 4 * g + r) * 32 + c16 * 2) = (bf16)f2bf(o[r]); }
#pragma unroll
                for (int pc = 0; pc < 2; ++pc) { const int pi = lane + 64 * pc, tok = pi >> 1; const v4u ov = *(const LAS v4u*)(stg + pi * 16);
                    *(v4u*)(OUT + (size_t)gla_rowmap(b, dir, 64 * c + tok) * GV + h * 256 + dvh * 128 + 16 * w + (pi & 1) * 8) = ov; }
            }
#pragma unroll
            for (int t = 0; t < 8; ++t) { f32x4 acc = S[t];
                { s16x4 t0, t1, t2, t3; const int ch = 2 * t + (pp >> 1), bo = (pp & 1) * 8, rl = 8 * g + qrow;
                  TR_RD(t0, Ksm + rl * 256 + ((ch ^ (rl & 15)) * 16) + bo); TR_RD(t1, Ksm + (rl + 4) * 256 + ((ch ^ ((rl + 4) & 15)) * 16) + bo);
                  TR_RD(t2, Ksm + (rl + 32) * 256 + ((ch ^ (rl & 15)) * 16) + bo); TR_RD(t3, Ksm + (rl + 36) * 256 + ((ch ^ ((rl + 4) & 15)) * 16) + bo);
                  TR_WAIT4(t0, t1, t2, t3);
                  acc = mfma16((bf16x8){t0[0], t0[1], t0[2], t0[3], t1[0], t1[1], t1[2], t1[3]}, vf[0], acc);
                  acc = mfma16((bf16x8){t2[0], t2[1], t2[2], t2[3], t3[0], t3[1], t3[2], t3[3]}, vf[1], acc); }
                const f32x4 d4 = *(const LAS f32x4*)(L + DCO + bi * 512 + (16 * t + 4 * g) * 4);
                S[t] = acc * d4; }
            if (c >= 4) asm volatile("s_waitcnt vmcnt(2) lgkmcnt(0)" ::: "memory"); else asm volatile("s_waitcnt vmcnt(0) lgkmcnt(0)" ::: "memory");
            __builtin_amdgcn_s_barrier(); asm volatile("" ::: "memory");
        }
#undef GLA_STAGE
    }
}
__device__ __forceinline__ void ph_scan_naive(const P& p, Frame& F) {
    const bf16* PG = WSP(bf16, WS_PG);
    LAS float* sq = (LAS float*)F.lds; LAS float* sk = sq + 128; LAS float* sa = sk + 128; LAS float* sv = sa + 128; LAS float* so = sv + 64;
    const int tid = F.tid, e = tid & 63, w = tid >> 6;
    for (int u = F.vcu; u < 512; u += F.G) {
        const int sl = u & 3, dir = (u >> 2) & 1, h = (u >> 3) & 3, b = u >> 5;
        float S[16];
#pragma unroll
        for (int i = 0; i < 16; ++i) S[i] = 0.f;
        bf16* OUT = WSP(bf16, WS_OF) + (dir ? (size_t)(WS_OB - WS_OF) / 2 : 0);
        for (int step = 0; step < CTX + SEQ; ++step) {
            int row; if (step < CTX) row = NL + b * CTX + (dir ? CTX - 1 - step : step); else { const int t = step - CTX; row = b * SEQ + (dir ? SEQ - 1 - t : t); }
            const bf16* pr = PG + (size_t)row * GIN;
            if (tid < 128) { const int col = h * 128 + tid; float z = p.gla_gate_b[dir * 512 + col];
#pragma unroll
                for (int r = 0; r < 16; ++r) z += bf2f(pr[3072 + dir * 16 + r]) * p.gla_gate_w2[(size_t)(dir * 16 + r) * 512 + col];
                const float ls = fminf(z, 0.f) - log1pf(expf(-fabsf(z)));
                sq[tid] = bf2f(pr[col]) * GLA_QS; sk[tid] = bf2f(pr[GQR + col]); sa[tid] = expf(ls * (1.f / 16.f)); }
            else if (tid < 192) sv[tid - 128] = bf2f(pr[GQR + GQK + h * 256 + sl * 64 + tid - 128]);
            __syncthreads();
            const float v = sv[e]; float o = 0.f;
#pragma unroll
            for (int i = 0; i < 16; ++i) { const int d = 16 * w + i; S[i] = sa[d] * S[i] + sk[d] * v; o += sq[d] * S[i]; }
            so[w * 64 + e] = o;
            __syncthreads();
            if (step >= CTX && tid < 64) { float s = 0.f;
#pragma unroll
                for (int q = 0; q < 8; ++q) s += so[q * 64 + tid];
                OUT[(size_t)row * GV + h * 256 + sl * 64 + tid] = (bf16)f2bf(s); }
        }
        __syncthreads();
    }
}

enum Phase { PH_PRO = 0, PH_NORM1_0, PH_QKV, PH_ATTN, PH_OUT0, PH_N2R0, PH_TOPK0, PH_UP0, PH_DN0, PH_COMB0, PH_GLAIN, PH_PREP, PH_SCAN, PH_READ, PH_OUT1, PH_N2R1, PH_TOPK1, PH_UP1, PH_DN1, PH_COMB1, PH_END };

__global__ void __launch_bounds__(NWAVES * 64, 2) k_fwd(P p) {
    extern __shared__ __attribute__((aligned(16))) unsigned char lds[];
    Frame F;
    F.lds = (LAS unsigned char*)lds;
    F.tid = threadIdx.x; F.lane = F.tid & 63; F.wave = __builtin_amdgcn_readfirstlane(F.tid >> 6);
    F.G = gridDim.x; { const int bx = blockIdx.x; F.vcu = (F.G % 8 == 0) ? (bx % 8) * (F.G / 8) + bx / 8 : bx; }
    F.ws = p.ws;
    volatile LAS unsigned* MISC = (volatile LAS unsigned*)(F.lds + MISC_OFF);
    for (int u = F.tid; u < (LDS_BYTES - LDSCTL_OFF) / 4; u += NWAVES * 64) ((LAS unsigned*)(F.lds + LDSCTL_OFF))[u] = 0u;
    __syncthreads();
    const int lo = p.lo, hi = p.hi;
    XcdBarrier bar; bar.bar = (unsigned*)(F.ws + WS_CTL) + CW_BAR; bar.x = 0; bar.st = nullptr;
    if (hi - lo > 1) bar = xcd_barrier_post((unsigned*)(F.ws + WS_CTL) + CW_BAR, MISC + 8);
#define IN(k) (lo <= (k) && (k) < hi)
#define SEAM(k) do { if (IN(k) && IN((k) + 1)) xcd_barrier(bar, F.tid == 0); } while (0)
#define PHASE(k, ...) do { if (IN(k)) { F.lane = (int)__builtin_amdgcn_mbcnt_hi(~0u, __builtin_amdgcn_mbcnt_lo(~0u, 0u)); F.tid = F.wave * 64 + F.lane; __VA_ARGS__; if ((PROBE_MASK >> (k)) & 1) { xcd_barrier(bar, F.tid == 0); __VA_ARGS__; } } SEAM(k); } while (0)
    PHASE(PH_PRO, ph_pro(p, F, (OPT_MASK & 0xff) != 0));
    PHASE(PH_NORM1_0, ph_norm1(p, F, 0));
    PHASE(PH_QKV, {
        pg8::Gemm g{WSP(bf16, WS_H), WSP(bf16, WS_WQKV), D * 2, nullptr}; pg8::TileOrder S; S.init(1, NT / 256, ATT_N / 256, NT / 256, F.G, (int)blockIdx.x);
        pg8::EpiQKV E{WSP(bf16, WS_Q), WSP(bf16, WS_K), WSP(bf16, WS_V), WSP(float, WS_ROPE)};
        pg8::gemm_phase<pg8::EpiQKV, pg8::TileOrder>(F.lds, g, S, E, F.tid);
        BG_SLOT(96, CVT_SPLIT0, CVT_Q1); });
    PHASE(PH_ATTN, { if (OPT_MASK & 256) ph_attn(p, F); else ph_attn_naive(p, F); });
    PHASE(PH_OUT0, {
        pg8::Gemm g{WSP(bf16, WS_O), WSP(bf16, WS_WO0), D * 2, nullptr}; pg8::TileOrder S; S.init(1, NT / 256, D / 256, NT / 256, F.G, (int)blockIdx.x);
        pg8::EpiResidT<false> E{p.x, p.ctx, WSP(xa_t, WS_XA), WSP(float, WS_MOD) + 2048};
        pg8::gemm_phase<pg8::EpiResidT<false>, pg8::TileOrder>(F.lds, g, S, E, F.tid);
        BG_SLOT(64, CVT_Q1, CVT_Q2); });
    PHASE(PH_N2R0, ph_norm2r(p, F, 0));
    PHASE(PH_TOPK0, ph_topkg(p, F, 0));
    PHASE(PH_UP0, {
        pg8::Gemm g{MOE_FP8 ? (const void*)WSP(unsigned char, WS_H8) : (const void*)WSP(bf16, WS_H), WSP(unsigned char, WS_WUP), D * EB, WSP(int, WS_ROWIDX)}; pg8::TileOrder S; S.init(NE, ESLOTS / 256, FF / 128, ESLOTS / 256, F.G, (int)blockIdx.x);
        pg8::EpiSwiglu E{WSP(unsigned char, WS_ACT)};
        pg8::gemm_phase<pg8::EpiSwiglu, pg8::TileOrder, MOE_FP8 != 0, true, true>(F.lds, g, S, E, F.tid);
        BG_SLOT(192, CVT_Q2, CVT_Q3); });
    PHASE(PH_DN0, {
        pg8::Gemm g{WSP(unsigned char, WS_ACT), WSP(unsigned char, WS_WDN), FF * EB, nullptr}; pg8::TileOrder S; S.init(NE, ESLOTS / 256, D / 256, ESLOTS / 256, F.G, (int)blockIdx.x);
        pg8::EpiDown E{WSP(bf16, WS_YS), WSP(float, WS_ROWG)};
        pg8::gemm_phase<pg8::EpiDown, pg8::TileOrder, MOE_FP8 != 0>(F.lds, g, S, E, F.tid);
        BG_SLOT(128, CVT_Q3, NPAIR_ALL); });
    PHASE(PH_COMB0, ph_combine(p, F, 0));
    PHASE(PH_GLAIN, {
        pg8::Gemm g{WSP(bf16, WS_H), WSP(bf16, WS_WGIN), D * 2, nullptr}; pg8::GlaInOrder S{F.G, (int)blockIdx.x};
        pg8::EpiGlaIn E{WSP(bf16, WS_PG)};
        pg8::gemm_phase<pg8::EpiGlaIn, pg8::GlaInOrder>(F.lds, g, S, E, F.tid); });
    PHASE(PH_PREP, { if (OPT_MASK & 512) ph_glaprep(p, F); });
    PHASE(PH_SCAN, { if (OPT_MASK & 512) ph_glascan(p, F); else ph_scan_naive(p, F); });
    PHASE(PH_READ, ph_readout(p, F));
    PHASE(PH_OUT1, {
        pg8::Gemm g{WSP(bf16, WS_H), WSP(bf16, WS_WO1), D * 2, nullptr}; pg8::TileOrder S; S.init(1, NL / 256, D / 256, NL / 256, F.G, (int)blockIdx.x);
        pg8::EpiResidT<true> E{nullptr, nullptr, WSP(xa_t, WS_XA), WSP(float, WS_MOD) + 17 * 6144 + 2048};
        pg8::gemm_phase<pg8::EpiResidT<true>, pg8::TileOrder>(F.lds, g, S, E, F.tid); });
    PHASE(PH_N2R1, ph_norm2r(p, F, 1));
    PHASE(PH_TOPK1, ph_topkg(p, F, 1));
    PHASE(PH_UP1, {
        pg8::Gemm g{MOE_FP8 ? (const void*)WSP(unsigned char, WS_H8) : (const void*)WSP(bf16, WS_H), WSP(unsigned char, WS_WUP) + (size_t)NE * 5632 * D * EB, D * EB, WSP(int, WS_ROWIDX)}; pg8::TileOrder S; S.init(NE, NB * CAPL / 256, FF / 128, ESLOTS / 256, F.G, (int)blockIdx.x);
        pg8::EpiSwiglu E{WSP(unsigned char, WS_ACT)};
        pg8::gemm_phase<pg8::EpiSwiglu, pg8::TileOrder, MOE_FP8 != 0, true, true>(F.lds, g, S, E, F.tid); });
    PHASE(PH_DN1, {
        pg8::Gemm g{WSP(unsigned char, WS_ACT), WSP(unsigned char, WS_WDN) + (size_t)NE * D * FF * EB, FF * EB, nullptr}; pg8::TileOrder S; S.init(NE, NB * CAPL / 256, D / 256, ESLOTS / 256, F.G, (int)blockIdx.x);
        pg8::EpiDown E{WSP(bf16, WS_YS), WSP(float, WS_ROWG)};
        pg8::gemm_phase<pg8::EpiDown, pg8::TileOrder, MOE_FP8 != 0>(F.lds, g, S, E, F.tid); });
    PHASE(PH_COMB1, ph_combine(p, F, 1));
#undef PHASE
#undef IN
#undef SEAM
}

__global__ void __launch_bounds__(256) n_gemm(const bf16* A, int lda, const float* W, int ldw, float* C, int ldc, int M, int N, int K) {
    __shared__ float As[16][65], Bs[16][64];
    const int t = threadIdx.x, tx = t & 15, ty = t >> 4, m0 = blockIdx.y * 64, n0 = blockIdx.x * 64;
    float acc[4][4];
#pragma unroll
    for (int i = 0; i < 4; ++i)
#pragma unroll
        for (int j = 0; j < 4; ++j) acc[i][j] = 0.f;
    for (int k0 = 0; k0 < K; k0 += 16) {
        { const int r = t >> 2, kq = (t & 3) * 4; const v2u w = *(const v2u*)(A + (size_t)(m0 + r) * lda + k0 + kq);
          As[kq + 0][r] = __uint_as_float(w.x << 16); As[kq + 1][r] = __uint_as_float(w.x & 0xffff0000u); As[kq + 2][r] = __uint_as_float(w.y << 16); As[kq + 3][r] = __uint_as_float(w.y & 0xffff0000u); }
        { const int k = t >> 4, n = (t & 15) * 4;
#pragma unroll
          for (int j = 0; j < 4; ++j) Bs[k][n + j] = (n0 + n + j < N) ? W[(size_t)(k0 + k) * ldw + n0 + n + j] : 0.f; }
        __syncthreads();
#pragma unroll
        for (int kk = 0; kk < 16; ++kk) { float a[4], b[4];
#pragma unroll
            for (int i = 0; i < 4; ++i) { a[i] = As[kk][ty * 4 + i]; b[i] = Bs[kk][tx * 4 + i]; }
#pragma unroll
            for (int i = 0; i < 4; ++i)
#pragma unroll
                for (int j = 0; j < 4; ++j) acc[i][j] += a[i] * b[j]; }
        __syncthreads();
    }
#pragma unroll
    for (int i = 0; i < 4; ++i)
#pragma unroll
        for (int j = 0; j < 4; ++j) if (n0 + tx * 4 + j < N) C[(size_t)(m0 + ty * 4 + i) * ldc + n0 + tx * 4 + j] = acc[i][j];
}
__global__ void n_post_qkv(const float* T, int r0, int rows, bf16* Q, bf16* Kb, bf16* Vb) {
    const size_t i = (size_t)blockIdx.x * blockDim.x + threadIdx.x; if (i >= (size_t)rows * ATT_N) return;
    const int rl = (int)(i / ATT_N), c = (int)(i % ATT_N), r = r0 + rl; float val = T[i];
    if (c < 1280 && r < NL) { const int d = c & 63, a = d >> 5, s = (d >> 4) & 1, f = d & 15, t = r & (SEQ - 1); const float xp = T[(size_t)rl * ATT_N + (s ? c - 16 : c + 16)];
        const float inv = powf(10000.f, -(float)f / 16.f), ang = (float)(a ? (t & 63) : (t >> 6)) * inv, cs = cosf(ang), sn = sinf(ang);
        val = s == 0 ? val * cs - xp * sn : val * cs + xp * sn; }
    if (c < 1024) Q[(size_t)r * 1024 + c] = (bf16)f2bf(val * QSCALE); else if (c < 1280) Kb[(size_t)r * 256 + c - 1024] = (bf16)f2bf(val); else Vb[(size_t)r * 256 + c - 1280] = (bf16)f2bf(val);
}
__global__ void n_post_resid(const float* T, int r0, int rows, const float* xlat, const float* xctx, float* XA, const float* mod_g) {
    const size_t i = (size_t)blockIdx.x * blockDim.x + threadIdx.x; if (i >= (size_t)rows * D) return;
    const int rl = (int)(i / D), c = (int)(i % D), r = r0 + rl; const int j = r < NL ? r / SEQ : 16;
    const float xs = r < NL ? xlat[(size_t)r * D + c] : xctx[(size_t)(r - NL) * D + c];
    XA[(size_t)r * D + c] = xs + mod_g[(size_t)j * 6144 + c] * T[i];
}
__global__ void n_post_swiglu(const float* T, int rows, bf16* ACTrow0) {
    const size_t i = (size_t)blockIdx.x * blockDim.x + threadIdx.x; if (i >= (size_t)rows * FF) return;
    const int rl = (int)(i / FF), f = (int)(i % FF); const float g = T[(size_t)rl * 5632 + f], u = T[(size_t)rl * 5632 + FF + f];
    ACTrow0[(size_t)rl * FF + f] = (bf16)f2bf(silu_f(g) * u);
}
__global__ void n_post_down(const float* T, int rows, bf16* YSrow0, const float* rowg0) {
    const size_t i = (size_t)blockIdx.x * blockDim.x + threadIdx.x; if (i >= (size_t)rows * D) return;
    const int rl = (int)(i / D); YSrow0[i] = (bf16)f2bf(rowg0[rl] * T[i]);
}
__global__ void n_post_cast(const float* T, size_t n, bf16* O) { const size_t i = (size_t)blockIdx.x * blockDim.x + threadIdx.x; if (i < n) O[i] = (bf16)f2bf(T[i]); }
__global__ void __launch_bounds__(256) n_attn(const bf16* Q, const bf16* Kb, const bf16* Vb, const float* sink, bf16* O) {
    const int i = blockIdx.x * blockDim.x + threadIdx.x; if (i >= NT * NQH) return;
    const int r = i >> 4, hq = i & 15, hk = hq >> 2;
    float q[64], acc[64];
#pragma unroll
    for (int d = 0; d < 64; ++d) { q[d] = bf2f(Q[(size_t)r * 1024 + hq * 64 + d]); acc[d] = 0.f; }
    float m = sink[hq] * LOG2E, l = 1.f;
    const bool lat = r < NL; const int b = lat ? r / SEQ : (r - NL) / CTX, t = r & (SEQ - 1);
    const int nlat = lat ? (min(SEQ - 1, t + 128) - max(0, t - 128) + 1) : 0, klo = max(0, t - 128);
    for (int kk = 0; kk < CTX + nlat; ++kk) {
        const int kr = kk < CTX ? NL + b * CTX + kk : b * SEQ + klo + (kk - CTX);
        const bf16* kp = Kb + (size_t)kr * 256 + hk * 64; const bf16* vp = Vb + (size_t)kr * 256 + hk * 64;
        float s = 0.f;
#pragma unroll
        for (int d = 0; d < 64; ++d) s += q[d] * bf2f(kp[d]);
        const float mn = fmaxf(m, s), sc = exp2f(m - mn), pe = exp2f(s - mn);
        l = l * sc + pe; m = mn;
#pragma unroll
        for (int d = 0; d < 64; ++d) acc[d] = acc[d] * sc + pe * bf2f(vp[d]);
    }
    const float il = 1.f / l;
#pragma unroll
    for (int d = 0; d < 64; ++d) O[(size_t)r * 1024 + hq * 64 + d] = (bf16)f2bf(acc[d] * il);
}
__global__ void __launch_bounds__(512) n_glascan(const bf16* PG, const float* w2, const float* gb, bf16* OF, bf16* OB) {
    const int u = blockIdx.x, sl = u & 3, dir = (u >> 2) & 1, h = (u >> 3) & 3, b = u >> 5;
    __shared__ float sq[128], sk[128], sa[128], sv[64], so[8][64];
    const int tid = threadIdx.x, e = tid & 63, w = tid >> 6;
    float S[16];
#pragma unroll
    for (int i = 0; i < 16; ++i) S[i] = 0.f;
    bf16* OUT = dir ? OB : OF;
    for (int step = 0; step < CTX + SEQ; ++step) {
        int row; if (step < CTX) row = NL + b * CTX + (dir ? CTX - 1 - step : step); else { const int t = step - CTX; row = b * SEQ + (dir ? SEQ - 1 - t : t); }
        const bf16* pr = PG + (size_t)row * GIN;
        if (tid < 128) { const int col = h * 128 + tid; float z = gb[dir * 512 + col];
#pragma unroll
            for (int r = 0; r < 16; ++r) z += bf2f(pr[3072 + dir * 16 + r]) * w2[(size_t)(dir * 16 + r) * 512 + col];
            const float ls = fminf(z, 0.f) - log1pf(expf(-fabsf(z)));
            sq[tid] = bf2f(pr[col]) * GLA_QS; sk[tid] = bf2f(pr[GQR + col]); sa[tid] = expf(ls * (1.f / 16.f)); }
        else if (tid < 192) sv[tid - 128] = bf2f(pr[GQR + GQK + h * 256 + sl * 64 + tid - 128]);
        __syncthreads();
        const float v = sv[e]; float o = 0.f;
#pragma unroll
        for (int i = 0; i < 16; ++i) { const int d = 16 * w + i; S[i] = sa[d] * S[i] + sk[d] * v; o += sq[d] * S[i]; }
        so[w][e] = o;
        __syncthreads();
        if (step >= CTX && tid < 64) { float s = 0.f;
#pragma unroll
            for (int q = 0; q < 8; ++q) s += so[q][tid];
            OUT[(size_t)row * GV + h * 256 + sl * 64 + tid] = (bf16)f2bf(s); }
    }
}

static void launch_phase(P p, int lo, int hi, int grid, hipStream_t stream) { p.lo = lo; p.hi = hi; hipLaunchKernelGGL(k_fwd, dim3(grid), dim3(NWAVES * 64), LDS_BYTES, stream, p); }
static void naive_gemm(const bf16* A, int lda, const float* W, int ldw, float* C, int ldc, int M, int N, int K, hipStream_t s) {
    hipLaunchKernelGGL(n_gemm, dim3((N + 63) / 64, M / 64), dim3(256), 0, s, A, lda, W, ldw, C, ldc, M, N, K);
}
#define EW_GRID(n) dim3((unsigned)(((size_t)(n) + 255) / 256)), dim3(256), 0, stream

extern "C" void kernel_launch(void* const* d_in, const int* in_sizes, int n_in, void* d_out, int out_size, void* d_ws, size_t ws_size, hipStream_t stream) {
    static int grid = 0;
    if (grid == 0) {
        if (n_in != 21 || out_size != NL * D || ws_size < WS_END) { fprintf(stderr, "kernel_launch: unexpected shapes (n_in %d out %d ws %zu need %zu)\n", n_in, out_size, ws_size, (size_t)WS_END); grid = -1; return; }
        int dev = 0, cus = 0;
        if (hipGetDevice(&dev) != hipSuccess || hipDeviceGetAttribute(&cus, hipDeviceAttributeMultiprocessorCount, dev) != hipSuccess) { grid = -1; return; }
        if (hipFuncSetAttribute((const void*)k_fwd, hipFuncAttributeMaxDynamicSharedMemorySize, LDS_BYTES) != hipSuccess) { fprintf(stderr, "kernel_launch: hipFuncSetAttribute failed\n"); grid = -1; return; }
        int per_cu = 0;
        if (hipOccupancyMaxActiveBlocksPerMultiprocessor(&per_cu, (const void*)k_fwd, NWAVES * 64, LDS_BYTES) != hipSuccess || per_cu < 1) fprintf(stderr, "kernel_launch: occupancy query says %d\n", per_cu);
        (void)hipGetLastError();
        grid = cus;
    }
    if (grid < 0) return;
    hipMemsetAsync((char*)d_ws + WS_CTL, 0, CTL_ZERO_BYTES, stream);
    P p{};
    const float** pp = (const float**)&p;
    for (int i = 0; i < 21; ++i) pp[i] = (const float*)d_in[i];
    p.out = (float*)d_out; p.ws = (unsigned char*)d_ws; p.lo = 0; p.hi = 0;
    unsigned char* ws = (unsigned char*)d_ws;
#define WS(T, off) ((T*)(ws + (off)))
#if ONE_LAUNCH
    launch_phase(p, 0, PH_END, grid, stream);
#else
    float* TMP = WS(float, WS_TMP);
    launch_phase(p, PH_PRO, PH_PRO + 1, grid, stream);
    launch_phase(p, PH_NORM1_0, PH_NORM1_0 + 1, grid, stream);
    if (OPT_MASK & 1) launch_phase(p, PH_QKV, PH_QKV + 1, grid, stream);
    else for (int ch = 0; ch < NT / 2048; ++ch) { const int r0 = ch * 2048;
        naive_gemm(WS(bf16, WS_H) + (size_t)r0 * D, D, p.attn_w_in, ATT_N, TMP, ATT_N, 2048, ATT_N, D, stream);
        hipLaunchKernelGGL(n_post_qkv, EW_GRID((size_t)2048 * ATT_N), TMP, r0, 2048, WS(bf16, WS_Q), WS(bf16, WS_K), WS(bf16, WS_V)); }
    if (OPT_MASK & 256) launch_phase(p, PH_ATTN, PH_ATTN + 1, grid, stream);
    else hipLaunchKernelGGL(n_attn, dim3(NT * NQH / 256), dim3(256), 0, stream, WS(bf16, WS_Q), WS(bf16, WS_K), WS(bf16, WS_V), p.attn_sink, WS(bf16, WS_O));
    if (OPT_MASK & 2) launch_phase(p, PH_OUT0, PH_OUT0 + 1, grid, stream);
    else for (int ch = 0; ch < NT / 2048; ++ch) { const int r0 = ch * 2048;
        naive_gemm(WS(bf16, WS_O) + (size_t)r0 * D, D, p.attn_w_out, D, TMP, D, 2048, D, D, stream);
        hipLaunchKernelGGL(n_post_resid, EW_GRID((size_t)2048 * D), TMP, r0, 2048, p.x, p.ctx, WS(float, WS_XA), WS(float, WS_MOD) + 2048); }
    launch_phase(p, PH_N2R0, PH_N2R0 + 1, grid, stream);
    launch_phase(p, PH_TOPK0, PH_TOPK0 + 1, grid, stream);
    for (int l = 0; l < 2; ++l) {
        if (l == 1) {
            if (OPT_MASK & 16) launch_phase(p, PH_GLAIN, PH_GLAIN + 1, grid, stream);
            else for (int ch = 0; ch < NT / 2048; ++ch) { const int r0 = ch * 2048;
                naive_gemm(WS(bf16, WS_H) + (size_t)r0 * D, D, p.gla_w_in, GIN, TMP, GIN, 2048, GIN, D, stream);
                hipLaunchKernelGGL(n_post_cast, EW_GRID((size_t)2048 * GIN), TMP, (size_t)2048 * GIN, WS(bf16, WS_PG) + (size_t)r0 * GIN); }
            if (OPT_MASK & 512) launch_phase(p, PH_SCAN, PH_SCAN + 1, grid, stream);
            else hipLaunchKernelGGL(n_glascan, dim3(512), dim3(512), 0, stream, WS(bf16, WS_PG), p.gla_gate_w2, p.gla_gate_b, WS(bf16, WS_OF), WS(bf16, WS_OB));
            launch_phase(p, PH_READ, PH_READ + 1, grid, stream);
            if (OPT_MASK & 32) launch_phase(p, PH_OUT1, PH_OUT1 + 1, grid, stream);
            else for (int ch = 0; ch < NL / 2048; ++ch) { const int r0 = ch * 2048;
                naive_gemm(WS(bf16, WS_H) + (size_t)r0 * D, D, p.gla_w_out, D, TMP, D, 2048, D, D, stream);
                hipLaunchKernelGGL(n_post_resid, EW_GRID((size_t)2048 * D), TMP, r0, 2048, WS(float, WS_XA), WS(float, WS_XA), WS(float, WS_XA), WS(float, WS_MOD) + 17 * 6144 + 2048); }
            launch_phase(p, PH_N2R1, PH_N2R1 + 1, grid, stream);
            launch_phase(p, PH_TOPK1, PH_TOPK1 + 1, grid, stream);
        }
        const int rows_e = l == 0 ? ESLOTS : NB * CAPL, chunk = l == 0 ? 2304 : 2048;
        const bool up_opt = OPT_MASK & (l == 0 ? 4 : 64), dn_opt = OPT_MASK & (l == 0 ? 8 : 128);
        if (up_opt && dn_opt) { launch_phase(p, l == 0 ? PH_UP0 : PH_UP1, (l == 0 ? PH_UP0 : PH_UP1) + 1, grid, stream); launch_phase(p, l == 0 ? PH_DN0 : PH_DN1, (l == 0 ? PH_DN0 : PH_DN1) + 1, grid, stream); }
        else {
            if (up_opt) launch_phase(p, l == 0 ? PH_UP0 : PH_UP1, (l == 0 ? PH_UP0 : PH_UP1) + 1, grid, stream);
            else for (int e = 0; e < NE; ++e) for (int r0 = 0; r0 < rows_e; r0 += chunk) {
                const size_t row = (size_t)e * ESLOTS + r0; const size_t le = (size_t)(l * NE + e);
                naive_gemm(WS(bf16, WS_XG) + row * D, D, p.exp_w_gate + le * D * FF, FF, TMP, 5632, chunk, FF, D, stream);
                naive_gemm(WS(bf16, WS_XG) + row * D, D, p.exp_w_up + le * D * FF, FF, TMP + FF, 5632, chunk, FF, D, stream);
                hipLaunchKernelGGL(n_post_swiglu, EW_GRID((size_t)chunk * FF), TMP, chunk, WS(bf16, WS_ACT) + row * FF); }
            if (dn_opt) launch_phase(p, l == 0 ? PH_DN0 : PH_DN1, (l == 0 ? PH_DN0 : PH_DN1) + 1, grid, stream);
            else for (int e = 0; e < NE; ++e) for (int r0 = 0; r0 < rows_e; r0 += chunk) {
                const size_t row = (size_t)e * ESLOTS + r0; const size_t le = (size_t)(l * NE + e);
                naive_gemm(WS(bf16, WS_ACT) + row * FF, FF, p.exp_w_down + le * FF * D, D, TMP, D, chunk, D, FF, stream);
                hipLaunchKernelGGL(n_post_down, EW_GRID((size_t)chunk * D), TMP, chunk, WS(bf16, WS_YS) + row * D, WS(float, WS_ROWG) + row); }
        }
        launch_phase(p, l == 0 ? PH_COMB0 : PH_COMB1, (l == 0 ? PH_COMB0 : PH_COMB1) + 1, grid, stream);
    }
#endif
}
```

```cpp
#include <hip/hip_runtime.h>
#include <cstdio>
#include <cstdint>

#ifndef OPT_MASK
#define OPT_MASK 0x3FF
#endif
#ifndef MOE_FP8
#define MOE_FP8 1
#endif
#ifndef PROBE_MASK
#define PROBE_MASK 0
#endif
#ifndef ONE_LAUNCH
#define ONE_LAUNCH 1
#endif

#define GAS __attribute__((address_space(1)))
#define LAS __attribute__((address_space(3)))
typedef unsigned short bf16;
typedef unsigned v4u __attribute__((ext_vector_type(4)));
typedef unsigned v2u __attribute__((ext_vector_type(2)));
typedef float f32x4 __attribute__((ext_vector_type(4)));
typedef float f32x2 __attribute__((ext_vector_type(2)));
typedef short bf16x8 __attribute__((ext_vector_type(8)));

constexpr int D = 1024, NB = 16, SEQ = 2048, CTX = 256;
constexpr int NL = NB * SEQ, NC = NB * CTX, NT = NL + NC;
constexpr int NQH = 16, NKV = 4, HD = 64, ATT_N = 1536;
constexpr int GH = 4, GDK = 128, GDV = 256, GQK = 512, GV = 1024, GQR = 1536, GIN = 3104, GIN_PAD = 3328;
constexpr int NE = 16, FF = 2816, CAPL = 256, CAPC = 32, ESLOTS = NB * CAPL + NB * CAPC;
constexpr float EPS = 1e-6f;
constexpr float LOG2E = 1.4426950408889634f;
constexpr float QSCALE = 0.125f * LOG2E;
constexpr float GLA_QS = 0.08838834764831845f;
constexpr int EB = MOE_FP8 ? 1 : 2;
constexpr float F8_ACT = 16.f, F8_W = 256.f, F8_INV = 1.f / (16.f * 256.f);

constexpr size_t MiB = 1ull << 20;
constexpr size_t WS_CTL = 0, CTL_ZERO_BYTES = 1 * MiB;
constexpr size_t WS_MOD = 1 * MiB;
constexpr size_t WS_ROPE = WS_MOD + 896 * 1024;
constexpr size_t WS_WQKV = 2 * MiB;
constexpr size_t WS_WO0 = 5 * MiB;
constexpr size_t WS_WGIN = 7 * MiB;
constexpr size_t WS_WO1 = 14 * MiB;
constexpr size_t WS_AFF = 16 * MiB;
constexpr size_t WS_SLOT = 19 * MiB;
constexpr size_t WS_ROWIDX = 22 * MiB;
constexpr size_t WS_ROWG = 22 * MiB + 512 * 1024;
constexpr size_t WS_WUP = 24 * MiB;
constexpr size_t WS_WDN = WS_WUP + 352 * MiB;
constexpr size_t WS_XA = WS_WDN + 176 * MiB;
constexpr size_t WS_H = WS_XA + 144 * MiB;
constexpr size_t WS_E = WS_H + 72 * MiB;
constexpr size_t WS_Q = WS_E, WS_K = WS_E + 72 * MiB, WS_V = WS_E + 90 * MiB, WS_O = WS_E + 108 * MiB;
constexpr size_t WS_PG = WS_E, WS_OF = WS_E + 220 * MiB, WS_OB = WS_E + 284 * MiB;
constexpr size_t WS_QT = WS_E + 348 * MiB, WS_KT = WS_E + 420 * MiB, WS_DEC = WS_E + 492 * MiB;
constexpr size_t WS_XG = WS_E, WS_YS = WS_E, WS_ACT = WS_E + 144 * MiB;
constexpr size_t WS_H8 = WS_E;
constexpr size_t WS_TMP = WS_E + 540 * MiB;
constexpr size_t WS_END = WS_TMP + 50 * MiB;
constexpr int CW_BAR = 4096;

constexpr int RING_BYTES = 131072;
constexpr int LDS_BYTES = 147456;
constexpr int LDSCTL_OFF = LDS_BYTES - 1024, MISC_OFF = LDSCTL_OFF + 320;
constexpr int NWAVES = 8;

__device__ __forceinline__ float bf2f(bf16 v) { return __uint_as_float(((unsigned)v) << 16); }
typedef __bf16 hwbf16x2 __attribute__((ext_vector_type(2)));
__device__ __forceinline__ unsigned pk2(float lo, float hi) { const f32x2 v = {lo, hi}; return __builtin_bit_cast(unsigned, __builtin_convertvector(v, hwbf16x2)); }
__device__ __forceinline__ unsigned f2bf(float f) { return pk2(f, 0.f) & 0xffffu; }
__device__ __forceinline__ float clamp448(float v) { return __builtin_fminf(__builtin_fmaxf(v, -448.f), 448.f); }
__device__ __forceinline__ unsigned pk4_fp8(float a, float b, float c, float d) { int w = 0; w = __builtin_amdgcn_cvt_pk_fp8_f32(clamp448(a), clamp448(b), w, false); w = __builtin_amdgcn_cvt_pk_fp8_f32(clamp448(c), clamp448(d), w, true); return (unsigned)w; }
typedef _Float16 f16x4 __attribute__((ext_vector_type(4)));
typedef unsigned short xa_t;
__device__ __forceinline__ v2u pack_h4(f32x4 v) { return __builtin_bit_cast(v2u, __builtin_convertvector(v, f16x4)); }
__device__ __forceinline__ f32x4 unpack_h4(v2u w) { return __builtin_convertvector(__builtin_bit_cast(f16x4, w), f32x4); }
template <int CTRL, int RMASK> __device__ __forceinline__ float dpp_add(float x) { return x + __builtin_bit_cast(float, __builtin_amdgcn_update_dpp(0, __builtin_bit_cast(int, x), CTRL, RMASK, 0xf, false)); }
__device__ __forceinline__ float wave_sum(float v) {
    v = dpp_add<0xB1, 0xf>(v);
    v = dpp_add<0x4E, 0xf>(v);
    v = dpp_add<0x141, 0xf>(v);
    v = dpp_add<0x140, 0xf>(v);
    v = dpp_add<0x142, 0xa>(v);
    v = dpp_add<0x143, 0xc>(v);
    return __builtin_bit_cast(float, __builtin_amdgcn_readlane(__builtin_bit_cast(int, v), 63));
}
__device__ __forceinline__ float silu_f(float v) { return v / (1.f + expf(-v)); }
__device__ __forceinline__ float fexp(float x) { return __builtin_amdgcn_exp2f(x * LOG2E); }
__device__ __forceinline__ float flog(float x) { return __builtin_amdgcn_logf(x) * 0.6931471805599453f; }
__device__ __forceinline__ float fsilu(float v) { return v * __builtin_amdgcn_rcpf(1.f + fexp(-v)); }
template <int d> __device__ __forceinline__ float dpp_shr(float x) { return __builtin_bit_cast(float, __builtin_amdgcn_update_dpp(0, __builtin_bit_cast(int, x), 0x110 + d, 0xf, 0xf, true)); }
#define LDS_WAIT() asm volatile("s_waitcnt lgkmcnt(0)" ::: "memory")
#define LDS_SYNC() asm volatile("s_waitcnt lgkmcnt(0)\n\ts_barrier" ::: "memory")
#define VM_WAIT() asm volatile("s_waitcnt vmcnt(0)" ::: "memory")

struct P {
    const float *x, *c, *ctx, *c_ctx, *ada_w, *ada_b, *norm1_g, *norm2_g, *attn_w_in, *attn_w_out, *attn_sink,
        *gla_w_in, *gla_gate_w2, *gla_gate_b, *gla_norm_g, *gla_w_out, *router_w, *exp_w_gate, *exp_w_up, *exp_w_down, *final_norm_g;
    float* out; unsigned char* ws;
    int lo, hi;
};

namespace pg8 {
#define PG8_LAS __attribute__((address_space(3)))
typedef unsigned short bf16_t;
typedef unsigned u32x4 __attribute__((ext_vector_type(4)));
typedef unsigned u32x2 __attribute__((ext_vector_type(2)));
constexpr int BM = 256, BK = 64, HALF = 128, HTB = HALF * BK * 2, STAGE_BYTES = 8 * HTB, NXCD = 8, WGM = 8;
__host__ __device__ __forceinline__ int lds_byte(int r, int c) { const int st = (r >> 4) * 2 + (c >> 5), rr = r & 15, cc = c & 31, ob = rr * 64 + cc * 2; return st * 1024 + (ob ^ (((ob >> 9) & 1) << 5)); }
__host__ __device__ __forceinline__ void stage_rc(int b, int& R, int& C) { const int st = b / 1024, sb = b % 1024, swz = sb ^ (((sb >> 9) & 1) << 5); R = (st >> 1) * 16 + swz / 64; C = (st & 1) * 32 + (swz % 64) / 2; }
__host__ __device__ __forceinline__ int perm32(int rho) { const int n = rho >> 4, i = rho & 15; return 8 * (i >> 2) + 4 * n + (i & 3); }
struct Unit { int pm, pn; };
struct Gemm { const void* A; const void* Bt; int KB; const int* gidx; };
struct TileOrder {
    int nG, nM, nN, sM, G, c, per, nwg;
    __device__ __forceinline__ void init(int nG_, int nM_, int nN_, int sM_, int G_, int c_) { nG = nG_; nM = nM_; nN = nN_; sM = sM_; G = G_; c = c_; per = nM * nN; nwg = nG * per; }
    __device__ __forceinline__ bool next(int i, Unit& u) const {
        const long L = (long)i * G + c; if (L >= nwg) return false;
        int wgid = (int)L; { const int q = nwg / NXCD, r = nwg % NXCD, xcd = wgid % NXCD, off = wgid / NXCD; wgid = (xcd < r ? xcd * (q + 1) : r * (q + 1) + (xcd - r) * q) + off; }
        const int g = wgid / per, rem = wgid % per;
        const int nig = WGM * nN, gid = rem / nig, fm = gid * WGM, gsz = (nM - fm) < WGM ? (nM - fm) : WGM;
        u.pm = g * sM + fm + ((rem % nig) % gsz); u.pn = g * nN + (rem % nig) / gsz; return true;
    }
};
struct GlaInOrder {
    int G, c;
    __device__ __forceinline__ bool next(int i, Unit& u) const {
        constexpr int NLAT = (NL / BM) * 13, NALL = NLAT + (NC / BM) * 7;
        const long L = (long)i * G + c; if (L >= NALL) return false;
        int wgid = (int)L; { const int q = NALL / NXCD, xcd = wgid % NXCD, off = wgid / NXCD; wgid = xcd * q + off; }
        if (wgid < NLAT) { const int nig = WGM * 13, gid = wgid / nig, fm = gid * WGM; u.pm = fm + ((wgid % nig) % WGM); u.pn = (wgid % nig) / WGM; }
        else { const int r = wgid - NLAT; u.pm = NL / BM + (r & 15); u.pn = 6 + (r >> 4); }
        return true;
    }
};
__device__ __forceinline__ unsigned cvt_pk_bf16(float lo, float hi) { unsigned r; asm volatile("v_cvt_pk_bf16_f32 %0, %1, %2" : "=v"(r) : "v"(lo), "v"(hi)); return r; }

struct EpiQKV {
    static constexpr bool PERM = false;
    bf16_t *Q, *Kb, *Vb; const float* rope;
    __device__ __forceinline__ void operator()(const f32x4 (&acc)[2][2][4][2], const Unit& u, int wr, int wc, int fr, int fq) const {
        const int row0 = u.pm * BM + wr * 64 + fr; const bool latent = u.pm < (NL / BM);
        const int kind = u.pn < 4 ? 0 : (u.pn == 4 ? 1 : 2);
        const size_t boff = (kind >= 1 ? (size_t)(WS_K - WS_Q) / 2 : 0) + (kind == 2 ? (size_t)(WS_V - WS_K) / 2 : 0);
        bf16_t* base = Q + boff; const int ldc = kind == 0 ? 1024 : 256; const int colt = kind == 0 ? u.pn * BM : 0;
        const float sc = kind == 0 ? QSCALE : 1.f;
        f32x4 rc0[2][4], rc1[2][4];
#pragma unroll
        for (int ai = 0; ai < 2; ++ai)
#pragma unroll
            for (int m = 0; m < 4; ++m) { const int t = (row0 + ai * HALF + m * 16) & (SEQ - 1);
                rc0[ai][m] = (f32x4){1.f, 0.f, 1.f, 0.f}; rc1[ai][m] = rc0[ai][m];
                if (latent && kind != 2) { const int pos = (wc & 1) ? (t & 63) : (t >> 6); const f32x4* tp = (const f32x4*)(rope + (size_t)(pos * 16 + 4 * fq) * 2); rc0[ai][m] = tp[0]; rc1[ai][m] = tp[1]; } }
#pragma unroll
        for (int ai = 0; ai < 2; ++ai)
#pragma unroll
            for (int m = 0; m < 4; ++m) {
                const int r = row0 + ai * HALF + m * 16;
                const f32x4 cs0 = rc0[ai][m], cs1 = rc1[ai][m];
                const float cs[4] = {cs0[0], cs0[2], cs1[0], cs1[2]}, sn[4] = {cs0[1], cs0[3], cs1[1], cs1[3]};
                bf16_t* rowp = base + (size_t)r * ldc + colt + wc * 32 + 4 * fq;
#pragma unroll
                for (int bj = 0; bj < 2; ++bj) {
                    const f32x4 x0 = acc[ai][bj][m][0], x1 = acc[ai][bj][m][1]; float o0[4], o1[4];
#pragma unroll
                    for (int j = 0; j < 4; ++j) { o0[j] = (x0[j] * cs[j] - x1[j] * sn[j]) * sc; o1[j] = (x1[j] * cs[j] + x0[j] * sn[j]) * sc; }
                    u32x2 w0, w1; w0.x = cvt_pk_bf16(o0[0], o0[1]); w0.y = cvt_pk_bf16(o0[2], o0[3]); w1.x = cvt_pk_bf16(o1[0], o1[1]); w1.y = cvt_pk_bf16(o1[2], o1[3]);
                    *(u32x2*)(rowp + bj * HALF) = w0; *(u32x2*)(rowp + bj * HALF + 16) = w1;
                }
            }
    }
};
template <bool SRC16>
struct EpiResidT {
    static constexpr bool PERM = false;
    const float *xlat, *xctx; xa_t* XA; const float* mod_g;
    __device__ __forceinline__ void operator()(const f32x4 (&acc)[2][2][4][2], const Unit& u, int wr, int wc, int fr, int fq) const {
        const int row0 = u.pm * BM + wr * 64 + fr, col0 = u.pn * BM + wc * 32 + 4 * fq; const bool latent = u.pm < (NL / BM);
        const float* src = latent ? xlat : xctx - (size_t)NL * D; const int j = latent ? (u.pm >> 3) : 16;
        f32x4 gv[2][2];
#pragma unroll
        for (int bj = 0; bj < 2; ++bj)
#pragma unroll
            for (int n = 0; n < 2; ++n) gv[bj][n] = *(const f32x4*)(mod_g + (size_t)j * 6144 + col0 + bj * HALF + n * 16);
#pragma unroll
        for (int ai = 0; ai < 2; ++ai)
#pragma unroll
            for (int mp = 0; mp < 2; ++mp) { f32x4 xs[2][2][2]; v2u xh[2][2][2];
#pragma unroll
                for (int mm = 0; mm < 2; ++mm) { const size_t off = (size_t)(row0 + ai * HALF + (2 * mp + mm) * 16) * D + col0;
#pragma unroll
                    for (int bj = 0; bj < 2; ++bj)
#pragma unroll
                        for (int n = 0; n < 2; ++n) { if constexpr (SRC16) xh[mm][bj][n] = *(const v2u*)(XA + off + bj * HALF + n * 16); else xs[mm][bj][n] = *(const f32x4*)(src + off + bj * HALF + n * 16); } }
                if constexpr (SRC16) asm volatile("" : "+v"(xh[0][0][0]), "+v"(xh[0][0][1]), "+v"(xh[0][1][0]), "+v"(xh[0][1][1]), "+v"(xh[1][0][0]), "+v"(xh[1][0][1]), "+v"(xh[1][1][0]), "+v"(xh[1][1][1]) :: "memory");
                else asm volatile("" : "+v"(xs[0][0][0]), "+v"(xs[0][0][1]), "+v"(xs[0][1][0]), "+v"(xs[0][1][1]), "+v"(xs[1][0][0]), "+v"(xs[1][0][1]), "+v"(xs[1][1][0]), "+v"(xs[1][1][1]) :: "memory");
#pragma unroll
                for (int mm = 0; mm < 2; ++mm) { const size_t off = (size_t)(row0 + ai * HALF + (2 * mp + mm) * 16) * D + col0;
#pragma unroll
                    for (int bj = 0; bj < 2; ++bj)
#pragma unroll
                        for (int n = 0; n < 2; ++n) { const f32x4 xin = SRC16 ? unpack_h4(xh[mm][bj][n]) : xs[mm][bj][n];
                            *(v2u*)(XA + off + bj * HALF + n * 16) = pack_h4(xin + gv[bj][n] * acc[ai][bj][2 * mp + mm][n]); } }
                asm volatile("" ::: "memory"); }
    }
};
struct EpiSwiglu {
    static constexpr bool PERM = true;
    unsigned char* ACT;
    __device__ __forceinline__ void operator()(const f32x4 (&acc)[2][2][4][2], const Unit& u, int wr, int wc, int fr, int fq) const {
        const int row0 = u.pm * BM + wr * 64 + fr, nl = u.pn % (FF / 128), col0 = nl * 128 + wc * 32 + 8 * fq;
        const float sin_ = MOE_FP8 ? F8_INV : 1.f, sout = MOE_FP8 ? F8_ACT : 1.f;
#pragma unroll
        for (int ai = 0; ai < 2; ++ai)
#pragma unroll
            for (int m = 0; m < 4; ++m) { float o[8];
#pragma unroll
                for (int n = 0; n < 2; ++n)
#pragma unroll
                    for (int j = 0; j < 4; ++j) { const float g = acc[ai][0][m][n][j] * sin_, up = acc[ai][1][m][n][j] * sin_; o[n * 4 + j] = g * __builtin_amdgcn_rcpf(1.f + __builtin_amdgcn_exp2f(g * -1.4426950408889634f)) * (up * sout); }
                unsigned char* dst = ACT + ((size_t)(row0 + ai * HALF + m * 16) * FF + col0) * EB;
                if (MOE_FP8) { u32x2 w; w.x = pk4_fp8(o[0], o[1], o[2], o[3]); w.y = pk4_fp8(o[4], o[5], o[6], o[7]); *(u32x2*)dst = w; }
                else { u32x4 w; w.x = cvt_pk_bf16(o[0], o[1]); w.y = cvt_pk_bf16(o[2], o[3]); w.z = cvt_pk_bf16(o[4], o[5]); w.w = cvt_pk_bf16(o[6], o[7]); *(u32x4*)dst = w; } }
    }
};
struct EpiDown {
    static constexpr bool PERM = true;
    bf16_t* YS; const float* rowg;
    __device__ __forceinline__ void operator()(const f32x4 (&acc)[2][2][4][2], const Unit& u, int wr, int wc, int fr, int fq) const {
        const int row0 = u.pm * BM + wr * 64 + fr, col0 = (u.pn & 3) * BM + wc * 32 + 8 * fq;
        float gr[2][4];
#pragma unroll
        for (int ai = 0; ai < 2; ++ai)
#pragma unroll
            for (int m = 0; m < 4; ++m) gr[ai][m] = rowg[row0 + ai * HALF + m * 16];
#pragma unroll
        for (int ai = 0; ai < 2; ++ai)
#pragma unroll
            for (int m = 0; m < 4; ++m) { const int r = row0 + ai * HALF + m * 16; const float g = gr[ai][m] * (MOE_FP8 ? F8_INV : 1.f);
#pragma unroll
                for (int bj = 0; bj < 2; ++bj) { const f32x4 v0 = acc[ai][bj][m][0] * g, v1 = acc[ai][bj][m][1] * g;
                    u32x4 w; w.x = cvt_pk_bf16(v0[0], v0[1]); w.y = cvt_pk_bf16(v0[2], v0[3]); w.z = cvt_pk_bf16(v1[0], v1[1]); w.w = cvt_pk_bf16(v1[2], v1[3]);
                    *(u32x4*)(YS + (size_t)r * D + col0 + bj * HALF) = w; } }
    }
};
struct EpiGlaIn {
    static constexpr bool PERM = true;
    bf16_t* PG;
    __device__ __forceinline__ void operator()(const f32x4 (&acc)[2][2][4][2], const Unit& u, int wr, int wc, int fr, int fq) const {
        const int row0 = u.pm * BM + wr * 64 + fr, col0 = u.pn * BM + wc * 32 + 8 * fq;
#pragma unroll
        for (int ai = 0; ai < 2; ++ai)
#pragma unroll
            for (int m = 0; m < 4; ++m) { const int r = row0 + ai * HALF + m * 16;
#pragma unroll
                for (int bj = 0; bj < 2; ++bj) { const f32x4 v0 = acc[ai][bj][m][0], v1 = acc[ai][bj][m][1];
                    u32x4 w; w.x = cvt_pk_bf16(v0[0], v0[1]); w.y = cvt_pk_bf16(v0[2], v0[3]); w.z = cvt_pk_bf16(v1[0], v1[1]); w.w = cvt_pk_bf16(v1[2], v1[3]);
                    if (col0 + bj * HALF < GIN) *(u32x4*)(PG + (size_t)r * GIN + col0 + bj * HALF) = w; } }
    }
};

typedef int v8i __attribute__((ext_vector_type(8)));
typedef int v4i __attribute__((ext_vector_type(4)));
__device__ __forceinline__ v8i cat8(bf16x8 lo, bf16x8 hi) { return __builtin_shufflevector(__builtin_bit_cast(v4i, lo), __builtin_bit_cast(v4i, hi), 0, 1, 2, 3, 4, 5, 6, 7); }
template <class Epi, class Sched, bool FP8 = false, bool ALIGN_EPI = true, bool GATHER = false>
__device__ __forceinline__ void gemm_phase(PG8_LAS unsigned char* lds, const Gemm g, const Sched& S, const Epi& E, const int tid) {
    const int wid = __builtin_amdgcn_readfirstlane(tid >> 6), lane = tid & 63, wr = wid >> 2, wc = wid & 3, fr = lane & 15, fq = lane >> 4;
    const int KB = g.KB, nt = KB / 128;
    unsigned voffA, voffB; int Rl, Cb;
    { int R, C; stage_rc(tid * 16, R, C); const int Rb = Epi::PERM ? ((R & ~31) + perm32(R & 31)) : R; voffA = (unsigned)(R * KB + C * 2); voffB = (unsigned)(Rb * KB + C * 2); Rl = R; Cb = C * 2; }
    unsigned gA[2][2], gN[2][2]; constexpr int GOFF = STAGE_BYTES;
    const unsigned r64 = 64u * (unsigned)KB;
    const unsigned kstep = 128u;
    const unsigned hstep = (unsigned)(HALF * KB);
    const unsigned tstep = 2u * hstep;
    const __amdgpu_buffer_rsrc_t rsA = __builtin_amdgcn_make_buffer_rsrc(const_cast<void*>(g.A), 0, 0x7fffffff, 0x00020000), rsB = __builtin_amdgcn_make_buffer_rsrc(const_cast<void*>(g.Bt), 0, 0x7fffffff, 0x00020000);
    const unsigned ldsw = (unsigned)wid * 1024u;
    const int aoff = lds_byte(wr * 64 + fr, fq * 8), boff = lds_byte(wc * 32 + fr, fq * 8);
    const int sw8 = (fr * 64 + (fq & 1) * 32) ^ (((fr >> 3) & 1) << 5);
    const int a8off = (wr * 8 + (fq >> 1)) * 1024 + sw8, b8off = (wc * 4 + (fq >> 1)) * 1024 + sw8;
#define PG8_SA(b, h) (((b) * 2 + (h)) * HTB)
#define PG8_SB(b, h) ((4 + (b) * 2 + (h)) * HTB)
#define PG8_STAGE(bufoff, rs, soff, voff) do { _Pragma("unroll") for (int _i = 0; _i < 2; ++_i) \
        __builtin_amdgcn_raw_ptr_buffer_load_lds(rs, (PG8_LAS void*)(lds + (bufoff) + ldsw + _i * 8192), 16, (int)(voff), (int)((soff) + _i * r64), 0, 0); } while (0)
#define PG8_STAGE_A(bufoff, h, soff, kofs, gsel) do { if constexpr (GATHER) { _Pragma("unroll") for (int _i = 0; _i < 2; ++_i) \
        __builtin_amdgcn_raw_ptr_buffer_load_lds(rsA, (PG8_LAS void*)(lds + (bufoff) + ldsw + _i * 8192), 16, (int)(gsel)[h][_i], (int)(kofs), 0, 0); } else PG8_STAGE(bufoff, rsA, soff, voffA); } while (0)
#define PG8_LDA(dst, b, h) do { _Pragma("unroll") for (int m = 0; m < 4; ++m) { if constexpr (FP8) dst##8[m] = cat8(*(const PG8_LAS bf16x8*)(lds + PG8_SA(b, h) + aoff + m * 2048), *(const PG8_LAS bf16x8*)(lds + PG8_SA(b, h) + aoff + m * 2048 + 1024)); \
        else { _Pragma("unroll") for (int k = 0; k < 2; ++k) dst[m][k] = *(const PG8_LAS bf16x8*)(lds + PG8_SA(b, h) + aoff + m * 2048 + k * 1024); } } } while (0)
#define PG8_LDB(dst, b, h) do { _Pragma("unroll") for (int n = 0; n < 2; ++n) { if constexpr (FP8) dst##8[n] = cat8(*(const PG8_LAS bf16x8*)(lds + PG8_SB(b, h) + boff + n * 2048), *(const PG8_LAS bf16x8*)(lds + PG8_SB(b, h) + boff + n * 2048 + 1024)); \
        else { _Pragma("unroll") for (int k = 0; k < 2; ++k) dst[n][k] = *(const PG8_LAS bf16x8*)(lds + PG8_SB(b, h) + boff + n * 2048 + k * 1024); } } } while (0)
#define PG8_MMA8(ai, bj, At, Bt) asm volatile("s_nop 1\n\t" \
        "v_mfma_scale_f32_16x16x128_f8f6f4 %0, %8, %10, %0, %14, %14 op_sel_hi:[0,0,0]\n\t" "v_mfma_scale_f32_16x16x128_f8f6f4 %1, %9, %10, %1, %14, %14 op_sel_hi:[0,0,0]\n\t" \
        "v_mfma_scale_f32_16x16x128_f8f6f4 %2, %8, %11, %2, %14, %14 op_sel_hi:[0,0,0]\n\t" "v_mfma_scale_f32_16x16x128_f8f6f4 %3, %9, %11, %3, %14, %14 op_sel_hi:[0,0,0]\n\t" \
        "v_mfma_scale_f32_16x16x128_f8f6f4 %4, %8, %12, %4, %14, %14 op_sel_hi:[0,0,0]\n\t" "v_mfma_scale_f32_16x16x128_f8f6f4 %5, %9, %12, %5, %14, %14 op_sel_hi:[0,0,0]\n\t" \
        "v_mfma_scale_f32_16x16x128_f8f6f4 %6, %8, %13, %6, %14, %14 op_sel_hi:[0,0,0]\n\t" "v_mfma_scale_f32_16x16x128_f8f6f4 %7, %9, %13, %7, %14, %14 op_sel_hi:[0,0,0]" \
        : "+v"(acc[ai][bj][0][0]), "+v"(acc[ai][bj][0][1]), "+v"(acc[ai][bj][1][0]), "+v"(acc[ai][bj][1][1]), "+v"(acc[ai][bj][2][0]), "+v"(acc[ai][bj][2][1]), "+v"(acc[ai][bj][3][0]), "+v"(acc[ai][bj][3][1]) \
        : "v"(Bt##8[0]), "v"(Bt##8[1]), "v"(At##8[0]), "v"(At##8[1]), "v"(At##8[2]), "v"(At##8[3]), "v"(scl8))
#define PG8_MMA(ai, bj, At, Bt) do { __builtin_amdgcn_s_setprio(1); if constexpr (FP8) { PG8_MMA8(ai, bj, At, Bt); } else { \
        _Pragma("unroll") for (int m = 0; m < 4; ++m) _Pragma("unroll") for (int n = 0; n < 2; ++n) _Pragma("unroll") for (int k = 0; k < 2; ++k) \
        acc[ai][bj][m][n] = __builtin_amdgcn_mfma_f32_16x16x32_bf16(Bt[n][k], At[m][k], acc[ai][bj][m][n], 0, 0, 0); } __builtin_amdgcn_s_setprio(0); } while (0)
#define PG8_WAIT_V(n) asm volatile("s_waitcnt vmcnt(" #n ")" ::: "memory")
#define PG8_WAIT_L(n) asm volatile("s_waitcnt lgkmcnt(" #n ")" ::: "memory")
#define PG8_BAR __builtin_amdgcn_s_barrier()
#define PG8_SCHED __builtin_amdgcn_sched_barrier(0)
    Unit cur, nxt; int ui = 0;
    if (!S.next(0, cur)) return;
    f32x4 acc[2][2][4][2];
#pragma unroll
    for (int a = 0; a < 2; ++a)
#pragma unroll
        for (int b = 0; b < 2; ++b)
#pragma unroll
            for (int m = 0; m < 4; ++m)
#pragma unroll
                for (int n = 0; n < 2; ++n) acc[a][b][m][n] = (f32x4){0.f, 0.f, 0.f, 0.f};
    int scl8 = 0x7f7f7f7f; asm volatile("" : "+v"(scl8));
    bf16x8 At[4][2], B0[2][2], B1[2][2]; v8i At8[4], B08[2], B18[2];
    unsigned cA = (unsigned)cur.pm * tstep, cB = (unsigned)cur.pn * tstep;
    if constexpr (GATHER) {
#pragma unroll
        for (int h = 0; h < 2; ++h)
#pragma unroll
            for (int i = 0; i < 2; ++i) { gA[h][i] = (unsigned)g.gidx[cur.pm * 256 + h * 128 + Rl + 64 * i] * (unsigned)KB + (unsigned)Cb; gN[h][i] = gA[h][i]; } }
    {
        PG8_STAGE(PG8_SB(0, 0), rsB, cB, voffB); PG8_STAGE(PG8_SB(0, 1), rsB, cB + hstep, voffB); PG8_STAGE_A(PG8_SA(0, 0), 0, cA, 0, gA); PG8_STAGE_A(PG8_SA(0, 1), 1, cA + hstep, 0, gA);
        if (wr == 1) PG8_BAR;
        PG8_WAIT_V(2); PG8_BAR;
        PG8_STAGE(PG8_SB(1, 0), rsB, cB + kstep, voffB); PG8_STAGE_A(PG8_SA(1, 0), 0, cA + kstep, kstep, gA); PG8_STAGE(PG8_SB(1, 1), rsB, cB + hstep + kstep, voffB);
        PG8_WAIT_V(6); PG8_BAR;
    }
    for (;;) {
        const bool has_next = S.next(ui + 1, nxt);
        const unsigned nA = has_next ? (unsigned)nxt.pm * tstep : cA, nB = has_next ? (unsigned)nxt.pn * tstep : cB;
        for (int t = 0; t < nt; t += 2) {
            const bool last = (t == nt - 2);
            const unsigned a1 = cA + (unsigned)(t + 1) * kstep;
            const unsigned a2 = last ? nA : cA + (unsigned)(t + 2) * kstep, b2 = last ? nB : cB + (unsigned)(t + 2) * kstep;
            const unsigned a3 = a2 + kstep, b3 = b2 + kstep;
            const unsigned k1 = (unsigned)(t + 1) * kstep, k2 = last ? 0u : (unsigned)(t + 2) * kstep, k3 = k2 + kstep;
            if constexpr (GATHER) {
                if (t == 0 && has_next && wid == 0) __builtin_amdgcn_global_load_lds((const unsigned*)(g.gidx + nxt.pm * 256 + lane * 4), (PG8_LAS unsigned*)(lds + GOFF + ((ui + 1) & 1) * 1024), 16, 0, 0);
                if (last && has_next) {
#pragma unroll
                    for (int h = 0; h < 2; ++h)
#pragma unroll
                        for (int i = 0; i < 2; ++i) gN[h][i] = (unsigned)*(const PG8_LAS int*)(lds + GOFF + ((ui + 1) & 1) * 1024 + (h * 128 + Rl + 64 * i) * 4) * (unsigned)KB + (unsigned)Cb; } }
            unsigned gS[2][2];
#pragma unroll
            for (int h = 0; h < 2; ++h)
#pragma unroll
                for (int i = 0; i < 2; ++i) gS[h][i] = last ? gN[h][i] : gA[h][i];
            PG8_LDB(B0, 0, 0); PG8_LDB(B1, 0, 1); PG8_SCHED; PG8_LDA(At, 0, 0); PG8_STAGE_A(PG8_SA(1, 1), 1, a1 + hstep, k1, gA);
            PG8_WAIT_V(8); PG8_WAIT_L(0); PG8_BAR; PG8_MMA(0, 0, At, B0); PG8_MMA(0, 1, At, B1); PG8_BAR; PG8_SCHED;
            PG8_LDA(At, 0, 1); PG8_STAGE(PG8_SB(0, 0), rsB, b2, voffB); PG8_STAGE(PG8_SB(0, 1), rsB, b2 + hstep, voffB); PG8_STAGE_A(PG8_SA(0, 0), 0, a2, k2, gS);
            PG8_WAIT_V(8); PG8_WAIT_L(0); PG8_BAR; PG8_MMA(1, 0, At, B0); PG8_MMA(1, 1, At, B1); PG8_BAR; PG8_SCHED;
            PG8_LDB(B0, 1, 0); PG8_LDB(B1, 1, 1); PG8_SCHED; PG8_LDA(At, 1, 0); PG8_STAGE_A(PG8_SA(0, 1), 1, a2 + hstep, k2, gS);
            PG8_WAIT_V(8); PG8_WAIT_L(0); PG8_BAR; PG8_MMA(0, 0, At, B0); PG8_MMA(0, 1, At, B1); PG8_BAR; PG8_SCHED;
            PG8_LDA(At, 1, 1); PG8_STAGE(PG8_SB(1, 0), rsB, b3, voffB); PG8_STAGE(PG8_SB(1, 1), rsB, b3 + hstep, voffB); PG8_STAGE_A(PG8_SA(1, 0), 0, a3, k3, gS);
            PG8_WAIT_V(8); PG8_WAIT_L(0); PG8_BAR; PG8_MMA(1, 0, At, B0); PG8_MMA(1, 1, At, B1); PG8_BAR; PG8_SCHED;
        }
        if constexpr (ALIGN_EPI) { if (wr == 0) PG8_BAR; }
        if constexpr (FP8) asm volatile("s_nop 15\n\ts_nop 15" ::: "memory");
        E(acc, cur, wr, wc, fr, fq);
        if (!has_next) break;
#pragma unroll
        for (int a = 0; a < 2; ++a)
#pragma unroll
            for (int b = 0; b < 2; ++b)
#pragma unroll
                for (int m = 0; m < 4; ++m)
#pragma unroll
                    for (int n = 0; n < 2; ++n) acc[a][b][m][n] = (f32x4){0.f, 0.f, 0.f, 0.f};
        cur = nxt; cA = nA; cB = nB; ++ui;
        if constexpr (GATHER) {
#pragma unroll
            for (int h = 0; h < 2; ++h)
#pragma unroll
                for (int i = 0; i < 2; ++i) gA[h][i] = gN[h][i]; }
        if constexpr (ALIGN_EPI) { if (wr == 1) PG8_BAR; }
    }
    PG8_WAIT_V(0);
    if constexpr (!ALIGN_EPI) { if (wr == 0) PG8_BAR; }
    PG8_BAR;
#undef PG8_STAGE_A
#undef PG8_SA
#undef PG8_SB
#undef PG8_STAGE
#undef PG8_LDA
#undef PG8_LDB
#undef PG8_MMA
#undef PG8_WAIT_V
#undef PG8_WAIT_L
#undef PG8_BAR
#undef PG8_SCHED
}
}

#define XB_TMO      128
#define XB_XCNT(j)  (256  + 64 * (j))
#define XB_XSUB(j)  (1280 + 64 * (j))
#define XB_XGEN(j)  (2304 + 64 * (j))
#define XB_TOP      3328
#define XB_TOPGEN   3392
#define XCD_BAR_WORDS 3456
#define XB_SPIN_CAP (1u << 18)
__device__ __forceinline__ unsigned xb_ld(unsigned* p)              { return __hip_atomic_load(p, __ATOMIC_RELAXED, __HIP_MEMORY_SCOPE_AGENT); }
__device__ __forceinline__ unsigned xb_add(unsigned* p, unsigned v) { return __hip_atomic_fetch_add(p, v, __ATOMIC_RELAXED, __HIP_MEMORY_SCOPE_AGENT); }
__device__ __forceinline__ unsigned xb_xcc_id() { return (unsigned)__builtin_amdgcn_s_getreg((3 << 11) | 20) & 0xFu; }
#define XB_SPIN(cond, bar) do { unsigned _sp = 0; while (cond) { __builtin_amdgcn_s_sleep(1); \
    if ((++_sp & 255u) == 0u) { if (xb_ld(&(bar)[XB_TMO])) break; if (_sp > XB_SPIN_CAP) { atomicAdd(&(bar)[XB_TMO], 1u); break; } } } } while (0)
struct XcdBarrier { unsigned* bar; unsigned x; volatile LAS unsigned* st; };
__device__ __forceinline__ XcdBarrier xcd_barrier_post(unsigned* bar, volatile LAS unsigned* st) {
    XcdBarrier b; b.bar = bar; b.x = xb_xcc_id(); b.st = st;
    if (threadIdx.x == 0) (void)xb_add(&bar[XB_XCNT(b.x)], 1u);
    return b;
}
__device__ __forceinline__ void xcd_barrier_complete(unsigned* bar, unsigned x, unsigned& nloc, unsigned& nx) {
    const unsigned G = gridDim.x * gridDim.y * gridDim.z;
    unsigned sum, cnt, mine, sp = 0u;
    for (;;) {
        sum = 0u; cnt = 0u; mine = 0u;
#pragma unroll
        for (unsigned j = 0; j < 16; ++j) { const unsigned c = xb_ld(&bar[XB_XCNT(j)]); sum += c; cnt += (c > 0u) ? 1u : 0u; mine = (j == x) ? c : mine; }
        if (sum == G) break;
        __builtin_amdgcn_s_sleep(1);
        if ((++sp & 255u) == 0u) { if (xb_ld(&bar[XB_TMO])) break; if (sp > XB_SPIN_CAP) { atomicAdd(&bar[XB_TMO], 1u); break; } }
    }
    nloc = mine > 0u ? mine : 1u; nx = cnt > 0u ? cnt : 1u;
}
__device__ __forceinline__ void xcd_barrier(const XcdBarrier& b, const bool thread0) {
    asm volatile("s_waitcnt vmcnt(0)" ::: "memory");
    __syncthreads();
    if (thread0) {
        unsigned* bar = b.bar;
        __builtin_amdgcn_s_waitcnt(0);
        unsigned nloc = b.st[0], nx = b.st[1];
        if (nloc == 0u) { xcd_barrier_complete(bar, b.x, nloc, nx); b.st[0] = nloc; b.st[1] = nx; }
        const unsigned old = xb_add(&bar[XB_XSUB(b.x)], 1u);
        const unsigned gen = old / nloc;
        if (old + 1u == (gen + 1u) * nloc) {
            __builtin_amdgcn_fence(__ATOMIC_RELEASE, "agent");
            asm volatile("s_waitcnt vmcnt(0)" ::: "memory");
            const unsigned og = xb_add(&bar[XB_TOP], 1u);
            const unsigned tg = og / nx;
            if (og + 1u == (tg + 1u) * nx) xb_add(&bar[XB_TOPGEN], 1u);
            else XB_SPIN(xb_ld(&bar[XB_TOPGEN]) == tg, bar);
            __builtin_amdgcn_fence(__ATOMIC_ACQUIRE, "agent");
            xb_add(&bar[XB_XGEN(b.x)], 1u);
            asm volatile("s_waitcnt vmcnt(0)" ::: "memory");
        } else {
            XB_SPIN(xb_ld(&bar[XB_XGEN(b.x)]) == gen, bar);
            __builtin_amdgcn_fence(__ATOMIC_ACQUIRE, "agent");
            asm volatile("s_waitcnt vmcnt(0)" ::: "memory");
        }
    }
    __syncthreads();
}

struct Frame {
    LAS unsigned char* lds;
    int tid, lane, wave, vcu, G;
    unsigned char* ws;
};
#define WSP(T, off) ((T*)(F.ws + (off)))

__device__ __forceinline__ void cvt_item(const float* W, int ldw, int nvalid, int k0, int n0, bf16* WT, int ldt, int drow0, LAS float* scr, int lane) {
    const int c4 = lane & 15, kr = lane >> 4;
    f32x4 v[16];
#pragma unroll
    for (int i = 0; i < 16; ++i) { const int r = 4 * i + kr; v[i] = (4 * c4 < nvalid) ? *(const GAS f32x4*)(W + (size_t)(k0 + r) * ldw + n0 + 4 * c4) : (f32x4){0.f, 0.f, 0.f, 0.f}; }
#pragma unroll
    for (int i = 0; i < 16; ++i) { const int r = 4 * i + kr; LAS float* s = scr + r * 65 + 4 * c4; s[0] = v[i][0]; s[1] = v[i][1]; s[2] = v[i][2]; s[3] = v[i][3]; }
    LDS_WAIT(); asm volatile("" ::: "memory");
    const int c = lane & 7;
#pragma unroll
    for (int j = 0; j < 8; ++j) { const int n = (lane >> 3) + 8 * j; const LAS float* s = scr + (8 * c) * 65 + n;
        v4u o; o.x = pk2(s[0 * 65], s[1 * 65]); o.y = pk2(s[2 * 65], s[3 * 65]); o.z = pk2(s[4 * 65], s[5 * 65]); o.w = pk2(s[6 * 65], s[7 * 65]);
        if (n < nvalid) *(GAS v4u*)(WT + (size_t)(drow0 + n) * ldt + k0 + 8 * c) = o; }
    LDS_WAIT(); asm volatile("" ::: "memory");
}

__device__ __forceinline__ void cvt8_load(const float* W, int ldw, int k0, int n0, f32x4 (&v)[16], int lane) {
    const int c4 = lane & 15, kr = lane >> 4;
#pragma unroll
    for (int i = 0; i < 16; ++i) v[i] = __builtin_nontemporal_load((const GAS f32x4*)(W + (size_t)(k0 + 4 * i + kr) * ldw + n0 + 4 * c4));
}
__device__ __forceinline__ void cvt8_finish(const f32x4 (&v)[16], int k0, unsigned char* WT, int ldt, int drow0, float scale, LAS float* scr, int lane) {
    const int c4 = lane & 15, kr = lane >> 4;
#pragma unroll
    for (int i = 0; i < 16; ++i) { const int r = 4 * i + kr; LAS float* s = scr + r * 65 + 4 * c4; s[0] = v[i][0]; s[1] = v[i][1]; s[2] = v[i][2]; s[3] = v[i][3]; }
    LDS_WAIT(); asm volatile("" ::: "memory");
    const int c = lane & 3;
#pragma unroll
    for (int j = 0; j < 4; ++j) { const int n = (lane >> 2) + 16 * j; const LAS float* s = scr + (16 * c) * 65 + n;
        v4u o;
        o.x = pk4_fp8(s[0 * 65] * scale, s[1 * 65] * scale, s[2 * 65] * scale, s[3 * 65] * scale); o.y = pk4_fp8(s[4 * 65] * scale, s[5 * 65] * scale, s[6 * 65] * scale, s[7 * 65] * scale);
        o.z = pk4_fp8(s[8 * 65] * scale, s[9 * 65] * scale, s[10 * 65] * scale, s[11 * 65] * scale); o.w = pk4_fp8(s[12 * 65] * scale, s[13 * 65] * scale, s[14 * 65] * scale, s[15 * 65] * scale);
        *(GAS v4u*)(WT + (size_t)(drow0 + n) * ldt + k0 + 16 * c) = o; }
    LDS_WAIT(); asm volatile("" ::: "memory");
}
struct ExpItem { const float* W; int ldw, k0, n0, ldt, drow0; unsigned char* WT; };
__device__ __forceinline__ ExpItem exp_item(const P& p, unsigned char* ws, int q, int half) {
    ExpItem e; const int le = q / 1056, rr = q % 1056, mk = rr / 352, ii = rr % 352;
    if (mk < 2) { const int kb2 = ii / 44, nb = ii % 44; e.n0 = 64 * nb; e.k0 = 64 * (2 * kb2 + half); e.W = (mk == 0 ? p.exp_w_gate : p.exp_w_up) + (size_t)le * D * FF; e.ldw = FF; e.ldt = D; e.drow0 = (e.n0 >> 7) * 256 + mk * 128 + (e.n0 & 127); e.WT = ws + WS_WUP + (size_t)le * 5632 * D; }
    else { const int kb2 = ii / 16, nb = ii % 16; e.n0 = 64 * nb; e.k0 = 64 * (2 * kb2 + half); e.W = p.exp_w_down + (size_t)le * FF * D; e.ldw = D; e.ldt = FF; e.drow0 = e.n0; e.WT = ws + WS_WDN + (size_t)le * D * FF; }
    return e;
}
constexpr int NPAIR_ALL = 32 * 1056;
__device__ __forceinline__ void cvt_pairs(const P& p, unsigned char* ws, LAS float* scr, int qfirst, int qstep, int qend, int lane) {
    f32x4 va[16], vb[16]; int q = qfirst;
    if (q < qend) { const ExpItem e = exp_item(p, ws, q, 0); cvt8_load(e.W, e.ldw, e.k0, e.n0, va, lane); }
    while (q < qend) {
        const ExpItem e0 = exp_item(p, ws, q, 0), e1 = exp_item(p, ws, q, 1);
        cvt8_load(e1.W, e1.ldw, e1.k0, e1.n0, vb, lane);
        cvt8_finish(va, e0.k0, e0.WT, e0.ldt, e0.drow0, F8_W, scr, lane);
        const int q2 = q + qstep;
        if (q2 < qend) { const ExpItem e2 = exp_item(p, ws, q2, 0); cvt8_load(e2.W, e2.ldw, e2.k0, e2.n0, va, lane); }
        cvt8_finish(vb, e1.k0, e1.WT, e1.ldt, e1.drow0, F8_W, scr, lane);
        q = q2;
    }
}
#ifndef BG_QKV
#define BG_QKV 2560
#define BG_OUT0 6144
#define BG_UP0 512
#define BG_DN0 4096
#endif
constexpr int CVT_Q3 = NPAIR_ALL - BG_DN0, CVT_Q2 = CVT_Q3 - BG_UP0, CVT_Q1 = CVT_Q2 - BG_OUT0, CVT_SPLIT0 = CVT_Q1 - BG_QKV;
static_assert(CVT_Q2 >= NPAIR_ALL / 2 && CVT_SPLIT0 >= 0, "the slices behind the layer-0 MoE must stay inside layer 1");
#define BG_SLOT(first, qb, qe) do { if (MOE_FP8 && F.G == 256 && (int)blockIdx.x >= (first) && (qb) < (qe)) { __syncthreads(); \
    cvt_pairs(p, F.ws, (LAS float*)(F.lds + F.wave * 16640), (qb) + ((int)blockIdx.x - (first)) * 8 + F.wave, (256 - (first)) * 8, (qe), F.lane); } } while (0)
__device__ __forceinline__ void ph_pro(const P& p, Frame& F, bool do_cvt) {
    float* MOD = WSP(float, WS_MOD); float* ROPE = WSP(float, WS_ROPE);
    if (F.vcu == 255 % F.G) {
        for (int i = F.tid; i < 1024; i += 512) { const int pos = i >> 4, f = i & 15; const float inv = powf(10000.f, -(float)f / 16.f); const float ang = (float)pos * inv; ROPE[2 * i] = cosf(ang); ROPE[2 * i + 1] = sinf(ang); }
    }
    if (F.vcu < 192) {
        LAS float* ssrc = (LAS float*)F.lds; LAS float* red = (LAS float*)(F.lds + 69632);
        for (int i = F.tid; i < 17 * 1024; i += 512) { const int j = i >> 10, k = i & 1023; const float v = (j < 16) ? p.c[j * 1024 + k] : p.c_ctx[k]; ssrc[i] = silu_f(v); }
        __syncthreads();
        for (int u = F.vcu; u < 192; u += F.G) {
            const int l = u / 96, c0 = (u % 96) * 64, col = c0 + (F.tid & 63), ks = F.tid >> 6;
            const float* w = p.ada_w + ((size_t)l * 1024 + ks * 128) * 6144 + col;
            float acc[17];
#pragma unroll
            for (int j = 0; j < 17; ++j) acc[j] = 0.f;
            float wa[8], wb[8];
#define ADA_LD(k0_, buf_) do { _Pragma("unroll") for (int i_ = 0; i_ < 8; ++i_) buf_[i_] = w[(size_t)((k0_) + i_) * 6144]; } while (0)
#define ADA_FMA(k0_, buf_) do { _Pragma("unroll") for (int j = 0; j < 17; ++j) { const f32x4 s0 = *(const LAS f32x4*)(ssrc + j * 1024 + ks * 128 + (k0_)), s1 = *(const LAS f32x4*)(ssrc + j * 1024 + ks * 128 + (k0_) + 4); \
                acc[j] += ((s0[0] * buf_[0] + s0[1] * buf_[1]) + (s0[2] * buf_[2] + s0[3] * buf_[3])) + ((s1[0] * buf_[4] + s1[1] * buf_[5]) + (s1[2] * buf_[6] + s1[3] * buf_[7])); } } while (0)
            ADA_LD(0, wa);
#pragma clang loop unroll(disable)
            for (int k = 0; k < 128; k += 16) {
                ADA_LD(k + 8, wb);
                ADA_FMA(k, wa);
                if (k + 16 < 128) ADA_LD(k + 16, wa);
                ADA_FMA(k + 8, wb);
            }
#undef ADA_LD
#undef ADA_FMA
#pragma unroll
            for (int j = 0; j < 17; ++j) red[(ks * 17 + j) * 64 + (F.tid & 63)] = acc[j];
            __syncthreads();
            for (int i = F.tid; i < 17 * 64; i += 512) { const int j = i >> 6, c = i & 63; float s = p.ada_b[l * 6144 + c0 + c];
#pragma unroll
                for (int q = 0; q < 8; ++q) s += red[(q * 17 + j) * 64 + c];
                MOD[(size_t)(l * 17 + j) * 6144 + c0 + c] = s; }
            __syncthreads();
        }
    }
    if (do_cvt) {
        __syncthreads();
        LAS float* scr = (LAS float*)(F.lds + F.wave * 16640);
        const int gw = F.vcu * NWAVES + F.wave, NGW = F.G * NWAVES;
        constexpr int I_QKV = 16 * 24, I_O = 16 * 16, I_GIN = 16 * 49, I_SMALL = I_QKV + I_O + I_GIN + I_O, I_E = 704, I_LE = 3 * I_E, NITEMS = I_SMALL + 32 * I_LE;
        for (int it = gw; it < I_SMALL; it += NGW) {
            int r = it;
            if (r < I_QKV) { cvt_item(p.attn_w_in, ATT_N, 64, 64 * (r / 24), 64 * (r % 24), WSP(bf16, WS_WQKV), D, 64 * (r % 24), scr, F.lane); continue; } r -= I_QKV;
            if (r < I_O) { cvt_item(p.attn_w_out, D, 64, 64 * (r / 16), 64 * (r % 16), WSP(bf16, WS_WO0), D, 64 * (r % 16), scr, F.lane); continue; } r -= I_O;
            if (r < I_GIN) { const int nb = r % 49; cvt_item(p.gla_w_in, GIN, nb == 48 ? 32 : 64, 64 * (r / 49), 64 * nb, WSP(bf16, WS_WGIN), D, 64 * nb, scr, F.lane); continue; } r -= I_GIN;
            cvt_item(p.gla_w_out, D, 64, 64 * (r / 16), 64 * (r % 16), WSP(bf16, WS_WO1), D, 64 * (r % 16), scr, F.lane);
        }
        constexpr int NEXP = 32 * I_LE;
        if (MOE_FP8) {
            cvt_pairs(p, F.ws, scr, gw, NGW, F.G == 256 ? CVT_SPLIT0 : NPAIR_ALL, F.lane);
        } else {
            for (int r = gw; r < NEXP; r += NGW) {
                const int le = r / I_LE, rr = r % I_LE, mk = rr / I_E, ii = rr % I_E;
                if (mk < 2) { const int kb = ii / 44, nb = ii % 44, n0 = 64 * nb; const float* W = (mk == 0 ? p.exp_w_gate : p.exp_w_up) + (size_t)le * D * FF; const int dr = (n0 >> 7) * 256 + mk * 128 + (n0 & 127);
                    cvt_item(W, FF, 64, 64 * kb, n0, WSP(bf16, WS_WUP) + (size_t)le * 5632 * D, D, dr, scr, F.lane); }
                else { const int kb = ii / 16, nb = ii % 16; cvt_item(p.exp_w_down + (size_t)le * FF * D, D, 64, 64 * kb, 64 * nb, WSP(bf16, WS_WDN) + (size_t)le * D * FF, FF, 64 * nb, scr, F.lane); }
            }
        }
        { v4u* z = (v4u*)(WSP(bf16, WS_WGIN) + (size_t)GIN * D); const int n16 = (GIN_PAD - GIN) * D * 2 / 16;
          for (int i = F.vcu * 512 + F.tid; i < n16; i += F.G * 512) z[i] = (v4u){0u, 0u, 0u, 0u}; }
    }
}

__device__ __forceinline__ void norm_mod_store(const f32x4 (&v)[4], float rstd, const float* g, const float* sh, const float* sc, bf16* orow, int lane) {
    f32x4 gv[4], shv[4], scv[4];
#pragma unroll
    for (int j = 0; j < 4; ++j) { const int c = 4 * (lane + 64 * j); gv[j] = *(const f32x4*)(g + c); shv[j] = *(const f32x4*)(sh + c); scv[j] = *(const f32x4*)(sc + c); }
#pragma unroll
    for (int j = 0; j < 4; ++j) { const int c = 4 * (lane + 64 * j);
        const f32x4 y = (v[j] * rstd * gv[j]) * (scv[j] + 1.f) + shv[j]; v2u o; o.x = pk2(y[0], y[1]); o.y = pk2(y[2], y[3]); *(v2u*)(orow + c) = o; }
}
__device__ __forceinline__ void ph_norm1(const P& p, Frame& F, int l) {
    const float* MOD = WSP(float, WS_MOD); bf16* H = WSP(bf16, WS_H); const float* XA = WSP(float, WS_XA);
    const int gw = F.vcu * NWAVES + F.wave, NGW = F.G * NWAVES; constexpr int RW = 3;
    f32x4 gv[4];
#pragma unroll
    for (int q = 0; q < 4; ++q) gv[q] = *(const f32x4*)(p.norm1_g + l * D + 4 * (F.lane + 64 * q));
    for (int r0 = gw; r0 < NT; r0 += RW * NGW) {
        f32x4 v[RW][4], shv[RW][4], scv[RW][4];
#pragma unroll
        for (int h = 0; h < RW; ++h) { const int r = r0 + h * NGW < NT ? r0 + h * NGW : r0;
            const float* xr = (l == 0) ? (r < NL ? p.x + (size_t)r * D : p.ctx + (size_t)(r - NL) * D) : XA + (size_t)r * D;
            const int j = r < NL ? r / SEQ : 16; const float* mr = MOD + (size_t)(l * 17 + j) * 6144;
#pragma unroll
            for (int q = 0; q < 4; ++q) { const int c = 4 * (F.lane + 64 * q); v[h][q] = *(const f32x4*)(xr + c); shv[h][q] = *(const f32x4*)(mr + c); scv[h][q] = *(const f32x4*)(mr + 1024 + c); } }
#pragma unroll
        for (int h = 0; h < RW; ++h) { const int r = r0 + h * NGW; if (r >= NT) break; float s = 0.f;
#pragma unroll
            for (int q = 0; q < 4; ++q) s += (v[h][q][0] * v[h][q][0] + v[h][q][1] * v[h][q][1]) + (v[h][q][2] * v[h][q][2] + v[h][q][3] * v[h][q][3]);
            const float rstd = 1.f / sqrtf(wave_sum(s) * (1.f / D) + EPS);
            bf16* orow = H + (size_t)r * D;
#pragma unroll
            for (int q = 0; q < 4; ++q) { const f32x4 y = (v[h][q] * rstd * gv[q]) * (scv[h][q] + 1.f) + shv[h][q]; v2u o; o.x = pk2(y[0], y[1]); o.y = pk2(y[2], y[3]); *(v2u*)(orow + 4 * (F.lane + 64 * q)) = o; } }
    }
}
__device__ __forceinline__ void ph_norm2r(const P& p, Frame& F, int l) {
    const float* MOD = WSP(float, WS_MOD); bf16* H = WSP(bf16, WS_H); const xa_t* XA = WSP(xa_t, WS_XA); float* AFF = WSP(float, WS_AFF);
    constexpr int HT = 1028;
    LAS float* rw = (LAS float*)F.lds; LAS float* h2t = (LAS float*)(F.lds + 65536); LAS float* part = (LAS float*)(F.lds + 65536 + 16 * HT * 4);
    for (int i = F.tid; i < D * NE / 4; i += 512) ((LAS f32x4*)rw)[i] = ((const f32x4*)(p.router_w + (size_t)l * D * NE))[i];
    const int ntile = (l == 0 ? NT : NL) / 16, lane = F.lane, w = F.wave;
    const float *g = p.norm2_g + l * D;
    f32x4 v[2][4], gq[4]; v2u vr[2][4];
#pragma unroll
    for (int q = 0; q < 4; ++q) gq[q] = *(const f32x4*)(g + 4 * (lane + 64 * q));
    if (F.vcu < ntile) {
#pragma unroll
        for (int h = 0; h < 2; ++h)
#pragma unroll
            for (int q = 0; q < 4; ++q) vr[h][q] = *(const v2u*)(XA + (size_t)(F.vcu * 16 + 2 * w + h) * D + 4 * (lane + 64 * q)); }
    __syncthreads();
    for (int tile = F.vcu; tile < ntile; tile += F.G) {
        const int r0 = tile * 16;
        f32x4 shq[4], scq[4];
        { const int j = r0 < NL ? r0 / SEQ : 16; const float* mr = MOD + (size_t)(l * 17 + j) * 6144;
#pragma unroll
          for (int q = 0; q < 4; ++q) { shq[q] = *(const f32x4*)(mr + 3072 + 4 * (lane + 64 * q)); scq[q] = *(const f32x4*)(mr + 4096 + 4 * (lane + 64 * q)); } }
#pragma unroll
        for (int h = 0; h < 2; ++h)
#pragma unroll
            for (int q = 0; q < 4; ++q) v[h][q] = unpack_h4(vr[h][q]);
#pragma unroll
        for (int h = 0; h < 2; ++h) { const int r = r0 + 2 * w + h; float s = 0.f;
#pragma unroll
            for (int q = 0; q < 4; ++q) s += (v[h][q][0] * v[h][q][0] + v[h][q][1] * v[h][q][1]) + (v[h][q][2] * v[h][q][2] + v[h][q][3] * v[h][q][3]);
            const float rstd = 1.f / sqrtf(wave_sum(s) * (1.f / D) + EPS);
            bf16* orow = H + (size_t)r * D;
#pragma unroll
            for (int q = 0; q < 4; ++q) { const int c = 4 * (lane + 64 * q); const f32x4 gv = gq[q], shv = shq[q], scv = scq[q];
                const f32x4 y = (v[h][q] * rstd * gv) * (scv + 1.f) + shv;
                if (MOE_FP8) *(unsigned*)(WSP(unsigned char, WS_H8) + (size_t)r * D + c) = pk4_fp8(y[0] * F8_ACT, y[1] * F8_ACT, y[2] * F8_ACT, y[3] * F8_ACT);
                else { v2u o; o.x = pk2(y[0], y[1]); o.y = pk2(y[2], y[3]); *(v2u*)(orow + c) = o; }
                *(LAS f32x4*)(h2t + (2 * w + h) * HT + c) = y; } }
        if (tile + F.G < ntile) {
#pragma unroll
            for (int h = 0; h < 2; ++h)
#pragma unroll
                for (int q = 0; q < 4; ++q) vr[h][q] = *(const v2u*)(XA + (size_t)((tile + F.G) * 16 + 2 * w + h) * D + 4 * (lane + 64 * q)); }
        LDS_SYNC();
        { f32x4 acc = (f32x4){0.f, 0.f, 0.f, 0.f}; const int i16 = lane & 15, kq = lane >> 4;
#pragma unroll 8
          for (int it = 0; it < 32; ++it) { const int k = 128 * w + 4 * it + kq; acc = __builtin_amdgcn_mfma_f32_16x16x4f32(h2t[i16 * HT + k], rw[k * 16 + i16], acc, 0, 0, 0); }
#pragma unroll
          for (int r = 0; r < 4; ++r) part[(w * 16 + 4 * kq + r) * 16 + i16] = acc[r]; }
        LDS_SYNC();
        if (F.tid < 256) { const int i = F.tid >> 4, e = F.tid & 15; float a = 0.f;
#pragma unroll
            for (int w2 = 0; w2 < 8; ++w2) a += part[(w2 * 16 + i) * 16 + e];
            float m = a;
#pragma unroll
            for (int o = 1; o < 16; o <<= 1) m = fmaxf(m, __shfl_xor(m, o));
            const float pe = expf(a - m); float ssum = pe;
#pragma unroll
            for (int o = 1; o < 16; o <<= 1) ssum += __shfl_xor(ssum, o);
            AFF[(size_t)(r0 + i) * 16 + e] = pe / ssum; }
    }
    __syncthreads();
}
__device__ __forceinline__ void ph_topkg(const P& p, Frame& F, int l) {
    const float* AFF = WSP(float, WS_AFF); int* SLOT = WSP(int, WS_SLOT); int* ROWIDX = WSP(int, WS_ROWIDX); float* ROWG = WSP(float, WS_ROWG);
    const bf16* H = WSP(bf16, WS_H); bf16* XG = WSP(bf16, WS_XG);
    LAS int* hist = (LAS int*)F.lds;
    LAS int* sel = hist + 256;
    LAS int* wtot = sel + 256;
    LAS int* shr = wtot + 8;
    const int nunits = l == 0 ? 512 : 256, tid = F.tid, lane = F.lane;
    for (int u = F.vcu; u < nunits; u += F.G) {
        const bool lat = u < 256; const int b = (u & 255) >> 4, e = u & 15;
        const int L = lat ? SEQ : CTX, cap = lat ? CAPL : CAPC, row0 = lat ? b * SEQ : NL + b * CTX, s0 = lat ? b * CAPL : NB * CAPL + b * CAPC;
        unsigned key[4]; const bool act = 4 * tid < L;
#pragma unroll
        for (int q = 0; q < 4; ++q) key[q] = act ? __float_as_uint(AFF[(size_t)(row0 + 4 * tid + q) * 16 + e]) : 0u;
        unsigned prefix = 0u; int kk = cap;
#pragma unroll
        for (int pass = 0; pass < 4; ++pass) { const int shift = 24 - 8 * pass;
            if (tid < 256) hist[tid] = 0;
            LDS_SYNC();
            if (act) {
#pragma unroll
                for (int q = 0; q < 4; ++q) { const bool cand = pass == 0 ? true : ((key[q] >> (shift + 8)) == (prefix >> (shift + 8))); if (cand) __hip_atomic_fetch_add(&hist[(key[q] >> shift) & 255u], 1, __ATOMIC_RELAXED, __HIP_MEMORY_SCOPE_WORKGROUP); } }
            LDS_SYNC();
            if (F.wave == 0) { const int h0 = hist[4 * lane], h1 = hist[4 * lane + 1], h2 = hist[4 * lane + 2], h3 = hist[4 * lane + 3]; const int tot = h0 + h1 + h2 + h3;
                int suf = tot;
#pragma unroll
                for (int o = 1; o < 64; o <<= 1) { const int t = __shfl_down(suf, o); if (lane + o < 64) suf += t; }
                int above = suf - tot;
                if (above < kk && kk <= above + h3) { shr[0] = 4 * lane + 3; shr[1] = above; } above += h3;
                if (above < kk && kk <= above + h2) { shr[0] = 4 * lane + 2; shr[1] = above; } above += h2;
                if (above < kk && kk <= above + h1) { shr[0] = 4 * lane + 1; shr[1] = above; } above += h1;
                if (above < kk && kk <= above + h0) { shr[0] = 4 * lane + 0; shr[1] = above; } }
            LDS_SYNC();
            prefix |= (unsigned)shr[0] << shift; kk -= shr[1];
        }
        const int n_gt = cap - kk;
        int cg = 0, ce = 0;
#pragma unroll
        for (int q = 0; q < 4; ++q) { cg += (act && key[q] > prefix) ? 1 : 0; ce += (act && key[q] == prefix) ? 1 : 0; }
        int pk = cg | (ce << 16), inc = pk;
#pragma unroll
        for (int o = 1; o < 64; o <<= 1) { const int t = __shfl_up(inc, o); if (lane >= o) inc += t; }
        if (lane == 63) wtot[F.wave] = inc;
        LDS_SYNC();
        int base = 0;
#pragma unroll
        for (int w2 = 0; w2 < 8; ++w2) base += (w2 < F.wave) ? wtot[w2] : 0;
        int ex = base + inc - pk; int rg = ex & 0xffff, re = ex >> 16;
        if (act) {
#pragma unroll
            for (int q = 0; q < 4; ++q) { const int row = row0 + 4 * tid + q; int s = -1;
                if (key[q] > prefix) { s = rg; ++rg; } else if (key[q] == prefix) { if (re < kk) s = n_gt + re; ++re; }
                if (s >= 0) { ROWIDX[e * ESLOTS + s0 + s] = row; ROWG[e * ESLOTS + s0 + s] = __uint_as_float(key[q]); sel[s] = row; s += s0; }
                SLOT[(size_t)row * 16 + e] = s; } }
        LDS_SYNC();
    }
}
__device__ __forceinline__ void ph_combine(const P& p, Frame& F, int l) {
    const float* MOD = WSP(float, WS_MOD); bf16* H = WSP(bf16, WS_H); xa_t* XA = WSP(xa_t, WS_XA); const int* SLOT = WSP(int, WS_SLOT); const bf16* YS = WSP(bf16, WS_YS);
    const int gw = F.vcu * NWAVES + F.wave, NGW = F.G * NWAVES; const int nrows = l == 0 ? NT : NL;
    f32x4 gn[4];
#pragma unroll
    for (int q = 0; q < 4; ++q) gn[q] = *(const f32x4*)((l == 0 ? p.norm1_g + D : p.final_norm_g) + 4 * (F.lane + 64 * q));
    for (int r0 = gw; r0 < nrows; r0 += 2 * NGW) {
        int sv[2]; f32x4 v[2][4], acc[2][4];
#pragma unroll
        for (int h = 0; h < 2; ++h) { const int r = r0 + h * NGW; sv[h] = F.lane < 16 ? SLOT[(size_t)r * 16 + F.lane] : -1;
#pragma unroll
            for (int q = 0; q < 4; ++q) { v[h][q] = unpack_h4(*(const v2u*)(XA + (size_t)r * D + 4 * (F.lane + 64 * q))); acc[h][q] = (f32x4){0.f, 0.f, 0.f, 0.f}; } }
        unsigned mk[2]; v2u yv[2][4][4];
#pragma unroll
        for (int h = 0; h < 2; ++h) { mk[h] = (unsigned)(__ballot(sv[h] >= 0) & 0xffffull); unsigned m2 = mk[h];
#pragma unroll
            for (int i = 0; i < 4; ++i) {
                if (m2) { const int e = __builtin_ctz(m2); m2 &= m2 - 1; const int sl = __builtin_amdgcn_readlane(sv[h], e); const bf16* yr = YS + (size_t)(e * ESLOTS + sl) * D;
#pragma unroll
                    for (int q = 0; q < 4; ++q) yv[h][i][q] = *(const v2u*)(yr + 4 * (F.lane + 64 * q)); }
                else {
#pragma unroll
                    for (int q = 0; q < 4; ++q) yv[h][i][q] = (v2u){0u, 0u}; } }
            mk[h] = m2; }
        f32x4 g2v[2][4], shn[2][4], scn[2][4];
#pragma unroll
        for (int h = 0; h < 2; ++h) { const int r = r0 + h * NGW; const int j = r < NL ? r / SEQ : 16; const float* g2 = MOD + (size_t)(l * 17 + j) * 6144 + 5120; const float* m1 = MOD + (size_t)(17 + j) * 6144;
#pragma unroll
            for (int q = 0; q < 4; ++q) { const int c = 4 * (F.lane + 64 * q); g2v[h][q] = *(const f32x4*)(g2 + c); if (l == 0) { shn[h][q] = *(const f32x4*)(m1 + c); scn[h][q] = *(const f32x4*)(m1 + 1024 + c); } } }
#pragma unroll
        for (int h = 0; h < 2; ++h) {
#pragma unroll
            for (int i = 0; i < 4; ++i)
#pragma unroll
                for (int q = 0; q < 4; ++q) { const v2u w = yv[h][i][q]; acc[h][q][0] += __uint_as_float(w.x << 16); acc[h][q][1] += __uint_as_float(w.x & 0xffff0000u); acc[h][q][2] += __uint_as_float(w.y << 16); acc[h][q][3] += __uint_as_float(w.y & 0xffff0000u); }
            unsigned m2 = mk[h];
            while (m2) { const int e = __builtin_ctz(m2); m2 &= m2 - 1; const int sl = __builtin_amdgcn_readlane(sv[h], e); const bf16* yr = YS + (size_t)(e * ESLOTS + sl) * D;
#pragma unroll
                for (int q = 0; q < 4; ++q) { const v2u w = *(const v2u*)(yr + 4 * (F.lane + 64 * q)); acc[h][q][0] += __uint_as_float(w.x << 16); acc[h][q][1] += __uint_as_float(w.x & 0xffff0000u); acc[h][q][2] += __uint_as_float(w.y << 16); acc[h][q][3] += __uint_as_float(w.y & 0xffff0000u); } } }
#pragma unroll
        for (int h = 0; h < 2; ++h) { const int r = r0 + h * NGW;
            xa_t* xr = XA + (size_t)r * D; float s = 0.f;
#pragma unroll
            for (int q = 0; q < 4; ++q) { v[h][q] = v[h][q] + g2v[h][q] * acc[h][q]; s += (v[h][q][0] * v[h][q][0] + v[h][q][1] * v[h][q][1]) + (v[h][q][2] * v[h][q][2] + v[h][q][3] * v[h][q][3]); }
            const float rstd = 1.f / sqrtf(wave_sum(s) * (1.f / D) + EPS);
            if (l == 0) {
#pragma unroll
                for (int q = 0; q < 4; ++q) *(v2u*)(xr + 4 * (F.lane + 64 * q)) = pack_h4(v[h][q]);
                bf16* orow = H + (size_t)r * D;
#pragma unroll
                for (int q = 0; q < 4; ++q) { const f32x4 y = (v[h][q] * rstd * gn[q]) * (scn[h][q] + 1.f) + shn[h][q]; v2u o; o.x = pk2(y[0], y[1]); o.y = pk2(y[2], y[3]); *(v2u*)(orow + 4 * (F.lane + 64 * q)) = o; }
            } else {
                float* orow = p.out + (size_t)r * D;
#pragma unroll
                for (int q = 0; q < 4; ++q) { const int c = 4 * (F.lane + 64 * q); *(f32x4*)(orow + c) = v[h][q] * rstd * gn[q]; }
            } }
    }
}
__device__ __forceinline__ void ph_readout(const P& p, Frame& F) {
    bf16* H = WSP(bf16, WS_H); const bf16* OF = WSP(bf16, WS_OF); const bf16* OB = WSP(bf16, WS_OB); const bf16* PG = WSP(bf16, WS_PG);
    const int gw = F.vcu * NWAVES + F.wave, NGW = F.G * NWAVES;
    f32x4 gnv[4];
#pragma unroll
    for (int q = 0; q < 4; ++q) gnv[q] = *(const f32x4*)(p.gla_norm_g + 4 * (F.lane + 64 * q));
    for (int r0 = gw; r0 < NL; r0 += 2 * NGW) {
        v2u a[2][4], b[2][4], rr[2][4];
#pragma unroll
        for (int h = 0; h < 2; ++h) { const int r = r0 + h * NGW;
#pragma unroll
            for (int q = 0; q < 4; ++q) { const int c = 4 * (F.lane + 64 * q); a[h][q] = *(const v2u*)(OF + (size_t)r * GV + c); b[h][q] = *(const v2u*)(OB + (size_t)r * GV + c); rr[h][q] = *(const v2u*)(PG + (size_t)r * GIN + GQK + c); } }
#pragma unroll
        for (int h = 0; h < 2; ++h) { const int r = r0 + h * NGW;
#pragma unroll
            for (int q = 0; q < 4; ++q) { const int c = 4 * (F.lane + 64 * q);
                f32x4 o; o[0] = __uint_as_float(a[h][q].x << 16) + __uint_as_float(b[h][q].x << 16); o[1] = __uint_as_float(a[h][q].x & 0xffff0000u) + __uint_as_float(b[h][q].x & 0xffff0000u);
                o[2] = __uint_as_float(a[h][q].y << 16) + __uint_as_float(b[h][q].y << 16); o[3] = __uint_as_float(a[h][q].y & 0xffff0000u) + __uint_as_float(b[h][q].y & 0xffff0000u);
                const float ss = wave_sum((o[0] * o[0] + o[1] * o[1]) + (o[2] * o[2] + o[3] * o[3]));
                const float rstd = 1.f / sqrtf(ss * (1.f / GDV) + EPS);
                const f32x4 gv = gnv[q];
                const float q0 = __uint_as_float(rr[h][q].x << 16), q1 = __uint_as_float(rr[h][q].x & 0xffff0000u), q2 = __uint_as_float(rr[h][q].y << 16), q3 = __uint_as_float(rr[h][q].y & 0xffff0000u);
                const float y0 = o[0] * rstd * gv[0] * fsilu(q0), y1 = o[1] * rstd * gv[1] * fsilu(q1), y2 = o[2] * rstd * gv[2] * fsilu(q2), y3 = o[3] * rstd * gv[3] * fsilu(q3);
                v2u w; w.x = pk2(y0, y1); w.y = pk2(y2, y3); *(v2u*)(H + (size_t)r * D + c) = w; } }
    }
}

typedef float f32x16 __attribute__((ext_vector_type(16)));
typedef short s16x4 __attribute__((ext_vector_type(4)));
__device__ __forceinline__ s16x4 lds_tr16(const LAS unsigned char* p) { return __builtin_bit_cast(s16x4, __builtin_amdgcn_ds_read_tr16_b64_v4i16((LAS s16x4*)p)); }
__device__ __forceinline__ int crow(int r, int hi) { return (r & 3) + 8 * (r >> 2) + 4 * hi; }
#define TR_RD(dst, ptr) asm volatile("ds_read_b64_tr_b16 %0, %1" : "=v"(dst) : "v"((unsigned)(uintptr_t)(ptr)) : "memory")
#define TR_WAIT4(a, b, c, d) asm volatile("s_waitcnt lgkmcnt(0)" : "+v"(a), "+v"(b), "+v"(c), "+v"(d) :: "memory")
__device__ __forceinline__ void ph_attn(const P& p, Frame& F) {
    const bf16* Q = WSP(bf16, WS_Q); const bf16* Kb = WSP(bf16, WS_K); const bf16* Vb = WSP(bf16, WS_V); bf16* O = WSP(bf16, WS_O);
    const int lane = F.lane, r32 = lane & 31, hi = lane >> 5, w = F.wave, gq = w >> 1, th = w & 1;
    LAS unsigned char* Ks = F.lds; LAS unsigned char* Vs = F.lds + 3 * 8192;
    const int kl = lane >> 3, chp = lane & 7;
    const int dgrp = (lane >> 4) & 1, qrow = (lane & 15) >> 2, pp = lane & 3;
#define ATT_DEC(u_, lat_, b_, hk_, t0_, qrow0_, jlo_, nt_) do { lat_ = (u_) < 2048; \
        if (lat_) { b_ = (u_) >> 7; hk_ = ((u_) >> 5) & 3; t0_ = 64 * ((u_) & 31); qrow0_ = b_ * SEQ + t0_; } \
        else { const int uc_ = (u_) - 2048; b_ = uc_ >> 4; hk_ = (uc_ >> 2) & 3; t0_ = 64 * (uc_ & 3); qrow0_ = NL + b_ * CTX + t0_; } \
        int jhi_ = -1; jlo_ = 0; \
        if (lat_) { jlo_ = t0_ >= 128 ? 0 : (128 - t0_) / 64; jhi_ = (SEQ - 64 - (t0_ - 128)) / 64; if (jhi_ > 4) jhi_ = 4; } \
        nt_ = 4 + (jhi_ - jlo_ + 1); } while (0)
#define ATT_KROW(b_, t0_, jlo_, it) ((it) < 4 ? NL + (b_) * CTX + 64 * (it) : (b_) * SEQ + (t0_) - 128 + 64 * ((jlo_) + (it) - 4))
#define ATT_DMA(b_, hk_, t0_, jlo_, it, sl) do { const size_t so_ = ((size_t)(ATT_KROW(b_, t0_, jlo_, it) + 8 * w + kl) * 256 + (hk_) * 64) * 2 + (size_t)((chp ^ kl) * 16); \
        __builtin_amdgcn_global_load_lds((const unsigned*)((const char*)Kb + so_), (LAS unsigned*)(Ks + (sl) * 8192 + w * 1024), 16, 0, 0); \
        __builtin_amdgcn_global_load_lds((const unsigned*)((const char*)Vb + so_), (LAS unsigned*)(Vs + (sl) * 8192 + w * 1024), 16, 0, 0); } while (0)
    constexpr int NU = 2048 + 256;
    const float snk0 = p.attn_sink[gq], snk1 = p.attn_sink[4 + gq], snk2 = p.attn_sink[8 + gq], snk3 = p.attn_sink[12 + gq];
    int sc = 0, sn2 = 2;
    bool first = true;
    bf16x8 qr[4], qn[4];
    if (F.vcu < NU) { bool lat; int b, hk, t0, qrow0, jlo, nt; ATT_DEC(F.vcu, lat, b, hk, t0, qrow0, jlo, nt); (void)nt; (void)lat;
#pragma unroll
        for (int d0 = 0; d0 < 4; ++d0) qr[d0] = *(const bf16x8*)(Q + (size_t)(qrow0 + 32 * th + r32) * 1024 + (hk * 4 + gq) * 64 + d0 * 16 + hi * 8);
        ATT_DMA(b, hk, t0, jlo, 0, 0); ATT_DMA(b, hk, t0, jlo, 1, 1); }
    for (int u = F.vcu; u < NU; u += F.G) {
        bool lat; int b, hk, t0, qrow0, jlo, nt; ATT_DEC(u, lat, b, hk, t0, qrow0, jlo, nt);
        const bool has_next = u + F.G < NU;
        bool nlat; int nb, nhk, nt0, nqrow0, njlo, nnt; { const int un = has_next ? u + F.G : u; ATT_DEC(un, nlat, nb, nhk, nt0, nqrow0, njlo, nnt); (void)nnt; (void)nlat; }
        const int hq = hk * 4 + gq; const int qr_row = qrow0 + 32 * th + r32;
#pragma unroll
        for (int d0 = 0; d0 < 4; ++d0) { const bf16* qp = Q + (size_t)(nqrow0 + 32 * th + r32) * 1024 + (nhk * 4 + gq) * 64 + d0 * 16 + hi * 8;
            asm volatile("global_load_dwordx4 %0, %1, off" : "=v"(qn[d0]) : "v"(qp) : "memory"); }
        float m = (hk == 0 ? snk0 : hk == 1 ? snk1 : hk == 2 ? snk2 : snk3) * LOG2E, l = hi == 0 ? 1.f : 0.f;
        f32x16 o[2];
#pragma unroll
        for (int r = 0; r < 16; ++r) { o[0][r] = 0.f; o[1][r] = 0.f; }
#pragma clang loop unroll(disable)
        for (int it = 0; it < nt; ++it) {
            if (it == nt - 1) { if (has_next) asm volatile("s_waitcnt vmcnt(2)" ::: "memory"); else asm volatile("s_waitcnt vmcnt(0)" ::: "memory"); }
            else if (it < 2) { if (first) asm volatile("s_waitcnt vmcnt(6)" ::: "memory"); else asm volatile("s_waitcnt vmcnt(14)" ::: "memory"); }
            else asm volatile("s_waitcnt vmcnt(2)" ::: "memory");
            __builtin_amdgcn_s_barrier(); asm volatile("" ::: "memory");
            if (it + 2 < nt) ATT_DMA(b, hk, t0, jlo, it + 2, sn2);
            else if (has_next) ATT_DMA(nb, nhk, nt0, njlo, it + 2 - nt, sn2);
            const int slot = sc * 8192;
            f32x16 p0, p1;
#pragma unroll
            for (int r = 0; r < 16; ++r) { p0[r] = 0.f; p1[r] = 0.f; }
#pragma unroll
            for (int d0 = 0; d0 < 4; ++d0) {
                const int off = r32 * 128 + (((2 * d0 + hi) ^ (r32 & 7)) * 16);
                const bf16x8 k0 = *(const LAS bf16x8*)(Ks + slot + off), k1 = *(const LAS bf16x8*)(Ks + slot + off + 32 * 128);
                p0 = __builtin_amdgcn_mfma_f32_32x32x16_bf16(k0, qr[d0], p0, 0, 0, 0);
                p1 = __builtin_amdgcn_mfma_f32_32x32x16_bf16(k1, qr[d0], p1, 0, 0, 0);
            }
            s16x4 vt[2][4][2];
#pragma unroll
            for (int dblk = 0; dblk < 2; ++dblk)
#pragma unroll
                for (int ks = 0; ks < 4; ++ks) { const int klo = 16 * ks + 4 * hi + qrow, khi = klo + 8, ch = 4 * dblk + 2 * dgrp + (pp >> 1), bo = (pp & 1) * 8;
                    TR_RD(vt[dblk][ks][0], Vs + slot + klo * 128 + ((ch ^ (klo & 7)) * 16) + bo); TR_RD(vt[dblk][ks][1], Vs + slot + khi * 128 + ((ch ^ (khi & 7)) * 16) + bo); }
            asm volatile("s_nop 7\n\ts_nop 7" : "+v"(p0), "+v"(p1));
            if (it >= 4) { const int j = jlo + it - 4;
                if (j == 0 || j == 4) { const int dq = 32 * th + r32;
                    const int sg = j == 0 ? 1 : -1;
#pragma unroll
                    for (int r = 0; r < 16; ++r) { const int kk = crow(r, hi);
                        p0[r] = sg * (dq - kk) > 0 ? -1e30f : p0[r]; p1[r] = sg * (dq - (kk + 32)) > 0 ? -1e30f : p1[r]; } } }
            float mx = p0[0];
#pragma unroll
            for (int r = 1; r < 16; ++r) mx = fmaxf(mx, p0[r]);
#pragma unroll
            for (int r = 0; r < 16; ++r) mx = fmaxf(mx, p1[r]);
            mx = fmaxf(mx, __shfl_xor(mx, 32));
            const float mn = fmaxf(m, mx);
            if (__any(mn > m)) { const float f = __builtin_amdgcn_exp2f(m - mn); l *= f;
#pragma unroll
                for (int r = 0; r < 16; ++r) { o[0][r] *= f; o[1][r] *= f; }
                m = mn; }
            float ls = 0.f;
#pragma unroll
            for (int r = 0; r < 16; ++r) { p0[r] = __builtin_amdgcn_exp2f(p0[r] - m); p1[r] = __builtin_amdgcn_exp2f(p1[r] - m); ls += p0[r] + p1[r]; }
            l += ls;
            v4u pw[4];
#pragma unroll
            for (int q4 = 0; q4 < 4; ++q4) { pw[0][q4] = pk2(p0[2 * q4], p0[2 * q4 + 1]); pw[1][q4] = pk2(p0[8 + 2 * q4], p0[9 + 2 * q4]); pw[2][q4] = pk2(p1[2 * q4], p1[2 * q4 + 1]); pw[3][q4] = pk2(p1[8 + 2 * q4], p1[9 + 2 * q4]); }
            asm volatile("s_waitcnt lgkmcnt(0)" : "+v"(vt[0][0][0]), "+v"(vt[0][0][1]), "+v"(vt[0][1][0]), "+v"(vt[0][1][1]), "+v"(vt[0][2][0]), "+v"(vt[0][2][1]), "+v"(vt[0][3][0]), "+v"(vt[0][3][1]),
                         "+v"(vt[1][0][0]), "+v"(vt[1][0][1]), "+v"(vt[1][1][0]), "+v"(vt[1][1][1]), "+v"(vt[1][2][0]), "+v"(vt[1][2][1]), "+v"(vt[1][3][0]), "+v"(vt[1][3][1]) :: "memory");
#pragma unroll
            for (int dblk = 0; dblk < 2; ++dblk)
#pragma unroll
                for (int ks = 0; ks < 4; ++ks) { const s16x4 vlo = vt[dblk][ks][0], vhi = vt[dblk][ks][1];
                    const bf16x8 vf = (bf16x8){vlo[0], vlo[1], vlo[2], vlo[3], vhi[0], vhi[1], vhi[2], vhi[3]};
                    o[dblk] = __builtin_amdgcn_mfma_f32_32x32x16_bf16(vf, __builtin_bit_cast(bf16x8, pw[ks]), o[dblk], 0, 0, 0); }
            sc = sc == 2 ? 0 : sc + 1; sn2 = sn2 == 2 ? 0 : sn2 + 1;
        }
#undef ATT_KROW
#undef ATT_DMA
        const float il = 1.f / (l + __shfl_xor(l, 32));
        bf16* orow = O + (size_t)qr_row * 1024 + hq * 64;
#pragma unroll
        for (int dblk = 0; dblk < 2; ++dblk)
#pragma unroll
            for (int rq = 0; rq < 4; ++rq) { v2u wv; wv.x = pk2(o[dblk][4 * rq] * il, o[dblk][4 * rq + 1] * il); wv.y = pk2(o[dblk][4 * rq + 2] * il, o[dblk][4 * rq + 3] * il);
                *(v2u*)(orow + 32 * dblk + 8 * rq + 4 * hi) = wv; }
#pragma unroll
        for (int d0 = 0; d0 < 4; ++d0) qr[d0] = qn[d0];
        first = false;
    }
#undef ATT_DEC
}
__device__ __forceinline__ void ph_attn_naive(const P& p, Frame& F) {
    const bf16* Q = WSP(bf16, WS_Q); const bf16* Kb = WSP(bf16, WS_K); const bf16* Vb = WSP(bf16, WS_V); bf16* O = WSP(bf16, WS_O);
    for (int i = F.vcu * 512 + F.tid; i < NT * NQH; i += F.G * 512) {
        const int r = i >> 4, hq = i & 15, hk = hq >> 2;
        float q[64], acc[64];
#pragma unroll
        for (int d = 0; d < 64; ++d) { q[d] = bf2f(Q[(size_t)r * 1024 + hq * 64 + d]); acc[d] = 0.f; }
        float m = p.attn_sink[hq] * LOG2E, l = 1.f;
        const bool lat = r < NL; const int b = lat ? r / SEQ : (r - NL) / CTX, t = r & (SEQ - 1);
        const int nlat = lat ? (min(SEQ - 1, t + 128) - max(0, t - 128) + 1) : 0, klo = max(0, t - 128);
        for (int kk = 0; kk < CTX + nlat; ++kk) {
            const int kr = kk < CTX ? NL + b * CTX + kk : b * SEQ + klo + (kk - CTX);
            const bf16* kp = Kb + (size_t)kr * 256 + hk * 64; const bf16* vp = Vb + (size_t)kr * 256 + hk * 64;
            float s = 0.f;
#pragma unroll
            for (int d = 0; d < 64; ++d) s += q[d] * bf2f(kp[d]);
            const float mn = fmaxf(m, s), sc = exp2f(m - mn), pe = exp2f(s - mn);
            l = l * sc + pe; m = mn;
#pragma unroll
            for (int d = 0; d < 64; ++d) acc[d] = acc[d] * sc + pe * bf2f(vp[d]);
        }
        const float il = 1.f / l;
#pragma unroll
        for (int d = 0; d < 64; ++d) O[(size_t)r * 1024 + hq * 64 + d] = (bf16)f2bf(acc[d] * il);
    }
}
__device__ __forceinline__ f32x4 mfma16(bf16x8 a, bf16x8 b, f32x4 c) { return __builtin_amdgcn_mfma_f32_16x16x32_bf16(a, b, c, 0, 0, 0); }
__device__ __forceinline__ int gla_rowmap(int b, int dir, int s) { return s < CTX ? NL + b * CTX + (dir ? CTX - 1 - s : s) : b * SEQ + (dir ? SEQ - 1 - (s - CTX) : s - CTX); }
__device__ __forceinline__ void glaprep_unit(const P& p, Frame& F, int uu, const bf16x8 (&lrf)[4], const v2u (&kk4)[2][4], const v2u (&qq4)[2][4], const LAS float* w2s, const LAS float* bs2) {
    bf16* QT = WSP(bf16, WS_QT); bf16* KT = WSP(bf16, WS_KT); float* DEC = WSP(float, WS_DEC);
    const int lane = F.lane, w = F.wave, c16 = lane & 15, g = lane >> 4;
    const int hf = uu & 1, u = uu >> 1, c = u % 36, dir = (u / 36) & 1, b = u / 72;
    const size_t obase = ((size_t)(dir * NB + b) * 2304 + 64 * c) * 512;
#pragma unroll
    for (int ctl = 0; ctl < 2; ++ctl) { const int col0 = 256 * hf + 16 * (2 * w + ctl);
        v4u wp = (v4u){0u, 0u, 0u, 0u};
        if (g < 2) { const LAS float* wsrc = w2s + (dir * 16 + 8 * g) * 512 + col0 + c16;
            wp.x = pk2(wsrc[0], wsrc[512]); wp.y = pk2(wsrc[1024], wsrc[1536]); wp.z = pk2(wsrc[2048], wsrc[2560]); wp.w = pk2(wsrc[3072], wsrc[3584]); }
        const bf16x8 wf = __builtin_bit_cast(bf16x8, wp);
        const f32x4 bias = *(const LAS f32x4*)(bs2 + dir * 512 + col0 + 4 * g);
        f32x4 carry = (f32x4){0.f, 0.f, 0.f, 0.f};
#pragma unroll
        for (int tt = 0; tt < 4; ++tt) {
            const int tok = 16 * tt + c16;
            const v2u kk = kk4[ctl][tt], qq = qq4[ctl][tt];
            const f32x4 z = mfma16(wf, lrf[tt], bias);
            f32x4 ls;
#pragma unroll
            for (int r = 0; r < 4; ++r) ls[r] = (fminf(z[r], 0.f) - flog(1.f + fexp(-fabsf(z[r])))) * (1.f / 16.f);
#pragma unroll
            for (int r = 0; r < 4; ++r) { ls[r] += dpp_shr<1>(ls[r]); ls[r] += dpp_shr<2>(ls[r]); ls[r] += dpp_shr<4>(ls[r]); ls[r] += dpp_shr<8>(ls[r]); }
            f32x4 bs = carry + ls;
#pragma unroll
            for (int r = 0; r < 4; ++r) carry[r] += __shfl(ls[r], 15, 16);
            const float k0 = __uint_as_float(kk.x << 16), k1 = __uint_as_float(kk.x & 0xffff0000u), k2 = __uint_as_float(kk.y << 16), k3 = __uint_as_float(kk.y & 0xffff0000u);
            v2u ko; ko.x = pk2(k0 * fexp(-bs[0]), k1 * fexp(-bs[1])); ko.y = pk2(k2 * fexp(-bs[2]), k3 * fexp(-bs[3]));
            *(v2u*)(KT + obase + (size_t)tok * 512 + col0 + 4 * g) = ko;
            if (c >= 4) { const float q0 = __uint_as_float(qq.x << 16), q1 = __uint_as_float(qq.x & 0xffff0000u), q2 = __uint_as_float(qq.y << 16), q3 = __uint_as_float(qq.y & 0xffff0000u);
                v2u qo; qo.x = pk2(q0 * GLA_QS * fexp(bs[0]), q1 * GLA_QS * fexp(bs[1])); qo.y = pk2(q2 * GLA_QS * fexp(bs[2]), q3 * GLA_QS * fexp(bs[3]));
                *(v2u*)(QT + obase + (size_t)tok * 512 + col0 + 4 * g) = qo; }
        }
        if (c16 == 15) { f32x4 dv; dv[0] = fexp(carry[0]); dv[1] = fexp(carry[1]); dv[2] = fexp(carry[2]); dv[3] = fexp(carry[3]);
            *(f32x4*)(DEC + ((size_t)(dir * NB + b) * 36 + c) * 512 + col0 + 4 * g) = dv; }
    }
}
__device__ __forceinline__ void ph_glaprep(const P& p, Frame& F) {
    const bf16* PG = WSP(bf16, WS_PG);
    const int lane = F.lane, w = F.wave, c16 = lane & 15, g = lane >> 4;
    LAS float* w2s = (LAS float*)F.lds; LAS float* bs2 = w2s + 2 * 16 * 512;
    for (int i = F.tid; i < 2 * 16 * 512 / 4; i += 512) ((LAS f32x4*)w2s)[i] = ((const f32x4*)p.gla_gate_w2)[i];
    for (int i = F.tid; i < 2 * 512 / 4; i += 512) ((LAS f32x4*)bs2)[i] = ((const f32x4*)p.gla_gate_b)[i];
    constexpr int NU = NB * 2 * 36 * 2;
#define PREP_LOAD(uu_, LRF, KK, QQ) do { const int hf_ = (uu_) & 1, u_ = (uu_) >> 1, c_ = u_ % 36, dir_ = (u_ / 36) & 1, b_ = u_ / 72; \
        const int rowA_ = gla_rowmap(b_, dir_, 64 * c_), rstep_ = dir_ ? -1 : 1;         \
        _Pragma("unroll") for (int tt = 0; tt < 4; ++tt) { LRF[tt] = (bf16x8){0, 0, 0, 0, 0, 0, 0, 0}; \
            if (g < 2) LRF[tt] = *(const bf16x8*)(PG + (size_t)(rowA_ + rstep_ * (16 * tt + c16)) * GIN + 3072 + 16 * dir_ + 8 * g); } \
        _Pragma("unroll") for (int ctl = 0; ctl < 2; ++ctl) { const int col0_ = 256 * hf_ + 16 * (2 * w + ctl); \
            _Pragma("unroll") for (int tt = 0; tt < 4; ++tt) { const bf16* pr_ = PG + (size_t)(rowA_ + rstep_ * (16 * tt + c16)) * GIN + col0_ + 4 * g; \
                KK[ctl][tt] = *(const v2u*)(pr_ + GQR); QQ[ctl][tt] = (v2u){0u, 0u}; if (c_ >= 4) QQ[ctl][tt] = *(const v2u*)pr_; } } } while (0)
    bf16x8 lrA[4], lrB[4]; v2u kkA[2][4], qqA[2][4], kkB[2][4], qqB[2][4];
    int uu = F.vcu;
    if (uu < NU) PREP_LOAD(uu, lrA, kkA, qqA);
    LDS_SYNC();
#pragma clang loop unroll(disable)
    for (; uu < NU; uu += 2 * F.G) {
        const bool has1 = uu + F.G < NU, has2 = uu + 2 * F.G < NU;
        if (has1) PREP_LOAD(uu + F.G, lrB, kkB, qqB);
        glaprep_unit(p, F, uu, lrA, kkA, qqA, w2s, bs2);
        if (has1) { if (has2) PREP_LOAD(uu + 2 * F.G, lrA, kkA, qqA);
            glaprep_unit(p, F, uu + F.G, lrB, kkB, qqB, w2s, bs2); }
    }
#undef PREP_LOAD
    __syncthreads();
}
__device__ __forceinline__ void ph_glascan(const P& p, Frame& F) {
    const bf16* PG = WSP(bf16, WS_PG); const bf16* QT = WSP(bf16, WS_QT); const bf16* KT = WSP(bf16, WS_KT); const float* DEC = WSP(float, WS_DEC);
    const int lane = F.lane, w = F.wave, g = lane >> 4, c16 = lane & 15, qrow = c16 >> 2, pp = c16 & 3;
    constexpr int BUF = 49152, QOFF = 0, KOFF = 16384, VOFF = 32768, AM = 98304, DCO = 106496;
    LAS unsigned char* L = F.lds; LAS unsigned char* stg = L + DCO + 1024 + w * 2048;
    for (int u = F.vcu; u < 256; u += F.G) {
        const int dvh = u & 1, dir = (u >> 1) & 1, h = (u >> 2) & 3, b = u >> 4;
        bf16* OUT = WSP(bf16, WS_OF) + (dir ? (size_t)(WS_OB - WS_OF) / 2 : 0);
        const size_t seqbase = (size_t)(dir * NB + b) * 2304;
#define GLA_STAGE(c, bufi) do { _Pragma("unroll") for (int pc = 0; pc < 2; ++pc) { const int piece = w + 8 * pc, row = piece * 4 + g, chs = c16 ^ (row & 15); \
            const size_t srow = seqbase + 64 * (c) + row; const unsigned ldst = (bufi) * BUF + piece * 1024; \
            if ((c) >= 4) __builtin_amdgcn_global_load_lds((const unsigned*)((const char*)(QT + srow * 512 + h * 128) + chs * 16), (LAS unsigned*)(L + QOFF + ldst), 16, 0, 0); \
            __builtin_amdgcn_global_load_lds((const unsigned*)((const char*)(KT + srow * 512 + h * 128) + chs * 16), (LAS unsigned*)(L + KOFF + ldst), 16, 0, 0); \
            __builtin_amdgcn_global_load_lds((const unsigned*)((const char*)(PG + (size_t)gla_rowmap(b, dir, 64 * (c) + row) * GIN + GQR + GQK + h * 256 + dvh * 128) + chs * 16), (LAS unsigned*)(L + VOFF + ldst), 16, 0, 0); } \
            if (w == 0 && lane < 32) __builtin_amdgcn_global_load_lds((const unsigned*)((const char*)(DEC + ((size_t)(dir * NB + b) * 36 + (c)) * 512 + h * 128) + lane * 16), (LAS unsigned*)(L + DCO + (bufi) * 512), 16, 0, 0); } while (0)
        f32x4 S[8];
#pragma unroll
        for (int t = 0; t < 8; ++t) S[t] = (f32x4){0.f, 0.f, 0.f, 0.f};
        GLA_STAGE(0, 0);
        asm volatile("s_waitcnt vmcnt(0)" ::: "memory"); __builtin_amdgcn_s_barrier(); asm volatile("" ::: "memory");
#pragma clang loop unroll(disable)
        for (int c = 0; c < 36; ++c) {
            const int bi = c & 1; LAS unsigned char* Qs = L + bi * BUF + QOFF; LAS unsigned char* Ksm = L + bi * BUF + KOFF; LAS unsigned char* Vsm = L + bi * BUF + VOFF; LAS unsigned char* Am = L + AM;
            if (c + 1 < 36) GLA_STAGE(c + 1, bi ^ 1);
            if (c >= 4) {
#pragma unroll
                for (int q2 = 0; q2 < 2; ++q2) { const int id = 2 * w + q2, ti = id >> 2, tj = id & 3; f32x4 a = (f32x4){0.f, 0.f, 0.f, 0.f};
                    if (tj <= ti) {
#pragma unroll
                        for (int ks = 0; ks < 4; ++ks) { const int co = ((4 * ks + g) ^ c16) * 16;
                            const bf16x8 qa = *(const LAS bf16x8*)(Qs + (16 * ti + c16) * 256 + co), kb = *(const LAS bf16x8*)(Ksm + (16 * tj + c16) * 256 + co);
                            a = mfma16(qa, kb, a); }
                        asm volatile("s_nop 7\n\ts_nop 7" : "+v"(a));
                        if (tj == ti) {
#pragma unroll
                            for (int r = 0; r < 4; ++r) a[r] = c16 > 4 * g + r ? 0.f : a[r]; } }
#pragma unroll
                    for (int r = 0; r < 4; ++r) { const int i = 16 * ti + 4 * g + r; *(LAS bf16*)(Am + i * 128 + (((2 * tj + (c16 >> 3)) ^ (i & 7)) * 16) + (c16 & 7) * 2) = (bf16)f2bf(a[r]); } }
            }
            asm volatile("s_waitcnt lgkmcnt(0)" ::: "memory"); __builtin_amdgcn_s_barrier(); asm volatile("" ::: "memory");
            bf16x8 vf[2];
            { s16x4 t0, t1, t2, t3; const int ch = 2 * w + (pp >> 1), bo = (pp & 1) * 8, rl = 8 * g + qrow;
              TR_RD(t0, Vsm + rl * 256 + ((ch ^ (rl & 15)) * 16) + bo); TR_RD(t1, Vsm + (rl + 4) * 256 + ((ch ^ ((rl + 4) & 15)) * 16) + bo);
              TR_RD(t2, Vsm + (rl + 32) * 256 + ((ch ^ (rl & 15)) * 16) + bo); TR_RD(t3, Vsm + (rl + 36) * 256 + ((ch ^ ((rl + 4) & 15)) * 16) + bo);
              TR_WAIT4(t0, t1, t2, t3);
              vf[0] = (bf16x8){t0[0], t0[1], t0[2], t0[3], t1[0], t1[1], t1[2], t1[3]}; vf[1] = (bf16x8){t2[0], t2[1], t2[2], t2[3], t3[0], t3[1], t3[2], t3[3]}; }
            if (c >= 4) {
                bf16x8 sf[4];
#pragma unroll
                for (int ks = 0; ks < 4; ++ks) { v4u t4; t4.x = pk2(S[2 * ks][0], S[2 * ks][1]); t4.y = pk2(S[2 * ks][2], S[2 * ks][3]); t4.z = pk2(S[2 * ks + 1][0], S[2 * ks + 1][1]); t4.w = pk2(S[2 * ks + 1][2], S[2 * ks + 1][3]); sf[ks] = __builtin_bit_cast(bf16x8, t4); }
#pragma unroll
                for (int tt = 0; tt < 4; ++tt) { f32x4 o = (f32x4){0.f, 0.f, 0.f, 0.f}; const int row = 16 * tt + c16;
#pragma unroll
                    for (int ks = 0; ks < 4; ++ks) { const int ch0 = 4 * ks + (g >> 1), bo = (g & 1) * 8;
                        const s16x4 alo = *(const LAS s16x4*)(Qs + row * 256 + ((ch0 ^ c16) * 16) + bo), ahi = *(const LAS s16x4*)(Qs + row * 256 + (((ch0 + 2) ^ c16) * 16) + bo);
                        o = mfma16((bf16x8){alo[0], alo[1], alo[2], alo[3], ahi[0], ahi[1], ahi[2], ahi[3]}, sf[ks], o); }
#pragma unroll
                    for (int ks2 = 0; ks2 < 2; ++ks2) { const bf16x8 am = *(const LAS bf16x8*)(Am + row * 128 + (((4 * ks2 + g) ^ (row & 7)) * 16)); o = mfma16(am, vf[ks2], o); }
#pragma unroll
                    for (int r = 0; r < 4; ++r) *(LAS bf16*)(stg + (16 * tt + 4 * g + r) * 32 + c16 * 2) = (bf16)f2bf(o[r]); }
#pragma unroll
                for (int pc = 0; pc < 2; ++pc) { const int pi = lane + 64 * pc, tok = pi >> 1; const v4u ov = *(const LAS v4u*)(stg + pi * 16);
                    *(v4u*)(OUT + (size_t)gla_rowmap(b, dir, 64 * c + tok) * GV + h * 256 + dvh * 128 + 16 * w + (pi & 1) * 8) = ov; }
            }
#pragma unroll
            for (int t = 0; t < 8; ++t) { f32x4 acc = S[t];
                { s16x4 t0, t1, t2, t3; const int ch = 2 * t + (pp >> 1), bo = (pp & 1) * 8, rl = 8 * g + qrow;
                  TR_RD(t0, Ksm + rl * 256 + ((ch ^ (rl & 15)) * 16) + bo); TR_RD(t1, Ksm + (rl + 4) * 256 + ((ch ^ ((rl + 4) & 15)) * 16) + bo);
                  TR_RD(t2, Ksm + (rl + 32) * 256 + ((ch ^ (rl & 15)) * 16) + bo); TR_RD(t3, Ksm + (rl + 36) * 256 + ((ch ^ ((rl + 4) & 15)) * 16) + bo);
                  TR_WAIT4(t0, t1, t2, t3);
                  acc = mfma16((bf16x8){t0[0], t0[1], t0[2], t0[3], t1[0], t1[1], t1[2], t1[3]}, vf[0], acc);
                  acc = mfma16((bf16x8){t2[0], t2[1], t2[2], t2[3], t3[0], t3[1], t3[2], t3[3]}, vf[1], acc); }
                const f32x4 d4 = *(const LAS f32x4*)(L + DCO + bi * 512 + (16 * t + 4 * g) * 4);
                S[t] = acc * d4; }
            if (c >= 4) asm volatile("s_waitcnt vmcnt(2) lgkmcnt(0)" ::: "memory"); else asm volatile("s_waitcnt vmcnt(0) lgkmcnt(0)" ::: "memory");
            __builtin_amdgcn_s_barrier(); asm volatile("" ::: "memory");
        }
#undef GLA_STAGE
    }
}
__device__ __forceinline__ void ph_scan_naive(const P& p, Frame& F) {
    const bf16* PG = WSP(bf16, WS_PG);
    LAS float* sq = (LAS float*)F.lds; LAS float* sk = sq + 128; LAS float* sa = sk + 128; LAS float* sv = sa + 128; LAS float* so = sv + 64;
    const int tid = F.tid, e = tid & 63, w = tid >> 6;
    for (int u = F.vcu; u < 512; u += F.G) {
        const int sl = u & 3, dir = (u >> 2) & 1, h = (u >> 3) & 3, b = u >> 5;
        float S[16];
#pragma unroll
        for (int i = 0; i < 16; ++i) S[i] = 0.f;
        bf16* OUT = WSP(bf16, WS_OF) + (dir ? (size_t)(WS_OB - WS_OF) / 2 : 0);
        for (int step = 0; step < CTX + SEQ; ++step) {
            int row; if (step < CTX) row = NL + b * CTX + (dir ? CTX - 1 - step : step); else { const int t = step - CTX; row = b * SEQ + (dir ? SEQ - 1 - t : t); }
            const bf16* pr = PG + (size_t)row * GIN;
            if (tid < 128) { const int col = h * 128 + tid; float z = p.gla_gate_b[dir * 512 + col];
#pragma unroll
                for (int r = 0; r < 16; ++r) z += bf2f(pr[3072 + dir * 16 + r]) * p.gla_gate_w2[(size_t)(dir * 16 + r) * 512 + col];
                const float ls = fminf(z, 0.f) - log1pf(expf(-fabsf(z)));
                sq[tid] = bf2f(pr[col]) * GLA_QS; sk[tid] = bf2f(pr[GQR + col]); sa[tid] = expf(ls * (1.f / 16.f)); }
            else if (tid < 192) sv[tid - 128] = bf2f(pr[GQR + GQK + h * 256 + sl * 64 + tid - 128]);
            __syncthreads();
            const float v = sv[e]; float o = 0.f;
#pragma unroll
            for (int i = 0; i < 16; ++i) { const int d = 16 * w + i; S[i] = sa[d] * S[i] + sk[d] * v; o += sq[d] * S[i]; }
            so[w * 64 + e] = o;
            __syncthreads();
            if (step >= CTX && tid < 64) { float s = 0.f;
#pragma unroll
                for (int q = 0; q < 8; ++q) s += so[q * 64 + tid];
                OUT[(size_t)row * GV + h * 256 + sl * 64 + tid] = (bf16)f2bf(s); }
        }
        __syncthreads();
    }
}

enum Phase { PH_PRO = 0, PH_NORM1_0, PH_QKV, PH_ATTN, PH_OUT0, PH_N2R0, PH_TOPK0, PH_UP0, PH_DN0, PH_COMB0, PH_GLAIN, PH_PREP, PH_SCAN, PH_READ, PH_OUT1, PH_N2R1, PH_TOPK1, PH_UP1, PH_DN1, PH_COMB1, PH_END };

__global__ void __launch_bounds__(NWAVES * 64, 2) k_fwd(P p) {
    extern __shared__ __attribute__((aligned(16))) unsigned char lds[];
    Frame F;
    F.lds = (LAS unsigned char*)lds;
    F.tid = threadIdx.x; F.lane = F.tid & 63; F.wave = __builtin_amdgcn_readfirstlane(F.tid >> 6);
    F.G = gridDim.x; { const int bx = blockIdx.x; F.vcu = (F.G % 8 == 0) ? (bx % 8) * (F.G / 8) + bx / 8 : bx; }
    F.ws = p.ws;
    volatile LAS unsigned* MISC = (volatile LAS unsigned*)(F.lds + MISC_OFF);
    for (int u = F.tid; u < (LDS_BYTES - LDSCTL_OFF) / 4; u += NWAVES * 64) ((LAS unsigned*)(F.lds + LDSCTL_OFF))[u] = 0u;
    __syncthreads();
    const int lo = p.lo, hi = p.hi;
    XcdBarrier bar; bar.bar = (unsigned*)(F.ws + WS_CTL) + CW_BAR; bar.x = 0; bar.st = nullptr;
    if (hi - lo > 1) bar = xcd_barrier_post((unsigned*)(F.ws + WS_CTL) + CW_BAR, MISC + 8);
#define IN(k) (lo <= (k) && (k) < hi)
#define SEAM(k) do { if (IN(k) && IN((k) + 1)) xcd_barrier(bar, F.tid == 0); } while (0)
#define PHASE(k, ...) do { if (IN(k)) { F.lane = (int)__builtin_amdgcn_mbcnt_hi(~0u, __builtin_amdgcn_mbcnt_lo(~0u, 0u)); F.tid = F.wave * 64 + F.lane; __VA_ARGS__; if ((PROBE_MASK >> (k)) & 1) { xcd_barrier(bar, F.tid == 0); __VA_ARGS__; } } SEAM(k); } while (0)
    PHASE(PH_PRO, ph_pro(p, F, (OPT_MASK & 0xff) != 0));
    PHASE(PH_NORM1_0, ph_norm1(p, F, 0));
    PHASE(PH_QKV, {
        pg8::Gemm g{WSP(bf16, WS_H), WSP(bf16, WS_WQKV), D * 2, nullptr}; pg8::TileOrder S; S.init(1, NT / 256, ATT_N / 256, NT / 256, F.G, (int)blockIdx.x);
        pg8::EpiQKV E{WSP(bf16, WS_Q), WSP(bf16, WS_K), WSP(bf16, WS_V), WSP(float, WS_ROPE)};
        pg8::gemm_phase<pg8::EpiQKV, pg8::TileOrder>(F.lds, g, S, E, F.tid);
        BG_SLOT(96, CVT_SPLIT0, CVT_Q1); });
    PHASE(PH_ATTN, { if (OPT_MASK & 256) ph_attn(p, F); else ph_attn_naive(p, F); });
    PHASE(PH_OUT0, {
        pg8::Gemm g{WSP(bf16, WS_O), WSP(bf16, WS_WO0), D * 2, nullptr}; pg8::TileOrder S; S.init(1, NT / 256, D / 256, NT / 256, F.G, (int)blockIdx.x);
        pg8::EpiResidT<false> E{p.x, p.ctx, WSP(xa_t, WS_XA), WSP(float, WS_MOD) + 2048};
        pg8::gemm_phase<pg8::EpiResidT<false>, pg8::TileOrder>(F.lds, g, S, E, F.tid);
        BG_SLOT(64, CVT_Q1, CVT_Q2); });
    PHASE(PH_N2R0, ph_norm2r(p, F, 0));
    PHASE(PH_TOPK0, ph_topkg(p, F, 0));
    PHASE(PH_UP0, {
        pg8::Gemm g{MOE_FP8 ? (const void*)WSP(unsigned char, WS_H8) : (const void*)WSP(bf16, WS_H), WSP(unsigned char, WS_WUP), D * EB, WSP(int, WS_ROWIDX)}; pg8::TileOrder S; S.init(NE, ESLOTS / 256, FF / 128, ESLOTS / 256, F.G, (int)blockIdx.x);
        pg8::EpiSwiglu E{WSP(unsigned char, WS_ACT)};
        pg8::gemm_phase<pg8::EpiSwiglu, pg8::TileOrder, MOE_FP8 != 0, true, true>(F.lds, g, S, E, F.tid);
        BG_SLOT(192, CVT_Q2, CVT_Q3); });
    PHASE(PH_DN0, {
        pg8::Gemm g{WSP(unsigned char, WS_ACT), WSP(unsigned char, WS_WDN), FF * EB, nullptr}; pg8::TileOrder S; S.init(NE, ESLOTS / 256, D / 256, ESLOTS / 256, F.G, (int)blockIdx.x);
        pg8::EpiDown E{WSP(bf16, WS_YS), WSP(float, WS_ROWG)};
        pg8::gemm_phase<pg8::EpiDown, pg8::TileOrder, MOE_FP8 != 0>(F.lds, g, S, E, F.tid);
        BG_SLOT(128, CVT_Q3, NPAIR_ALL); });
    PHASE(PH_COMB0, ph_combine(p, F, 0));
    PHASE(PH_GLAIN, {
        pg8::Gemm g{WSP(bf16, WS_H), WSP(bf16, WS_WGIN), D * 2, nullptr}; pg8::GlaInOrder S{F.G, (int)blockIdx.x};
        pg8::EpiGlaIn E{WSP(bf16, WS_PG)};
        pg8::gemm_phase<pg8::EpiGlaIn, pg8::GlaInOrder>(F.lds, g, S, E, F.tid); });
    PHASE(PH_PREP, { if (OPT_MASK & 512) ph_glaprep(p, F); });
    PHASE(PH_SCAN, { if (OPT_MASK & 512) ph_glascan(p, F); else ph_scan_naive(p, F); });
    PHASE(PH_READ, ph_readout(p, F));
    PHASE(PH_OUT1, {
        pg8::Gemm g{WSP(bf16, WS_H), WSP(bf16, WS_WO1), D * 2, nullptr}; pg8::TileOrder S; S.init(1, NL / 256, D / 256, NL / 256, F.G, (int)blockIdx.x);
        pg8::EpiResidT<true> E{nullptr, nullptr, WSP(xa_t, WS_XA), WSP(float, WS_MOD) + 17 * 6144 + 2048};
        pg8::gemm_phase<pg8::EpiResidT<true>, pg8::TileOrder>(F.lds, g, S, E, F.tid); });
    PHASE(PH_N2R1, ph_norm2r(p, F, 1));
    PHASE(PH_TOPK1, ph_topkg(p, F, 1));
    PHASE(PH_UP1, {
        pg8::Gemm g{MOE_FP8 ? (const void*)WSP(unsigned char, WS_H8) : (const void*)WSP(bf16, WS_H), WSP(unsigned char, WS_WUP) + (size_t)NE * 5632 * D * EB, D * EB, WSP(int, WS_ROWIDX)}; pg8::TileOrder S; S.init(NE, NB * CAPL / 256, FF / 128, ESLOTS / 256, F.G, (int)blockIdx.x);
        pg8::EpiSwiglu E{WSP(unsigned char, WS_ACT)};
        pg8::gemm_phase<pg8::EpiSwiglu, pg8::TileOrder, MOE_FP8 != 0, true, true>(F.lds, g, S, E, F.tid); });
    PHASE(PH_DN1, {
        pg8::Gemm g{WSP(unsigned char, WS_ACT), WSP(unsigned char, WS_WDN) + (size_t)NE * D * FF * EB, FF * EB, nullptr}; pg8::TileOrder S; S.init(NE, NB * CAPL / 256, D / 256, ESLOTS / 256, F.G, (int)blockIdx.x);
        pg8::EpiDown E{WSP(bf16, WS_YS), WSP(float, WS_ROWG)};
        pg8::gemm_phase<pg8::EpiDown, pg8::TileOrder, MOE_FP8 != 0>(F.lds, g, S, E, F.tid); });
    PHASE(PH_COMB1, ph_combine(p, F, 1));
#undef PHASE
#undef IN
#undef SEAM
}

__global__ void __launch_bounds__(256) n_gemm(const bf16* A, int lda, const float* W, int ldw, float* C, int ldc, int M, int N, int K) {
    __shared__ float As[16][65], Bs[16][64];
    const int t = threadIdx.x, tx = t & 15, ty = t >> 4, m0 = blockIdx.y * 64, n0 = blockIdx.x * 64;
    float acc[4][4];
#pragma unroll
    for (int i = 0; i < 4; ++i)
#pragma unroll
        for (int j = 0; j < 4; ++j) acc[i][j] = 0.f;
    for (int k0 = 0; k0 < K; k0 += 16) {
        { const int r = t >> 2, kq = (t & 3) * 4; const v2u w = *(const v2u*)(A + (size_t)(m0 + r) * lda + k0 + kq);
          As[kq + 0][r] = __uint_as_float(w.x << 16); As[kq + 1][r] = __uint_as_float(w.x & 0xffff0000u); As[kq + 2][r] = __uint_as_float(w.y << 16); As[kq + 3][r] = __uint_as_float(w.y & 0xffff0000u); }
        { const int k = t >> 4, n = (t & 15) * 4;
#pragma unroll
          for (int j = 0; j < 4; ++j) Bs[k][n + j] = (n0 + n + j < N) ? W[(size_t)(k0 + k) * ldw + n0 + n + j] : 0.f; }
        __syncthreads();
#pragma unroll
        for (int kk = 0; kk < 16; ++kk) { float a[4], b[4];
#pragma unroll
            for (int i = 0; i < 4; ++i) { a[i] = As[kk][ty * 4 + i]; b[i] = Bs[kk][tx * 4 + i]; }
#pragma unroll
            for (int i = 0; i < 4; ++i)
#pragma unroll
                for (int j = 0; j < 4; ++j) acc[i][j] += a[i] * b[j]; }
        __syncthreads();
    }
#pragma unroll
    for (int i = 0; i < 4; ++i)
#pragma unroll
        for (int j = 0; j < 4; ++j) if (n0 + tx * 4 + j < N) C[(size_t)(m0 + ty * 4 + i) * ldc + n0 + tx * 4 + j] = acc[i][j];
}
__global__ void n_post_qkv(const float* T, int r0, int rows, bf16* Q, bf16* Kb, bf16* Vb) {
    const size_t i = (size_t)blockIdx.x * blockDim.x + threadIdx.x; if (i >= (size_t)rows * ATT_N) return;
    const int rl = (int)(i / ATT_N), c = (int)(i % ATT_N), r = r0 + rl; float val = T[i];
    if (c < 1280 && r < NL) { const int d = c & 63, a = d >> 5, s = (d >> 4) & 1, f = d & 15, t = r & (SEQ - 1); const float xp = T[(size_t)rl * ATT_N + (s ? c - 16 : c + 16)];
        const float inv = powf(10000.f, -(float)f / 16.f), ang = (float)(a ? (t & 63) : (t >> 6)) * inv, cs = cosf(ang), sn = sinf(ang);
        val = s == 0 ? val * cs - xp * sn : val * cs + xp * sn; }
    if (c < 1024) Q[(size_t)r * 1024 + c] = (bf16)f2bf(val * QSCALE); else if (c < 1280) Kb[(size_t)r * 256 + c - 1024] = (bf16)f2bf(val); else Vb[(size_t)r * 256 + c - 1280] = (bf16)f2bf(val);
}
__global__ void n_post_resid(const float* T, int r0, int rows, const float* xlat, const float* xctx, float* XA, const float* mod_g) {
    const size_t i = (size_t)blockIdx.x * blockDim.x + threadIdx.x; if (i >= (size_t)rows * D) return;
    const int rl = (int)(i / D), c = (int)(i % D), r = r0 + rl; const int j = r < NL ? r / SEQ : 16;
    const float xs = r < NL ? xlat[(size_t)r * D + c] : xctx[(size_t)(r - NL) * D + c];
    XA[(size_t)r * D + c] = xs + mod_g[(size_t)j * 6144 + c] * T[i];
}
__global__ void n_post_swiglu(const float* T, int rows, bf16* ACTrow0) {
    const size_t i = (size_t)blockIdx.x * blockDim.x + threadIdx.x; if (i >= (size_t)rows * FF) return;
    const int rl = (int)(i / FF), f = (int)(i % FF); const float g = T[(size_t)rl * 5632 + f], u = T[(size_t)rl * 5632 + FF + f];
    ACTrow0[(size_t)rl * FF + f] = (bf16)f2bf(silu_f(g) * u);
}
__global__ void n_post_down(const float* T, int rows, bf16* YSrow0, const float* rowg0) {
    const size_t i = (size_t)blockIdx.x * blockDim.x + threadIdx.x; if (i >= (size_t)rows * D) return;
    const int rl = (int)(i / D); YSrow0[i] = (bf16)f2bf(rowg0[rl] * T[i]);
}
__global__ void n_post_cast(const float* T, size_t n, bf16* O) { const size_t i = (size_t)blockIdx.x * blockDim.x + threadIdx.x; if (i < n) O[i] = (bf16)f2bf(T[i]); }
__global__ void __launch_bounds__(256) n_attn(const bf16* Q, const bf16* Kb, const bf16* Vb, const float* sink, bf16* O) {
    const int i = blockIdx.x * blockDim.x + threadIdx.x; if (i >= NT * NQH) return;
    const int r = i >> 4, hq = i & 15, hk = hq >> 2;
    float q[64], acc[64];
#pragma unroll
    for (int d = 0; d < 64; ++d) { q[d] = bf2f(Q[(size_t)r * 1024 + hq * 64 + d]); acc[d] = 0.f; }
    float m = sink[hq] * LOG2E, l = 1.f;
    const bool lat = r < NL; const int b = lat ? r / SEQ : (r - NL) / CTX, t = r & (SEQ - 1);
    const int nlat = lat ? (min(SEQ - 1, t + 128) - max(0, t - 128) + 1) : 0, klo = max(0, t - 128);
    for (int kk = 0; kk < CTX + nlat; ++kk) {
        const int kr = kk < CTX ? NL + b * CTX + kk : b * SEQ + klo + (kk - CTX);
        const bf16* kp = Kb + (size_t)kr * 256 + hk * 64; const bf16* vp = Vb + (size_t)kr * 256 + hk * 64;
        float s = 0.f;
#pragma unroll
        for (int d = 0; d < 64; ++d) s += q[d] * bf2f(kp[d]);
        const float mn = fmaxf(m, s), sc = exp2f(m - mn), pe = exp2f(s - mn);
        l = l * sc + pe; m = mn;
#pragma unroll
        for (int d = 0; d < 64; ++d) acc[d] = acc[d] * sc + pe * bf2f(vp[d]);
    }
    const float il = 1.f / l;
#pragma unroll
    for (int d = 0; d < 64; ++d) O[(size_t)r * 1024 + hq * 64 + d] = (bf16)f2bf(acc[d] * il);
}
__global__ void __launch_bounds__(512) n_glascan(const bf16* PG, const float* w2, const float* gb, bf16* OF, bf16* OB) {
    const int u = blockIdx.x, sl = u & 3, dir = (u >> 2) & 1, h = (u >> 3) & 3, b = u >> 5;
    __shared__ float sq[128], sk[128], sa[128], sv[64], so[8][64];
    const int tid = threadIdx.x, e = tid & 63, w = tid >> 6;
    float S[16];
#pragma unroll
    for (int i = 0; i < 16; ++i) S[i] = 0.f;
    bf16* OUT = dir ? OB : OF;
    for (int step = 0; step < CTX + SEQ; ++step) {
        int row; if (step < CTX) row = NL + b * CTX + (dir ? CTX - 1 - step : step); else { const int t = step - CTX; row = b * SEQ + (dir ? SEQ - 1 - t : t); }
        const bf16* pr = PG + (size_t)row * GIN;
        if (tid < 128) { const int col = h * 128 + tid; float z = gb[dir * 512 + col];
#pragma unroll
            for (int r = 0; r < 16; ++r) z += bf2f(pr[3072 + dir * 16 + r]) * w2[(size_t)(dir * 16 + r) * 512 + col];
            const float ls = fminf(z, 0.f) - log1pf(expf(-fabsf(z)));
            sq[tid] = bf2f(pr[col]) * GLA_QS; sk[tid] = bf2f(pr[GQR + col]); sa[tid] = expf(ls * (1.f / 16.f)); }
        else if (tid < 192) sv[tid - 128] = bf2f(pr[GQR + GQK + h * 256 + sl * 64 + tid - 128]);
        __syncthreads();
        const float v = sv[e]; float o = 0.f;
#pragma unroll
        for (int i = 0; i < 16; ++i) { const int d = 16 * w + i; S[i] = sa[d] * S[i] + sk[d] * v; o += sq[d] * S[i]; }
        so[w][e] = o;
        __syncthreads();
        if (step >= CTX && tid < 64) { float s = 0.f;
#pragma unroll
            for (int q = 0; q < 8; ++q) s += so[q][tid];
            OUT[(size_t)row * GV + h * 256 + sl * 64 + tid] = (bf16)f2bf(s); }
    }
}

static void launch_phase(P p, int lo, int hi, int grid, hipStream_t stream) { p.lo = lo; p.hi = hi; hipLaunchKernelGGL(k_fwd, dim3(grid), dim3(NWAVES * 64), LDS_BYTES, stream, p); }
static void naive_gemm(const bf16* A, int lda, const float* W, int ldw, float* C, int ldc, int M, int N, int K, hipStream_t s) {
    hipLaunchKernelGGL(n_gemm, dim3((N + 63) / 64, M / 64), dim3(256), 0, s, A, lda, W, ldw, C, ldc, M, N, K);
}
#define EW_GRID(n) dim3((unsigned)(((size_t)(n) + 255) / 256)), dim3(256), 0, stream

extern "C" void kernel_launch(void* const* d_in, const int* in_sizes, int n_in, void* d_out, int out_size, void* d_ws, size_t ws_size, hipStream_t stream) {
    static int grid = 0;
    if (grid == 0) {
        if (n_in != 21 || out_size != NL * D || ws_size < WS_END) { fprintf(stderr, "kernel_launch: unexpected shapes (n_in %d out %d ws %zu need %zu)\n", n_in, out_size, ws_size, (size_t)WS_END); grid = -1; return; }
        int dev = 0, cus = 0;
        if (hipGetDevice(&dev) != hipSuccess || hipDeviceGetAttribute(&cus, hipDeviceAttributeMultiprocessorCount, dev) != hipSuccess) { grid = -1; return; }
        if (hipFuncSetAttribute((const void*)k_fwd, hipFuncAttributeMaxDynamicSharedMemorySize, LDS_BYTES) != hipSuccess) { fprintf(stderr, "kernel_launch: hipFuncSetAttribute failed\n"); grid = -1; return; }
        int per_cu = 0;
        if (hipOccupancyMaxActiveBlocksPerMultiprocessor(&per_cu, (const void*)k_fwd, NWAVES * 64, LDS_BYTES) != hipSuccess || per_cu < 1) fprintf(stderr, "kernel_launch: occupancy query says %d\n", per_cu);
        (void)hipGetLastError();
        grid = cus;
    }
    if (grid < 0) return;
    hipMemsetAsync((char*)d_ws + WS_CTL, 0, CTL_ZERO_BYTES, stream);
    P p{};
    const float** pp = (const float**)&p;
    for (int i = 0; i < 21; ++i) pp[i] = (const float*)d_in[i];
    p.out = (float*)d_out; p.ws = (unsigned char*)d_ws; p.lo = 0; p.hi = 0;
    unsigned char* ws = (unsigned char*)d_ws;
#define WS(T, off) ((T*)(ws + (off)))
#if ONE_LAUNCH
    launch_phase(p, 0, PH_END, grid, stream);
#else
    float* TMP = WS(float, WS_TMP);
    launch_phase(p, PH_PRO, PH_PRO + 1, grid, stream);
    launch_phase(p, PH_NORM1_0, PH_NORM1_0 + 1, grid, stream);
    if (OPT_MASK & 1) launch_phase(p, PH_QKV, PH_QKV + 1, grid, stream);
    else for (int ch = 0; ch < NT / 2048; ++ch) { const int r0 = ch * 2048;
        naive_gemm(WS(bf16, WS_H) + (size_t)r0 * D, D, p.attn_w_in, ATT_N, TMP, ATT_N, 2048, ATT_N, D, stream);
        hipLaunchKernelGGL(n_post_qkv, EW_GRID((size_t)2048 * ATT_N), TMP, r0, 2048, WS(bf16, WS_Q), WS(bf16, WS_K), WS(bf16, WS_V)); }
    if (OPT_MASK & 256) launch_phase(p, PH_ATTN, PH_ATTN + 1, grid, stream);
    else hipLaunchKernelGGL(n_attn, dim3(NT * NQH / 256), dim3(256), 0, stream, WS(bf16, WS_Q), WS(bf16, WS_K), WS(bf16, WS_V), p.attn_sink, WS(bf16, WS_O));
    if (OPT_MASK & 2) launch_phase(p, PH_OUT0, PH_OUT0 + 1, grid, stream);
    else for (int ch = 0; ch < NT / 2048; ++ch) { const int r0 = ch * 2048;
        naive_gemm(WS(bf16, WS_O) + (size_t)r0 * D, D, p.attn_w_out, D, TMP, D, 2048, D, D, stream);
        hipLaunchKernelGGL(n_post_resid, EW_GRID((size_t)2048 * D), TMP, r0, 2048, p.x, p.ctx, WS(float, WS_XA), WS(float, WS_MOD) + 2048); }
    launch_phase(p, PH_N2R0, PH_N2R0 + 1, grid, stream);
    launch_phase(p, PH_TOPK0, PH_TOPK0 + 1, grid, stream);
    for (int l = 0; l < 2; ++l) {
        if (l == 1) {
            if (OPT_MASK & 16) launch_phase(p, PH_GLAIN, PH_GLAIN + 1, grid, stream);
            else for (int ch = 0; ch < NT / 2048; ++ch) { const int r0 = ch * 2048;
                naive_gemm(WS(bf16, WS_H) + (size_t)r0 * D, D, p.gla_w_in, GIN, TMP, GIN, 2048, GIN, D, stream);
                hipLaunchKernelGGL(n_post_cast, EW_GRID((size_t)2048 * GIN), TMP, (size_t)2048 * GIN, WS(bf16, WS_PG) + (size_t)r0 * GIN); }
            if (OPT_MASK & 512) launch_phase(p, PH_SCAN, PH_SCAN + 1, grid, stream);
            else hipLaunchKernelGGL(n_glascan, dim3(512), dim3(512), 0, stream, WS(bf16, WS_PG), p.gla_gate_w2, p.gla_gate_b, WS(bf16, WS_OF), WS(bf16, WS_OB));
            launch_phase(p, PH_READ, PH_READ + 1, grid, stream);
            if (OPT_MASK & 32) launch_phase(p, PH_OUT1, PH_OUT1 + 1, grid, stream);
            else for (int ch = 0; ch < NL / 2048; ++ch) { const int r0 = ch * 2048;
                naive_gemm(WS(bf16, WS_H) + (size_t)r0 * D, D, p.gla_w_out, D, TMP, D, 2048, D, D, stream);
                hipLaunchKernelGGL(n_post_resid, EW_GRID((size_t)2048 * D), TMP, r0, 2048, WS(float, WS_XA), WS(float, WS_XA), WS(float, WS_XA), WS(float, WS_MOD) + 17 * 6144 + 2048); }
            launch_phase(p, PH_N2R1, PH_N2R1 + 1, grid, stream);
            launch_phase(p, PH_TOPK1, PH_TOPK1 + 1, grid, stream);
        }
        const int rows_e = l == 0 ? ESLOTS : NB * CAPL, chunk = l == 0 ? 2304 : 2048;
        const bool up_opt = OPT_MASK & (l == 0 ? 4 : 64), dn_opt = OPT_MASK & (l == 0 ? 8 : 128);
        if (up_opt && dn_opt) { launch_phase(p, l == 0 ? PH_UP0 : PH_UP1, (l == 0 ? PH_UP0 : PH_UP1) + 1, grid, stream); launch_phase(p, l == 0 ? PH_DN0 : PH_DN1, (l == 0 ? PH_DN0 : PH_DN1) + 1, grid, stream); }
        else {
            if (up_opt) launch_phase(p, l == 0 ? PH_UP0 : PH_UP1, (l == 0 ? PH_UP0 : PH_UP1) + 1, grid, stream);
            else for (int e = 0; e < NE; ++e) for (int r0 = 0; r0 < rows_e; r0 += chunk) {
                const size_t row = (size_t)e * ESLOTS + r0; const size_t le = (size_t)(l * NE + e);
                naive_gemm(WS(bf16, WS_XG) + row * D, D, p.exp_w_gate + le * D * FF, FF, TMP, 5632, chunk, FF, D, stream);
                naive_gemm(WS(bf16, WS_XG) + row * D, D, p.exp_w_up + le * D * FF, FF, TMP + FF, 5632, chunk, FF, D, stream);
                hipLaunchKernelGGL(n_post_swiglu, EW_GRID((size_t)chunk * FF), TMP, chunk, WS(bf16, WS_ACT) + row * FF); }
            if (dn_opt) launch_phase(p, l == 0 ? PH_DN0 : PH_DN1, (l == 0 ? PH_DN0 : PH_DN1) + 1, grid, stream);
            else for (int e = 0; e < NE; ++e) for (int r0 = 0; r0 < rows_e; r0 += chunk) {
                const size_t row = (size_t)e * ESLOTS + r0; const size_t le = (size_t)(l * NE + e);
                naive_gemm(WS(bf16, WS_ACT) + row * FF, FF, p.exp_w_down + le * FF * D, D, TMP, D, chunk, D, FF, stream);
                hipLaunchKernelGGL(n_post_down, EW_GRID((size_t)chunk * D), TMP, chunk, WS(bf16, WS_YS) + row * D, WS(float, WS_ROWG) + row); }
        }
        launch_phase(p, l == 0 ? PH_COMB0 : PH_COMB1, (l == 0 ? PH_COMB0 : PH_COMB1) + 1, grid, stream);
    }
#endif
}
```

```cpp
#include <hip/hip_runtime.h>
#include <cstdio>
#include <cstdint>

#ifndef OPT_MASK
#define OPT_MASK 0x3FF
#endif
#ifndef MOE_FP8
#define MOE_FP8 1
#endif
#ifndef PROBE_MASK
#define PROBE_MASK 0
#endif
#ifndef ONE_LAUNCH
#define ONE_LAUNCH 1
#endif

#define GAS __attribute__((address_space(1)))
#define LAS __attribute__((address_space(3)))
typedef unsigned short bf16;
typedef unsigned v4u __attribute__((ext_vector_type(4)));
typedef unsigned v2u __attribute__((ext_vector_type(2)));
typedef float f32x4 __attribute__((ext_vector_type(4)));
typedef float f32x2 __attribute__((ext_vector_type(2)));
typedef short bf16x8 __attribute__((ext_vector_type(8)));

constexpr int D = 1024, NB = 16, SEQ = 2048, CTX = 256;
constexpr int NL = NB * SEQ, NC = NB * CTX, NT = NL + NC;
constexpr int NQH = 16, NKV = 4, HD = 64, ATT_N = 1536;
constexpr int GH = 4, GDK = 128, GDV = 256, GQK = 512, GV = 1024, GQR = 1536, GIN = 3104, GIN_PAD = 3328;
constexpr int NE = 16, FF = 2816, CAPL = 256, CAPC = 32, ESLOTS = NB * CAPL + NB * CAPC;
constexpr float EPS = 1e-6f;
constexpr float LOG2E = 1.4426950408889634f;
constexpr float QSCALE = 0.125f * LOG2E;
constexpr float GLA_QS = 0.08838834764831845f;
constexpr int EB = MOE_FP8 ? 1 : 2;
constexpr float F8_ACT = 16.f, F8_W = 256.f, F8_INV = 1.f / (16.f * 256.f);

constexpr size_t MiB = 1ull << 20;
constexpr size_t WS_CTL = 0, CTL_ZERO_BYTES = 1 * MiB;
constexpr size_t WS_MOD = 1 * MiB;
constexpr size_t WS_ROPE = WS_MOD + 896 * 1024;
constexpr size_t WS_WQKV = 2 * MiB;
constexpr size_t WS_WO0 = 5 * MiB;
constexpr size_t WS_WGIN = 7 * MiB;
constexpr size_t WS_WO1 = 14 * MiB;
constexpr size_t WS_AFF = 16 * MiB;
constexpr size_t WS_SLOT = 19 * MiB;
constexpr size_t WS_ROWIDX = 22 * MiB;
constexpr size_t WS_ROWG = 22 * MiB + 512 * 1024;
constexpr size_t WS_WUP = 24 * MiB;
constexpr size_t WS_WDN = WS_WUP + 352 * MiB;
constexpr size_t WS_XA = WS_WDN + 176 * MiB;
constexpr size_t WS_H = WS_XA + 144 * MiB;
constexpr size_t WS_E = WS_H + 72 * MiB;
constexpr size_t WS_Q = WS_E, WS_K = WS_E + 72 * MiB, WS_V = WS_E + 90 * MiB, WS_O = WS_E + 108 * MiB;
constexpr size_t WS_PG = WS_E, WS_OF = WS_E + 220 * MiB, WS_OB = WS_E + 284 * MiB;
constexpr size_t WS_QT = WS_E + 348 * MiB, WS_KT = WS_E + 420 * MiB, WS_DEC = WS_E + 492 * MiB;
constexpr size_t WS_XG = WS_E, WS_YS = WS_E, WS_ACT = WS_E + 144 * MiB;
constexpr size_t WS_H8 = WS_E;
constexpr size_t WS_TMP = WS_E + 540 * MiB;
constexpr size_t WS_END = WS_TMP + 50 * MiB;
constexpr int CW_BAR = 4096;

constexpr int RING_BYTES = 131072;
constexpr int LDS_BYTES = 147456;
constexpr int LDSCTL_OFF = LDS_BYTES - 1024, MISC_OFF = LDSCTL_OFF + 320;
constexpr int NWAVES = 8;

__device__ __forceinline__ float bf2f(bf16 v) { return __uint_as_float(((unsigned)v) << 16); }
typedef __bf16 hwbf16x2 __attribute__((ext_vector_type(2)));
__device__ __forceinline__ unsigned pk2(float lo, float hi) { const f32x2 v = {lo, hi}; return __builtin_bit_cast(unsigned, __builtin_convertvector(v, hwbf16x2)); }
__device__ __forceinline__ unsigned f2bf(float f) { return pk2(f, 0.f) & 0xffffu; }
__device__ __forceinline__ float clamp448(float v) { return __builtin_fminf(__builtin_fmaxf(v, -448.f), 448.f); }
__device__ __forceinline__ unsigned pk4_fp8(float a, float b, float c, float d) { int w = 0; w = __builtin_amdgcn_cvt_pk_fp8_f32(clamp448(a), clamp448(b), w, false); w = __builtin_amdgcn_cvt_pk_fp8_f32(clamp448(c), clamp448(d), w, true); return (unsigned)w; }
typedef _Float16 f16x4 __attribute__((ext_vector_type(4)));
typedef unsigned short xa_t;
__device__ __forceinline__ v2u pack_h4(f32x4 v) { return __builtin_bit_cast(v2u, __builtin_convertvector(v, f16x4)); }
__device__ __forceinline__ f32x4 unpack_h4(v2u w) { return __builtin_convertvector(__builtin_bit_cast(f16x4, w), f32x4); }
template <int CTRL, int RMASK> __device__ __forceinline__ float dpp_add(float x) { return x + __builtin_bit_cast(float, __builtin_amdgcn_update_dpp(0, __builtin_bit_cast(int, x), CTRL, RMASK, 0xf, false)); }
__device__ __forceinline__ float wave_sum(float v) {
    v = dpp_add<0xB1, 0xf>(v);
    v = dpp_add<0x4E, 0xf>(v);
    v = dpp_add<0x141, 0xf>(v);
    v = dpp_add<0x140, 0xf>(v);
    v = dpp_add<0x142, 0xa>(v);
    v = dpp_add<0x143, 0xc>(v);
    return __builtin_bit_cast(float, __builtin_amdgcn_readlane(__builtin_bit_cast(int, v), 63));
}
__device__ __forceinline__ float silu_f(float v) { return v / (1.f + expf(-v)); }
__device__ __forceinline__ float fexp(float x) { return __builtin_amdgcn_exp2f(x * LOG2E); }
__device__ __forceinline__ float flog(float x) { return __builtin_amdgcn_logf(x) * 0.6931471805599453f; }
__device__ __forceinline__ float fsilu(float v) { return v * __builtin_amdgcn_rcpf(1.f + fexp(-v)); }
template <int d> __device__ __forceinline__ float dpp_shr(float x) { return __builtin_bit_cast(float, __builtin_amdgcn_update_dpp(0, __builtin_bit_cast(int, x), 0x110 + d, 0xf, 0xf, true)); }
#define LDS_WAIT() asm volatile("s_waitcnt lgkmcnt(0)" ::: "memory")
#define LDS_SYNC() asm volatile("s_waitcnt lgkmcnt(0)\n\ts_barrier" ::: "memory")
#define VM_WAIT() asm volatile("s_waitcnt vmcnt(0)" ::: "memory")

struct P {
    const float *x, *c, *ctx, *c_ctx, *ada_w, *ada_b, *norm1_g, *norm2_g, *attn_w_in, *attn_w_out, *attn_sink,
        *gla_w_in, *gla_gate_w2, *gla_gate_b, *gla_norm_g, *gla_w_out, *router_w, *exp_w_gate, *exp_w_up, *exp_w_down, *final_norm_g;
    float* out; unsigned char* ws;
    int lo, hi;
};

namespace pg8 {
#define PG8_LAS __attribute__((address_space(3)))
typedef unsigned short bf16_t;
typedef unsigned u32x4 __attribute__((ext_vector_type(4)));
typedef unsigned u32x2 __attribute__((ext_vector_type(2)));
constexpr int BM = 256, BK = 64, HALF = 128, HTB = HALF * BK * 2, STAGE_BYTES = 8 * HTB, NXCD = 8, WGM = 8;
__host__ __device__ __forceinline__ int lds_byte(int r, int c) { const int st = (r >> 4) * 2 + (c >> 5), rr = r & 15, cc = c & 31, ob = rr * 64 + cc * 2; return st * 1024 + (ob ^ (((ob >> 9) & 1) << 5)); }
__host__ __device__ __forceinline__ void stage_rc(int b, int& R, int& C) { const int st = b / 1024, sb = b % 1024, swz = sb ^ (((sb >> 9) & 1) << 5); R = (st >> 1) * 16 + swz / 64; C = (st & 1) * 32 + (swz % 64) / 2; }
__host__ __device__ __forceinline__ int perm32(int rho) { const int n = rho >> 4, i = rho & 15; return 8 * (i >> 2) + 4 * n + (i & 3); }
struct Unit { int pm, pn; };
struct Gemm { const void* A; const void* Bt; int KB; const int* gidx; };
struct TileOrder {
    int nG, nM, nN, sM, G, c, per, nwg;
    __device__ __forceinline__ void init(int nG_, int nM_, int nN_, int sM_, int G_, int c_) { nG = nG_; nM = nM_; nN = nN_; sM = sM_; G = G_; c = c_; per = nM * nN; nwg = nG * per; }
    __device__ __forceinline__ bool next(int i, Unit& u) const {
        const long L = (long)i * G + c; if (L >= nwg) return false;
        int wgid = (int)L; { const int q = nwg / NXCD, r = nwg % NXCD, xcd = wgid % NXCD, off = wgid / NXCD; wgid = (xcd < r ? xcd * (q + 1) : r * (q + 1) + (xcd - r) * q) + off; }
        const int g = wgid / per, rem = wgid % per;
        const int nig = WGM * nN, gid = rem / nig, fm = gid * WGM, gsz = (nM - fm) < WGM ? (nM - fm) : WGM;
        u.pm = g * sM + fm + ((rem % nig) % gsz); u.pn = g * nN + (rem % nig) / gsz; return true;
    }
};
struct GlaInOrder {
    int G, c;
    __device__ __forceinline__ bool next(int i, Unit& u) const {
        constexpr int NLAT = (NL / BM) * 13, NALL = NLAT + (NC / BM) * 7;
        const long L = (long)i * G + c; if (L >= NALL) return false;
        int wgid = (int)L; { const int q = NALL / NXCD, xcd = wgid % NXCD, off = wgid / NXCD; wgid = xcd * q + off; }
        if (wgid < NLAT) { const int nig = WGM * 13, gid = wgid / nig, fm = gid * WGM; u.pm = fm + ((wgid % nig) % WGM); u.pn = (wgid % nig) / WGM; }
        else { const int r = wgid - NLAT; u.pm = NL / BM + (r & 15); u.pn = 6 + (r >> 4); }
        return true;
    }
};
__device__ __forceinline__ unsigned cvt_pk_bf16(float lo, float hi) { unsigned r; asm volatile("v_cvt_pk_bf16_f32 %0, %1, %2" : "=v"(r) : "v"(lo), "v"(hi)); return r; }

struct EpiQKV {
    static constexpr bool PERM = false;
    bf16_t *Q, *Kb, *Vb; const float* rope;
    __device__ __forceinline__ void operator()(const f32x4 (&acc)[2][2][4][2], const Unit& u, int wr, int wc, int fr, int fq) const {
        const int row0 = u.pm * BM + wr * 64 + fr; const bool latent = u.pm < (NL / BM);
        const int kind = u.pn < 4 ? 0 : (u.pn == 4 ? 1 : 2);
        const size_t boff = (kind >= 1 ? (size_t)(WS_K - WS_Q) / 2 : 0) + (kind == 2 ? (size_t)(WS_V - WS_K) / 2 : 0);
        bf16_t* base = Q + boff; const int ldc = kind == 0 ? 1024 : 256; const int colt = kind == 0 ? u.pn * BM : 0;
        const float sc = kind == 0 ? QSCALE : 1.f;
        f32x4 rc0[2][4], rc1[2][4];
#pragma unroll
        for (int ai = 0; ai < 2; ++ai)
#pragma unroll
            for (int m = 0; m < 4; ++m) { const int t = (row0 + ai * HALF + m * 16) & (SEQ - 1);
                rc0[ai][m] = (f32x4){1.f, 0.f, 1.f, 0.f}; rc1[ai][m] = rc0[ai][m];
                if (latent && kind != 2) { const int pos = (wc & 1) ? (t & 63) : (t >> 6); const f32x4* tp = (const f32x4*)(rope + (size_t)(pos * 16 + 4 * fq) * 2); rc0[ai][m] = tp[0]; rc1[ai][m] = tp[1]; } }
#pragma unroll
        for (int ai = 0; ai < 2; ++ai)
#pragma unroll
            for (int m = 0; m < 4; ++m) {
                const int r = row0 + ai * HALF + m * 16;
                const f32x4 cs0 = rc0[ai][m], cs1 = rc1[ai][m];
                const float cs[4] = {cs0[0], cs0[2], cs1[0], cs1[2]}, sn[4] = {cs0[1], cs0[3], cs1[1], cs1[3]};
                bf16_t* rowp = base + (size_t)r * ldc + colt + wc * 32 + 4 * fq;
#pragma unroll
                for (int bj = 0; bj < 2; ++bj) {
                    const f32x4 x0 = acc[ai][bj][m][0], x1 = acc[ai][bj][m][1]; float o0[4], o1[4];
#pragma unroll
                    for (int j = 0; j < 4; ++j) { o0[j] = (x0[j] * cs[j] - x1[j] * sn[j]) * sc; o1[j] = (x1[j] * cs[j] + x0[j] * sn[j]) * sc; }
                    u32x2 w0, w1; w0.x = cvt_pk_bf16(o0[0], o0[1]); w0.y = cvt_pk_bf16(o0[2], o0[3]); w1.x = cvt_pk_bf16(o1[0], o1[1]); w1.y = cvt_pk_bf16(o1[2], o1[3]);
                    *(u32x2*)(rowp + bj * HALF) = w0; *(u32x2*)(rowp + bj * HALF + 16) = w1;
                }
            }
    }
};
template <bool SRC16>
struct EpiResidT {
    static constexpr bool PERM = false;
    const float *xlat, *xctx; xa_t* XA; const float* mod_g;
    __device__ __forceinline__ void operator()(const f32x4 (&acc)[2][2][4][2], const Unit& u, int wr, int wc, int fr, int fq) const {
        const int row0 = u.pm * BM + wr * 64 + fr, col0 = u.pn * BM + wc * 32 + 4 * fq; const bool latent = u.pm < (NL / BM);
        const float* src = latent ? xlat : xctx - (size_t)NL * D; const int j = latent ? (u.pm >> 3) : 16;
        f32x4 gv[2][2];
#pragma unroll
        for (int bj = 0; bj < 2; ++bj)
#pragma unroll
            for (int n = 0; n < 2; ++n) gv[bj][n] = *(const f32x4*)(mod_g + (size_t)j * 6144 + col0 + bj * HALF + n * 16);
#pragma unroll
        for (int ai = 0; ai < 2; ++ai)
#pragma unroll
            for (int mp = 0; mp < 2; ++mp) { f32x4 xs[2][2][2]; v2u xh[2][2][2];
#pragma unroll
                for (int mm = 0; mm < 2; ++mm) { const size_t off = (size_t)(row0 + ai * HALF + (2 * mp + mm) * 16) * D + col0;
#pragma unroll
                    for (int bj = 0; bj < 2; ++bj)
#pragma unroll
                        for (int n = 0; n < 2; ++n) { if constexpr (SRC16) xh[mm][bj][n] = *(const v2u*)(XA + off + bj * HALF + n * 16); else xs[mm][bj][n] = *(const f32x4*)(src + off + bj * HALF + n * 16); } }
                if constexpr (SRC16) asm volatile("" : "+v"(xh[0][0][0]), "+v"(xh[0][0][1]), "+v"(xh[0][1][0]), "+v"(xh[0][1][1]), "+v"(xh[1][0][0]), "+v"(xh[1][0][1]), "+v"(xh[1][1][0]), "+v"(xh[1][1][1]) :: "memory");
                else asm volatile("" : "+v"(xs[0][0][0]), "+v"(xs[0][0][1]), "+v"(xs[0][1][0]), "+v"(xs[0][1][1]), "+v"(xs[1][0][0]), "+v"(xs[1][0][1]), "+v"(xs[1][1][0]), "+v"(xs[1][1][1]) :: "memory");
#pragma unroll
                for (int mm = 0; mm < 2; ++mm) { const size_t off = (size_t)(row0 + ai * HALF + (2 * mp + mm) * 16) * D + col0;
#pragma unroll
                    for (int bj = 0; bj < 2; ++bj)
#pragma unroll
                        for (int n = 0; n < 2; ++n) { const f32x4 xin = SRC16 ? unpack_h4(xh[mm][bj][n]) : xs[mm][bj][n];
                            *(v2u*)(XA + off + bj * HALF + n * 16) = pack_h4(xin + gv[bj][n] * acc[ai][bj][2 * mp + mm][n]); } }
                asm volatile("" ::: "memory"); }
    }
};
struct EpiSwiglu {
    static constexpr bool PERM = true;
    unsigned char* ACT;
    __device__ __forceinline__ void operator()(const f32x4 (&acc)[2][2][4][2], const Unit& u, int wr, int wc, int fr, int fq) const {
        const int row0 = u.pm * BM + wr * 64 + fr, nl = u.pn % (FF / 128), col0 = nl * 128 + wc * 32 + 8 * fq;
        const float sin_ = MOE_FP8 ? F8_INV : 1.f, sout = MOE_FP8 ? F8_ACT : 1.f;
#pragma unroll
        for (int ai = 0; ai < 2; ++ai)
#pragma unroll
            for (int m = 0; m < 4; ++m) { float o[8];
#pragma unroll
                for (int n = 0; n < 2; ++n)
#pragma unroll
                    for (int j = 0; j < 4; ++j) { const float g = acc[ai][0][m][n][j] * sin_, up = acc[ai][1][m][n][j] * sin_; o[n * 4 + j] = g * __builtin_amdgcn_rcpf(1.f + __builtin_amdgcn_exp2f(g * -1.4426950408889634f)) * (up * sout); }
                unsigned char* dst = ACT + ((size_t)(row0 + ai * HALF + m * 16) * FF + col0) * EB;
                if (MOE_FP8) { u32x2 w; w.x = pk4_fp8(o[0], o[1], o[2], o[3]); w.y = pk4_fp8(o[4], o[5], o[6], o[7]); *(u32x2*)dst = w; }
                else { u32x4 w; w.x = cvt_pk_bf16(o[0], o[1]); w.y = cvt_pk_bf16(o[2], o[3]); w.z = cvt_pk_bf16(o[4], o[5]); w.w = cvt_pk_bf16(o[6], o[7]); *(u32x4*)dst = w; } }
    }
};
struct EpiDown {
    static constexpr bool PERM = true;
    bf16_t* YS; const float* rowg;
    __device__ __forceinline__ void operator()(const f32x4 (&acc)[2][2][4][2], const Unit& u, int wr, int wc, int fr, int fq) const {
        const int row0 = u.pm * BM + wr * 64 + fr, col0 = (u.pn & 3) * BM + wc * 32 + 8 * fq;
        float gr[2][4];
#pragma unroll
        for (int ai = 0; ai < 2; ++ai)
#pragma unroll
            for (int m = 0; m < 4; ++m) gr[ai][m] = rowg[row0 + ai * HALF + m * 16];
#pragma unroll
        for (int ai = 0; ai < 2; ++ai)
#pragma unroll
            for (int m = 0; m < 4; ++m) { const int r = row0 + ai * HALF + m * 16; const float g = gr[ai][m] * (MOE_FP8 ? F8_INV : 1.f);
#pragma unroll
                for (int bj = 0; bj < 2; ++bj) { const f32x4 v0 = acc[ai][bj][m][0] * g, v1 = acc[ai][bj][m][1] * g;
                    u32x4 w; w.x = cvt_pk_bf16(v0[0], v0[1]); w.y = cvt_pk_bf16(v0[2], v0[3]); w.z = cvt_pk_bf16(v1[0], v1[1]); w.w = cvt_pk_bf16(v1[2], v1[3]);
                    *(u32x4*)(YS + (size_t)r * D + col0 + bj * HALF) = w; } }
    }
};
struct EpiGlaIn {
    static constexpr bool PERM = true;
    bf16_t* PG;
    __device__ __forceinline__ void operator()(const f32x4 (&acc)[2][2][4][2], const Unit& u, int wr, int wc, int fr, int fq) const {
        const int row0 = u.pm * BM + wr * 64 + fr, col0 = u.pn * BM + wc * 32 + 8 * fq;
#pragma unroll
        for (int ai = 0; ai < 2; ++ai)
#pragma unroll
            for (int m = 0; m < 4; ++m) { const int r = row0 + ai * HALF + m * 16;
#pragma unroll
                for (int bj = 0; bj < 2; ++bj) { const f32x4 v0 = acc[ai][bj][m][0], v1 = acc[ai][bj][m][1];
                    u32x4 w; w.x = cvt_pk_bf16(v0[0], v0[1]); w.y = cvt_pk_bf16(v0[2], v0[3]); w.z = cvt_pk_bf16(v1[0], v1[1]); w.w = cvt_pk_bf16(v1[2], v1[3]);
                    if (col0 + bj * HALF < GIN) *(u32x4*)(PG + (size_t)r * GIN + col0 + bj * HALF) = w; } }
    }
};

typedef int v8i __attribute__((ext_vector_type(8)));
typedef int v4i __attribute__((ext_vector_type(4)));
__device__ __forceinline__ v8i cat8(bf16x8 lo, bf16x8 hi) { return __builtin_shufflevector(__builtin_bit_cast(v4i, lo), __builtin_bit_cast(v4i, hi), 0, 1, 2, 3, 4, 5, 6, 7); }
template <class Epi, class Sched, bool FP8 = false, bool ALIGN_EPI = true, bool GATHER = false>
__device__ __forceinline__ void gemm_phase(PG8_LAS unsigned char* lds, const Gemm g, const Sched& S, const Epi& E, const int tid) {
    const int wid = __builtin_amdgcn_readfirstlane(tid >> 6), lane = tid & 63, wr = wid >> 2, wc = wid & 3, fr = lane & 15, fq = lane >> 4;
    const int KB = g.KB, nt = KB / 128;
    unsigned voffA, voffB; int Rl, Cb;
    { int R, C; stage_rc(tid * 16, R, C); const int Rb = Epi::PERM ? ((R & ~31) + perm32(R & 31)) : R; voffA = (unsigned)(R * KB + C * 2); voffB = (unsigned)(Rb * KB + C * 2); Rl = R; Cb = C * 2; }
    unsigned gA[2][2], gN[2][2]; constexpr int GOFF = STAGE_BYTES;
    const unsigned r64 = 64u * (unsigned)KB;
    const unsigned kstep = 128u;
    const unsigned hstep = (unsigned)(HALF * KB);
    const unsigned tstep = 2u * hstep;
    const __amdgpu_buffer_rsrc_t rsA = __builtin_amdgcn_make_buffer_rsrc(const_cast<void*>(g.A), 0, 0x7fffffff, 0x00020000), rsB = __builtin_amdgcn_make_buffer_rsrc(const_cast<void*>(g.Bt), 0, 0x7fffffff, 0x00020000);
    const unsigned ldsw = (unsigned)wid * 1024u;
    const int aoff = lds_byte(wr * 64 + fr, fq * 8), boff = lds_byte(wc * 32 + fr, fq * 8);
    const int sw8 = (fr * 64 + (fq & 1) * 32) ^ (((fr >> 3) & 1) << 5);
    const int a8off = (wr * 8 + (fq >> 1)) * 1024 + sw8, b8off = (wc * 4 + (fq >> 1)) * 1024 + sw8;
#define PG8_SA(b, h) (((b) * 2 + (h)) * HTB)
#define PG8_SB(b, h) ((4 + (b) * 2 + (h)) * HTB)
#define PG8_STAGE(bufoff, rs, soff, voff) do { _Pragma("unroll") for (int _i = 0; _i < 2; ++_i) \
        __builtin_amdgcn_raw_ptr_buffer_load_lds(rs, (PG8_LAS void*)(lds + (bufoff) + ldsw + _i * 8192), 16, (int)(voff), (int)((soff) + _i * r64), 0, 0); } while (0)
#define PG8_STAGE_A(bufoff, h, soff, kofs, gsel) do { if constexpr (GATHER) { _Pragma("unroll") for (int _i = 0; _i < 2; ++_i) \
        __builtin_amdgcn_raw_ptr_buffer_load_lds(rsA, (PG8_LAS void*)(lds + (bufoff) + ldsw + _i * 8192), 16, (int)(gsel)[h][_i], (int)(kofs), 0, 0); } else PG8_STAGE(bufoff, rsA, soff, voffA); } while (0)
#define PG8_LDA(dst, b, h) do { _Pragma("unroll") for (int m = 0; m < 4; ++m) { if constexpr (FP8) dst##8[m] = cat8(*(const PG8_LAS bf16x8*)(lds + PG8_SA(b, h) + aoff + m * 2048), *(const PG8_LAS bf16x8*)(lds + PG8_SA(b, h) + aoff + m * 2048 + 1024)); \
        else { _Pragma("unroll") for (int k = 0; k < 2; ++k) dst[m][k] = *(const PG8_LAS bf16x8*)(lds + PG8_SA(b, h) + aoff + m * 2048 + k * 1024); } } } while (0)
#define PG8_LDB(dst, b, h) do { _Pragma("unroll") for (int n = 0; n < 2; ++n) { if constexpr (FP8) dst##8[n] = cat8(*(const PG8_LAS bf16x8*)(lds + PG8_SB(b, h) + boff + n * 2048), *(const PG8_LAS bf16x8*)(lds + PG8_SB(b, h) + boff + n * 2048 + 1024)); \
        else { _Pragma("unroll") for (int k = 0; k < 2; ++k) dst[n][k] = *(const PG8_LAS bf16x8*)(lds + PG8_SB(b, h) + boff + n * 2048 + k * 1024); } } } while (0)
#define PG8_MMA8(ai, bj, At, Bt) asm volatile("s_nop 1\n\t" \
        "v_mfma_scale_f32_16x16x128_f8f6f4 %0, %8, %10, %0, %14, %14 op_sel_hi:[0,0,0]\n\t" "v_mfma_scale_f32_16x16x128_f8f6f4 %1, %9, %10, %1, %14, %14 op_sel_hi:[0,0,0]\n\t" \
        "v_mfma_scale_f32_16x16x128_f8f6f4 %2, %8, %11, %2, %14, %14 op_sel_hi:[0,0,0]\n\t" "v_mfma_scale_f32_16x16x128_f8f6f4 %3, %9, %11, %3, %14, %14 op_sel_hi:[0,0,0]\n\t" \
        "v_mfma_scale_f32_16x16x128_f8f6f4 %4, %8, %12, %4, %14, %14 op_sel_hi:[0,0,0]\n\t" "v_mfma_scale_f32_16x16x128_f8f6f4 %5, %9, %12, %5, %14, %14 op_sel_hi:[0,0,0]\n\t" \
        "v_mfma_scale_f32_16x16x128_f8f6f4 %6, %8, %13, %6, %14, %14 op_sel_hi:[0,0,0]\n\t" "v_mfma_scale_f32_16x16x128_f8f6f4 %7, %9, %13, %7, %14, %14 op_sel_hi:[0,0,0]" \
        : "+v"(acc[ai][bj][0][0]), "+v"(acc[ai][bj][0][1]), "+v"(acc[ai][bj][1][0]), "+v"(acc[ai][bj][1][1]), "+v"(acc[ai][bj][2][0]), "+v"(acc[ai][bj][2][1]), "+v"(acc[ai][bj][3][0]), "+v"(acc[ai][bj][3][1]) \
        : "v"(Bt##8[0]), "v"(Bt##8[1]), "v"(At##8[0]), "v"(At##8[1]), "v"(At##8[2]), "v"(At##8[3]), "v"(scl8))
#define PG8_MMA(ai, bj, At, Bt) do { __builtin_amdgcn_s_setprio(1); if constexpr (FP8) { PG8_MMA8(ai, bj, At, Bt); } else { \
        _Pragma("unroll") for (int m = 0; m < 4; ++m) _Pragma("unroll") for (int n = 0; n < 2; ++n) _Pragma("unroll") for (int k = 0; k < 2; ++k) \
        acc[ai][bj][m][n] = __builtin_amdgcn_mfma_f32_16x16x32_bf16(Bt[n][k], At[m][k], acc[ai][bj][m][n], 0, 0, 0); } __builtin_amdgcn_s_setprio(0); } while (0)
#define PG8_WAIT_V(n) asm volatile("s_waitcnt vmcnt(" #n ")" ::: "memory")
#define PG8_WAIT_L(n) asm volatile("s_waitcnt lgkmcnt(" #n ")" ::: "memory")
#define PG8_BAR __builtin_amdgcn_s_barrier()
#define PG8_SCHED __builtin_amdgcn_sched_barrier(0)
    Unit cur, nxt; int ui = 0;
    if (!S.next(0, cur)) return;
    f32x4 acc[2][2][4][2];
#pragma unroll
    for (int a = 0; a < 2; ++a)
#pragma unroll
        for (int b = 0; b < 2; ++b)
#pragma unroll
            for (int m = 0; m < 4; ++m)
#pragma unroll
                for (int n = 0; n < 2; ++n) acc[a][b][m][n] = (f32x4){0.f, 0.f, 0.f, 0.f};
    int scl8 = 0x7f7f7f7f; asm volatile("" : "+v"(scl8));
    bf16x8 At[4][2], B0[2][2], B1[2][2]; v8i At8[4], B08[2], B18[2];
    unsigned cA = (unsigned)cur.pm * tstep, cB = (unsigned)cur.pn * tstep;
    if constexpr (GATHER) {
#pragma unroll
        for (int h = 0; h < 2; ++h)
#pragma unroll
            for (int i = 0; i < 2; ++i) { gA[h][i] = (unsigned)g.gidx[cur.pm * 256 + h * 128 + Rl + 64 * i] * (unsigned)KB + (unsigned)Cb; gN[h][i] = gA[h][i]; } }
    {
        PG8_STAGE(PG8_SB(0, 0), rsB, cB, voffB); PG8_STAGE(PG8_SB(0, 1), rsB, cB + hstep, voffB); PG8_STAGE_A(PG8_SA(0, 0), 0, cA, 0, gA); PG8_STAGE_A(PG8_SA(0, 1), 1, cA + hstep, 0, gA);
        if (wr == 1) PG8_BAR;
        PG8_WAIT_V(2); PG8_BAR;
        PG8_STAGE(PG8_SB(1, 0), rsB, cB + kstep, voffB); PG8_STAGE_A(PG8_SA(1, 0), 0, cA + kstep, kstep, gA); PG8_STAGE(PG8_SB(1, 1), rsB, cB + hstep + kstep, voffB);
        PG8_WAIT_V(6); PG8_BAR;
    }
    for (;;) {
        const bool has_next = S.next(ui + 1, nxt);
        const unsigned nA = has_next ? (unsigned)nxt.pm * tstep : cA, nB = has_next ? (unsigned)nxt.pn * tstep : cB;
        for (int t = 0; t < nt; t += 2) {
            const bool last = (t == nt - 2);
            const unsigned a1 = cA + (unsigned)(t + 1) * kstep;
            const unsigned a2 = last ? nA : cA + (unsigned)(t + 2) * kstep, b2 = last ? nB : cB + (unsigned)(t + 2) * kstep;
            const unsigned a3 = a2 + kstep, b3 = b2 + kstep;
            const unsigned k1 = (unsigned)(t + 1) * kstep, k2 = last ? 0u : (unsigned)(t + 2) * kstep, k3 = k2 + kstep;
            if constexpr (GATHER) {
                if (t == 0 && has_next && wid == 0) __builtin_amdgcn_global_load_lds((const unsigned*)(g.gidx + nxt.pm * 256 + lane * 4), (PG8_LAS unsigned*)(lds + GOFF + ((ui + 1) & 1) * 1024), 16, 0, 0);
                if (last && has_next) {
#pragma unroll
                    for (int h = 0; h < 2; ++h)
#pragma unroll
                        for (int i = 0; i < 2; ++i) gN[h][i] = (unsigned)*(const PG8_LAS int*)(lds + GOFF + ((ui + 1) & 1) * 1024 + (h * 128 + Rl + 64 * i) * 4) * (unsigned)KB + (unsigned)Cb; } }
            unsigned gS[2][2];
#pragma unroll
            for (int h = 0; h < 2; ++h)
#pragma unroll
                for (int i = 0; i < 2; ++i) gS[h][i] = last ? gN[h][i] : gA[h][i];
            PG8_LDB(B0, 0, 0); PG8_LDB(B1, 0, 1); PG8_SCHED; PG8_LDA(At, 0, 0); PG8_STAGE_A(PG8_SA(1, 1), 1, a1 + hstep, k1, gA);
            PG8_WAIT_V(8); PG8_WAIT_L(0); PG8_BAR; PG8_MMA(0, 0, At, B0); PG8_MMA(0, 1, At, B1); PG8_BAR; PG8_SCHED;
            PG8_LDA(At, 0, 1); PG8_STAGE(PG8_SB(0, 0), rsB, b2, voffB); PG8_STAGE(PG8_SB(0, 1), rsB, b2 + hstep, voffB); PG8_STAGE_A(PG8_SA(0, 0), 0, a2, k2, gS);
            PG8_WAIT_V(8); PG8_WAIT_L(0); PG8_BAR; PG8_MMA(1, 0, At, B0); PG8_MMA(1, 1, At, B1); PG8_BAR; PG8_SCHED;
            PG8_LDB(B0, 1, 0); PG8_LDB(B1, 1, 1); PG8_SCHED; PG8_LDA(At, 1, 0); PG8_STAGE_A(PG8_SA(0, 1), 1, a2 + hstep, k2, gS);
            PG8_WAIT_V(8); PG8_WAIT_L(0); PG8_BAR; PG8_MMA(0, 0, At, B0); PG8_MMA(0, 1, At, B1); PG8_BAR; PG8_SCHED;
            PG8_LDA(At, 1, 1); PG8_STAGE(PG8_SB(1, 0), rsB, b3, voffB); PG8_STAGE(PG8_SB(1, 1), rsB, b3 + hstep, voffB); PG8_STAGE_A(PG8_SA(1, 0), 0, a3, k3, gS);
            PG8_WAIT_V(8); PG8_WAIT_L(0); PG8_BAR; PG8_MMA(1, 0, At, B0); PG8_MMA(1, 1, At, B1); PG8_BAR; PG8_SCHED;
        }
        if constexpr (ALIGN_EPI) { if (wr == 0) PG8_BAR; }
        if constexpr (FP8) asm volatile("s_nop 15\n\ts_nop 15" ::: "memory");
        E(acc, cur, wr, wc, fr, fq);
        if (!has_next) break;
#pragma unroll
        for (int a = 0; a < 2; ++a)
#pragma unroll
            for (int b = 0; b < 2; ++b)
#pragma unroll
                for (int m = 0; m < 4; ++m)
#pragma unroll
                    for (int n = 0; n < 2; ++n) acc[a][b][m][n] = (f32x4){0.f, 0.f, 0.f, 0.f};
        cur = nxt; cA = nA; cB = nB; ++ui;
        if constexpr (GATHER) {
#pragma unroll
            for (int h = 0; h < 2; ++h)
#pragma unroll
                for (int i = 0; i < 2; ++i) gA[h][i] = gN[h][i]; }
        if constexpr (ALIGN_EPI) { if (wr == 1) PG8_BAR; }
    }
    PG8_WAIT_V(0);
    if constexpr (!ALIGN_EPI) { if (wr == 0) PG8_BAR; }
    PG8_BAR;
#undef PG8_STAGE_A
#undef PG8_SA
#undef PG8_SB
#undef PG8_STAGE
#undef PG8_LDA
#undef PG8_LDB
#undef PG8_MMA
#undef PG8_WAIT_V
#undef PG8_WAIT_L
#undef PG8_BAR
#undef PG8_SCHED
}
}

#define XB_TMO      128
#define XB_XCNT(j)  (256  + 64 * (j))
#define XB_XSUB(j)  (1280 + 64 * (j))
#define XB_XGEN(j)  (2304 + 64 * (j))
#define XB_TOP      3328
#define XB_TOPGEN   3392
#define XCD_BAR_WORDS 3456
#define XB_SPIN_CAP (1u << 18)
__device__ __forceinline__ unsigned xb_ld(unsigned* p)              { return __hip_atomic_load(p, __ATOMIC_RELAXED, __HIP_MEMORY_SCOPE_AGENT); }
__device__ __forceinline__ unsigned xb_add(unsigned* p, unsigned v) { return __hip_atomic_fetch_add(p, v, __ATOMIC_RELAXED, __HIP_MEMORY_SCOPE_AGENT); }
__device__ __forceinline__ unsigned xb_xcc_id() { return (unsigned)__builtin_amdgcn_s_getreg((3 << 11) | 20) & 0xFu; }
#define XB_SPIN(cond, bar) do { unsigned _sp = 0; while (cond) { __builtin_amdgcn_s_sleep(1); \
    if ((++_sp & 255u) == 0u) { if (xb_ld(&(bar)[XB_TMO])) break; if (_sp > XB_SPIN_CAP) { atomicAdd(&(bar)[XB_TMO], 1u); break; } } } } while (0)
struct XcdBarrier { unsigned* bar; unsigned x; volatile LAS unsigned* st; };
__device__ __forceinline__ XcdBarrier xcd_barrier_post(unsigned* bar, volatile LAS unsigned* st) {
    XcdBarrier b; b.bar = bar; b.x = xb_xcc_id(); b.st = st;
    if (threadIdx.x == 0) (void)xb_add(&bar[XB_XCNT(b.x)], 1u);
    return b;
}
__device__ __forceinline__ void xcd_barrier_complete(unsigned* bar, unsigned x, unsigned& nloc, unsigned& nx) {
    const unsigned G = gridDim.x * gridDim.y * gridDim.z;
    unsigned sum, cnt, mine, sp = 0u;
    for (;;) {
        sum = 0u; cnt = 0u; mine = 0u;
#pragma unroll
        for (unsigned j = 0; j < 16; ++j) { const unsigned c = xb_ld(&bar[XB_XCNT(j)]); sum += c; cnt += (c > 0u) ? 1u : 0u; mine = (j == x) ? c : mine; }
        if (sum == G) break;
        __builtin_amdgcn_s_sleep(1);
        if ((++sp & 255u) == 0u) { if (xb_ld(&bar[XB_TMO])) break; if (sp > XB_SPIN_CAP) { atomicAdd(&bar[XB_TMO], 1u); break; } }
    }
    nloc = mine > 0u ? mine : 1u; nx = cnt > 0u ? cnt : 1u;
}
__device__ __forceinline__ void xcd_barrier(const XcdBarrier& b, const bool thread0) {
    asm volatile("s_waitcnt vmcnt(0)" ::: "memory");
    __syncthreads();
    if (thread0) {
        unsigned* bar = b.bar;
        __builtin_amdgcn_s_waitcnt(0);
        unsigned nloc = b.st[0], nx = b.st[1];
        if (nloc == 0u) { xcd_barrier_complete(bar, b.x, nloc, nx); b.st[0] = nloc; b.st[1] = nx; }
        const unsigned old = xb_add(&bar[XB_XSUB(b.x)], 1u);
        const unsigned gen = old / nloc;
        if (old + 1u == (gen + 1u) * nloc) {
            __builtin_amdgcn_fence(__ATOMIC_RELEASE, "agent");
            asm volatile("s_waitcnt vmcnt(0)" ::: "memory");
            const unsigned og = xb_add(&bar[XB_TOP], 1u);
            const unsigned tg = og / nx;
            if (og + 1u == (tg + 1u) * nx) xb_add(&bar[XB_TOPGEN], 1u);
            else XB_SPIN(xb_ld(&bar[XB_TOPGEN]) == tg, bar);
            __builtin_amdgcn_fence(__ATOMIC_ACQUIRE, "agent");
            xb_add(&bar[XB_XGEN(b.x)], 1u);
            asm volatile("s_waitcnt vmcnt(0)" ::: "memory");
        } else {
            XB_SPIN(xb_ld(&bar[XB_XGEN(b.x)]) == gen, bar);
            __builtin_amdgcn_fence(__ATOMIC_ACQUIRE, "agent");
            asm volatile("s_waitcnt vmcnt(0)" ::: "memory");
        }
    }
    __syncthreads();
}

struct Frame {
    LAS unsigned char* lds;
    int tid, lane, wave, vcu, G;
    unsigned char* ws;
};
#define WSP(T, off) ((T*)(F.ws + (off)))

__device__ __forceinline__ void cvt_item(const float* W, int ldw, int nvalid, int k0, int n0, bf16* WT, int ldt, int drow0, LAS float* scr, int lane) {
    const int c4 = lane & 15, kr = lane >> 4;
    f32x4 v[16];
#pragma unroll
    for (int i = 0; i < 16; ++i) { const int r = 4 * i + kr; v[i] = (4 * c4 < nvalid) ? *(const GAS f32x4*)(W + (size_t)(k0 + r) * ldw + n0 + 4 * c4) : (f32x4){0.f, 0.f, 0.f, 0.f}; }
#pragma unroll
    for (int i = 0; i < 16; ++i) { const int r = 4 * i + kr; LAS float* s = scr + r * 65 + 4 * c4; s[0] = v[i][0]; s[1] = v[i][1]; s[2] = v[i][2]; s[3] = v[i][3]; }
    LDS_WAIT(); asm volatile("" ::: "memory");
    const int c = lane & 7;
#pragma unroll
    for (int j = 0; j < 8; ++j) { const int n = (lane >> 3) + 8 * j; const LAS float* s = scr + (8 * c) * 65 + n;
        v4u o; o.x = pk2(s[0 * 65], s[1 * 65]); o.y = pk2(s[2 * 65], s[3 * 65]); o.z = pk2(s[4 * 65], s[5 * 65]); o.w = pk2(s[6 * 65], s[7 * 65]);
        if (n < nvalid) *(GAS v4u*)(WT + (size_t)(drow0 + n) * ldt + k0 + 8 * c) = o; }
    LDS_WAIT(); asm volatile("" ::: "memory");
}

__device__ __forceinline__ void cvt8_load(const float* W, int ldw, int k0, int n0, f32x4 (&v)[16], int lane) {
    const int c4 = lane & 15, kr = lane >> 4;
#pragma unroll
    for (int i = 0; i < 16; ++i) v[i] = __builtin_nontemporal_load((const GAS f32x4*)(W + (size_t)(k0 + 4 * i + kr) * ldw + n0 + 4 * c4));
}
__device__ __forceinline__ void cvt8_finish(const f32x4 (&v)[16], int k0, unsigned char* WT, int ldt, int drow0, float scale, LAS float* scr, int lane) {
    const int c4 = lane & 15, kr = lane >> 4;
#pragma unroll
    for (int i = 0; i < 16; ++i) { const int r = 4 * i + kr; LAS float* s = scr + r * 65 + 4 * c4; s[0] = v[i][0]; s[1] = v[i][1]; s[2] = v[i][2]; s[3] = v[i][3]; }
    LDS_WAIT(); asm volatile("" ::: "memory");
    const int c = lane & 3;
#pragma unroll
    for (int j = 0; j < 4; ++j) { const int n = (lane >> 2) + 16 * j; const LAS float* s = scr + (16 * c) * 65 + n;
        v4u o;
        o.x = pk4_fp8(s[0 * 65] * scale, s[1 * 65] * scale, s[2 * 65] * scale, s[3 * 65] * scale); o.y = pk4_fp8(s[4 * 65] * scale, s[5 * 65] * scale, s[6 * 65] * scale, s[7 * 65] * scale);
        o.z = pk4_fp8(s[8 * 65] * scale, s[9 * 65] * scale, s[10 * 65] * scale, s[11 * 65] * scale); o.w = pk4_fp8(s[12 * 65] * scale, s[13 * 65] * scale, s[14 * 65] * scale, s[15 * 65] * scale);
        *(GAS v4u*)(WT + (size_t)(drow0 + n) * ldt + k0 + 16 * c) = o; }
    LDS_WAIT(); asm volatile("" ::: "memory");
}
struct ExpItem { const float* W; int ldw, k0, n0, ldt, drow0; unsigned char* WT; };
__device__ __forceinline__ ExpItem exp_item(const P& p, unsigned char* ws, int q, int half) {
    ExpItem e; const int le = q / 1056, rr = q % 1056, mk = rr / 352, ii = rr % 352;
    if (mk < 2) { const int kb2 = ii / 44, nb = ii % 44; e.n0 = 64 * nb; e.k0 = 64 * (2 * kb2 + half); e.W = (mk == 0 ? p.exp_w_gate : p.exp_w_up) + (size_t)le * D * FF; e.ldw = FF; e.ldt = D; e.drow0 = (e.n0 >> 7) * 256 + mk * 128 + (e.n0 & 127); e.WT = ws + WS_WUP + (size_t)le * 5632 * D; }
    else { const int kb2 = ii / 16, nb = ii % 16; e.n0 = 64 * nb; e.k0 = 64 * (2 * kb2 + half); e.W = p.exp_w_down + (size_t)le * FF * D; e.ldw = D; e.ldt = FF; e.drow0 = e.n0; e.WT = ws + WS_WDN + (size_t)le * D * FF; }
    return e;
}
constexpr int NPAIR_ALL = 32 * 1056;
__device__ __forceinline__ void cvt_pairs(const P& p, unsigned char* ws, LAS float* scr, int qfirst, int qstep, int qend, int lane) {
    f32x4 va[16], vb[16]; int q = qfirst;
    if (q < qend) { const ExpItem e = exp_item(p, ws, q, 0); cvt8_load(e.W, e.ldw, e.k0, e.n0, va, lane); }
    while (q < qend) {
        const ExpItem e0 = exp_item(p, ws, q, 0), e1 = exp_item(p, ws, q, 1);
        cvt8_load(e1.W, e1.ldw, e1.k0, e1.n0, vb, lane);
        cvt8_finish(va, e0.k0, e0.WT, e0.ldt, e0.drow0, F8_W, scr, lane);
        const int q2 = q + qstep;
        if (q2 < qend) { const ExpItem e2 = exp_item(p, ws, q2, 0); cvt8_load(e2.W, e2.ldw, e2.k0, e2.n0, va, lane); }
        cvt8_finish(vb, e1.k0, e1.WT, e1.ldt, e1.drow0, F8_W, scr, lane);
        q = q2;
    }
}
#ifndef BG_QKV
#define BG_QKV 2560
#define BG_OUT0 6144
#define BG_UP0 512
#define BG_DN0 4096
#endif
constexpr int CVT_Q3 = NPAIR_ALL - BG_DN0, CVT_Q2 = CVT_Q3 - BG_UP0, CVT_Q1 = CVT_Q2 - BG_OUT0, CVT_SPLIT0 = CVT_Q1 - BG_QKV;
static_assert(CVT_Q2 >= NPAIR_ALL / 2 && CVT_SPLIT0 >= 0, "the slices behind the layer-0 MoE must stay inside layer 1");
#define BG_SLOT(first, qb, qe) do { if (MOE_FP8 && F.G == 256 && (int)blockIdx.x >= (first) && (qb) < (qe)) { __syncthreads(); \
    cvt_pairs(p, F.ws, (LAS float*)(F.lds + F.wave * 16640), (qb) + ((int)blockIdx.x - (first)) * 8 + F.wave, (256 - (first)) * 8, (qe), F.lane); } } while (0)
__device__ __forceinline__ void ph_pro(const P& p, Frame& F, bool do_cvt) {
    float* MOD = WSP(float, WS_MOD); float* ROPE = WSP(float, WS_ROPE);
    if (F.vcu == 255 % F.G) {
        for (int i = F.tid; i < 1024; i += 512) { const int pos = i >> 4, f = i & 15; const float inv = powf(10000.f, -(float)f / 16.f); const float ang = (float)pos * inv; ROPE[2 * i] = cosf(ang); ROPE[2 * i + 1] = sinf(ang); }
    }
    if (F.vcu < 192) {
        LAS float* ssrc = (LAS float*)F.lds; LAS float* red = (LAS float*)(F.lds + 69632);
        for (int i = F.tid; i < 17 * 1024; i += 512) { const int j = i >> 10, k = i & 1023; const float v = (j < 16) ? p.c[j * 1024 + k] : p.c_ctx[k]; ssrc[i] = silu_f(v); }
        __syncthreads();
        for (int u = F.vcu; u < 192; u += F.G) {
            const int l = u / 96, c0 = (u % 96) * 64, col = c0 + (F.tid & 63), ks = F.tid >> 6;
            const float* w = p.ada_w + ((size_t)l * 1024 + ks * 128) * 6144 + col;
            float acc[17];
#pragma unroll
            for (int j = 0; j < 17; ++j) acc[j] = 0.f;
            float wa[8], wb[8];
#define ADA_LD(k0_, buf_) do { _Pragma("unroll") for (int i_ = 0; i_ < 8; ++i_) buf_[i_] = w[(size_t)((k0_) + i_) * 6144]; } while (0)
#define ADA_FMA(k0_, buf_) do { _Pragma("unroll") for (int j = 0; j < 17; ++j) { const f32x4 s0 = *(const LAS f32x4*)(ssrc + j * 1024 + ks * 128 + (k0_)), s1 = *(const LAS f32x4*)(ssrc + j * 1024 + ks * 128 + (k0_) + 4); \
                acc[j] += ((s0[0] * buf_[0] + s0[1] * buf_[1]) + (s0[2] * buf_[2] + s0[3] * buf_[3])) + ((s1[0] * buf_[4] + s1[1] * buf_[5]) + (s1[2] * buf_[6] + s1[3] * buf_[7])); } } while (0)
            ADA_LD(0, wa);
#pragma clang loop unroll(disable)
            for (int k = 0; k < 128; k += 16) {
                ADA_LD(k + 8, wb);
                ADA_FMA(k, wa);
                if (k + 16 < 128) ADA_LD(k + 16, wa);
                ADA_FMA(k + 8, wb);
            }
#undef ADA_LD
#undef ADA_FMA
#pragma unroll
            for (int j = 0; j < 17; ++j) red[(ks * 17 + j) * 64 + (F.tid & 63)] = acc[j];
            __syncthreads();
            for (int i = F.tid; i < 17 * 64; i += 512) { const int j = i >> 6, c = i & 63; float s = p.ada_b[l * 6144 + c0 + c];
#pragma unroll
                for (int q = 0; q < 8; ++q) s += red[(q * 17 + j) * 64 + c];
                MOD[(size_t)(l * 17 + j) * 6144 + c0 + c] = s; }
            __syncthreads();
        }
    }
    if (do_cvt) {
        __syncthreads();
        LAS float* scr = (LAS float*)(F.lds + F.wave * 16640);
        const int gw = F.vcu * NWAVES + F.wave, NGW = F.G * NWAVES;
        constexpr int I_QKV = 16 * 24, I_O = 16 * 16, I_GIN = 16 * 49, I_SMALL = I_QKV + I_O + I_GIN + I_O, I_E = 704, I_LE = 3 * I_E, NITEMS = I_SMALL + 32 * I_LE;
        for (int it = gw; it < I_SMALL; it += NGW) {
            int r = it;
            if (r < I_QKV) { cvt_item(p.attn_w_in, ATT_N, 64, 64 * (r / 24), 64 * (r % 24), WSP(bf16, WS_WQKV), D, 64 * (r % 24), scr, F.lane); continue; } r -= I_QKV;
            if (r < I_O) { cvt_item(p.attn_w_out, D, 64, 64 * (r / 16), 64 * (r % 16), WSP(bf16, WS_WO0), D, 64 * (r % 16), scr, F.lane); continue; } r -= I_O;
            if (r < I_GIN) { const int nb = r % 49; cvt_item(p.gla_w_in, GIN, nb == 48 ? 32 : 64, 64 * (r / 49), 64 * nb, WSP(bf16, WS_WGIN), D, 64 * nb, scr, F.lane); continue; } r -= I_GIN;
            cvt_item(p.gla_w_out, D, 64, 64 * (r / 16), 64 * (r % 16), WSP(bf16, WS_WO1), D, 64 * (r % 16), scr, F.lane);
        }
        constexpr int NEXP = 32 * I_LE;
        if (MOE_FP8) {
            cvt_pairs(p, F.ws, scr, gw, NGW, F.G == 256 ? CVT_SPLIT0 : NPAIR_ALL, F.lane);
        } else {
            for (int r = gw; r < NEXP; r += NGW) {
                const int le = r / I_LE, rr = r % I_LE, mk = rr / I_E, ii = rr % I_E;
                if (mk < 2) { const int kb = ii / 44, nb = ii % 44, n0 = 64 * nb; const float* W = (mk == 0 ? p.exp_w_gate : p.exp_w_up) + (size_t)le * D * FF; const int dr = (n0 >> 7) * 256 + mk * 128 + (n0 & 127);
                    cvt_item(W, FF, 64, 64 * kb, n0, WSP(bf16, WS_WUP) + (size_t)le * 5632 * D, D, dr, scr, F.lane); }
                else { const int kb = ii / 16, nb = ii % 16; cvt_item(p.exp_w_down + (size_t)le * FF * D, D, 64, 64 * kb, 64 * nb, WSP(bf16, WS_WDN) + (size_t)le * D * FF, FF, 64 * nb, scr, F.lane); }
            }
        }
        { v4u* z = (v4u*)(WSP(bf16, WS_WGIN) + (size_t)GIN * D); const int n16 = (GIN_PAD - GIN) * D * 2 / 16;
          for (int i = F.vcu * 512 + F.tid; i < n16; i += F.G * 512) z[i] = (v4u){0u, 0u, 0u, 0u}; }
    }
}

__device__ __forceinline__ void norm_mod_store(const f32x4 (&v)[4], float rstd, const float* g, const float* sh, const float* sc, bf16* orow, int lane) {
    f32x4 gv[4], shv[4], scv[4];
#pragma unroll
    for (int j = 0; j < 4; ++j) { const int c = 4 * (lane + 64 * j); gv[j] = *(const f32x4*)(g + c); shv[j] = *(const f32x4*)(sh + c); scv[j] = *(const f32x4*)(sc + c); }
#pragma unroll
    for (int j = 0; j < 4; ++j) { const int c = 4 * (lane + 64 * j);
        const f32x4 y = (v[j] * rstd * gv[j]) * (scv[j] + 1.f) + shv[j]; v2u o; o.x = pk2(y[0], y[1]); o.y = pk2(y[2], y[3]); *(v2u*)(orow + c) = o; }
}
__device__ __forceinline__ void ph_norm1(const P& p, Frame& F, int l) {
    const float* MOD = WSP(float, WS_MOD); bf16* H = WSP(bf16, WS_H); const float* XA = WSP(float, WS_XA);
    const int gw = F.vcu * NWAVES + F.wave, NGW = F.G * NWAVES; constexpr int RW = 3;
    f32x4 gv[4];
#pragma unroll
    for (int q = 0; q < 4; ++q) gv[q] = *(const f32x4*)(p.norm1_g + l * D + 4 * (F.lane + 64 * q));
    for (int r0 = gw; r0 < NT; r0 += RW * NGW) {
        f32x4 v[RW][4], shv[RW][4], scv[RW][4];
#pragma unroll
        for (int h = 0; h < RW; ++h) { const int r = r0 + h * NGW < NT ? r0 + h * NGW : r0;
            const float* xr = (l == 0) ? (r < NL ? p.x + (size_t)r * D : p.ctx + (size_t)(r - NL) * D) : XA + (size_t)r * D;
            const int j = r < NL ? r / SEQ : 16; const float* mr = MOD + (size_t)(l * 17 + j) * 6144;
#pragma unroll
            for (int q = 0; q < 4; ++q) { const int c = 4 * (F.lane + 64 * q); v[h][q] = *(const f32x4*)(xr + c); shv[h][q] = *(const f32x4*)(mr + c); scv[h][q] = *(const f32x4*)(mr + 1024 + c); } }
#pragma unroll
        for (int h = 0; h < RW; ++h) { const int r = r0 + h * NGW; if (r >= NT) break; float s = 0.f;
#pragma unroll
            for (int q = 0; q < 4; ++q) s += (v[h][q][0] * v[h][q][0] + v[h][q][1] * v[h][q][1]) + (v[h][q][2] * v[h][q][2] + v[h][q][3] * v[h][q][3]);
            const float rstd = 1.f / sqrtf(wave_sum(s) * (1.f / D) + EPS);
            bf16* orow = H + (size_t)r * D;
#pragma unroll
            for (int q = 0; q < 4; ++q) { const f32x4 y = (v[h][q] * rstd * gv[q]) * (scv[h][q] + 1.f) + shv[h][q]; v2u o; o.x = pk2(y[0], y[1]); o.y = pk2(y[2], y[3]); *(v2u*)(orow + 4 * (F.lane + 64 * q)) = o; } }
    }
}
__device__ __forceinline__ void ph_norm2r(const P& p, Frame& F, int l) {
    const float* MOD = WSP(float, WS_MOD); bf16* H = WSP(bf16, WS_H); const xa_t* XA = WSP(xa_t, WS_XA); float* AFF = WSP(float, WS_AFF);
    constexpr int HT = 1028;
    LAS float* rw = (LAS float*)F.lds; LAS float* h2t = (LAS float*)(F.lds + 65536); LAS float* part = (LAS float*)(F.lds + 65536 + 16 * HT * 4);
    for (int i = F.tid; i < D * NE / 4; i += 512) ((LAS f32x4*)rw)[i] = ((const f32x4*)(p.router_w + (size_t)l * D * NE))[i];
    const int ntile = (l == 0 ? NT : NL) / 16, lane = F.lane, w = F.wave;
    const float *g = p.norm2_g + l * D;
    f32x4 v[2][4], gq[4]; v2u vr[2][4];
#pragma unroll
    for (int q = 0; q < 4; ++q) gq[q] = *(const f32x4*)(g + 4 * (lane + 64 * q));
    if (F.vcu < ntile) {
#pragma unroll
        for (int h = 0; h < 2; ++h)
#pragma unroll
            for (int q = 0; q < 4; ++q) vr[h][q] = *(const v2u*)(XA + (size_t)(F.vcu * 16 + 2 * w + h) * D + 4 * (lane + 64 * q)); }
    __syncthreads();
    for (int tile = F.vcu; tile < ntile; tile += F.G) {
        const int r0 = tile * 16;
        f32x4 shq[4], scq[4];
        { const int j = r0 < NL ? r0 / SEQ : 16; const float* mr = MOD + (size_t)(l * 17 + j) * 6144;
#pragma unroll
          for (int q = 0; q < 4; ++q) { shq[q] = *(const f32x4*)(mr + 3072 + 4 * (lane + 64 * q)); scq[q] = *(const f32x4*)(mr + 4096 + 4 * (lane + 64 * q)); } }
#pragma unroll
        for (int h = 0; h < 2; ++h)
#pragma unroll
            for (int q = 0; q < 4; ++q) v[h][q] = unpack_h4(vr[h][q]);
#pragma unroll
        for (int h = 0; h < 2; ++h) { const int r = r0 + 2 * w + h; float s = 0.f;
#pragma unroll
            for (int q = 0; q < 4; ++q) s += (v[h][q][0] * v[h][q][0] + v[h][q][1] * v[h][q][1]) + (v[h][q][2] * v[h][q][2] + v[h][q][3] * v[h][q][3]);
            const float rstd = 1.f / sqrtf(wave_sum(s) * (1.f / D) + EPS);
            bf16* orow = H + (size_t)r * D;
#pragma unroll
            for (int q = 0; q < 4; ++q) { const int c = 4 * (lane + 64 * q); const f32x4 gv = gq[q], shv = shq[q], scv = scq[q];
                const f32x4 y = (v[h][q] * rstd * gv) * (scv + 1.f) + shv;
                if (MOE_FP8) *(unsigned*)(WSP(unsigned char, WS_H8) + (size_t)r * D + c) = pk4_fp8(y[0] * F8_ACT, y[1] * F8_ACT, y[2] * F8_ACT, y[3] * F8_ACT);
                else { v2u o; o.x = pk2(y[0], y[1]); o.y = pk2(y[2], y[3]); *(v2u*)(orow + c) = o; }
                *(LAS f32x4*)(h2t + (2 * w + h) * HT + c) = y; } }
        if (tile + F.G < ntile) {
#pragma unroll
            for (int h = 0; h < 2; ++h)
#pragma unroll
                for (int q = 0; q < 4; ++q) vr[h][q] = *(const v2u*)(XA + (size_t)((tile + F.G) * 16 + 2 * w + h) * D + 4 * (lane + 64 * q)); }
        LDS_SYNC();
        { f32x4 acc = (f32x4){0.f, 0.f, 0.f, 0.f}; const int i16 = lane & 15, kq = lane >> 4;
#pragma unroll 8
          for (int it = 0; it < 32; ++it) { const int k = 128 * w + 4 * it + kq; acc = __builtin_amdgcn_mfma_f32_16x16x4f32(h2t[i16 * HT + k], rw[k * 16 + i16], acc, 0, 0, 0); }
#pragma unroll
          for (int r = 0; r < 4; ++r) part[(w * 16 + 4 * kq + r) * 16 + i16] = acc[r]; }
        LDS_SYNC();
        if (F.tid < 256) { const int i = F.tid >> 4, e = F.tid & 15; float a = 0.f;
#pragma unroll
            for (int w2 = 0; w2 < 8; ++w2) a += part[(w2 * 16 + i) * 16 + e];
            float m = a;
#pragma unroll
            for (int o = 1; o < 16; o <<= 1) m = fmaxf(m, __shfl_xor(m, o));
            const float pe = expf(a - m); float ssum = pe;
#pragma unroll
            for (int o = 1; o < 16; o <<= 1) ssum += __shfl_xor(ssum, o);
            AFF[(size_t)(r0 + i) * 16 + e] = pe / ssum; }
    }
    __syncthreads();
}
__device__ __forceinline__ void ph_topkg(const P& p, Frame& F, int l) {
    const float* AFF = WSP(float, WS_AFF); int* SLOT = WSP(int, WS_SLOT); int* ROWIDX = WSP(int, WS_ROWIDX); float* ROWG = WSP(float, WS_ROWG);
    const bf16* H = WSP(bf16, WS_H); bf16* XG = WSP(bf16, WS_XG);
    LAS int* hist = (LAS int*)F.lds;
    LAS int* sel = hist + 256;
    LAS int* wtot = sel + 256;
    LAS int* shr = wtot + 8;
    const int nunits = l == 0 ? 512 : 256, tid = F.tid, lane = F.lane;
    for (int u = F.vcu; u < nunits; u += F.G) {
        const bool lat = u < 256; const int b = (u & 255) >> 4, e = u & 15;
        const int L = lat ? SEQ : CTX, cap = lat ? CAPL : CAPC, row0 = lat ? b * SEQ : NL + b * CTX, s0 = lat ? b * CAPL : NB * CAPL + b * CAPC;
        unsigned key[4]; const bool act = 4 * tid < L;
#pragma unroll
        for (int q = 0; q < 4; ++q) key[q] = act ? __float_as_uint(AFF[(size_t)(row0 + 4 * tid + q) * 16 + e]) : 0u;
        unsigned prefix = 0u; int kk = cap;
#pragma unroll
        for (int pass = 0; pass < 4; ++pass) { const int shift = 24 - 8 * pass;
            if (tid < 256) hist[tid] = 0;
            LDS_SYNC();
            if (act) {
#pragma unroll
                for (int q = 0; q < 4; ++q) { const bool cand = pass == 0 ? true : ((key[q] >> (shift + 8)) == (prefix >> (shift + 8))); if (cand) __hip_atomic_fetch_add(&hist[(key[q] >> shift) & 255u], 1, __ATOMIC_RELAXED, __HIP_MEMORY_SCOPE_WORKGROUP); } }
            LDS_SYNC();
            if (F.wave == 0) { const int h0 = hist[4 * lane], h1 = hist[4 * lane + 1], h2 = hist[4 * lane + 2], h3 = hist[4 * lane + 3]; const int tot = h0 + h1 + h2 + h3;
                int suf = tot;
#pragma unroll
                for (int o = 1; o < 64; o <<= 1) { const int t = __shfl_down(suf, o); if (lane + o < 64) suf += t; }
                int above = suf - tot;
                if (above < kk && kk <= above + h3) { shr[0] = 4 * lane + 3; shr[1] = above; } above += h3;
                if (above < kk && kk <= above + h2) { shr[0] = 4 * lane + 2; shr[1] = above; } above += h2;
                if (above < kk && kk <= above + h1) { shr[0] = 4 * lane + 1; shr[1] = above; } above += h1;
                if (above < kk && kk <= above + h0) { shr[0] = 4 * lane + 0; shr[1] = above; } }
            LDS_SYNC();
            prefix |= (unsigned)shr[0] << shift; kk -= shr[1];
        }
        const int n_gt = cap - kk;
        int cg = 0, ce = 0;
#pragma unroll
        for (int q = 0; q < 4; ++q) { cg += (act && key[q] > prefix) ? 1 : 0; ce += (act && key[q] == prefix) ? 1 : 0; }
        int pk = cg | (ce << 16), inc = pk;
#pragma unroll
        for (int o = 1; o < 64; o <<= 1) { const int t = __shfl_up(inc, o); if (lane >= o) inc += t; }
        if (lane == 63) wtot[F.wave] = inc;
        LDS_SYNC();
        int base = 0;
#pragma unroll
        for (int w2 = 0; w2 < 8; ++w2) base += (w2 < F.wave) ? wtot[w2] : 0;
        int ex = base + inc - pk; int rg = ex & 0xffff, re = ex >> 16;
        if (act) {
#pragma unroll
            for (int q = 0; q < 4; ++q) { const int row = row0 + 4 * tid + q; int s = -1;
                if (key[q] > prefix) { s = rg; ++rg; } else if (key[q] == prefix) { if (re < kk) s = n_gt + re; ++re; }
                if (s >= 0) { ROWIDX[e * ESLOTS + s0 + s] = row; ROWG[e * ESLOTS + s0 + s] = __uint_as_float(key[q]); sel[s] = row; s += s0; }
                SLOT[(size_t)row * 16 + e] = s; } }
        LDS_SYNC();
    }
}
__device__ __forceinline__ void ph_combine(const P& p, Frame& F, int l) {
    const float* MOD = WSP(float, WS_MOD); bf16* H = WSP(bf16, WS_H); xa_t* XA = WSP(xa_t, WS_XA); const int* SLOT = WSP(int, WS_SLOT); const bf16* YS = WSP(bf16, WS_YS);
    const int gw = F.vcu * NWAVES + F.wave, NGW = F.G * NWAVES; const int nrows = l == 0 ? NT : NL;
    f32x4 gn[4];
#pragma unroll
    for (int q = 0; q < 4; ++q) gn[q] = *(const f32x4*)((l == 0 ? p.norm1_g + D : p.final_norm_g) + 4 * (F.lane + 64 * q));
    for (int r0 = gw; r0 < nrows; r0 += 2 * NGW) {
        int sv[2]; f32x4 v[2][4], acc[2][4];
#pragma unroll
        for (int h = 0; h < 2; ++h) { const int r = r0 + h * NGW; sv[h] = F.lane < 16 ? SLOT[(size_t)r * 16 + F.lane] : -1;
#pragma unroll
            for (int q = 0; q < 4; ++q) { v[h][q] = unpack_h4(*(const v2u*)(XA + (size_t)r * D + 4 * (F.lane + 64 * q))); acc[h][q] = (f32x4){0.f, 0.f, 0.f, 0.f}; } }
        unsigned mk[2]; v2u yv[2][4][4];
#pragma unroll
        for (int h = 0; h < 2; ++h) { mk[h] = (unsigned)(__ballot(sv[h] >= 0) & 0xffffull); unsigned m2 = mk[h];
#pragma unroll
            for (int i = 0; i < 4; ++i) {
                if (m2) { const int e = __builtin_ctz(m2); m2 &= m2 - 1; const int sl = __builtin_amdgcn_readlane(sv[h], e); const bf16* yr = YS + (size_t)(e * ESLOTS + sl) * D;
#pragma unroll
                    for (int q = 0; q < 4; ++q) yv[h][i][q] = *(const v2u*)(yr + 4 * (F.lane + 64 * q)); }
                else {
#pragma unroll
                    for (int q = 0; q < 4; ++q) yv[h][i][q] = (v2u){0u, 0u}; } }
            mk[h] = m2; }
        f32x4 g2v[2][4], shn[2][4], scn[2][4];
#pragma unroll
        for (int h = 0; h < 2; ++h) { const int r = r0 + h * NGW; const int j = r < NL ? r / SEQ : 16; const float* g2 = MOD + (size_t)(l * 17 + j) * 6144 + 5120; const float* m1 = MOD + (size_t)(17 + j) * 6144;
#pragma unroll
            for (int q = 0; q < 4; ++q) { const int c = 4 * (F.lane + 64 * q); g2v[h][q] = *(const f32x4*)(g2 + c); if (l == 0) { shn[h][q] = *(const f32x4*)(m1 + c); scn[h][q] = *(const f32x4*)(m1 + 1024 + c); } } }
#pragma unroll
        for (int h = 0; h < 2; ++h) {
#pragma unroll
            for (int i = 0; i < 4; ++i)
#pragma unroll
                for (int q = 0; q < 4; ++q) { const v2u w = yv[h][i][q]; acc[h][q][0] += __uint_as_float(w.x << 16); acc[h][q][1] += __uint_as_float(w.x & 0xffff0000u); acc[h][q][2] += __uint_as_float(w.y << 16); acc[h][q][3] += __uint_as_float(w.y & 0xffff0000u); }
            unsigned m2 = mk[h];
            while (m2) { const int e = __builtin_ctz(m2); m2 &= m2 - 1; const int sl = __builtin_amdgcn_readlane(sv[h], e); const bf16* yr = YS + (size_t)(e * ESLOTS + sl) * D;
#pragma unroll
                for (int q = 0; q < 4; ++q) { const v2u w = *(const v2u*)(yr + 4 * (F.lane + 64 * q)); acc[h][q][0] += __uint_as_float(w.x << 16); acc[h][q][1] += __uint_as_float(w.x & 0xffff0000u); acc[h][q][2] += __uint_as_float(w.y << 16); acc[h][q][3] += __uint_as_float(w.y & 0xffff0000u); } } }
#pragma unroll
        for (int h = 0; h < 2; ++h) { const int r = r0 + h * NGW;
            xa_t* xr = XA + (size_t)r * D; float s = 0.f;
#pragma unroll
            for (int q = 0; q < 4; ++q) { v[h][q] = v[h][q] + g2v[h][q] * acc[h][q]; s += (v[h][q][0] * v[h][q][0] + v[h][q][1] * v[h][q][1]) + (v[h][q][2] * v[h][q][2] + v[h][q][3] * v[h][q][3]); }
            const float rstd = 1.f / sqrtf(wave_sum(s) * (1.f / D) + EPS);
            if (l == 0) {
#pragma unroll
                for (int q = 0; q < 4; ++q) *(v2u*)(xr + 4 * (F.lane + 64 * q)) = pack_h4(v[h][q]);
                bf16* orow = H + (size_t)r * D;
#pragma unroll
                for (int q = 0; q < 4; ++q) { const f32x4 y = (v[h][q] * rstd * gn[q]) * (scn[h][q] + 1.f) + shn[h][q]; v2u o; o.x = pk2(y[0], y[1]); o.y = pk2(y[2], y[3]); *(v2u*)(orow + 4 * (F.lane + 64 * q)) = o; }
            } else {
                float* orow = p.out + (size_t)r * D;
#pragma unroll
                for (int q = 0; q < 4; ++q) { const int c = 4 * (F.lane + 64 * q); *(f32x4*)(orow + c) = v[h][q] * rstd * gn[q]; }
            } }
    }
}
__device__ __forceinline__ void ph_readout(const P& p, Frame& F) {
    bf16* H = WSP(bf16, WS_H); const bf16* OF = WSP(bf16, WS_OF); const bf16* OB = WSP(bf16, WS_OB); const bf16* PG = WSP(bf16, WS_PG);
    const int gw = F.vcu * NWAVES + F.wave, NGW = F.G * NWAVES;
    f32x4 gnv[4];
#pragma unroll
    for (int q = 0; q < 4; ++q) gnv[q] = *(const f32x4*)(p.gla_norm_g + 4 * (F.lane + 64 * q));
    for (int r0 = gw; r0 < NL; r0 += 2 * NGW) {
        v2u a[2][4], b[2][4], rr[2][4];
#pragma unroll
        for (int h = 0; h < 2; ++h) { const int r = r0 + h * NGW;
#pragma unroll
            for (int q = 0; q < 4; ++q) { const int c = 4 * (F.lane + 64 * q); a[h][q] = *(const v2u*)(OF + (size_t)r * GV + c); b[h][q] = *(const v2u*)(OB + (size_t)r * GV + c); rr[h][q] = *(const v2u*)(PG + (size_t)r * GIN + GQK + c); } }
#pragma unroll
        for (int h = 0; h < 2; ++h) { const int r = r0 + h * NGW;
#pragma unroll
            for (int q = 0; q < 4; ++q) { const int c = 4 * (F.lane + 64 * q);
                f32x4 o; o[0] = __uint_as_float(a[h][q].x << 16) + __uint_as_float(b[h][q].x << 16); o[1] = __uint_as_float(a[h][q].x & 0xffff0000u) + __uint_as_float(b[h][q].x & 0xffff0000u);
                o[2] = __uint_as_float(a[h][q].y << 16) + __uint_as_float(b[h][q].y << 16); o[3] = __uint_as_float(a[h][q].y & 0xffff0000u) + __uint_as_float(b[h][q].y & 0xffff0000u);
                const float ss = wave_sum((o[0] * o[0] + o[1] * o[1]) + (o[2] * o[2] + o[3] * o[3]));
                const float rstd = 1.f / sqrtf(ss * (1.f / GDV) + EPS);
                const f32x4 gv = gnv[q];
                const float q0 = __uint_as_float(rr[h][q].x << 16), q1 = __uint_as_float(rr[h][q].x & 0xffff0000u), q2 = __uint_as_float(rr[h][q].y << 16), q3 = __uint_as_float(rr[h][q].y & 0xffff0000u);
                const float y0 = o[0] * rstd * gv[0] * fsilu(q0), y1 = o[1] * rstd * gv[1] * fsilu(q1), y2 = o[2] * rstd * gv[2] * fsilu(q2), y3 = o[3] * rstd * gv[3] * fsilu(q3);
                v2u w; w.x = pk2(y0, y1); w.y = pk2(y2, y3); *(v2u*)(H + (size_t)r * D + c) = w; } }
    }
}

typedef float f32x16 __attribute__((ext_vector_type(16)));
typedef short s16x4 __attribute__((ext_vector_type(4)));
__device__ __forceinline__ s16x4 lds_tr16(const LAS unsigned char* p) { return __builtin_bit_cast(s16x4, __builtin_amdgcn_ds_read_tr16_b64_v4i16((LAS s16x4*)p)); }
__device__ __forceinline__ int crow(int r, int hi) { return (r & 3) + 8 * (r >> 2) + 4 * hi; }
#define TR_RD(dst, ptr) asm volatile("ds_read_b64_tr_b16 %0, %1" : "=v"(dst) : "v"((unsigned)(uintptr_t)(ptr)) : "memory")
#define TR_WAIT4(a, b, c, d) asm volatile("s_waitcnt lgkmcnt(0)" : "+v"(a), "+v"(b), "+v"(c), "+v"(d) :: "memory")
__device__ __forceinline__ void ph_attn(const P& p, Frame& F) {
    const bf16* Q = WSP(bf16, WS_Q); const bf16* Kb = WSP(bf16, WS_K); const bf16* Vb = WSP(bf16, WS_V); bf16* O = WSP(bf16, WS_O);
    const int lane = F.lane, r32 = lane & 31, hi = lane >> 5, w = F.wave, gq = w >> 1, th = w & 1;
    LAS unsigned char* Ks = F.lds; LAS unsigned char* Vs = F.lds + 3 * 8192;
    const int kl = lane >> 3, chp = lane & 7;
    const int dgrp = (lane >> 4) & 1, qrow = (lane & 15) >> 2, pp = lane & 3;
#define ATT_DEC(u_, lat_, b_, hk_, t0_, qrow0_, jlo_, nt_) do { lat_ = (u_) < 2048; \
        if (lat_) { b_ = (u_) >> 7; hk_ = ((u_) >> 5) & 3; t0_ = 64 * ((u_) & 31); qrow0_ = b_ * SEQ + t0_; } \
        else { const int uc_ = (u_) - 2048; b_ = uc_ >> 4; hk_ = (uc_ >> 2) & 3; t0_ = 64 * (uc_ & 3); qrow0_ = NL + b_ * CTX + t0_; } \
        int jhi_ = -1; jlo_ = 0; \
        if (lat_) { jlo_ = t0_ >= 128 ? 0 : (128 - t0_) / 64; jhi_ = (SEQ - 64 - (t0_ - 128)) / 64; if (jhi_ > 4) jhi_ = 4; } \
        nt_ = 4 + (jhi_ - jlo_ + 1); } while (0)
#define ATT_KROW(b_, t0_, jlo_, it) ((it) < 4 ? NL + (b_) * CTX + 64 * (it) : (b_) * SEQ + (t0_) - 128 + 64 * ((jlo_) + (it) - 4))
#define ATT_DMA(b_, hk_, t0_, jlo_, it, sl) do { const size_t so_ = ((size_t)(ATT_KROW(b_, t0_, jlo_, it) + 8 * w + kl) * 256 + (hk_) * 64) * 2 + (size_t)((chp ^ kl) * 16); \
        __builtin_amdgcn_global_load_lds((const unsigned*)((const char*)Kb + so_), (LAS unsigned*)(Ks + (sl) * 8192 + w * 1024), 16, 0, 0); \
        __builtin_amdgcn_global_load_lds((const unsigned*)((const char*)Vb + so_), (LAS unsigned*)(Vs + (sl) * 8192 + w * 1024), 16, 0, 0); } while (0)
    constexpr int NU = 2048 + 256;
    const float snk0 = p.attn_sink[gq], snk1 = p.attn_sink[4 + gq], snk2 = p.attn_sink[8 + gq], snk3 = p.attn_sink[12 + gq];
    int sc = 0, sn2 = 2;
    bool first = true;
    bf16x8 qr[4], qn[4];
    if (F.vcu < NU) { bool lat; int b, hk, t0, qrow0, jlo, nt; ATT_DEC(F.vcu, lat, b, hk, t0, qrow0, jlo, nt); (void)nt; (void)lat;
#pragma unroll
        for (int d0 = 0; d0 < 4; ++d0) qr[d0] = *(const bf16x8*)(Q + (size_t)(qrow0 + 32 * th + r32) * 1024 + (hk * 4 + gq) * 64 + d0 * 16 + hi * 8);
        ATT_DMA(b, hk, t0, jlo, 0, 0); ATT_DMA(b, hk, t0, jlo, 1, 1); }
    for (int u = F.vcu; u < NU; u += F.G) {
        bool lat; int b, hk, t0, qrow0, jlo, nt; ATT_DEC(u, lat, b, hk, t0, qrow0, jlo, nt);
        const bool has_next = u + F.G < NU;
        bool nlat; int nb, nhk, nt0, nqrow0, njlo, nnt; { const int un = has_next ? u + F.G : u; ATT_DEC(un, nlat, nb, nhk, nt0, nqrow0, njlo, nnt); (void)nnt; (void)nlat; }
        const int hq = hk * 4 + gq; const int qr_row = qrow0 + 32 * th + r32;
#pragma unroll
        for (int d0 = 0; d0 < 4; ++d0) { const bf16* qp = Q + (size_t)(nqrow0 + 32 * th + r32) * 1024 + (nhk * 4 + gq) * 64 + d0 * 16 + hi * 8;
            asm volatile("global_load_dwordx4 %0, %1, off" : "=v"(qn[d0]) : "v"(qp) : "memory"); }
        float m = (hk == 0 ? snk0 : hk == 1 ? snk1 : hk == 2 ? snk2 : snk3) * LOG2E, l = hi == 0 ? 1.f : 0.f;
        f32x16 o[2];
#pragma unroll
        for (int r = 0; r < 16; ++r) { o[0][r] = 0.f; o[1][r] = 0.f; }
#pragma clang loop unroll(disable)
        for (int it = 0; it < nt; ++it) {
            if (it == nt - 1) { if (has_next) asm volatile("s_waitcnt vmcnt(2)" ::: "memory"); else asm volatile("s_waitcnt vmcnt(0)" ::: "memory"); }
            else if (it < 2) { if (first) asm volatile("s_waitcnt vmcnt(6)" ::: "memory"); else asm volatile("s_waitcnt vmcnt(14)" ::: "memory"); }
            else asm volatile("s_waitcnt vmcnt(2)" ::: "memory");
            __builtin_amdgcn_s_barrier(); asm volatile("" ::: "memory");
            if (it + 2 < nt) ATT_DMA(b, hk, t0, jlo, it + 2, sn2);
            else if (has_next) ATT_DMA(nb, nhk, nt0, njlo, it + 2 - nt, sn2);
            const int slot = sc * 8192;
            f32x16 p0, p1;
            { const float nm = -m;
#pragma unroll
              for (int r = 0; r < 16; ++r) { p0[r] = nm; p1[r] = nm; } }
#pragma unroll
            for (int d0 = 0; d0 < 4; ++d0) {
                const int off = r32 * 128 + (((2 * d0 + hi) ^ (r32 & 7)) * 16);
                const bf16x8 k0 = *(const LAS bf16x8*)(Ks + slot + off), k1 = *(const LAS bf16x8*)(Ks + slot + off + 32 * 128);
                p0 = __builtin_amdgcn_mfma_f32_32x32x16_bf16(k0, qr[d0], p0, 0, 0, 0);
                p1 = __builtin_amdgcn_mfma_f32_32x32x16_bf16(k1, qr[d0], p1, 0, 0, 0);
            }
            s16x4 vt[2][4][2];
#pragma unroll
            for (int dblk = 0; dblk < 2; ++dblk)
#pragma unroll
                for (int ks = 0; ks < 4; ++ks) { const int klo = 16 * ks + 4 * hi + qrow, khi = klo + 8, ch = 4 * dblk + 2 * dgrp + (pp >> 1), bo = (pp & 1) * 8;
                    TR_RD(vt[dblk][ks][0], Vs + slot + klo * 128 + ((ch ^ (klo & 7)) * 16) + bo); TR_RD(vt[dblk][ks][1], Vs + slot + khi * 128 + ((ch ^ (khi & 7)) * 16) + bo); }
            asm volatile("s_nop 7\n\ts_nop 7" : "+v"(p0), "+v"(p1));
            if (it >= 4) { const int j = jlo + it - 4;
                if (j == 0 || j == 4) { const int dq = 32 * th + r32;
                    const int sg = j == 0 ? 1 : -1;
#pragma unroll
                    for (int r = 0; r < 16; ++r) { const int kk = crow(r, hi);
                        p0[r] = sg * (dq - kk) > 0 ? -1e30f : p0[r]; p1[r] = sg * (dq - (kk + 32)) > 0 ? -1e30f : p1[r]; } } }
            float mx = p0[0];
#pragma unroll
            for (int r = 1; r < 16; ++r) mx = fmaxf(mx, p0[r]);
#pragma unroll
            for (int r = 0; r < 16; ++r) mx = fmaxf(mx, p1[r]);
            mx = fmaxf(mx, __shfl_xor(mx, 32));
            if (__any(mx > 8.f)) { const float d = fmaxf(mx, 0.f), f = __builtin_amdgcn_exp2f(-d); l *= f;
#pragma unroll
                for (int r = 0; r < 16; ++r) { o[0][r] *= f; o[1][r] *= f; p0[r] -= d; p1[r] -= d; }
                m += d; }
            float ls = 0.f;
#pragma unroll
            for (int r = 0; r < 16; ++r) { p0[r] = __builtin_amdgcn_exp2f(p0[r]); p1[r] = __builtin_amdgcn_exp2f(p1[r]); ls += p0[r] + p1[r]; }
            l += ls;
            v4u pw[4];
#pragma unroll
            for (int q4 = 0; q4 < 4; ++q4) { pw[0][q4] = pk2(p0[2 * q4], p0[2 * q4 + 1]); pw[1][q4] = pk2(p0[8 + 2 * q4], p0[9 + 2 * q4]); pw[2][q4] = pk2(p1[2 * q4], p1[2 * q4 + 1]); pw[3][q4] = pk2(p1[8 + 2 * q4], p1[9 + 2 * q4]); }
            asm volatile("s_waitcnt lgkmcnt(0)" : "+v"(vt[0][0][0]), "+v"(vt[0][0][1]), "+v"(vt[0][1][0]), "+v"(vt[0][1][1]), "+v"(vt[0][2][0]), "+v"(vt[0][2][1]), "+v"(vt[0][3][0]), "+v"(vt[0][3][1]),
                         "+v"(vt[1][0][0]), "+v"(vt[1][0][1]), "+v"(vt[1][1][0]), "+v"(vt[1][1][1]), "+v"(vt[1][2][0]), "+v"(vt[1][2][1]), "+v"(vt[1][3][0]), "+v"(vt[1][3][1]) :: "memory");
#pragma unroll
            for (int dblk = 0; dblk < 2; ++dblk)
#pragma unroll
                for (int ks = 0; ks < 4; ++ks) { const s16x4 vlo = vt[dblk][ks][0], vhi = vt[dblk][ks][1];
                    const bf16x8 vf = (bf16x8){vlo[0], vlo[1], vlo[2], vlo[3], vhi[0], vhi[1], vhi[2], vhi[3]};
                    o[dblk] = __builtin_amdgcn_mfma_f32_32x32x16_bf16(vf, __builtin_bit_cast(bf16x8, pw[ks]), o[dblk], 0, 0, 0); }
            sc = sc == 2 ? 0 : sc + 1; sn2 = sn2 == 2 ? 0 : sn2 + 1;
        }
#undef ATT_KROW
#undef ATT_DMA
        const float il = 1.f / (l + __shfl_xor(l, 32));
        bf16* orow = O + (size_t)qr_row * 1024 + hq * 64;
#pragma unroll
        for (int dblk = 0; dblk < 2; ++dblk)
#pragma unroll
            for (int rq = 0; rq < 4; ++rq) { v2u wv; wv.x = pk2(o[dblk][4 * rq] * il, o[dblk][4 * rq + 1] * il); wv.y = pk2(o[dblk][4 * rq + 2] * il, o[dblk][4 * rq + 3] * il);
                *(v2u*)(orow + 32 * dblk + 8 * rq + 4 * hi) = wv; }
#pragma unroll
        for (int d0 = 0; d0 < 4; ++d0) qr[d0] = qn[d0];
        first = false;
    }
#undef ATT_DEC
}
__device__ __forceinline__ void ph_attn_naive(const P& p, Frame& F) {
    const bf16* Q = WSP(bf16, WS_Q); const bf16* Kb = WSP(bf16, WS_K); const bf16* Vb = WSP(bf16, WS_V); bf16* O = WSP(bf16, WS_O);
    for (int i = F.vcu * 512 + F.tid; i < NT * NQH; i += F.G * 512) {
        const int r = i >> 4, hq = i & 15, hk = hq >> 2;
        float q[64], acc[64];
#pragma unroll
        for (int d = 0; d < 64; ++d) { q[d] = bf2f(Q[(size_t)r * 1024 + hq * 64 + d]); acc[d] = 0.f; }
        float m = p.attn_sink[hq] * LOG2E, l = 1.f;
        const bool lat = r < NL; const int b = lat ? r / SEQ : (r - NL) / CTX, t = r & (SEQ - 1);
        const int nlat = lat ? (min(SEQ - 1, t + 128) - max(0, t - 128) + 1) : 0, klo = max(0, t - 128);
        for (int kk = 0; kk < CTX + nlat; ++kk) {
            const int kr = kk < CTX ? NL + b * CTX + kk : b * SEQ + klo + (kk - CTX);
            const bf16* kp = Kb + (size_t)kr * 256 + hk * 64; const bf16* vp = Vb + (size_t)kr * 256 + hk * 64;
            float s = 0.f;
#pragma unroll
            for (int d = 0; d < 64; ++d) s += q[d] * bf2f(kp[d]);
            const float mn = fmaxf(m, s), sc = exp2f(m - mn), pe = exp2f(s - mn);
            l = l * sc + pe; m = mn;
#pragma unroll
            for (int d = 0; d < 64; ++d) acc[d] = acc[d] * sc + pe * bf2f(vp[d]);
        }
        const float il = 1.f / l;
#pragma unroll
        for (int d = 0; d < 64; ++d) O[(size_t)r * 1024 + hq * 64 + d] = (bf16)f2bf(acc[d] * il);
    }
}
__device__ __forceinline__ f32x4 mfma16(bf16x8 a, bf16x8 b, f32x4 c) { return __builtin_amdgcn_mfma_f32_16x16x32_bf16(a, b, c, 0, 0, 0); }
__device__ __forceinline__ int gla_rowmap(int b, int dir, int s) { return s < CTX ? NL + b * CTX + (dir ? CTX - 1 - s : s) : b * SEQ + (dir ? SEQ - 1 - (s - CTX) : s - CTX); }
__device__ __forceinline__ void glaprep_unit(const P& p, Frame& F, int uu, const bf16x8 (&lrf)[4], const v2u (&kk4)[2][4], const v2u (&qq4)[2][4], const LAS float* w2s, const LAS float* bs2) {
    bf16* QT = WSP(bf16, WS_QT); bf16* KT = WSP(bf16, WS_KT); float* DEC = WSP(float, WS_DEC);
    const int lane = F.lane, w = F.wave, c16 = lane & 15, g = lane >> 4;
    const int hf = uu & 1, u = uu >> 1, c = u % 36, dir = (u / 36) & 1, b = u / 72;
    const size_t obase = ((size_t)(dir * NB + b) * 2304 + 64 * c) * 512;
#pragma unroll
    for (int ctl = 0; ctl < 2; ++ctl) { const int col0 = 256 * hf + 16 * (2 * w + ctl);
        v4u wp = (v4u){0u, 0u, 0u, 0u};
        if (g < 2) { const LAS float* wsrc = w2s + (dir * 16 + 8 * g) * 512 + col0 + c16;
            wp.x = pk2(wsrc[0], wsrc[512]); wp.y = pk2(wsrc[1024], wsrc[1536]); wp.z = pk2(wsrc[2048], wsrc[2560]); wp.w = pk2(wsrc[3072], wsrc[3584]); }
        const bf16x8 wf = __builtin_bit_cast(bf16x8, wp);
        const f32x4 bias = *(const LAS f32x4*)(bs2 + dir * 512 + col0 + 4 * g);
        f32x4 carry = (f32x4){0.f, 0.f, 0.f, 0.f};
#pragma unroll
        for (int tt = 0; tt < 4; ++tt) {
            const int tok = 16 * tt + c16;
            const v2u kk = kk4[ctl][tt], qq = qq4[ctl][tt];
            const f32x4 z = mfma16(wf, lrf[tt], bias);
            f32x4 ls;
#pragma unroll
            for (int r = 0; r < 4; ++r) ls[r] = (fminf(z[r], 0.f) - flog(1.f + fexp(-fabsf(z[r])))) * (1.f / 16.f);
#pragma unroll
            for (int r = 0; r < 4; ++r) { ls[r] += dpp_shr<1>(ls[r]); ls[r] += dpp_shr<2>(ls[r]); ls[r] += dpp_shr<4>(ls[r]); ls[r] += dpp_shr<8>(ls[r]); }
            f32x4 bs = carry + ls;
#pragma unroll
            for (int r = 0; r < 4; ++r) carry[r] += __shfl(ls[r], 15, 16);
            const float k0 = __uint_as_float(kk.x << 16), k1 = __uint_as_float(kk.x & 0xffff0000u), k2 = __uint_as_float(kk.y << 16), k3 = __uint_as_float(kk.y & 0xffff0000u);
            v2u ko; ko.x = pk2(k0 * fexp(-bs[0]), k1 * fexp(-bs[1])); ko.y = pk2(k2 * fexp(-bs[2]), k3 * fexp(-bs[3]));
            *(v2u*)(KT + obase + (size_t)tok * 512 + col0 + 4 * g) = ko;
            if (c >= 4) { const float q0 = __uint_as_float(qq.x << 16), q1 = __uint_as_float(qq.x & 0xffff0000u), q2 = __uint_as_float(qq.y << 16), q3 = __uint_as_float(qq.y & 0xffff0000u);
                v2u qo; qo.x = pk2(q0 * GLA_QS * fexp(bs[0]), q1 * GLA_QS * fexp(bs[1])); qo.y = pk2(q2 * GLA_QS * fexp(bs[2]), q3 * GLA_QS * fexp(bs[3]));
                *(v2u*)(QT + obase + (size_t)tok * 512 + col0 + 4 * g) = qo; }
        }
        if (c16 == 15) { f32x4 dv; dv[0] = fexp(carry[0]); dv[1] = fexp(carry[1]); dv[2] = fexp(carry[2]); dv[3] = fexp(carry[3]);
            *(f32x4*)(DEC + ((size_t)(dir * NB + b) * 36 + c) * 512 + col0 + 4 * g) = dv; }
    }
}
__device__ __forceinline__ void ph_glaprep(const P& p, Frame& F) {
    const bf16* PG = WSP(bf16, WS_PG);
    const int lane = F.lane, w = F.wave, c16 = lane & 15, g = lane >> 4;
    LAS float* w2s = (LAS float*)F.lds; LAS float* bs2 = w2s + 2 * 16 * 512;
    for (int i = F.tid; i < 2 * 16 * 512 / 4; i += 512) ((LAS f32x4*)w2s)[i] = ((const f32x4*)p.gla_gate_w2)[i];
    for (int i = F.tid; i < 2 * 512 / 4; i += 512) ((LAS f32x4*)bs2)[i] = ((const f32x4*)p.gla_gate_b)[i];
    constexpr int NU = NB * 2 * 36 * 2;
#define PREP_LOAD(uu_, LRF, KK, QQ) do { const int hf_ = (uu_) & 1, u_ = (uu_) >> 1, c_ = u_ % 36, dir_ = (u_ / 36) & 1, b_ = u_ / 72; \
        const int rowA_ = gla_rowmap(b_, dir_, 64 * c_), rstep_ = dir_ ? -1 : 1;         \
        _Pragma("unroll") for (int tt = 0; tt < 4; ++tt) { LRF[tt] = (bf16x8){0, 0, 0, 0, 0, 0, 0, 0}; \
            if (g < 2) LRF[tt] = *(const bf16x8*)(PG + (size_t)(rowA_ + rstep_ * (16 * tt + c16)) * GIN + 3072 + 16 * dir_ + 8 * g); } \
        _Pragma("unroll") for (int ctl = 0; ctl < 2; ++ctl) { const int col0_ = 256 * hf_ + 16 * (2 * w + ctl); \
            _Pragma("unroll") for (int tt = 0; tt < 4; ++tt) { const bf16* pr_ = PG + (size_t)(rowA_ + rstep_ * (16 * tt + c16)) * GIN + col0_ + 4 * g; \
                KK[ctl][tt] = *(const v2u*)(pr_ + GQR); QQ[ctl][tt] = (v2u){0u, 0u}; if (c_ >= 4) QQ[ctl][tt] = *(const v2u*)pr_; } } } while (0)
    bf16x8 lrA[4], lrB[4]; v2u kkA[2][4], qqA[2][4], kkB[2][4], qqB[2][4];
    int uu = F.vcu;
    if (uu < NU) PREP_LOAD(uu, lrA, kkA, qqA);
    LDS_SYNC();
#pragma clang loop unroll(disable)
    for (; uu < NU; uu += 2 * F.G) {
        const bool has1 = uu + F.G < NU, has2 = uu + 2 * F.G < NU;
        if (has1) PREP_LOAD(uu + F.G, lrB, kkB, qqB);
        glaprep_unit(p, F, uu, lrA, kkA, qqA, w2s, bs2);
        if (has1) { if (has2) PREP_LOAD(uu + 2 * F.G, lrA, kkA, qqA);
            glaprep_unit(p, F, uu + F.G, lrB, kkB, qqB, w2s, bs2); }
    }
#undef PREP_LOAD
    __syncthreads();
}
__device__ __forceinline__ void ph_glascan(const P& p, Frame& F) {
    const bf16* PG = WSP(bf16, WS_PG); const bf16* QT = WSP(bf16, WS_QT); const bf16* KT = WSP(bf16, WS_KT); const float* DEC = WSP(float, WS_DEC);
    const int lane = F.lane, w = F.wave, g = lane >> 4, c16 = lane & 15, qrow = c16 >> 2, pp = c16 & 3;
    constexpr int BUF = 49152, QOFF = 0, KOFF = 16384, VOFF = 32768, AM = 98304, DCO = 106496;
    LAS unsigned char* L = F.lds; LAS unsigned char* stg = L + DCO + 1024 + w * 2048;
    for (int u = F.vcu; u < 256; u += F.G) {
        const int dvh = u & 1, dir = (u >> 1) & 1, h = (u >> 2) & 3, b = u >> 4;
        bf16* OUT = WSP(bf16, WS_OF) + (dir ? (size_t)(WS_OB - WS_OF) / 2 : 0);
        const size_t seqbase = (size_t)(dir * NB + b) * 2304;
#define GLA_STAGE(c, bufi) do { _Pragma("unroll") for (int pc = 0; pc < 2; ++pc) { const int piece = w + 8 * pc, row = piece * 4 + g, chs = c16 ^ (row & 15); \
            const size_t srow = seqbase + 64 * (c) + row; const unsigned ldst = (bufi) * BUF + piece * 1024; \
            if ((c) >= 4) __builtin_amdgcn_global_load_lds((const unsigned*)((const char*)(QT + srow * 512 + h * 128) + chs * 16), (LAS unsigned*)(L + QOFF + ldst), 16, 0, 0); \
            __builtin_amdgcn_global_load_lds((const unsigned*)((const char*)(KT + srow * 512 + h * 128) + chs * 16), (LAS unsigned*)(L + KOFF + ldst), 16, 0, 0); \
            __builtin_amdgcn_global_load_lds((const unsigned*)((const char*)(PG + (size_t)gla_rowmap(b, dir, 64 * (c) + row) * GIN + GQR + GQK + h * 256 + dvh * 128) + chs * 16), (LAS unsigned*)(L + VOFF + ldst), 16, 0, 0); } \
            if (w == 0 && lane < 32) __builtin_amdgcn_global_load_lds((const unsigned*)((const char*)(DEC + ((size_t)(dir * NB + b) * 36 + (c)) * 512 + h * 128) + lane * 16), (LAS unsigned*)(L + DCO + (bufi) * 512), 16, 0, 0); } while (0)
        f32x4 S[8];
#pragma unroll
        for (int t = 0; t < 8; ++t) S[t] = (f32x4){0.f, 0.f, 0.f, 0.f};
        GLA_STAGE(0, 0);
        asm volatile("s_waitcnt vmcnt(0)" ::: "memory"); __builtin_amdgcn_s_barrier(); asm volatile("" ::: "memory");
#pragma clang loop unroll(disable)
        for (int c = 0; c < 36; ++c) {
            const int bi = c & 1; LAS unsigned char* Qs = L + bi * BUF + QOFF; LAS unsigned char* Ksm = L + bi * BUF + KOFF; LAS unsigned char* Vsm = L + bi * BUF + VOFF; LAS unsigned char* Am = L + AM;
            if (c + 1 < 36) GLA_STAGE(c + 1, bi ^ 1);
            if (c >= 4) {
#pragma unroll
                for (int q2 = 0; q2 < 2; ++q2) { const int id = 2 * w + q2, ti = id >> 2, tj = id & 3; f32x4 a = (f32x4){0.f, 0.f, 0.f, 0.f};
                    if (tj <= ti) {
#pragma unroll
                        for (int ks = 0; ks < 4; ++ks) { const int co = ((4 * ks + g) ^ c16) * 16;
                            const bf16x8 qa = *(const LAS bf16x8*)(Qs + (16 * ti + c16) * 256 + co), kb = *(const LAS bf16x8*)(Ksm + (16 * tj + c16) * 256 + co);
                            a = mfma16(qa, kb, a); }
                        asm volatile("s_nop 7\n\ts_nop 7" : "+v"(a));
                        if (tj == ti) {
#pragma unroll
                            for (int r = 0; r < 4; ++r) a[r] = c16 > 4 * g + r ? 0.f : a[r]; } }
#pragma unroll
                    for (int r = 0; r < 4; ++r) { const int i = 16 * ti + 4 * g + r; *(LAS bf16*)(Am + i * 128 + (((2 * tj + (c16 >> 3)) ^ (i & 7)) * 16) + (c16 & 7) * 2) = (bf16)f2bf(a[r]); } }
            }
            asm volatile("s_waitcnt lgkmcnt(0)" ::: "memory"); __builtin_amdgcn_s_barrier(); asm volatile("" ::: "memory");
            bf16x8 vf[2];
            { s16x4 t0, t1, t2, t3; const int ch = 2 * w + (pp >> 1), bo = (pp & 1) * 8, rl = 8 * g + qrow;
              TR_RD(t0, Vsm + rl * 256 + ((ch ^ (rl & 15)) * 16) + bo); TR_RD(t1, Vsm + (rl + 4) * 256 + ((ch ^ ((rl + 4) & 15)) * 16) + bo);
              TR_RD(t2, Vsm + (rl + 32) * 256 + ((ch ^ (rl & 15)) * 16) + bo); TR_RD(t3, Vsm + (rl + 36) * 256 + ((ch ^ ((rl + 4) & 15)) * 16) + bo);
              TR_WAIT4(t0, t1, t2, t3);
              vf[0] = (bf16x8){t0[0], t0[1], t0[2], t0[3], t1[0], t1[1], t1[2], t1[3]}; vf[1] = (bf16x8){t2[0], t2[1], t2[2], t2[3], t3[0], t3[1], t3[2], t3[3]}; }
            if (c >= 4) {
                bf16x8 sf[4];
#pragma unroll
                for (int ks = 0; ks < 4; ++ks) { v4u t4; t4.x = pk2(S[2 * ks][0], S[2 * ks][1]); t4.y = pk2(S[2 * ks][2], S[2 * ks][3]); t4.z = pk2(S[2 * ks + 1][0], S[2 * ks + 1][1]); t4.w = pk2(S[2 * ks + 1][2], S[2 * ks + 1][3]); sf[ks] = __builtin_bit_cast(bf16x8, t4); }
#pragma unroll
                for (int tt = 0; tt < 4; ++tt) { f32x4 o = (f32x4){0.f, 0.f, 0.f, 0.f}; const int row = 16 * tt + c16;
#pragma unroll
                    for (int ks = 0; ks < 4; ++ks) { const int ch0 = 4 * ks + (g >> 1), bo = (g & 1) * 8;
                        const s16x4 alo = *(const LAS s16x4*)(Qs + row * 256 + ((ch0 ^ c16) * 16) + bo), ahi = *(const LAS s16x4*)(Qs + row * 256 + (((ch0 + 2) ^ c16) * 16) + bo);
                        o = mfma16((bf16x8){alo[0], alo[1], alo[2], alo[3], ahi[0], ahi[1], ahi[2], ahi[3]}, sf[ks], o); }
#pragma unroll
                    for (int ks2 = 0; ks2 < 2; ++ks2) { const bf16x8 am = *(const LAS bf16x8*)(Am + row * 128 + (((4 * ks2 + g) ^ (row & 7)) * 16)); o = mfma16(am, vf[ks2], o); }
#pragma unroll
                    for (int r = 0; r < 4; ++r) *(LAS bf16*)(stg + (16 * tt + 4 * g + r) * 32 + c16 * 2) = (bf16)f2bf(o[r]); }
#pragma unroll
                for (int pc = 0; pc < 2; ++pc) { const int pi = lane + 64 * pc, tok = pi >> 1; const v4u ov = *(const LAS v4u*)(stg + pi * 16);
                    *(v4u*)(OUT + (size_t)gla_rowmap(b, dir, 64 * c + tok) * GV + h * 256 + dvh * 128 + 16 * w + (pi & 1) * 8) = ov; }
            }
#pragma unroll
            for (int t = 0; t < 8; ++t) { f32x4 acc = S[t];
                { s16x4 t0, t1, t2, t3; const int ch = 2 * t + (pp >> 1), bo = (pp & 1) * 8, rl = 8 * g + qrow;
                  TR_RD(t0, Ksm + rl * 256 + ((ch ^ (rl & 15)) * 16) + bo); TR_RD(t1, Ksm + (rl + 4) * 256 + ((ch ^ ((rl + 4) & 15)) * 16) + bo);
                  TR_RD(t2, Ksm + (rl + 32) * 256 + ((ch ^ (rl & 15)) * 16) + bo); TR_RD(t3, Ksm + (rl + 36) * 256 + ((ch ^ ((rl + 4) & 15)) * 16) + bo);
                  TR_WAIT4(t0, t1, t2, t3);
                  acc = mfma16((bf16x8){t0[0], t0[1], t0[2], t0[3], t1[0], t1[1], t1[2], t1[3]}, vf[0], acc);
                  acc = mfma16((bf16x8){t2[0], t2[1], t2[2], t2[3], t3[0], t3[1], t3[2], t3[3]}, vf[1], acc); }
                const f32x4 d4 = *(const LAS f32x4*)(L + DCO + bi * 512 + (16 * t + 4 * g) * 4);
                S[t] = acc * d4; }
            if (c >= 4) asm volatile("s_waitcnt vmcnt(2) lgkmcnt(0)" ::: "memory"); else asm volatile("s_waitcnt vmcnt(0) lgkmcnt(0)" ::: "memory");
            __builtin_amdgcn_s_barrier(); asm volatile("" ::: "memory");
        }
#undef GLA_STAGE
    }
}
__device__ __forceinline__ void ph_scan_naive(const P& p, Frame& F) {
    const bf16* PG = WSP(bf16, WS_PG);
    LAS float* sq = (LAS float*)F.lds; LAS float* sk = sq + 128; LAS float* sa = sk + 128; LAS float* sv = sa + 128; LAS float* so = sv + 64;
    const int tid = F.tid, e = tid & 63, w = tid >> 6;
    for (int u = F.vcu; u < 512; u += F.G) {
        const int sl = u & 3, dir = (u >> 2) & 1, h = (u >> 3) & 3, b = u >> 5;
        float S[16];
#pragma unroll
        for (int i = 0; i < 16; ++i) S[i] = 0.f;
        bf16* OUT = WSP(bf16, WS_OF) + (dir ? (size_t)(WS_OB - WS_OF) / 2 : 0);
        for (int step = 0; step < CTX + SEQ; ++step) {
            int row; if (step < CTX) row = NL + b * CTX + (dir ? CTX - 1 - step : step); else { const int t = step - CTX; row = b * SEQ + (dir ? SEQ - 1 - t : t); }
            const bf16* pr = PG + (size_t)row * GIN;
            if (tid < 128) { const int col = h * 128 + tid; float z = p.gla_gate_b[dir * 512 + col];
#pragma unroll
                for (int r = 0; r < 16; ++r) z += bf2f(pr[3072 + dir * 16 + r]) * p.gla_gate_w2[(size_t)(dir * 16 + r) * 512 + col];
                const float ls = fminf(z, 0.f) - log1pf(expf(-fabsf(z)));
                sq[tid] = bf2f(pr[col]) * GLA_QS; sk[tid] = bf2f(pr[GQR + col]); sa[tid] = expf(ls * (1.f / 16.f)); }
            else if (tid < 192) sv[tid - 128] = bf2f(pr[GQR + GQK + h * 256 + sl * 64 + tid - 128]);
            __syncthreads();
            const float v = sv[e]; float o = 0.f;
#pragma unroll
            for (int i = 0; i < 16; ++i) { const int d = 16 * w + i; S[i] = sa[d] * S[i] + sk[d] * v; o += sq[d] * S[i]; }
            so[w * 64 + e] = o;
            __syncthreads();
            if (step >= CTX && tid < 64) { float s = 0.f;
#pragma unroll
                for (int q = 0; q < 8; ++q) s += so[q * 64 + tid];
                OUT[(size_t)row * GV + h * 256 + sl * 64 + tid] = (bf16)f2bf(s); }
        }
        __syncthreads();
    }
}

enum Phase { PH_PRO = 0, PH_NORM1_0, PH_QKV, PH_ATTN, PH_OUT0, PH_N2R0, PH_TOPK0, PH_UP0, PH_DN0, PH_COMB0, PH_GLAIN, PH_PREP, PH_SCAN, PH_READ, PH_OUT1, PH_N2R1, PH_TOPK1, PH_UP1, PH_DN1, PH_COMB1, PH_END };

__global__ void __launch_bounds__(NWAVES * 64, 2) k_fwd(P p) {
    extern __shared__ __attribute__((aligned(16))) unsigned char lds[];
    Frame F;
    F.lds = (LAS unsigned char*)lds;
    F.tid = threadIdx.x; F.lane = F.tid & 63; F.wave = __builtin_amdgcn_readfirstlane(F.tid >> 6);
    F.G = gridDim.x; { const int bx = blockIdx.x; F.vcu = (F.G % 8 == 0) ? (bx % 8) * (F.G / 8) + bx / 8 : bx; }
    F.ws = p.ws;
    volatile LAS unsigned* MISC = (volatile LAS unsigned*)(F.lds + MISC_OFF);
    for (int u = F.tid; u < (LDS_BYTES - LDSCTL_OFF) / 4; u += NWAVES * 64) ((LAS unsigned*)(F.lds + LDSCTL_OFF))[u] = 0u;
    __syncthreads();
    const int lo = p.lo, hi = p.hi;
    XcdBarrier bar; bar.bar = (unsigned*)(F.ws + WS_CTL) + CW_BAR; bar.x = 0; bar.st = nullptr;
    if (hi - lo > 1) bar = xcd_barrier_post((unsigned*)(F.ws + WS_CTL) + CW_BAR, MISC + 8);
#define IN(k) (lo <= (k) && (k) < hi)
#define SEAM(k) do { if (IN(k) && IN((k) + 1)) xcd_barrier(bar, F.tid == 0); } while (0)
#define PHASE(k, ...) do { if (IN(k)) { F.lane = (int)__builtin_amdgcn_mbcnt_hi(~0u, __builtin_amdgcn_mbcnt_lo(~0u, 0u)); F.tid = F.wave * 64 + F.lane; __VA_ARGS__; if ((PROBE_MASK >> (k)) & 1) { xcd_barrier(bar, F.tid == 0); __VA_ARGS__; } } SEAM(k); } while (0)
    PHASE(PH_PRO, ph_pro(p, F, (OPT_MASK & 0xff) != 0));
    PHASE(PH_NORM1_0, ph_norm1(p, F, 0));
    PHASE(PH_QKV, {
        pg8::Gemm g{WSP(bf16, WS_H), WSP(bf16, WS_WQKV), D * 2, nullptr}; pg8::TileOrder S; S.init(1, NT / 256, ATT_N / 256, NT / 256, F.G, (int)blockIdx.x);
        pg8::EpiQKV E{WSP(bf16, WS_Q), WSP(bf16, WS_K), WSP(bf16, WS_V), WSP(float, WS_ROPE)};
        pg8::gemm_phase<pg8::EpiQKV, pg8::TileOrder>(F.lds, g, S, E, F.tid);
        BG_SLOT(96, CVT_SPLIT0, CVT_Q1); });
    PHASE(PH_ATTN, { if (OPT_MASK & 256) ph_attn(p, F); else ph_attn_naive(p, F); });
    PHASE(PH_OUT0, {
        pg8::Gemm g{WSP(bf16, WS_O), WSP(bf16, WS_WO0), D * 2, nullptr}; pg8::TileOrder S; S.init(1, NT / 256, D / 256, NT / 256, F.G, (int)blockIdx.x);
        pg8::EpiResidT<false> E{p.x, p.ctx, WSP(xa_t, WS_XA), WSP(float, WS_MOD) + 2048};
        pg8::gemm_phase<pg8::EpiResidT<false>, pg8::TileOrder>(F.lds, g, S, E, F.tid);
        BG_SLOT(64, CVT_Q1, CVT_Q2); });
    PHASE(PH_N2R0, ph_norm2r(p, F, 0));
    PHASE(PH_TOPK0, ph_topkg(p, F, 0));
    PHASE(PH_UP0, {
        pg8::Gemm g{MOE_FP8 ? (const void*)WSP(unsigned char, WS_H8) : (const void*)WSP(bf16, WS_H), WSP(unsigned char, WS_WUP), D * EB, WSP(int, WS_ROWIDX)}; pg8::TileOrder S; S.init(NE, ESLOTS / 256, FF / 128, ESLOTS / 256, F.G, (int)blockIdx.x);
        pg8::EpiSwiglu E{WSP(unsigned char, WS_ACT)};
        pg8::gemm_phase<pg8::EpiSwiglu, pg8::TileOrder, MOE_FP8 != 0, true, true>(F.lds, g, S, E, F.tid);
        BG_SLOT(192, CVT_Q2, CVT_Q3); });
    PHASE(PH_DN0, {
        pg8::Gemm g{WSP(unsigned char, WS_ACT), WSP(unsigned char, WS_WDN), FF * EB, nullptr}; pg8::TileOrder S; S.init(NE, ESLOTS / 256, D / 256, ESLOTS / 256, F.G, (int)blockIdx.x);
        pg8::EpiDown E{WSP(bf16, WS_YS), WSP(float, WS_ROWG)};
        pg8::gemm_phase<pg8::EpiDown, pg8::TileOrder, MOE_FP8 != 0>(F.lds, g, S, E, F.tid);
        BG_SLOT(128, CVT_Q3, NPAIR_ALL); });
    PHASE(PH_COMB0, ph_combine(p, F, 0));
    PHASE(PH_GLAIN, {
        pg8::Gemm g{WSP(bf16, WS_H), WSP(bf16, WS_WGIN), D * 2, nullptr}; pg8::GlaInOrder S{F.G, (int)blockIdx.x};
        pg8::EpiGlaIn E{WSP(bf16, WS_PG)};
        pg8::gemm_phase<pg8::EpiGlaIn, pg8::GlaInOrder>(F.lds, g, S, E, F.tid); });
    PHASE(PH_PREP, { if (OPT_MASK & 512) ph_glaprep(p, F); });
    PHASE(PH_SCAN, { if (OPT_MASK & 512) ph_glascan(p, F); else ph_scan_naive(p, F); });
    PHASE(PH_READ, ph_readout(p, F));
    PHASE(PH_OUT1, {
        pg8::Gemm g{WSP(bf16, WS_H), WSP(bf16, WS_WO1), D * 2, nullptr}; pg8::TileOrder S; S.init(1, NL / 256, D / 256, NL / 256, F.G, (int)blockIdx.x);
        pg8::EpiResidT<true> E{nullptr, nullptr, WSP(xa_t, WS_XA), WSP(float, WS_MOD) + 17 * 6144 + 2048};
        pg8::gemm_phase<pg8::EpiResidT<true>, pg8::TileOrder>(F.lds, g, S, E, F.tid); });
    PHASE(PH_N2R1, ph_norm2r(p, F, 1));
    PHASE(PH_TOPK1, ph_topkg(p, F, 1));
    PHASE(PH_UP1, {
        pg8::Gemm g{MOE_FP8 ? (const void*)WSP(unsigned char, WS_H8) : (const void*)WSP(bf16, WS_H), WSP(unsigned char, WS_WUP) + (size_t)NE * 5632 * D * EB, D * EB, WSP(int, WS_ROWIDX)}; pg8::TileOrder S; S.init(NE, NB * CAPL / 256, FF / 128, ESLOTS / 256, F.G, (int)blockIdx.x);
        pg8::EpiSwiglu E{WSP(unsigned char, WS_ACT)};
        pg8::gemm_phase<pg8::EpiSwiglu, pg8::TileOrder, MOE_FP8 != 0, true, true>(F.lds, g, S, E, F.tid); });
    PHASE(PH_DN1, {
        pg8::Gemm g{WSP(unsigned char, WS_ACT), WSP(unsigned char, WS_WDN) + (size_t)NE * D * FF * EB, FF * EB, nullptr}; pg8::TileOrder S; S.init(NE, NB * CAPL / 256, D / 256, ESLOTS / 256, F.G, (int)blockIdx.x);
        pg8::EpiDown E{WSP(bf16, WS_YS), WSP(float, WS_ROWG)};
        pg8::gemm_phase<pg8::EpiDown, pg8::TileOrder, MOE_FP8 != 0>(F.lds, g, S, E, F.tid); });
    PHASE(PH_COMB1, ph_combine(p, F, 1));
#undef PHASE
#undef IN
#undef SEAM
}

__global__ void __launch_bounds__(256) n_gemm(const bf16* A, int lda, const float* W, int ldw, float* C, int ldc, int M, int N, int K) {
    __shared__ float As[16][65], Bs[16][64];
    const int t = threadIdx.x, tx = t & 15, ty = t >> 4, m0 = blockIdx.y * 64, n0 = blockIdx.x * 64;
    float acc[4][4];
#pragma unroll
    for (int i = 0; i < 4; ++i)
#pragma unroll
        for (int j = 0; j < 4; ++j) acc[i][j] = 0.f;
    for (int k0 = 0; k0 < K; k0 += 16) {
        { const int r = t >> 2, kq = (t & 3) * 4; const v2u w = *(const v2u*)(A + (size_t)(m0 + r) * lda + k0 + kq);
          As[kq + 0][r] = __uint_as_float(w.x << 16); As[kq + 1][r] = __uint_as_float(w.x & 0xffff0000u); As[kq + 2][r] = __uint_as_float(w.y << 16); As[kq + 3][r] = __uint_as_float(w.y & 0xffff0000u); }
        { const int k = t >> 4, n = (t & 15) * 4;
#pragma unroll
          for (int j = 0; j < 4; ++j) Bs[k][n + j] = (n0 + n + j < N) ? W[(size_t)(k0 + k) * ldw + n0 + n + j] : 0.f; }
        __syncthreads();
#pragma unroll
        for (int kk = 0; kk < 16; ++kk) { float a[4], b[4];
#pragma unroll
            for (int i = 0; i < 4; ++i) { a[i] = As[kk][ty * 4 + i]; b[i] = Bs[kk][tx * 4 + i]; }
#pragma unroll
            for (int i = 0; i < 4; ++i)
#pragma unroll
                for (int j = 0; j < 4; ++j) acc[i][j] += a[i] * b[j]; }
        __syncthreads();
    }
#pragma unroll
    for (int i = 0; i < 4; ++i)
#pragma unroll
        for (int j = 0; j < 4; ++j) if (n0 + tx * 4 + j < N) C[(size_t)(m0 + ty * 4 + i) * ldc + n0 + tx * 4 + j] = acc[i][j];
}
__global__ void n_post_qkv(const float* T, int r0, int rows, bf16* Q, bf16* Kb, bf16* Vb) {
    const size_t i = (size_t)blockIdx.x * blockDim.x + threadIdx.x; if (i >= (size_t)rows * ATT_N) return;
    const int rl = (int)(i / ATT_N), c = (int)(i % ATT_N), r = r0 + rl; float val = T[i];
    if (c < 1280 && r < NL) { const int d = c & 63, a = d >> 5, s = (d >> 4) & 1, f = d & 15, t = r & (SEQ - 1); const float xp = T[(size_t)rl * ATT_N + (s ? c - 16 : c + 16)];
        const float inv = powf(10000.f, -(float)f / 16.f), ang = (float)(a ? (t & 63) : (t >> 6)) * inv, cs = cosf(ang), sn = sinf(ang);
        val = s == 0 ? val * cs - xp * sn : val * cs + xp * sn; }
    if (c < 1024) Q[(size_t)r * 1024 + c] = (bf16)f2bf(val * QSCALE); else if (c < 1280) Kb[(size_t)r * 256 + c - 1024] = (bf16)f2bf(val); else Vb[(size_t)r * 256 + c - 1280] = (bf16)f2bf(val);
}
__global__ void n_post_resid(const float* T, int r0, int rows, const float* xlat, const float* xctx, float* XA, const float* mod_g) {
    const size_t i = (size_t)blockIdx.x * blockDim.x + threadIdx.x; if (i >= (size_t)rows * D) return;
    const int rl = (int)(i / D), c = (int)(i % D), r = r0 + rl; const int j = r < NL ? r / SEQ : 16;
    const float xs = r < NL ? xlat[(size_t)r * D + c] : xctx[(size_t)(r - NL) * D + c];
    XA[(size_t)r * D + c] = xs + mod_g[(size_t)j * 6144 + c] * T[i];
}
__global__ void n_post_swiglu(const float* T, int rows, bf16* ACTrow0) {
    const size_t i = (size_t)blockIdx.x * blockDim.x + threadIdx.x; if (i >= (size_t)rows * FF) return;
    const int rl = (int)(i / FF), f = (int)(i % FF); const float g = T[(size_t)rl * 5632 + f], u = T[(size_t)rl * 5632 + FF + f];
    ACTrow0[(size_t)rl * FF + f] = (bf16)f2bf(silu_f(g) * u);
}
__global__ void n_post_down(const float* T, int rows, bf16* YSrow0, const float* rowg0) {
    const size_t i = (size_t)blockIdx.x * blockDim.x + threadIdx.x; if (i >= (size_t)rows * D) return;
    const int rl = (int)(i / D); YSrow0[i] = (bf16)f2bf(rowg0[rl] * T[i]);
}
__global__ void n_post_cast(const float* T, size_t n, bf16* O) { const size_t i = (size_t)blockIdx.x * blockDim.x + threadIdx.x; if (i < n) O[i] = (bf16)f2bf(T[i]); }
__global__ void __launch_bounds__(256) n_attn(const bf16* Q, const bf16* Kb, const bf16* Vb, const float* sink, bf16* O) {
    const int i = blockIdx.x * blockDim.x + threadIdx.x; if (i >= NT * NQH) return;
    const int r = i >> 4, hq = i & 15, hk = hq >> 2;
    float q[64], acc[64];
#pragma unroll
    for (int d = 0; d < 64; ++d) { q[d] = bf2f(Q[(size_t)r * 1024 + hq * 64 + d]); acc[d] = 0.f; }
    float m = sink[hq] * LOG2E, l = 1.f;
    const bool lat = r < NL; const int b = lat ? r / SEQ : (r - NL) / CTX, t = r & (SEQ - 1);
    const int nlat = lat ? (min(SEQ - 1, t + 128) - max(0, t - 128) + 1) : 0, klo = max(0, t - 128);
    for (int kk = 0; kk < CTX + nlat; ++kk) {
        const int kr = kk < CTX ? NL + b * CTX + kk : b * SEQ + klo + (kk - CTX);
        const bf16* kp = Kb + (size_t)kr * 256 + hk * 64; const bf16* vp = Vb + (size_t)kr * 256 + hk * 64;
        float s = 0.f;
#pragma unroll
        for (int d = 0; d < 64; ++d) s += q[d] * bf2f(kp[d]);
        const float mn = fmaxf(m, s), sc = exp2f(m - mn), pe = exp2f(s - mn);
        l = l * sc + pe; m = mn;
#pragma unroll
        for (int d = 0; d < 64; ++d) acc[d] = acc[d] * sc + pe * bf2f(vp[d]);
    }
    const float il = 1.f / l;
#pragma unroll
    for (int d = 0; d < 64; ++d) O[(size_t)r * 1024 + hq * 64 + d] = (bf16)f2bf(acc[d] * il);
}
__global__ void __launch_bounds__(512) n_glascan(const bf16* PG, const float* w2, const float* gb, bf16* OF, bf16* OB) {
    const int u = blockIdx.x, sl = u & 3, dir = (u >> 2) & 1, h = (u >> 3) & 3, b = u >> 5;
    __shared__ float sq[128], sk[128], sa[128], sv[64], so[8][64];
    const int tid = threadIdx.x, e = tid & 63, w = tid >> 6;
    float S[16];
#pragma unroll
    for (int i = 0; i < 16; ++i) S[i] = 0.f;
    bf16* OUT = dir ? OB : OF;
    for (int step = 0; step < CTX + SEQ; ++step) {
        int row; if (step < CTX) row = NL + b * CTX + (dir ? CTX - 1 - step : step); else { const int t = step - CTX; row = b * SEQ + (dir ? SEQ - 1 - t : t); }
        const bf16* pr = PG + (size_t)row * GIN;
        if (tid < 128) { const int col = h * 128 + tid; float z = gb[dir * 512 + col];
#pragma unroll
            for (int r = 0; r < 16; ++r) z += bf2f(pr[3072 + dir * 16 + r]) * w2[(size_t)(dir * 16 + r) * 512 + col];
            const float ls = fminf(z, 0.f) - log1pf(expf(-fabsf(z)));
            sq[tid] = bf2f(pr[col]) * GLA_QS; sk[tid] = bf2f(pr[GQR + col]); sa[tid] = expf(ls * (1.f / 16.f)); }
        else if (tid < 192) sv[tid - 128] = bf2f(pr[GQR + GQK + h * 256 + sl * 64 + tid - 128]);
        __syncthreads();
        const float v = sv[e]; float o = 0.f;
#pragma unroll
        for (int i = 0; i < 16; ++i) { const int d = 16 * w + i; S[i] = sa[d] * S[i] + sk[d] * v; o += sq[d] * S[i]; }
        so[w][e] = o;
        __syncthreads();
        if (step >= CTX && tid < 64) { float s = 0.f;
#pragma unroll
            for (int q = 0; q < 8; ++q) s += so[q][tid];
            OUT[(size_t)row * GV + h * 256 + sl * 64 + tid] = (bf16)f2bf(s); }
    }
}

static void launch_phase(P p, int lo, int hi, int grid, hipStream_t stream) { p.lo = lo; p.hi = hi; hipLaunchKernelGGL(k_fwd, dim3(grid), dim3(NWAVES * 64), LDS_BYTES, stream, p); }
static void naive_gemm(const bf16* A, int lda, const float* W, int ldw, float* C, int ldc, int M, int N, int K, hipStream_t s) {
    hipLaunchKernelGGL(n_gemm, dim3((N + 63) / 64, M / 64), dim3(256), 0, s, A, lda, W, ldw, C, ldc, M, N, K);
}
#define EW_GRID(n) dim3((unsigned)(((size_t)(n) + 255) / 256)), dim3(256), 0, stream

extern "C" void kernel_launch(void* const* d_in, const int* in_sizes, int n_in, void* d_out, int out_size, void* d_ws, size_t ws_size, hipStream_t stream) {
    static int grid = 0;
    if (grid == 0) {
        if (n_in != 21 || out_size != NL * D || ws_size < WS_END) { fprintf(stderr, "kernel_launch: unexpected shapes (n_in %d out %d ws %zu need %zu)\n", n_in, out_size, ws_size, (size_t)WS_END); grid = -1; return; }
        int dev = 0, cus = 0;
        if (hipGetDevice(&dev) != hipSuccess || hipDeviceGetAttribute(&cus, hipDeviceAttributeMultiprocessorCount, dev) != hipSuccess) { grid = -1; return; }
        if (hipFuncSetAttribute((const void*)k_fwd, hipFuncAttributeMaxDynamicSharedMemorySize, LDS_BYTES) != hipSuccess) { fprintf(stderr, "kernel_launch: hipFuncSetAttribute failed\n"); grid = -1; return; }
        int per_cu = 0;
        if (hipOccupancyMaxActiveBlocksPerMultiprocessor(&per_cu, (const void*)k_fwd, NWAVES * 64, LDS_BYTES) != hipSuccess || per_cu < 1) fprintf(stderr, "kernel_launch: occupancy query says %d\n", per_cu);
        (void)hipGetLastError();
        grid = cus;
    }
    if (grid < 0) return;
    hipMemsetAsync((char*)d_ws + WS_CTL, 0, CTL_ZERO_BYTES, stream);
    P p{};
    const float** pp = (const float**)&p;
    for (int i = 0; i < 21; ++i) pp[i] = (const float*)d_in[i];
    p.out = (float*)d_out; p.ws = (unsigned char*)d_ws; p.lo = 0; p.hi = 0;
    unsigned char* ws = (unsigned char*)d_ws;
#define WS(T, off) ((T*)(ws + (off)))
#if ONE_LAUNCH
    launch_phase(p, 0, PH_END, grid, stream);
#else
    float* TMP = WS(float, WS_TMP);
    launch_phase(p, PH_PRO, PH_PRO + 1, grid, stream);
    launch_phase(p, PH_NORM1_0, PH_NORM1_0 + 1, grid, stream);
    if (OPT_MASK & 1) launch_phase(p, PH_QKV, PH_QKV + 1, grid, stream);
    else for (int ch = 0; ch < NT / 2048; ++ch) { const int r0 = ch * 2048;
        naive_gemm(WS(bf16, WS_H) + (size_t)r0 * D, D, p.attn_w_in, ATT_N, TMP, ATT_N, 2048, ATT_N, D, stream);
        hipLaunchKernelGGL(n_post_qkv, EW_GRID((size_t)2048 * ATT_N), TMP, r0, 2048, WS(bf16, WS_Q), WS(bf16, WS_K), WS(bf16, WS_V)); }
    if (OPT_MASK & 256) launch_phase(p, PH_ATTN, PH_ATTN + 1, grid, stream);
    else hipLaunchKernelGGL(n_attn, dim3(NT * NQH / 256), dim3(256), 0, stream, WS(bf16, WS_Q), WS(bf16, WS_K), WS(bf16, WS_V), p.attn_sink, WS(bf16, WS_O));
    if (OPT_MASK & 2) launch_phase(p, PH_OUT0, PH_OUT0 + 1, grid, stream);
    else for (int ch = 0; ch < NT / 2048; ++ch) { const int r0 = ch * 2048;
        naive_gemm(WS(bf16, WS_O) + (size_t)r0 * D, D, p.attn_w_out, D, TMP, D, 2048, D, D, stream);
        hipLaunchKernelGGL(n_post_resid, EW_GRID((size_t)2048 * D), TMP, r0, 2048, p.x, p.ctx, WS(float, WS_XA), WS(float, WS_MOD) + 2048); }
    launch_phase(p, PH_N2R0, PH_N2R0 + 1, grid, stream);
    launch_phase(p, PH_TOPK0, PH_TOPK0 + 1, grid, stream);
    for (int l = 0; l < 2; ++l) {
        if (l == 1) {
            if (OPT_MASK & 16) launch_phase(p, PH_GLAIN, PH_GLAIN + 1, grid, stream);
            else for (int ch = 0; ch < NT / 2048; ++ch) { const int r0 = ch * 2048;
                naive_gemm(WS(bf16, WS_H) + (size_t)r0 * D, D, p.gla_w_in, GIN, TMP, GIN, 2048, GIN, D, stream);
                hipLaunchKernelGGL(n_post_cast, EW_GRID((size_t)2048 * GIN), TMP, (size_t)2048 * GIN, WS(bf16, WS_PG) + (size_t)r0 * GIN); }
            if (OPT_MASK & 512) launch_phase(p, PH_SCAN, PH_SCAN + 1, grid, stream);
            else hipLaunchKernelGGL(n_glascan, dim3(512), dim3(512), 0, stream, WS(bf16, WS_PG), p.gla_gate_w2, p.gla_gate_b, WS(bf16, WS_OF), WS(bf16, WS_OB));
            launch_phase(p, PH_READ, PH_READ + 1, grid, stream);
            if (OPT_MASK & 32) launch_phase(p, PH_OUT1, PH_OUT1 + 1, grid, stream);
            else for (int ch = 0; ch < NL / 2048; ++ch) { const int r0 = ch * 2048;
                naive_gemm(WS(bf16, WS_H) + (size_t)r0 * D, D, p.gla_w_out, D, TMP, D, 2048, D, D, stream);
                hipLaunchKernelGGL(n_post_resid, EW_GRID((size_t)2048 * D), TMP, r0, 2048, WS(float, WS_XA), WS(float, WS_XA), WS(float, WS_XA), WS(float, WS_MOD) + 17 * 6144 + 2048); }
            launch_phase(p, PH_N2R1, PH_N2R1 + 1, grid, stream);
            launch_phase(p, PH_TOPK1, PH_TOPK1 + 1, grid, stream);
        }
        const int rows_e = l == 0 ? ESLOTS : NB * CAPL, chunk = l == 0 ? 2304 : 2048;
        const bool up_opt = OPT_MASK & (l == 0 ? 4 : 64), dn_opt = OPT_MASK & (l == 0 ? 8 : 128);
        if (up_opt && dn_opt) { launch_phase(p, l == 0 ? PH_UP0 : PH_UP1, (l == 0 ? PH_UP0 : PH_UP1) + 1, grid, stream); launch_phase(p, l == 0 ? PH_DN0 : PH_DN1, (l == 0 ? PH_DN0 : PH_DN1) + 1, grid, stream); }
        else {
            if (up_opt) launch_phase(p, l == 0 ? PH_UP0 : PH_UP1, (l == 0 ? PH_UP0 : PH_UP1) + 1, grid, stream);
            else for (int e = 0; e < NE; ++e) for (int r0 = 0; r0 < rows_e; r0 += chunk) {
                const size_t row = (size_t)e * ESLOTS + r0; const size_t le = (size_t)(l * NE + e);
                naive_gemm(WS(bf16, WS_XG) + row * D, D, p.exp_w_gate + le * D * FF, FF, TMP, 5632, chunk, FF, D, stream);
                naive_gemm(WS(bf16, WS_XG) + row * D, D, p.exp_w_up + le * D * FF, FF, TMP + FF, 5632, chunk, FF, D, stream);
                hipLaunchKernelGGL(n_post_swiglu, EW_GRID((size_t)chunk * FF), TMP, chunk, WS(bf16, WS_ACT) + row * FF); }
            if (dn_opt) launch_phase(p, l == 0 ? PH_DN0 : PH_DN1, (l == 0 ? PH_DN0 : PH_DN1) + 1, grid, stream);
            else for (int e = 0; e < NE; ++e) for (int r0 = 0; r0 < rows_e; r0 += chunk) {
                const size_t row = (size_t)e * ESLOTS + r0; const size_t le = (size_t)(l * NE + e);
                naive_gemm(WS(bf16, WS_ACT) + row * FF, FF, p.exp_w_down + le * FF * D, D, TMP, D, chunk, D, FF, stream);
                hipLaunchKernelGGL(n_post_down, EW_GRID((size_t)chunk * D), TMP, chunk, WS(bf16, WS_YS) + row * D, WS(float, WS_ROWG) + row); }
        }
        launch_phase(p, l == 0 ? PH_COMB0 : PH_COMB1, (l == 0 ? PH_COMB0 : PH_COMB1) + 1, grid, stream);
    }
#endif
}
```

```cpp
#include <hip/hip_runtime.h>
#include <cstdio>
#include <cstdint>

#ifndef OPT_MASK
#define OPT_MASK 0x3FF
#endif
#ifndef MOE_FP8
#define MOE_FP8 1
#endif
#ifndef PROBE_MASK
#define PROBE_MASK 0
#endif
#ifndef ONE_LAUNCH
#define ONE_LAUNCH 1
#endif

#define GAS __attribute__((address_space(1)))
#define LAS __attribute__((address_space(3)))
typedef unsigned short bf16;
typedef unsigned v4u __attribute__((ext_vector_type(4)));
typedef unsigned v2u __attribute__((ext_vector_type(2)));
typedef float f32x4 __attribute__((ext_vector_type(4)));
typedef float f32x2 __attribute__((ext_vector_type(2)));
typedef short bf16x8 __attribute__((ext_vector_type(8)));

constexpr int D = 1024, NB = 16, SEQ = 2048, CTX = 256;
constexpr int NL = NB * SEQ, NC = NB * CTX, NT = NL + NC;
constexpr int NQH = 16, NKV = 4, HD = 64, ATT_N = 1536;
constexpr int GH = 4, GDK = 128, GDV = 256, GQK = 512, GV = 1024, GQR = 1536, GIN = 3104, GIN_PAD = 3328;
constexpr int NE = 16, FF = 2816, CAPL = 256, CAPC = 32, ESLOTS = NB * CAPL + NB * CAPC;
constexpr float EPS = 1e-6f;
constexpr float LOG2E = 1.4426950408889634f;
constexpr float QSCALE = 0.125f * LOG2E;
constexpr float GLA_QS = 0.08838834764831845f;
constexpr int EB = MOE_FP8 ? 1 : 2;
constexpr float F8_ACT = 16.f, F8_W = 256.f, F8_INV = 1.f / (16.f * 256.f);

constexpr size_t MiB = 1ull << 20;
constexpr size_t WS_CTL = 0, CTL_ZERO_BYTES = 1 * MiB;
constexpr size_t WS_MOD = 1 * MiB;
constexpr size_t WS_ROPE = WS_MOD + 896 * 1024;
constexpr size_t WS_WQKV = 2 * MiB;
constexpr size_t WS_WO0 = 5 * MiB;
constexpr size_t WS_WGIN = 7 * MiB;
constexpr size_t WS_WO1 = 14 * MiB;
constexpr size_t WS_AFF = 16 * MiB;
constexpr size_t WS_SLOT = 19 * MiB;
constexpr size_t WS_ROWIDX = 22 * MiB;
constexpr size_t WS_ROWG = 22 * MiB + 512 * 1024;
constexpr size_t WS_WUP = 24 * MiB;
constexpr size_t WS_WDN = WS_WUP + 352 * MiB;
constexpr size_t WS_XA = WS_WDN + 176 * MiB;
constexpr size_t WS_H = WS_XA + 144 * MiB;
constexpr size_t WS_E = WS_H + 72 * MiB;
constexpr size_t WS_Q = WS_E, WS_K = WS_E + 72 * MiB, WS_V = WS_E + 90 * MiB, WS_O = WS_E + 108 * MiB;
constexpr size_t WS_PG = WS_E, WS_OF = WS_E + 220 * MiB, WS_OB = WS_E + 284 * MiB;
constexpr size_t WS_QT = WS_E + 348 * MiB, WS_KT = WS_E + 420 * MiB, WS_DEC = WS_E + 492 * MiB;
constexpr size_t WS_XG = WS_E, WS_YS = WS_E, WS_ACT = WS_E + 144 * MiB;
constexpr size_t WS_H8 = WS_E;
constexpr size_t WS_TMP = WS_E + 540 * MiB;
constexpr size_t WS_END = WS_TMP + 50 * MiB;
constexpr int CW_BAR = 4096;

constexpr int RING_BYTES = 131072;
constexpr int LDS_BYTES = 147456;
constexpr int LDSCTL_OFF = LDS_BYTES - 1024, MISC_OFF = LDSCTL_OFF + 320;
constexpr int NWAVES = 8;

__device__ __forceinline__ float bf2f(bf16 v) { return __uint_as_float(((unsigned)v) << 16); }
typedef __bf16 hwbf16x2 __attribute__((ext_vector_type(2)));
__device__ __forceinline__ unsigned pk2(float lo, float hi) { const f32x2 v = {lo, hi}; return __builtin_bit_cast(unsigned, __builtin_convertvector(v, hwbf16x2)); }
__device__ __forceinline__ unsigned f2bf(float f) { return pk2(f, 0.f) & 0xffffu; }
__device__ __forceinline__ float clamp448(float v) { return __builtin_fminf(__builtin_fmaxf(v, -448.f), 448.f); }
__device__ __forceinline__ unsigned pk4_fp8(float a, float b, float c, float d) { int w = 0; w = __builtin_amdgcn_cvt_pk_fp8_f32(clamp448(a), clamp448(b), w, false); w = __builtin_amdgcn_cvt_pk_fp8_f32(clamp448(c), clamp448(d), w, true); return (unsigned)w; }
typedef _Float16 f16x4 __attribute__((ext_vector_type(4)));
typedef unsigned short xa_t;
__device__ __forceinline__ v2u pack_h4(f32x4 v) { return __builtin_bit_cast(v2u, __builtin_convertvector(v, f16x4)); }
__device__ __forceinline__ f32x4 unpack_h4(v2u w) { return __builtin_convertvector(__builtin_bit_cast(f16x4, w), f32x4); }
template <int CTRL, int RMASK> __device__ __forceinline__ float dpp_add(float x) { return x + __builtin_bit_cast(float, __builtin_amdgcn_update_dpp(0, __builtin_bit_cast(int, x), CTRL, RMASK, 0xf, false)); }
__device__ __forceinline__ float wave_sum(float v) {
    v = dpp_add<0xB1, 0xf>(v);
    v = dpp_add<0x4E, 0xf>(v);
    v = dpp_add<0x141, 0xf>(v);
    v = dpp_add<0x140, 0xf>(v);
    v = dpp_add<0x142, 0xa>(v);
    v = dpp_add<0x143, 0xc>(v);
    return __builtin_bit_cast(float, __builtin_amdgcn_readlane(__builtin_bit_cast(int, v), 63));
}
__device__ __forceinline__ float silu_f(float v) { return v / (1.f + expf(-v)); }
__device__ __forceinline__ float fexp(float x) { return __builtin_amdgcn_exp2f(x * LOG2E); }
__device__ __forceinline__ float flog(float x) { return __builtin_amdgcn_logf(x) * 0.6931471805599453f; }
__device__ __forceinline__ float fsilu(float v) { return v * __builtin_amdgcn_rcpf(1.f + fexp(-v)); }
template <int d> __device__ __forceinline__ float dpp_shr(float x) { return __builtin_bit_cast(float, __builtin_amdgcn_update_dpp(0, __builtin_bit_cast(int, x), 0x110 + d, 0xf, 0xf, true)); }
#define LDS_WAIT() asm volatile("s_waitcnt lgkmcnt(0)" ::: "memory")
#define LDS_SYNC() asm volatile("s_waitcnt lgkmcnt(0)\n\ts_barrier" ::: "memory")
#define VM_WAIT() asm volatile("s_waitcnt vmcnt(0)" ::: "memory")

struct P {
    const float *x, *c, *ctx, *c_ctx, *ada_w, *ada_b, *norm1_g, *norm2_g, *attn_w_in, *attn_w_out, *attn_sink,
        *gla_w_in, *gla_gate_w2, *gla_gate_b, *gla_norm_g, *gla_w_out, *router_w, *exp_w_gate, *exp_w_up, *exp_w_down, *final_norm_g;
    float* out; unsigned char* ws;
    int lo, hi;
};

namespace pg8 {
#define PG8_LAS __attribute__((address_space(3)))
typedef unsigned short bf16_t;
typedef unsigned u32x4 __attribute__((ext_vector_type(4)));
typedef unsigned u32x2 __attribute__((ext_vector_type(2)));
constexpr int BM = 256, BK = 64, HALF = 128, HTB = HALF * BK * 2, STAGE_BYTES = 8 * HTB, NXCD = 8, WGM = 8;
__host__ __device__ __forceinline__ int lds_byte(int r, int c) { const int st = (r >> 4) * 2 + (c >> 5), rr = r & 15, cc = c & 31, ob = rr * 64 + cc * 2; return st * 1024 + (ob ^ (((ob >> 9) & 1) << 5)); }
__host__ __device__ __forceinline__ void stage_rc(int b, int& R, int& C) { const int st = b / 1024, sb = b % 1024, swz = sb ^ (((sb >> 9) & 1) << 5); R = (st >> 1) * 16 + swz / 64; C = (st & 1) * 32 + (swz % 64) / 2; }
__host__ __device__ __forceinline__ int perm32(int rho) { const int n = rho >> 4, i = rho & 15; return 8 * (i >> 2) + 4 * n + (i & 3); }
struct Unit { int pm, pn; };
struct Gemm { const void* A; const void* Bt; int KB; const int* gidx; };
struct TileOrder {
    int nG, nM, nN, sM, G, c, per, nwg;
    __device__ __forceinline__ void init(int nG_, int nM_, int nN_, int sM_, int G_, int c_) { nG = nG_; nM = nM_; nN = nN_; sM = sM_; G = G_; c = c_; per = nM * nN; nwg = nG * per; }
    __device__ __forceinline__ bool next(int i, Unit& u) const {
        const long L = (long)i * G + c; if (L >= nwg) return false;
        int wgid = (int)L; { const int q = nwg / NXCD, r = nwg % NXCD, xcd = wgid % NXCD, off = wgid / NXCD; wgid = (xcd < r ? xcd * (q + 1) : r * (q + 1) + (xcd - r) * q) + off; }
        const int g = wgid / per, rem = wgid % per;
        const int nig = WGM * nN, gid = rem / nig, fm = gid * WGM, gsz = (nM - fm) < WGM ? (nM - fm) : WGM;
        u.pm = g * sM + fm + ((rem % nig) % gsz); u.pn = g * nN + (rem % nig) / gsz; return true;
    }
};
struct GlaInOrder {
    int G, c;
    __device__ __forceinline__ bool next(int i, Unit& u) const {
        constexpr int NLAT = (NL / BM) * 13, NALL = NLAT + (NC / BM) * 7;
        const long L = (long)i * G + c; if (L >= NALL) return false;
        int wgid = (int)L; { const int q = NALL / NXCD, xcd = wgid % NXCD, off = wgid / NXCD; wgid = xcd * q + off; }
        if (wgid < NLAT) { const int nig = WGM * 13, gid = wgid / nig, fm = gid * WGM; u.pm = fm + ((wgid % nig) % WGM); u.pn = (wgid % nig) / WGM; }
        else { const int r = wgid - NLAT; u.pm = NL / BM + (r & 15); u.pn = 6 + (r >> 4); }
        return true;
    }
};
__device__ __forceinline__ unsigned cvt_pk_bf16(float lo, float hi) { unsigned r; asm volatile("v_cvt_pk_bf16_f32 %0, %1, %2" : "=v"(r) : "v"(lo), "v"(hi)); return r; }

struct EpiQKV {
    static constexpr bool PERM = false;
    bf16_t *Q, *Kb, *Vb; const float* rope;
    __device__ __forceinline__ void operator()(const f32x4 (&acc)[2][2][4][2], const Unit& u, int wr, int wc, int fr, int fq) const {
        const int row0 = u.pm * BM + wr * 64 + fr; const bool latent = u.pm < (NL / BM);
        const int kind = u.pn < 4 ? 0 : (u.pn == 4 ? 1 : 2);
        const size_t boff = (kind >= 1 ? (size_t)(WS_K - WS_Q) / 2 : 0) + (kind == 2 ? (size_t)(WS_V - WS_K) / 2 : 0);
        bf16_t* base = Q + boff; const int ldc = kind == 0 ? 1024 : 256; const int colt = kind == 0 ? u.pn * BM : 0;
        const float sc = kind == 0 ? QSCALE : 1.f;
        f32x4 rc0[2][4], rc1[2][4];
#pragma unroll
        for (int ai = 0; ai < 2; ++ai)
#pragma unroll
            for (int m = 0; m < 4; ++m) { const int t = (row0 + ai * HALF + m * 16) & (SEQ - 1);
                rc0[ai][m] = (f32x4){1.f, 0.f, 1.f, 0.f}; rc1[ai][m] = rc0[ai][m];
                if (latent && kind != 2) { const int pos = (wc & 1) ? (t & 63) : (t >> 6); const f32x4* tp = (const f32x4*)(rope + (size_t)(pos * 16 + 4 * fq) * 2); rc0[ai][m] = tp[0]; rc1[ai][m] = tp[1]; } }
#pragma unroll
        for (int ai = 0; ai < 2; ++ai)
#pragma unroll
            for (int m = 0; m < 4; ++m) {
                const int r = row0 + ai * HALF + m * 16;
                const f32x4 cs0 = rc0[ai][m], cs1 = rc1[ai][m];
                const float cs[4] = {cs0[0], cs0[2], cs1[0], cs1[2]}, sn[4] = {cs0[1], cs0[3], cs1[1], cs1[3]};
                bf16_t* rowp = base + (size_t)r * ldc + colt + wc * 32 + 4 * fq;
#pragma unroll
                for (int bj = 0; bj < 2; ++bj) {
                    const f32x4 x0 = acc[ai][bj][m][0], x1 = acc[ai][bj][m][1]; float o0[4], o1[4];
#pragma unroll
                    for (int j = 0; j < 4; ++j) { o0[j] = (x0[j] * cs[j] - x1[j] * sn[j]) * sc; o1[j] = (x1[j] * cs[j] + x0[j] * sn[j]) * sc; }
                    u32x2 w0, w1; w0.x = cvt_pk_bf16(o0[0], o0[1]); w0.y = cvt_pk_bf16(o0[2], o0[3]); w1.x = cvt_pk_bf16(o1[0], o1[1]); w1.y = cvt_pk_bf16(o1[2], o1[3]);
                    *(u32x2*)(rowp + bj * HALF) = w0; *(u32x2*)(rowp + bj * HALF + 16) = w1;
                }
            }
    }
};
template <bool SRC16>
struct EpiResidT {
    static constexpr bool PERM = false;
    const float *xlat, *xctx; xa_t* XA; const float* mod_g;
    __device__ __forceinline__ void operator()(const f32x4 (&acc)[2][2][4][2], const Unit& u, int wr, int wc, int fr, int fq) const {
        const int row0 = u.pm * BM + wr * 64 + fr, col0 = u.pn * BM + wc * 32 + 4 * fq; const bool latent = u.pm < (NL / BM);
        const float* src = latent ? xlat : xctx - (size_t)NL * D; const int j = latent ? (u.pm >> 3) : 16;
        f32x4 gv[2][2];
#pragma unroll
        for (int bj = 0; bj < 2; ++bj)
#pragma unroll
            for (int n = 0; n < 2; ++n) gv[bj][n] = *(const f32x4*)(mod_g + (size_t)j * 6144 + col0 + bj * HALF + n * 16);
#pragma unroll
        for (int ai = 0; ai < 2; ++ai)
#pragma unroll
            for (int mp = 0; mp < 2; ++mp) { f32x4 xs[2][2][2]; v2u xh[2][2][2];
#pragma unroll
                for (int mm = 0; mm < 2; ++mm) { const size_t off = (size_t)(row0 + ai * HALF + (2 * mp + mm) * 16) * D + col0;
#pragma unroll
                    for (int bj = 0; bj < 2; ++bj)
#pragma unroll
                        for (int n = 0; n < 2; ++n) { if constexpr (SRC16) xh[mm][bj][n] = *(const v2u*)(XA + off + bj * HALF + n * 16); else xs[mm][bj][n] = *(const f32x4*)(src + off + bj * HALF + n * 16); } }
                if constexpr (SRC16) asm volatile("" : "+v"(xh[0][0][0]), "+v"(xh[0][0][1]), "+v"(xh[0][1][0]), "+v"(xh[0][1][1]), "+v"(xh[1][0][0]), "+v"(xh[1][0][1]), "+v"(xh[1][1][0]), "+v"(xh[1][1][1]) :: "memory");
                else asm volatile("" : "+v"(xs[0][0][0]), "+v"(xs[0][0][1]), "+v"(xs[0][1][0]), "+v"(xs[0][1][1]), "+v"(xs[1][0][0]), "+v"(xs[1][0][1]), "+v"(xs[1][1][0]), "+v"(xs[1][1][1]) :: "memory");
#pragma unroll
                for (int mm = 0; mm < 2; ++mm) { const size_t off = (size_t)(row0 + ai * HALF + (2 * mp + mm) * 16) * D + col0;
#pragma unroll
                    for (int bj = 0; bj < 2; ++bj)
#pragma unroll
                        for (int n = 0; n < 2; ++n) { const f32x4 xin = SRC16 ? unpack_h4(xh[mm][bj][n]) : xs[mm][bj][n];
                            *(v2u*)(XA + off + bj * HALF + n * 16) = pack_h4(xin + gv[bj][n] * acc[ai][bj][2 * mp + mm][n]); } }
                asm volatile("" ::: "memory"); }
    }
};
struct EpiSwiglu {
    static constexpr bool PERM = true;
    unsigned char* ACT;
    __device__ __forceinline__ void operator()(const f32x4 (&acc)[2][2][4][2], const Unit& u, int wr, int wc, int fr, int fq) const {
        const int row0 = u.pm * BM + wr * 64 + fr, nl = u.pn % (FF / 128), col0 = nl * 128 + wc * 32 + 8 * fq;
        const float sin_ = MOE_FP8 ? F8_INV : 1.f, sout = MOE_FP8 ? F8_ACT : 1.f;
#pragma unroll
        for (int ai = 0; ai < 2; ++ai)
#pragma unroll
            for (int m = 0; m < 4; ++m) { float o[8];
#pragma unroll
                for (int n = 0; n < 2; ++n)
#pragma unroll
                    for (int j = 0; j < 4; ++j) { const float g = acc[ai][0][m][n][j] * sin_, up = acc[ai][1][m][n][j] * sin_; o[n * 4 + j] = g * __builtin_amdgcn_rcpf(1.f + __builtin_amdgcn_exp2f(g * -1.4426950408889634f)) * (up * sout); }
                unsigned char* dst = ACT + ((size_t)(row0 + ai * HALF + m * 16) * FF + col0) * EB;
                if (MOE_FP8) { u32x2 w; w.x = pk4_fp8(o[0], o[1], o[2], o[3]); w.y = pk4_fp8(o[4], o[5], o[6], o[7]); *(u32x2*)dst = w; }
                else { u32x4 w; w.x = cvt_pk_bf16(o[0], o[1]); w.y = cvt_pk_bf16(o[2], o[3]); w.z = cvt_pk_bf16(o[4], o[5]); w.w = cvt_pk_bf16(o[6], o[7]); *(u32x4*)dst = w; } }
    }
};
struct EpiDown {
    static constexpr bool PERM = true;
    bf16_t* YS; const float* rowg;
    __device__ __forceinline__ void operator()(const f32x4 (&acc)[2][2][4][2], const Unit& u, int wr, int wc, int fr, int fq) const {
        const int row0 = u.pm * BM + wr * 64 + fr, col0 = (u.pn & 3) * BM + wc * 32 + 8 * fq;
        float gr[2][4];
#pragma unroll
        for (int ai = 0; ai < 2; ++ai)
#pragma unroll
            for (int m = 0; m < 4; ++m) gr[ai][m] = rowg[row0 + ai * HALF + m * 16];
#pragma unroll
        for (int ai = 0; ai < 2; ++ai)
#pragma unroll
            for (int m = 0; m < 4; ++m) { const int r = row0 + ai * HALF + m * 16; const float g = gr[ai][m] * (MOE_FP8 ? F8_INV : 1.f);
#pragma unroll
                for (int bj = 0; bj < 2; ++bj) { const f32x4 v0 = acc[ai][bj][m][0] * g, v1 = acc[ai][bj][m][1] * g;
                    u32x4 w; w.x = cvt_pk_bf16(v0[0], v0[1]); w.y = cvt_pk_bf16(v0[2], v0[3]); w.z = cvt_pk_bf16(v1[0], v1[1]); w.w = cvt_pk_bf16(v1[2], v1[3]);
                    *(u32x4*)(YS + (size_t)r * D + col0 + bj * HALF) = w; } }
    }
};
struct EpiGlaIn {
    static constexpr bool PERM = true;
    bf16_t* PG;
    __device__ __forceinline__ void operator()(const f32x4 (&acc)[2][2][4][2], const Unit& u, int wr, int wc, int fr, int fq) const {
        const int row0 = u.pm * BM + wr * 64 + fr, col0 = u.pn * BM + wc * 32 + 8 * fq;
#pragma unroll
        for (int ai = 0; ai < 2; ++ai)
#pragma unroll
            for (int m = 0; m < 4; ++m) { const int r = row0 + ai * HALF + m * 16;
#pragma unroll
                for (int bj = 0; bj < 2; ++bj) { const f32x4 v0 = acc[ai][bj][m][0], v1 = acc[ai][bj][m][1];
                    u32x4 w; w.x = cvt_pk_bf16(v0[0], v0[1]); w.y = cvt_pk_bf16(v0[2], v0[3]); w.z = cvt_pk_bf16(v1[0], v1[1]); w.w = cvt_pk_bf16(v1[2], v1[3]);
                    if (col0 + bj * HALF < GIN) *(u32x4*)(PG + (size_t)r * GIN + col0 + bj * HALF) = w; } }
    }
};

typedef int v8i __attribute__((ext_vector_type(8)));
typedef int v4i __attribute__((ext_vector_type(4)));
__device__ __forceinline__ v8i cat8(bf16x8 lo, bf16x8 hi) { return __builtin_shufflevector(__builtin_bit_cast(v4i, lo), __builtin_bit_cast(v4i, hi), 0, 1, 2, 3, 4, 5, 6, 7); }
template <class Epi, class Sched, bool FP8 = false, bool ALIGN_EPI = true, bool GATHER = false>
__device__ __forceinline__ void gemm_phase(PG8_LAS unsigned char* lds, const Gemm g, const Sched& S, const Epi& E, const int tid) {
    const int wid = __builtin_amdgcn_readfirstlane(tid >> 6), lane = tid & 63, wr = wid >> 2, wc = wid & 3, fr = lane & 15, fq = lane >> 4;
    const int KB = g.KB, nt = KB / 128;
    unsigned voffA, voffB; int Rl, Cb;
    { int R, C; stage_rc(tid * 16, R, C); const int Rb = Epi::PERM ? ((R & ~31) + perm32(R & 31)) : R; voffA = (unsigned)(R * KB + C * 2); voffB = (unsigned)(Rb * KB + C * 2); Rl = R; Cb = C * 2; }
    unsigned gA[2][2], gN[2][2]; constexpr int GOFF = STAGE_BYTES;
    const unsigned r64 = 64u * (unsigned)KB;
    const unsigned kstep = 128u;
    const unsigned hstep = (unsigned)(HALF * KB);
    const unsigned tstep = 2u * hstep;
    const __amdgpu_buffer_rsrc_t rsA = __builtin_amdgcn_make_buffer_rsrc(const_cast<void*>(g.A), 0, 0x7fffffff, 0x00020000), rsB = __builtin_amdgcn_make_buffer_rsrc(const_cast<void*>(g.Bt), 0, 0x7fffffff, 0x00020000);
    const unsigned ldsw = (unsigned)wid * 1024u;
    const int aoff = lds_byte(wr * 64 + fr, fq * 8), boff = lds_byte(wc * 32 + fr, fq * 8);
    const int sw8 = (fr * 64 + (fq & 1) * 32) ^ (((fr >> 3) & 1) << 5);
    const int a8off = (wr * 8 + (fq >> 1)) * 1024 + sw8, b8off = (wc * 4 + (fq >> 1)) * 1024 + sw8;
#define PG8_SA(b, h) (((b) * 2 + (h)) * HTB)
#define PG8_SB(b, h) ((4 + (b) * 2 + (h)) * HTB)
#define PG8_STAGE(bufoff, rs, soff, voff) do { _Pragma("unroll") for (int _i = 0; _i < 2; ++_i) \
        __builtin_amdgcn_raw_ptr_buffer_load_lds(rs, (PG8_LAS void*)(lds + (bufoff) + ldsw + _i * 8192), 16, (int)(voff), (int)((soff) + _i * r64), 0, 0); } while (0)
#define PG8_STAGE_A(bufoff, h, soff, kofs, gsel) do { if constexpr (GATHER) { _Pragma("unroll") for (int _i = 0; _i < 2; ++_i) \
        __builtin_amdgcn_raw_ptr_buffer_load_lds(rsA, (PG8_LAS void*)(lds + (bufoff) + ldsw + _i * 8192), 16, (int)(gsel)[h][_i], (int)(kofs), 0, 0); } else PG8_STAGE(bufoff, rsA, soff, voffA); } while (0)
#define PG8_LDA(dst, b, h) do { _Pragma("unroll") for (int m = 0; m < 4; ++m) { if constexpr (FP8) dst##8[m] = cat8(*(const PG8_LAS bf16x8*)(lds + PG8_SA(b, h) + aoff + m * 2048), *(const PG8_LAS bf16x8*)(lds + PG8_SA(b, h) + aoff + m * 2048 + 1024)); \
        else { _Pragma("unroll") for (int k = 0; k < 2; ++k) dst[m][k] = *(const PG8_LAS bf16x8*)(lds + PG8_SA(b, h) + aoff + m * 2048 + k * 1024); } } } while (0)
#define PG8_LDB(dst, b, h) do { _Pragma("unroll") for (int n = 0; n < 2; ++n) { if constexpr (FP8) dst##8[n] = cat8(*(const PG8_LAS bf16x8*)(lds + PG8_SB(b, h) + boff + n * 2048), *(const PG8_LAS bf16x8*)(lds + PG8_SB(b, h) + boff + n * 2048 + 1024)); \
        else { _Pragma("unroll") for (int k = 0; k < 2; ++k) dst[n][k] = *(const PG8_LAS bf16x8*)(lds + PG8_SB(b, h) + boff + n * 2048 + k * 1024); } } } while (0)
#define PG8_MMA8(ai, bj, At, Bt) asm volatile("s_nop 1\n\t" \
        "v_mfma_scale_f32_16x16x128_f8f6f4 %0, %8, %10, %0, %14, %14 op_sel_hi:[0,0,0]\n\t" "v_mfma_scale_f32_16x16x128_f8f6f4 %1, %9, %10, %1, %14, %14 op_sel_hi:[0,0,0]\n\t" \
        "v_mfma_scale_f32_16x16x128_f8f6f4 %2, %8, %11, %2, %14, %14 op_sel_hi:[0,0,0]\n\t" "v_mfma_scale_f32_16x16x128_f8f6f4 %3, %9, %11, %3, %14, %14 op_sel_hi:[0,0,0]\n\t" \
        "v_mfma_scale_f32_16x16x128_f8f6f4 %4, %8, %12, %4, %14, %14 op_sel_hi:[0,0,0]\n\t" "v_mfma_scale_f32_16x16x128_f8f6f4 %5, %9, %12, %5, %14, %14 op_sel_hi:[0,0,0]\n\t" \
        "v_mfma_scale_f32_16x16x128_f8f6f4 %6, %8, %13, %6, %14, %14 op_sel_hi:[0,0,0]\n\t" "v_mfma_scale_f32_16x16x128_f8f6f4 %7, %9, %13, %7, %14, %14 op_sel_hi:[0,0,0]" \
        : "+v"(acc[ai][bj][0][0]), "+v"(acc[ai][bj][0][1]), "+v"(acc[ai][bj][1][0]), "+v"(acc[ai][bj][1][1]), "+v"(acc[ai][bj][2][0]), "+v"(acc[ai][bj][2][1]), "+v"(acc[ai][bj][3][0]), "+v"(acc[ai][bj][3][1]) \
        : "v"(Bt##8[0]), "v"(Bt##8[1]), "v"(At##8[0]), "v"(At##8[1]), "v"(At##8[2]), "v"(At##8[3]), "v"(scl8))
#define PG8_MMA(ai, bj, At, Bt) do { __builtin_amdgcn_s_setprio(1); if constexpr (FP8) { PG8_MMA8(ai, bj, At, Bt); } else { \
        _Pragma("unroll") for (int m = 0; m < 4; ++m) _Pragma("unroll") for (int n = 0; n < 2; ++n) _Pragma("unroll") for (int k = 0; k < 2; ++k) \
        acc[ai][bj][m][n] = __builtin_amdgcn_mfma_f32_16x16x32_bf16(Bt[n][k], At[m][k], acc[ai][bj][m][n], 0, 0, 0); } __builtin_amdgcn_s_setprio(0); } while (0)
#define PG8_WAIT_V(n) asm volatile("s_waitcnt vmcnt(" #n ")" ::: "memory")
#define PG8_WAIT_L(n) asm volatile("s_waitcnt lgkmcnt(" #n ")" ::: "memory")
#define PG8_BAR __builtin_amdgcn_s_barrier()
#define PG8_SCHED __builtin_amdgcn_sched_barrier(0)
    Unit cur, nxt; int ui = 0;
    if (!S.next(0, cur)) return;
    f32x4 acc[2][2][4][2];
#pragma unroll
    for (int a = 0; a < 2; ++a)
#pragma unroll
        for (int b = 0; b < 2; ++b)
#pragma unroll
            for (int m = 0; m < 4; ++m)
#pragma unroll
                for (int n = 0; n < 2; ++n) acc[a][b][m][n] = (f32x4){0.f, 0.f, 0.f, 0.f};
    int scl8 = 0x7f7f7f7f; asm volatile("" : "+v"(scl8));
    bf16x8 At[4][2], B0[2][2], B1[2][2]; v8i At8[4], B08[2], B18[2];
    unsigned cA = (unsigned)cur.pm * tstep, cB = (unsigned)cur.pn * tstep;
    if constexpr (GATHER) {
#pragma unroll
        for (int h = 0; h < 2; ++h)
#pragma unroll
            for (int i = 0; i < 2; ++i) { gA[h][i] = (unsigned)g.gidx[cur.pm * 256 + h * 128 + Rl + 64 * i] * (unsigned)KB + (unsigned)Cb; gN[h][i] = gA[h][i]; } }
    {
        PG8_STAGE(PG8_SB(0, 0), rsB, cB, voffB); PG8_STAGE(PG8_SB(0, 1), rsB, cB + hstep, voffB); PG8_STAGE_A(PG8_SA(0, 0), 0, cA, 0, gA); PG8_STAGE_A(PG8_SA(0, 1), 1, cA + hstep, 0, gA);
        if (wr == 1) PG8_BAR;
        PG8_WAIT_V(2); PG8_BAR;
        PG8_STAGE(PG8_SB(1, 0), rsB, cB + kstep, voffB); PG8_STAGE_A(PG8_SA(1, 0), 0, cA + kstep, kstep, gA); PG8_STAGE(PG8_SB(1, 1), rsB, cB + hstep + kstep, voffB);
        PG8_WAIT_V(6); PG8_BAR;
    }
    for (;;) {
        const bool has_next = S.next(ui + 1, nxt);
        const unsigned nA = has_next ? (unsigned)nxt.pm * tstep : cA, nB = has_next ? (unsigned)nxt.pn * tstep : cB;
        for (int t = 0; t < nt; t += 2) {
            const bool last = (t == nt - 2);
            const unsigned a1 = cA + (unsigned)(t + 1) * kstep;
            const unsigned a2 = last ? nA : cA + (unsigned)(t + 2) * kstep, b2 = last ? nB : cB + (unsigned)(t + 2) * kstep;
            const unsigned a3 = a2 + kstep, b3 = b2 + kstep;
            const unsigned k1 = (unsigned)(t + 1) * kstep, k2 = last ? 0u : (unsigned)(t + 2) * kstep, k3 = k2 + kstep;
            if constexpr (GATHER) {
                if (t == 0 && has_next && wid == 0) __builtin_amdgcn_global_load_lds((const unsigned*)(g.gidx + nxt.pm * 256 + lane * 4), (PG8_LAS unsigned*)(lds + GOFF + ((ui + 1) & 1) * 1024), 16, 0, 0);
                if (last && has_next) {
#pragma unroll
                    for (int h = 0; h < 2; ++h)
#pragma unroll
                        for (int i = 0; i < 2; ++i) gN[h][i] = (unsigned)*(const PG8_LAS int*)(lds + GOFF + ((ui + 1) & 1) * 1024 + (h * 128 + Rl + 64 * i) * 4) * (unsigned)KB + (unsigned)Cb; } }
            unsigned gS[2][2];
#pragma unroll
            for (int h = 0; h < 2; ++h)
#pragma unroll
                for (int i = 0; i < 2; ++i) gS[h][i] = last ? gN[h][i] : gA[h][i];
            PG8_LDB(B0, 0, 0); PG8_LDB(B1, 0, 1); PG8_SCHED; PG8_LDA(At, 0, 0); PG8_STAGE_A(PG8_SA(1, 1), 1, a1 + hstep, k1, gA);
            PG8_WAIT_V(8); PG8_WAIT_L(0); PG8_BAR; PG8_MMA(0, 0, At, B0); PG8_MMA(0, 1, At, B1); PG8_BAR; PG8_SCHED;
            PG8_LDA(At, 0, 1); PG8_STAGE(PG8_SB(0, 0), rsB, b2, voffB); PG8_STAGE(PG8_SB(0, 1), rsB, b2 + hstep, voffB); PG8_STAGE_A(PG8_SA(0, 0), 0, a2, k2, gS);
            PG8_WAIT_V(8); PG8_WAIT_L(0); PG8_BAR; PG8_MMA(1, 0, At, B0); PG8_MMA(1, 1, At, B1); PG8_BAR; PG8_SCHED;
            PG8_LDB(B0, 1, 0); PG8_LDB(B1, 1, 1); PG8_SCHED; PG8_LDA(At, 1, 0); PG8_STAGE_A(PG8_SA(0, 1), 1, a2 + hstep, k2, gS);
            PG8_WAIT_V(8); PG8_WAIT_L(0); PG8_BAR; PG8_MMA(0, 0, At, B0); PG8_MMA(0, 1, At, B1); PG8_BAR; PG8_SCHED;
            PG8_LDA(At, 1, 1); PG8_STAGE(PG8_SB(1, 0), rsB, b3, voffB); PG8_STAGE(PG8_SB(1, 1), rsB, b3 + hstep, voffB); PG8_STAGE_A(PG8_SA(1, 0), 0, a3, k3, gS);
            PG8_WAIT_V(8); PG8_WAIT_L(0); PG8_BAR; PG8_MMA(1, 0, At, B0); PG8_MMA(1, 1, At, B1); PG8_BAR; PG8_SCHED;
        }
        if constexpr (ALIGN_EPI) { if (wr == 0) PG8_BAR; }
        if constexpr (FP8) asm volatile("s_nop 15\n\ts_nop 15" ::: "memory");
        E(acc, cur, wr, wc, fr, fq);
        if (!has_next) break;
#pragma unroll
        for (int a = 0; a < 2; ++a)
#pragma unroll
            for (int b = 0; b < 2; ++b)
#pragma unroll
                for (int m = 0; m < 4; ++m)
#pragma unroll
                    for (int n = 0; n < 2; ++n) acc[a][b][m][n] = (f32x4){0.f, 0.f, 0.f, 0.f};
        cur = nxt; cA = nA; cB = nB; ++ui;
        if constexpr (GATHER) {
#pragma unroll
            for (int h = 0; h < 2; ++h)
#pragma unroll
                for (int i = 0; i < 2; ++i) gA[h][i] = gN[h][i]; }
        if constexpr (ALIGN_EPI) { if (wr == 1) PG8_BAR; }
    }
    PG8_WAIT_V(0);
    if constexpr (!ALIGN_EPI) { if (wr == 0) PG8_BAR; }
    PG8_BAR;
#undef PG8_STAGE_A
#undef PG8_SA
#undef PG8_SB
#undef PG8_STAGE
#undef PG8_LDA
#undef PG8_LDB
#undef PG8_MMA
#undef PG8_WAIT_V
#undef PG8_WAIT_L
#undef PG8_BAR
#undef PG8_SCHED
}
}

#define XB_TMO      128
#define XB_XCNT(j)  (256  + 64 * (j))
#define XB_XSUB(j)  (1280 + 64 * (j))
#define XB_XGEN(j)  (2304 + 64 * (j))
#define XB_TOP      3328
#define XB_TOPGEN   3392
#define XCD_BAR_WORDS 3456
#define XB_SPIN_CAP (1u << 18)
__device__ __forceinline__ unsigned xb_ld(unsigned* p)              { return __hip_atomic_load(p, __ATOMIC_RELAXED, __HIP_MEMORY_SCOPE_AGENT); }
__device__ __forceinline__ unsigned xb_add(unsigned* p, unsigned v) { return __hip_atomic_fetch_add(p, v, __ATOMIC_RELAXED, __HIP_MEMORY_SCOPE_AGENT); }
__device__ __forceinline__ unsigned xb_xcc_id() { return (unsigned)__builtin_amdgcn_s_getreg((3 << 11) | 20) & 0xFu; }
#define XB_SPIN(cond, bar) do { unsigned _sp = 0; while (cond) { __builtin_amdgcn_s_sleep(1); \
    if ((++_sp & 255u) == 0u) { if (xb_ld(&(bar)[XB_TMO])) break; if (_sp > XB_SPIN_CAP) { atomicAdd(&(bar)[XB_TMO], 1u); break; } } } } while (0)
struct XcdBarrier { unsigned* bar; unsigned x; volatile LAS unsigned* st; };
__device__ __forceinline__ XcdBarrier xcd_barrier_post(unsigned* bar, volatile LAS unsigned* st) {
    XcdBarrier b; b.bar = bar; b.x = xb_xcc_id(); b.st = st;
    if (threadIdx.x == 0) (void)xb_add(&bar[XB_XCNT(b.x)], 1u);
    return b;
}
__device__ __forceinline__ void xcd_barrier_complete(unsigned* bar, unsigned x, unsigned& nloc, unsigned& nx) {
    const unsigned G = gridDim.x * gridDim.y * gridDim.z;
    unsigned sum, cnt, mine, sp = 0u;
    for (;;) {
        sum = 0u; cnt = 0u; mine = 0u;
#pragma unroll
        for (unsigned j = 0; j < 16; ++j) { const unsigned c = xb_ld(&bar[XB_XCNT(j)]); sum += c; cnt += (c > 0u) ? 1u : 0u; mine = (j == x) ? c : mine; }
        if (sum == G) break;
        __builtin_amdgcn_s_sleep(1);
        if ((++sp & 255u) == 0u) { if (xb_ld(&bar[XB_TMO])) break; if (sp > XB_SPIN_CAP) { atomicAdd(&bar[XB_TMO], 1u); break; } }
    }
    nloc = mine > 0u ? mine : 1u; nx = cnt > 0u ? cnt : 1u;
}
__device__ __forceinline__ void xcd_barrier(const XcdBarrier& b, const bool thread0) {
    asm volatile("s_waitcnt vmcnt(0)" ::: "memory");
    __syncthreads();
    if (thread0) {
        unsigned* bar = b.bar;
        __builtin_amdgcn_s_waitcnt(0);
        unsigned nloc = b.st[0], nx = b.st[1];
        if (nloc == 0u) { xcd_barrier_complete(bar, b.x, nloc, nx); b.st[0] = nloc; b.st[1] = nx; }
        const unsigned old = xb_add(&bar[XB_XSUB(b.x)], 1u);
        const unsigned gen = old / nloc;
        if (old + 1u == (gen + 1u) * nloc) {
            __builtin_amdgcn_fence(__ATOMIC_RELEASE, "agent");
            asm volatile("s_waitcnt vmcnt(0)" ::: "memory");
            const unsigned og = xb_add(&bar[XB_TOP], 1u);
            const unsigned tg = og / nx;
            if (og + 1u == (tg + 1u) * nx) xb_add(&bar[XB_TOPGEN], 1u);
            else XB_SPIN(xb_ld(&bar[XB_TOPGEN]) == tg, bar);
            __builtin_amdgcn_fence(__ATOMIC_ACQUIRE, "agent");
            xb_add(&bar[XB_XGEN(b.x)], 1u);
            asm volatile("s_waitcnt vmcnt(0)" ::: "memory");
        } else {
            XB_SPIN(xb_ld(&bar[XB_XGEN(b.x)]) == gen, bar);
            __builtin_amdgcn_fence(__ATOMIC_ACQUIRE, "agent");
            asm volatile("s_waitcnt vmcnt(0)" ::: "memory");
        }
    }
    __syncthreads();
}

struct Frame {
    LAS unsigned char* lds;
    int tid, lane, wave, vcu, G;
    unsigned char* ws;
};
#define WSP(T, off) ((T*)(F.ws + (off)))

__device__ __forceinline__ void cvt_item(const float* W, int ldw, int nvalid, int k0, int n0, bf16* WT, int ldt, int drow0, LAS float* scr, int lane) {
    const int c4 = lane & 15, kr = lane >> 4;
    f32x4 v[16];
#pragma unroll
    for (int i = 0; i < 16; ++i) { const int r = 4 * i + kr; v[i] = (4 * c4 < nvalid) ? *(const GAS f32x4*)(W + (size_t)(k0 + r) * ldw + n0 + 4 * c4) : (f32x4){0.f, 0.f, 0.f, 0.f}; }
#pragma unroll
    for (int i = 0; i < 16; ++i) { const int r = 4 * i + kr; LAS float* s = scr + r * 65 + 4 * c4; s[0] = v[i][0]; s[1] = v[i][1]; s[2] = v[i][2]; s[3] = v[i][3]; }
    LDS_WAIT(); asm volatile("" ::: "memory");
    const int c = lane & 7;
#pragma unroll
    for (int j = 0; j < 8; ++j) { const int n = (lane >> 3) + 8 * j; const LAS float* s = scr + (8 * c) * 65 + n;
        v4u o; o.x = pk2(s[0 * 65], s[1 * 65]); o.y = pk2(s[2 * 65], s[3 * 65]); o.z = pk2(s[4 * 65], s[5 * 65]); o.w = pk2(s[6 * 65], s[7 * 65]);
        if (n < nvalid) *(GAS v4u*)(WT + (size_t)(drow0 + n) * ldt + k0 + 8 * c) = o; }
    LDS_WAIT(); asm volatile("" ::: "memory");
}

__device__ __forceinline__ void cvt8_load(const float* W, int ldw, int k0, int n0, f32x4 (&v)[16], int lane) {
    const int c4 = lane & 15, kr = lane >> 4;
#pragma unroll
    for (int i = 0; i < 16; ++i) v[i] = __builtin_nontemporal_load((const GAS f32x4*)(W + (size_t)(k0 + 4 * i + kr) * ldw + n0 + 4 * c4));
}
__device__ __forceinline__ void cvt8_finish(const f32x4 (&v)[16], int k0, unsigned char* WT, int ldt, int drow0, float scale, LAS float* scr, int lane) {
    const int c4 = lane & 15, kr = lane >> 4;
#pragma unroll
    for (int i = 0; i < 16; ++i) { const int r = 4 * i + kr; LAS float* s = scr + r * 65 + 4 * c4; s[0] = v[i][0]; s[1] = v[i][1]; s[2] = v[i][2]; s[3] = v[i][3]; }
    LDS_WAIT(); asm volatile("" ::: "memory");
    const int c = lane & 3;
#pragma unroll
    for (int j = 0; j < 4; ++j) { const int n = (lane >> 2) + 16 * j; const LAS float* s = scr + (16 * c) * 65 + n;
        v4u o;
        o.x = pk4_fp8(s[0 * 65] * scale, s[1 * 65] * scale, s[2 * 65] * scale, s[3 * 65] * scale); o.y = pk4_fp8(s[4 * 65] * scale, s[5 * 65] * scale, s[6 * 65] * scale, s[7 * 65] * scale);
        o.z = pk4_fp8(s[8 * 65] * scale, s[9 * 65] * scale, s[10 * 65] * scale, s[11 * 65] * scale); o.w = pk4_fp8(s[12 * 65] * scale, s[13 * 65] * scale, s[14 * 65] * scale, s[15 * 65] * scale);
        *(GAS v4u*)(WT + (size_t)(drow0 + n) * ldt + k0 + 16 * c) = o; }
    LDS_WAIT(); asm volatile("" ::: "memory");
}
struct ExpItem { const float* W; int ldw, k0, n0, ldt, drow0; unsigned char* WT; };
__device__ __forceinline__ ExpItem exp_item(const P& p, unsigned char* ws, int q, int half) {
    ExpItem e; const int le = q / 1056, rr = q % 1056, mk = rr / 352, ii = rr % 352;
    if (mk < 2) { const int kb2 = ii / 44, nb = ii % 44; e.n0 = 64 * nb; e.k0 = 64 * (2 * kb2 + half); e.W = (mk == 0 ? p.exp_w_gate : p.exp_w_up) + (size_t)le * D * FF; e.ldw = FF; e.ldt = D; e.drow0 = (e.n0 >> 7) * 256 + mk * 128 + (e.n0 & 127); e.WT = ws + WS_WUP + (size_t)le * 5632 * D; }
    else { const int kb2 = ii / 16, nb = ii % 16; e.n0 = 64 * nb; e.k0 = 64 * (2 * kb2 + half); e.W = p.exp_w_down + (size_t)le * FF * D; e.ldw = D; e.ldt = FF; e.drow0 = e.n0; e.WT = ws + WS_WDN + (size_t)le * D * FF; }
    return e;
}
constexpr int NPAIR_ALL = 32 * 1056;
__device__ __forceinline__ void cvt_pairs(const P& p, unsigned char* ws, LAS float* scr, int qfirst, int qstep, int qend, int lane) {
    f32x4 va[16], vb[16]; int q = qfirst;
    if (q < qend) { const ExpItem e = exp_item(p, ws, q, 0); cvt8_load(e.W, e.ldw, e.k0, e.n0, va, lane); }
    while (q < qend) {
        const ExpItem e0 = exp_item(p, ws, q, 0), e1 = exp_item(p, ws, q, 1);
        cvt8_load(e1.W, e1.ldw, e1.k0, e1.n0, vb, lane);
        cvt8_finish(va, e0.k0, e0.WT, e0.ldt, e0.drow0, F8_W, scr, lane);
        const int q2 = q + qstep;
        if (q2 < qend) { const ExpItem e2 = exp_item(p, ws, q2, 0); cvt8_load(e2.W, e2.ldw, e2.k0, e2.n0, va, lane); }
        cvt8_finish(vb, e1.k0, e1.WT, e1.ldt, e1.drow0, F8_W, scr, lane);
        q = q2;
    }
}
#ifndef BG_QKV
#define BG_QKV 2560
#define BG_OUT0 6144
#define BG_UP0 512
#define BG_DN0 4096
#endif
constexpr int CVT_Q3 = NPAIR_ALL - BG_DN0, CVT_Q2 = CVT_Q3 - BG_UP0, CVT_Q1 = CVT_Q2 - BG_OUT0, CVT_SPLIT0 = CVT_Q1 - BG_QKV;
static_assert(CVT_Q2 >= NPAIR_ALL / 2 && CVT_SPLIT0 >= 0, "the slices behind the layer-0 MoE must stay inside layer 1");
#define BG_SLOT(first, qb, qe) do { if (MOE_FP8 && F.G == 256 && (int)blockIdx.x >= (first) && (qb) < (qe)) { __syncthreads(); \
    cvt_pairs(p, F.ws, (LAS float*)(F.lds + F.wave * 16640), (qb) + ((int)blockIdx.x - (first)) * 8 + F.wave, (256 - (first)) * 8, (qe), F.lane); } } while (0)
__device__ __forceinline__ void ph_pro(const P& p, Frame& F, bool do_cvt) {
    float* MOD = WSP(float, WS_MOD); float* ROPE = WSP(float, WS_ROPE);
    if (F.vcu == 255 % F.G) {
        for (int i = F.tid; i < 1024; i += 512) { const int pos = i >> 4, f = i & 15; const float inv = powf(10000.f, -(float)f / 16.f); const float ang = (float)pos * inv; ROPE[2 * i] = cosf(ang); ROPE[2 * i + 1] = sinf(ang); }
    }
    if (F.vcu < 192) {
        LAS float* ssrc = (LAS float*)F.lds; LAS float* red = (LAS float*)(F.lds + 69632);
        for (int i = F.tid; i < 17 * 1024; i += 512) { const int j = i >> 10, k = i & 1023; const float v = (j < 16) ? p.c[j * 1024 + k] : p.c_ctx[k]; ssrc[i] = silu_f(v); }
        __syncthreads();
        for (int u = F.vcu; u < 192; u += F.G) {
            const int l = u / 96, c0 = (u % 96) * 64, col = c0 + (F.tid & 63), ks = F.tid >> 6;
            const float* w = p.ada_w + ((size_t)l * 1024 + ks * 128) * 6144 + col;
            float acc[17];
#pragma unroll
            for (int j = 0; j < 17; ++j) acc[j] = 0.f;
            float wa[8], wb[8];
#define ADA_LD(k0_, buf_) do { _Pragma("unroll") for (int i_ = 0; i_ < 8; ++i_) buf_[i_] = w[(size_t)((k0_) + i_) * 6144]; } while (0)
#define ADA_FMA(k0_, buf_) do { _Pragma("unroll") for (int j = 0; j < 17; ++j) { const f32x4 s0 = *(const LAS f32x4*)(ssrc + j * 1024 + ks * 128 + (k0_)), s1 = *(const LAS f32x4*)(ssrc + j * 1024 + ks * 128 + (k0_) + 4); \
                acc[j] += ((s0[0] * buf_[0] + s0[1] * buf_[1]) + (s0[2] * buf_[2] + s0[3] * buf_[3])) + ((s1[0] * buf_[4] + s1[1] * buf_[5]) + (s1[2] * buf_[6] + s1[3] * buf_[7])); } } while (0)
            ADA_LD(0, wa);
#pragma clang loop unroll(disable)
            for (int k = 0; k < 128; k += 16) {
                ADA_LD(k + 8, wb);
                ADA_FMA(k, wa);
                if (k + 16 < 128) ADA_LD(k + 16, wa);
                ADA_FMA(k + 8, wb);
            }
#undef ADA_LD
#undef ADA_FMA
#pragma unroll
            for (int j = 0; j < 17; ++j) red[(ks * 17 + j) * 64 + (F.tid & 63)] = acc[j];
            __syncthreads();
            for (int i = F.tid; i < 17 * 64; i += 512) { const int j = i >> 6, c = i & 63; float s = p.ada_b[l * 6144 + c0 + c];
#pragma unroll
                for (int q = 0; q < 8; ++q) s += red[(q * 17 + j) * 64 + c];
                MOD[(size_t)(l * 17 + j) * 6144 + c0 + c] = s; }
            __syncthreads();
        }
    }
    if (do_cvt) {
        __syncthreads();
        LAS float* scr = (LAS float*)(F.lds + F.wave * 16640);
        const int gw = F.vcu * NWAVES + F.wave, NGW = F.G * NWAVES;
        constexpr int I_QKV = 16 * 24, I_O = 16 * 16, I_GIN = 16 * 49, I_SMALL = I_QKV + I_O + I_GIN + I_O, I_E = 704, I_LE = 3 * I_E, NITEMS = I_SMALL + 32 * I_LE;
        for (int it = gw; it < I_SMALL; it += NGW) {
            int r = it;
            if (r < I_QKV) { cvt_item(p.attn_w_in, ATT_N, 64, 64 * (r / 24), 64 * (r % 24), WSP(bf16, WS_WQKV), D, 64 * (r % 24), scr, F.lane); continue; } r -= I_QKV;
            if (r < I_O) { cvt_item(p.attn_w_out, D, 64, 64 * (r / 16), 64 * (r % 16), WSP(bf16, WS_WO0), D, 64 * (r % 16), scr, F.lane); continue; } r -= I_O;
            if (r < I_GIN) { const int nb = r % 49; cvt_item(p.gla_w_in, GIN, nb == 48 ? 32 : 64, 64 * (r / 49), 64 * nb, WSP(bf16, WS_WGIN), D, 64 * nb, scr, F.lane); continue; } r -= I_GIN;
            cvt_item(p.gla_w_out, D, 64, 64 * (r / 16), 64 * (r % 16), WSP(bf16, WS_WO1), D, 64 * (r % 16), scr, F.lane);
        }
        constexpr int NEXP = 32 * I_LE;
        if (MOE_FP8) {
            cvt_pairs(p, F.ws, scr, gw, NGW, F.G == 256 ? CVT_SPLIT0 : NPAIR_ALL, F.lane);
        } else {
            for (int r = gw; r < NEXP; r += NGW) {
                const int le = r / I_LE, rr = r % I_LE, mk = rr / I_E, ii = rr % I_E;
                if (mk < 2) { const int kb = ii / 44, nb = ii % 44, n0 = 64 * nb; const float* W = (mk == 0 ? p.exp_w_gate : p.exp_w_up) + (size_t)le * D * FF; const int dr = (n0 >> 7) * 256 + mk * 128 + (n0 & 127);
                    cvt_item(W, FF, 64, 64 * kb, n0, WSP(bf16, WS_WUP) + (size_t)le * 5632 * D, D, dr, scr, F.lane); }
                else { const int kb = ii / 16, nb = ii % 16; cvt_item(p.exp_w_down + (size_t)le * FF * D, D, 64, 64 * kb, 64 * nb, WSP(bf16, WS_WDN) + (size_t)le * D * FF, FF, 64 * nb, scr, F.lane); }
            }
        }
        { v4u* z = (v4u*)(WSP(bf16, WS_WGIN) + (size_t)GIN * D); const int n16 = (GIN_PAD - GIN) * D * 2 / 16;
          for (int i = F.vcu * 512 + F.tid; i < n16; i += F.G * 512) z[i] = (v4u){0u, 0u, 0u, 0u}; }
    }
}

__device__ __forceinline__ void norm_mod_store(const f32x4 (&v)[4], float rstd, const float* g, const float* sh, const float* sc, bf16* orow, int lane) {
    f32x4 gv[4], shv[4], scv[4];
#pragma unroll
    for (int j = 0; j < 4; ++j) { const int c = 4 * (lane + 64 * j); gv[j] = *(const f32x4*)(g + c); shv[j] = *(const f32x4*)(sh + c); scv[j] = *(const f32x4*)(sc + c); }
#pragma unroll
    for (int j = 0; j < 4; ++j) { const int c = 4 * (lane + 64 * j);
        const f32x4 y = (v[j] * rstd * gv[j]) * (scv[j] + 1.f) + shv[j]; v2u o; o.x = pk2(y[0], y[1]); o.y = pk2(y[2], y[3]); *(v2u*)(orow + c) = o; }
}
__device__ __forceinline__ void ph_norm1(const P& p, Frame& F, int l) {
    const float* MOD = WSP(float, WS_MOD); bf16* H = WSP(bf16, WS_H); const float* XA = WSP(float, WS_XA);
    const int gw = F.vcu * NWAVES + F.wave, NGW = F.G * NWAVES; constexpr int RW = 3;
    f32x4 gv[4];
#pragma unroll
    for (int q = 0; q < 4; ++q) gv[q] = *(const f32x4*)(p.norm1_g + l * D + 4 * (F.lane + 64 * q));
    for (int r0 = gw; r0 < NT; r0 += RW * NGW) {
        f32x4 v[RW][4], shv[RW][4], scv[RW][4];
#pragma unroll
        for (int h = 0; h < RW; ++h) { const int r = r0 + h * NGW < NT ? r0 + h * NGW : r0;
            const float* xr = (l == 0) ? (r < NL ? p.x + (size_t)r * D : p.ctx + (size_t)(r - NL) * D) : XA + (size_t)r * D;
            const int j = r < NL ? r / SEQ : 16; const float* mr = MOD + (size_t)(l * 17 + j) * 6144;
#pragma unroll
            for (int q = 0; q < 4; ++q) { const int c = 4 * (F.lane + 64 * q); v[h][q] = *(const f32x4*)(xr + c); shv[h][q] = *(const f32x4*)(mr + c); scv[h][q] = *(const f32x4*)(mr + 1024 + c); } }
#pragma unroll
        for (int h = 0; h < RW; ++h) { const int r = r0 + h * NGW; if (r >= NT) break; float s = 0.f;
#pragma unroll
            for (int q = 0; q < 4; ++q) s += (v[h][q][0] * v[h][q][0] + v[h][q][1] * v[h][q][1]) + (v[h][q][2] * v[h][q][2] + v[h][q][3] * v[h][q][3]);
            const float rstd = 1.f / sqrtf(wave_sum(s) * (1.f / D) + EPS);
            bf16* orow = H + (size_t)r * D;
#pragma unroll
            for (int q = 0; q < 4; ++q) { const f32x4 y = (v[h][q] * rstd * gv[q]) * (scv[h][q] + 1.f) + shv[h][q]; v2u o; o.x = pk2(y[0], y[1]); o.y = pk2(y[2], y[3]); *(v2u*)(orow + 4 * (F.lane + 64 * q)) = o; } }
    }
}
__device__ __forceinline__ void ph_norm2r(const P& p, Frame& F, int l) {
    const float* MOD = WSP(float, WS_MOD); bf16* H = WSP(bf16, WS_H); const xa_t* XA = WSP(xa_t, WS_XA); float* AFF = WSP(float, WS_AFF);
    constexpr int HT = 1028;
    LAS float* rw = (LAS float*)F.lds; LAS float* h2t = (LAS float*)(F.lds + 65536); LAS float* part = (LAS float*)(F.lds + 65536 + 16 * HT * 4);
    for (int i = F.tid; i < D * NE / 4; i += 512) ((LAS f32x4*)rw)[i] = ((const f32x4*)(p.router_w + (size_t)l * D * NE))[i];
    const int ntile = (l == 0 ? NT : NL) / 16, lane = F.lane, w = F.wave;
    const float *g = p.norm2_g + l * D;
    f32x4 v[2][4], gq[4]; v2u vr[2][4];
#pragma unroll
    for (int q = 0; q < 4; ++q) gq[q] = *(const f32x4*)(g + 4 * (lane + 64 * q));
    if (F.vcu < ntile) {
#pragma unroll
        for (int h = 0; h < 2; ++h)
#pragma unroll
            for (int q = 0; q < 4; ++q) vr[h][q] = *(const v2u*)(XA + (size_t)(F.vcu * 16 + 2 * w + h) * D + 4 * (lane + 64 * q)); }
    __syncthreads();
    for (int tile = F.vcu; tile < ntile; tile += F.G) {
        const int r0 = tile * 16;
        f32x4 shq[4], scq[4];
        { const int j = r0 < NL ? r0 / SEQ : 16; const float* mr = MOD + (size_t)(l * 17 + j) * 6144;
#pragma unroll
          for (int q = 0; q < 4; ++q) { shq[q] = *(const f32x4*)(mr + 3072 + 4 * (lane + 64 * q)); scq[q] = *(const f32x4*)(mr + 4096 + 4 * (lane + 64 * q)); } }
#pragma unroll
        for (int h = 0; h < 2; ++h)
#pragma unroll
            for (int q = 0; q < 4; ++q) v[h][q] = unpack_h4(vr[h][q]);
#pragma unroll
        for (int h = 0; h < 2; ++h) { const int r = r0 + 2 * w + h; float s = 0.f;
#pragma unroll
            for (int q = 0; q < 4; ++q) s += (v[h][q][0] * v[h][q][0] + v[h][q][1] * v[h][q][1]) + (v[h][q][2] * v[h][q][2] + v[h][q][3] * v[h][q][3]);
            const float rstd = 1.f / sqrtf(wave_sum(s) * (1.f / D) + EPS);
            bf16* orow = H + (size_t)r * D;
#pragma unroll
            for (int q = 0; q < 4; ++q) { const int c = 4 * (lane + 64 * q); const f32x4 gv = gq[q], shv = shq[q], scv = scq[q];
                const f32x4 y = (v[h][q] * rstd * gv) * (scv + 1.f) + shv;
                if (MOE_FP8) *(unsigned*)(WSP(unsigned char, WS_H8) + (size_t)r * D + c) = pk4_fp8(y[0] * F8_ACT, y[1] * F8_ACT, y[2] * F8_ACT, y[3] * F8_ACT);
                else { v2u o; o.x = pk2(y[0], y[1]); o.y = pk2(y[2], y[3]); *(v2u*)(orow + c) = o; }
                *(LAS f32x4*)(h2t + (2 * w + h) * HT + c) = y; } }
        if (tile + F.G < ntile) {
#pragma unroll
            for (int h = 0; h < 2; ++h)
#pragma unroll
                for (int q = 0; q < 4; ++q) vr[h][q] = *(const v2u*)(XA + (size_t)((tile + F.G) * 16 + 2 * w + h) * D + 4 * (lane + 64 * q)); }
        LDS_SYNC();
        { f32x4 acc = (f32x4){0.f, 0.f, 0.f, 0.f}; const int i16 = lane & 15, kq = lane >> 4;
#pragma unroll 8
          for (int it = 0; it < 32; ++it) { const int k = 128 * w + 4 * it + kq; acc = __builtin_amdgcn_mfma_f32_16x16x4f32(h2t[i16 * HT + k], rw[k * 16 + i16], acc, 0, 0, 0); }
#pragma unroll
          for (int r = 0; r < 4; ++r) part[(w * 16 + 4 * kq + r) * 16 + i16] = acc[r]; }
        LDS_SYNC();
        if (F.tid < 256) { const int i = F.tid >> 4, e = F.tid & 15; float a = 0.f;
#pragma unroll
            for (int w2 = 0; w2 < 8; ++w2) a += part[(w2 * 16 + i) * 16 + e];
            float m = a;
#pragma unroll
            for (int o = 1; o < 16; o <<= 1) m = fmaxf(m, __shfl_xor(m, o));
            const float pe = expf(a - m); float ssum = pe;
#pragma unroll
            for (int o = 1; o < 16; o <<= 1) ssum += __shfl_xor(ssum, o);
            AFF[(size_t)(r0 + i) * 16 + e] = pe / ssum; }
    }
    __syncthreads();
}
__device__ __forceinline__ void ph_topkg(const P& p, Frame& F, int l) {
    const float* AFF = WSP(float, WS_AFF); int* SLOT = WSP(int, WS_SLOT); int* ROWIDX = WSP(int, WS_ROWIDX); float* ROWG = WSP(float, WS_ROWG);
    const bf16* H = WSP(bf16, WS_H); bf16* XG = WSP(bf16, WS_XG);
    LAS int* hist = (LAS int*)F.lds;
    LAS int* sel = hist + 256;
    LAS int* wtot = sel + 256;
    LAS int* shr = wtot + 8;
    const int nunits = l == 0 ? 512 : 256, tid = F.tid, lane = F.lane;
    for (int u = F.vcu; u < nunits; u += F.G) {
        const bool lat = u < 256; const int b = (u & 255) >> 4, e = u & 15;
        const int L = lat ? SEQ : CTX, cap = lat ? CAPL : CAPC, row0 = lat ? b * SEQ : NL + b * CTX, s0 = lat ? b * CAPL : NB * CAPL + b * CAPC;
        unsigned key[4]; const bool act = 4 * tid < L;
#pragma unroll
        for (int q = 0; q < 4; ++q) key[q] = act ? __float_as_uint(AFF[(size_t)(row0 + 4 * tid + q) * 16 + e]) : 0u;
        unsigned prefix = 0u; int kk = cap;
#pragma unroll
        for (int pass = 0; pass < 4; ++pass) { const int shift = 24 - 8 * pass;
            if (tid < 256) hist[tid] = 0;
            LDS_SYNC();
            if (act) {
#pragma unroll
                for (int q = 0; q < 4; ++q) { const bool cand = pass == 0 ? true : ((key[q] >> (shift + 8)) == (prefix >> (shift + 8))); if (cand) __hip_atomic_fetch_add(&hist[(key[q] >> shift) & 255u], 1, __ATOMIC_RELAXED, __HIP_MEMORY_SCOPE_WORKGROUP); } }
            LDS_SYNC();
            if (F.wave == 0) { const int h0 = hist[4 * lane], h1 = hist[4 * lane + 1], h2 = hist[4 * lane + 2], h3 = hist[4 * lane + 3]; const int tot = h0 + h1 + h2 + h3;
                int suf = tot;
#pragma unroll
                for (int o = 1; o < 64; o <<= 1) { const int t = __shfl_down(suf, o); if (lane + o < 64) suf += t; }
                int above = suf - tot;
                if (above < kk && kk <= above + h3) { shr[0] = 4 * lane + 3; shr[1] = above; } above += h3;
                if (above < kk && kk <= above + h2) { shr[0] = 4 * lane + 2; shr[1] = above; } above += h2;
                if (above < kk && kk <= above + h1) { shr[0] = 4 * lane + 1; shr[1] = above; } above += h1;
                if (above < kk && kk <= above + h0) { shr[0] = 4 * lane + 0; shr[1] = above; } }
            LDS_SYNC();
            prefix |= (unsigned)shr[0] << shift; kk -= shr[1];
        }
        const int n_gt = cap - kk;
        int cg = 0, ce = 0;
#pragma unroll
        for (int q = 0; q < 4; ++q) { cg += (act && key[q] > prefix) ? 1 : 0; ce += (act && key[q] == prefix) ? 1 : 0; }
        int pk = cg | (ce << 16), inc = pk;
#pragma unroll
        for (int o = 1; o < 64; o <<= 1) { const int t = __shfl_up(inc, o); if (lane >= o) inc += t; }
        if (lane == 63) wtot[F.wave] = inc;
        LDS_SYNC();
        int base = 0;
#pragma unroll
        for (int w2 = 0; w2 < 8; ++w2) base += (w2 < F.wave) ? wtot[w2] : 0;
        int ex = base + inc - pk; int rg = ex & 0xffff, re = ex >> 16;
        if (act) {
#pragma unroll
            for (int q = 0; q < 4; ++q) { const int row = row0 + 4 * tid + q; int s = -1;
                if (key[q] > prefix) { s = rg; ++rg; } else if (key[q] == prefix) { if (re < kk) s = n_gt + re; ++re; }
                if (s >= 0) { ROWIDX[e * ESLOTS + s0 + s] = row; ROWG[e * ESLOTS + s0 + s] = __uint_as_float(key[q]); sel[s] = row; s += s0; }
                SLOT[(size_t)row * 16 + e] = s; } }
        LDS_SYNC();
    }
}
__device__ __forceinline__ void ph_combine(const P& p, Frame& F, int l) {
    const float* MOD = WSP(float, WS_MOD); bf16* H = WSP(bf16, WS_H); xa_t* XA = WSP(xa_t, WS_XA); const int* SLOT = WSP(int, WS_SLOT); const bf16* YS = WSP(bf16, WS_YS);
    const int gw = F.vcu * NWAVES + F.wave, NGW = F.G * NWAVES; const int nrows = l == 0 ? NT : NL;
    f32x4 gn[4];
#pragma unroll
    for (int q = 0; q < 4; ++q) gn[q] = *(const f32x4*)((l == 0 ? p.norm1_g + D : p.final_norm_g) + 4 * (F.lane + 64 * q));
    for (int r0 = gw; r0 < nrows; r0 += 2 * NGW) {
        int sv[2]; f32x4 v[2][4], acc[2][4];
#pragma unroll
        for (int h = 0; h < 2; ++h) { const int r = r0 + h * NGW; sv[h] = F.lane < 16 ? SLOT[(size_t)r * 16 + F.lane] : -1;
#pragma unroll
            for (int q = 0; q < 4; ++q) { v[h][q] = unpack_h4(*(const v2u*)(XA + (size_t)r * D + 4 * (F.lane + 64 * q))); acc[h][q] = (f32x4){0.f, 0.f, 0.f, 0.f}; } }
        unsigned mk[2]; v2u yv[2][4][4];
#pragma unroll
        for (int h = 0; h < 2; ++h) { mk[h] = (unsigned)(__ballot(sv[h] >= 0) & 0xffffull); unsigned m2 = mk[h];
#pragma unroll
            for (int i = 0; i < 4; ++i) {
                if (m2) { const int e = __builtin_ctz(m2); m2 &= m2 - 1; const int sl = __builtin_amdgcn_readlane(sv[h], e); const bf16* yr = YS + (size_t)(e * ESLOTS + sl) * D;
#pragma unroll
                    for (int q = 0; q < 4; ++q) yv[h][i][q] = *(const v2u*)(yr + 4 * (F.lane + 64 * q)); }
                else {
#pragma unroll
                    for (int q = 0; q < 4; ++q) yv[h][i][q] = (v2u){0u, 0u}; } }
            mk[h] = m2; }
        f32x4 g2v[2][4], shn[2][4], scn[2][4];
#pragma unroll
        for (int h = 0; h < 2; ++h) { const int r = r0 + h * NGW; const int j = r < NL ? r / SEQ : 16; const float* g2 = MOD + (size_t)(l * 17 + j) * 6144 + 5120; const float* m1 = MOD + (size_t)(17 + j) * 6144;
#pragma unroll
            for (int q = 0; q < 4; ++q) { const int c = 4 * (F.lane + 64 * q); g2v[h][q] = *(const f32x4*)(g2 + c); if (l == 0) { shn[h][q] = *(const f32x4*)(m1 + c); scn[h][q] = *(const f32x4*)(m1 + 1024 + c); } } }
#pragma unroll
        for (int h = 0; h < 2; ++h) {
#pragma unroll
            for (int i = 0; i < 4; ++i)
#pragma unroll
                for (int q = 0; q < 4; ++q) { const v2u w = yv[h][i][q]; acc[h][q][0] += __uint_as_float(w.x << 16); acc[h][q][1] += __uint_as_float(w.x & 0xffff0000u); acc[h][q][2] += __uint_as_float(w.y << 16); acc[h][q][3] += __uint_as_float(w.y & 0xffff0000u); }
            unsigned m2 = mk[h];
            while (m2) { const int e = __builtin_ctz(m2); m2 &= m2 - 1; const int sl = __builtin_amdgcn_readlane(sv[h], e); const bf16* yr = YS + (size_t)(e * ESLOTS + sl) * D;
#pragma unroll
                for (int q = 0; q < 4; ++q) { const v2u w = *(const v2u*)(yr + 4 * (F.lane + 64 * q)); acc[h][q][0] += __uint_as_float(w.x << 16); acc[h][q][1] += __uint_as_float(w.x & 0xffff0000u); acc[h][q][2] += __uint_as_float(w.y << 16); acc[h][q][3] += __uint_as_float(w.y & 0xffff0000u); } } }
#pragma unroll
        for (int h = 0; h < 2; ++h) { const int r = r0 + h * NGW;
            xa_t* xr = XA + (size_t)r * D; float s = 0.f;
#pragma unroll
            for (int q = 0; q < 4; ++q) { v[h][q] = v[h][q] + g2v[h][q] * acc[h][q]; s += (v[h][q][0] * v[h][q][0] + v[h][q][1] * v[h][q][1]) + (v[h][q][2] * v[h][q][2] + v[h][q][3] * v[h][q][3]); }
            const float rstd = 1.f / sqrtf(wave_sum(s) * (1.f / D) + EPS);
            if (l == 0) {
#pragma unroll
                for (int q = 0; q < 4; ++q) *(v2u*)(xr + 4 * (F.lane + 64 * q)) = pack_h4(v[h][q]);
                bf16* orow = H + (size_t)r * D;
#pragma unroll
                for (int q = 0; q < 4; ++q) { const f32x4 y = (v[h][q] * rstd * gn[q]) * (scn[h][q] + 1.f) + shn[h][q]; v2u o; o.x = pk2(y[0], y[1]); o.y = pk2(y[2], y[3]); *(v2u*)(orow + 4 * (F.lane + 64 * q)) = o; }
            } else {
                float* orow = p.out + (size_t)r * D;
#pragma unroll
                for (int q = 0; q < 4; ++q) { const int c = 4 * (F.lane + 64 * q); *(f32x4*)(orow + c) = v[h][q] * rstd * gn[q]; }
            } }
    }
}
__device__ __forceinline__ void ph_readout(const P& p, Frame& F) {
    bf16* H = WSP(bf16, WS_H); const bf16* OF = WSP(bf16, WS_OF); const bf16* OB = WSP(bf16, WS_OB); const bf16* PG = WSP(bf16, WS_PG);
    const int gw = F.vcu * NWAVES + F.wave, NGW = F.G * NWAVES;
    f32x4 gnv[4];
#pragma unroll
    for (int q = 0; q < 4; ++q) gnv[q] = *(const f32x4*)(p.gla_norm_g + 4 * (F.lane + 64 * q));
    for (int r0 = gw; r0 < NL; r0 += 2 * NGW) {
        v2u a[2][4], b[2][4], rr[2][4];
#pragma unroll
        for (int h = 0; h < 2; ++h) { const int r = r0 + h * NGW;
#pragma unroll
            for (int q = 0; q < 4; ++q) { const int c = 4 * (F.lane + 64 * q); a[h][q] = *(const v2u*)(OF + (size_t)r * GV + c); b[h][q] = *(const v2u*)(OB + (size_t)r * GV + c); rr[h][q] = *(const v2u*)(PG + (size_t)r * GIN + GQK + c); } }
#pragma unroll
        for (int h = 0; h < 2; ++h) { const int r = r0 + h * NGW;
#pragma unroll
            for (int q = 0; q < 4; ++q) { const int c = 4 * (F.lane + 64 * q);
                f32x4 o; o[0] = __uint_as_float(a[h][q].x << 16) + __uint_as_float(b[h][q].x << 16); o[1] = __uint_as_float(a[h][q].x & 0xffff0000u) + __uint_as_float(b[h][q].x & 0xffff0000u);
                o[2] = __uint_as_float(a[h][q].y << 16) + __uint_as_float(b[h][q].y << 16); o[3] = __uint_as_float(a[h][q].y & 0xffff0000u) + __uint_as_float(b[h][q].y & 0xffff0000u);
                const float ss = wave_sum((o[0] * o[0] + o[1] * o[1]) + (o[2] * o[2] + o[3] * o[3]));
                const float rstd = 1.f / sqrtf(ss * (1.f / GDV) + EPS);
                const f32x4 gv = gnv[q];
                const float q0 = __uint_as_float(rr[h][q].x << 16), q1 = __uint_as_float(rr[h][q].x & 0xffff0000u), q2 = __uint_as_float(rr[h][q].y << 16), q3 = __uint_as_float(rr[h][q].y & 0xffff0000u);
                const float y0 = o[0] * rstd * gv[0] * fsilu(q0), y1 = o[1] * rstd * gv[1] * fsilu(q1), y2 = o[2] * rstd * gv[2] * fsilu(q2), y3 = o[3] * rstd * gv[3] * fsilu(q3);
                v2u w; w.x = pk2(y0, y1); w.y = pk2(y2, y3); *(v2u*)(H + (size_t)r * D + c) = w; } }
    }
}

typedef float f32x16 __attribute__((ext_vector_type(16)));
typedef short s16x4 __attribute__((ext_vector_type(4)));
__device__ __forceinline__ s16x4 lds_tr16(const LAS unsigned char* p) { return __builtin_bit_cast(s16x4, __builtin_amdgcn_ds_read_tr16_b64_v4i16((LAS s16x4*)p)); }
__device__ __forceinline__ int crow(int r, int hi) { return (r & 3) + 8 * (r >> 2) + 4 * hi; }
#define TR_RD(dst, ptr) asm volatile("ds_read_b64_tr_b16 %0, %1" : "=v"(dst) : "v"((unsigned)(uintptr_t)(ptr)) : "memory")
#define TR_WAIT4(a, b, c, d) asm volatile("s_waitcnt lgkmcnt(0)" : "+v"(a), "+v"(b), "+v"(c), "+v"(d) :: "memory")
__device__ __forceinline__ void ph_attn(const P& p, Frame& F) {
    const bf16* Q = WSP(bf16, WS_Q); const bf16* Kb = WSP(bf16, WS_K); const bf16* Vb = WSP(bf16, WS_V); bf16* O = WSP(bf16, WS_O);
    const int lane = F.lane, r32 = lane & 31, hi = lane >> 5, w = F.wave, gq = w >> 1, th = w & 1;
    LAS unsigned char* Ks = F.lds; LAS unsigned char* Vs = F.lds + 3 * 8192;
    const int kl = lane >> 3, chp = lane & 7;
    const int dgrp = (lane >> 4) & 1, qrow = (lane & 15) >> 2, pp = lane & 3;
#define ATT_DEC(u_, lat_, b_, hk_, t0_, qrow0_, jlo_, nt_) do { lat_ = (u_) < 2048; \
        if (lat_) { b_ = (u_) >> 7; hk_ = ((u_) >> 5) & 3; t0_ = 64 * ((u_) & 31); qrow0_ = b_ * SEQ + t0_; } \
        else { const int uc_ = (u_) - 2048; b_ = uc_ >> 4; hk_ = (uc_ >> 2) & 3; t0_ = 64 * (uc_ & 3); qrow0_ = NL + b_ * CTX + t0_; } \
        int jhi_ = -1; jlo_ = 0; \
        if (lat_) { jlo_ = t0_ >= 128 ? 0 : (128 - t0_) / 64; jhi_ = (SEQ - 64 - (t0_ - 128)) / 64; if (jhi_ > 4) jhi_ = 4; } \
        nt_ = 4 + (jhi_ - jlo_ + 1); } while (0)
#define ATT_KROW(b_, t0_, jlo_, it) ((it) < 4 ? NL + (b_) * CTX + 64 * (it) : (b_) * SEQ + (t0_) - 128 + 64 * ((jlo_) + (it) - 4))
#define ATT_DMA(b_, hk_, t0_, jlo_, it, sl) do { const size_t so_ = ((size_t)(ATT_KROW(b_, t0_, jlo_, it) + 8 * w + kl) * 256 + (hk_) * 64) * 2 + (size_t)((chp ^ kl) * 16); \
        __builtin_amdgcn_global_load_lds((const unsigned*)((const char*)Kb + so_), (LAS unsigned*)(Ks + (sl) * 8192 + w * 1024), 16, 0, 0); \
        __builtin_amdgcn_global_load_lds((const unsigned*)((const char*)Vb + so_), (LAS unsigned*)(Vs + (sl) * 8192 + w * 1024), 16, 0, 0); } while (0)
    constexpr int NU = 2048 + 256;
    const float snk0 = p.attn_sink[gq], snk1 = p.attn_sink[4 + gq], snk2 = p.attn_sink[8 + gq], snk3 = p.attn_sink[12 + gq];
    int sc = 0, sn2 = 2;
    bool first = true;
    bf16x8 qr[4], qn[4];
    if (F.vcu < NU) { bool lat; int b, hk, t0, qrow0, jlo, nt; ATT_DEC(F.vcu, lat, b, hk, t0, qrow0, jlo, nt); (void)nt; (void)lat;
#pragma unroll
        for (int d0 = 0; d0 < 4; ++d0) qr[d0] = *(const bf16x8*)(Q + (size_t)(qrow0 + 32 * th + r32) * 1024 + (hk * 4 + gq) * 64 + d0 * 16 + hi * 8);
        ATT_DMA(b, hk, t0, jlo, 0, 0); ATT_DMA(b, hk, t0, jlo, 1, 1); }
    for (int u = F.vcu; u < NU; u += F.G) {
        bool lat; int b, hk, t0, qrow0, jlo, nt; ATT_DEC(u, lat, b, hk, t0, qrow0, jlo, nt);
        const bool has_next = u + F.G < NU;
        bool nlat; int nb, nhk, nt0, nqrow0, njlo, nnt; { const int un = has_next ? u + F.G : u; ATT_DEC(un, nlat, nb, nhk, nt0, nqrow0, njlo, nnt); (void)nnt; (void)nlat; }
        const int hq = hk * 4 + gq; const int qr_row = qrow0 + 32 * th + r32;
#pragma unroll
        for (int d0 = 0; d0 < 4; ++d0) { const bf16* qp = Q + (size_t)(nqrow0 + 32 * th + r32) * 1024 + (nhk * 4 + gq) * 64 + d0 * 16 + hi * 8;
            asm volatile("global_load_dwordx4 %0, %1, off" : "=v"(qn[d0]) : "v"(qp) : "memory"); }
        float m = (hk == 0 ? snk0 : hk == 1 ? snk1 : hk == 2 ? snk2 : snk3) * LOG2E, l = hi == 0 ? 1.f : 0.f;
        f32x16 o[2], cneg;
#pragma unroll
        for (int r = 0; r < 16; ++r) { o[0][r] = 0.f; o[1][r] = 0.f; cneg[r] = -m; }
#pragma clang loop unroll(disable)
        for (int it = 0; it < nt; ++it) {
            if (it == nt - 1) { if (has_next) asm volatile("s_waitcnt vmcnt(2)" ::: "memory"); else asm volatile("s_waitcnt vmcnt(0)" ::: "memory"); }
            else if (it < 2) { if (first) asm volatile("s_waitcnt vmcnt(6)" ::: "memory"); else asm volatile("s_waitcnt vmcnt(14)" ::: "memory"); }
            else asm volatile("s_waitcnt vmcnt(2)" ::: "memory");
            __builtin_amdgcn_s_barrier(); asm volatile("" ::: "memory");
            if (it + 2 < nt) ATT_DMA(b, hk, t0, jlo, it + 2, sn2);
            else if (has_next) ATT_DMA(nb, nhk, nt0, njlo, it + 2 - nt, sn2);
            const int slot = sc * 8192;
            f32x16 p0, p1;
#pragma unroll
            for (int d0 = 0; d0 < 4; ++d0) {
                const int off = r32 * 128 + (((2 * d0 + hi) ^ (r32 & 7)) * 16);
                const bf16x8 k0 = *(const LAS bf16x8*)(Ks + slot + off), k1 = *(const LAS bf16x8*)(Ks + slot + off + 32 * 128);
                p0 = __builtin_amdgcn_mfma_f32_32x32x16_bf16(k0, qr[d0], d0 == 0 ? cneg : p0, 0, 0, 0);
                p1 = __builtin_amdgcn_mfma_f32_32x32x16_bf16(k1, qr[d0], d0 == 0 ? cneg : p1, 0, 0, 0);
            }
            s16x4 vt[2][4][2];
#pragma unroll
            for (int dblk = 0; dblk < 2; ++dblk)
#pragma unroll
                for (int ks = 0; ks < 4; ++ks) { const int klo = 16 * ks + 4 * hi + qrow, khi = klo + 8, ch = 4 * dblk + 2 * dgrp + (pp >> 1), bo = (pp & 1) * 8;
                    TR_RD(vt[dblk][ks][0], Vs + slot + klo * 128 + ((ch ^ (klo & 7)) * 16) + bo); TR_RD(vt[dblk][ks][1], Vs + slot + khi * 128 + ((ch ^ (khi & 7)) * 16) + bo); }
            asm volatile("s_nop 7\n\ts_nop 7" : "+v"(p0), "+v"(p1));
            if (it >= 4) { const int j = jlo + it - 4;
                if (j == 0 || j == 4) { const int dq = 32 * th + r32;
                    const int sg = j == 0 ? 1 : -1;
#pragma unroll
                    for (int r = 0; r < 16; ++r) { const int kk = crow(r, hi);
                        p0[r] = sg * (dq - kk) > 0 ? -1e30f : p0[r]; p1[r] = sg * (dq - (kk + 32)) > 0 ? -1e30f : p1[r]; } } }
            float mx = p0[0];
#pragma unroll
            for (int r = 1; r < 16; ++r) mx = fmaxf(mx, p0[r]);
#pragma unroll
            for (int r = 0; r < 16; ++r) mx = fmaxf(mx, p1[r]);
            mx = fmaxf(mx, __shfl_xor(mx, 32));
            if (__any(mx > 8.f)) { const float d = fmaxf(mx, 0.f), f = __builtin_amdgcn_exp2f(-d); l *= f;
#pragma unroll
                for (int r = 0; r < 16; ++r) { o[0][r] *= f; o[1][r] *= f; p0[r] -= d; p1[r] -= d; }
                m += d;
#pragma unroll
                for (int r = 0; r < 16; ++r) cneg[r] = -m; }
            float ls = 0.f;
#pragma unroll
            for (int r = 0; r < 16; ++r) { p0[r] = __builtin_amdgcn_exp2f(p0[r]); p1[r] = __builtin_amdgcn_exp2f(p1[r]); ls += p0[r] + p1[r]; }
            l += ls;
            v4u pw[4];
#pragma unroll
            for (int q4 = 0; q4 < 4; ++q4) { pw[0][q4] = pk2(p0[2 * q4], p0[2 * q4 + 1]); pw[1][q4] = pk2(p0[8 + 2 * q4], p0[9 + 2 * q4]); pw[2][q4] = pk2(p1[2 * q4], p1[2 * q4 + 1]); pw[3][q4] = pk2(p1[8 + 2 * q4], p1[9 + 2 * q4]); }
            asm volatile("s_waitcnt lgkmcnt(0)" : "+v"(vt[0][0][0]), "+v"(vt[0][0][1]), "+v"(vt[0][1][0]), "+v"(vt[0][1][1]), "+v"(vt[0][2][0]), "+v"(vt[0][2][1]), "+v"(vt[0][3][0]), "+v"(vt[0][3][1]),
                         "+v"(vt[1][0][0]), "+v"(vt[1][0][1]), "+v"(vt[1][1][0]), "+v"(vt[1][1][1]), "+v"(vt[1][2][0]), "+v"(vt[1][2][1]), "+v"(vt[1][3][0]), "+v"(vt[1][3][1]) :: "memory");
#pragma unroll
            for (int dblk = 0; dblk < 2; ++dblk)
#pragma unroll
                for (int ks = 0; ks < 4; ++ks) { const s16x4 vlo = vt[dblk][ks][0], vhi = vt[dblk][ks][1];
                    const bf16x8 vf = (bf16x8){vlo[0], vlo[1], vlo[2], vlo[3], vhi[0], vhi[1], vhi[2], vhi[3]};
                    o[dblk] = __builtin_amdgcn_mfma_f32_32x32x16_bf16(vf, __builtin_bit_cast(bf16x8, pw[ks]), o[dblk], 0, 0, 0); }
            sc = sc == 2 ? 0 : sc + 1; sn2 = sn2 == 2 ? 0 : sn2 + 1;
        }
#undef ATT_KROW
#undef ATT_DMA
        const float il = 1.f / (l + __shfl_xor(l, 32));
        bf16* orow = O + (size_t)qr_row * 1024 + hq * 64;
#pragma unroll
        for (int dblk = 0; dblk < 2; ++dblk)
#pragma unroll
            for (int rq = 0; rq < 4; ++rq) { v2u wv; wv.x = pk2(o[dblk][4 * rq] * il, o[dblk][4 * rq + 1] * il); wv.y = pk2(o[dblk][4 * rq + 2] * il, o[dblk][4 * rq + 3] * il);
                *(v2u*)(orow + 32 * dblk + 8 * rq + 4 * hi) = wv; }
#pragma unroll
        for (int d0 = 0; d0 < 4; ++d0) qr[d0] = qn[d0];
        first = false;
    }
#undef ATT_DEC
}
__device__ __forceinline__ void ph_attn_naive(const P& p, Frame& F) {
    const bf16* Q = WSP(bf16, WS_Q); const bf16* Kb = WSP(bf16, WS_K); const bf16* Vb = WSP(bf16, WS_V); bf16* O = WSP(bf16, WS_O);
    for (int i = F.vcu * 512 + F.tid; i < NT * NQH; i += F.G * 512) {
        const int r = i >> 4, hq = i & 15, hk = hq >> 2;
        float q[64], acc[64];
#pragma unroll
        for (int d = 0; d < 64; ++d) { q[d] = bf2f(Q[(size_t)r * 1024 + hq * 64 + d]); acc[d] = 0.f; }
        float m = p.attn_sink[hq] * LOG2E, l = 1.f;
        const bool lat = r < NL; const int b = lat ? r / SEQ : (r - NL) / CTX, t = r & (SEQ - 1);
        const int nlat = lat ? (min(SEQ - 1, t + 128) - max(0, t - 128) + 1) : 0, klo = max(0, t - 128);
        for (int kk = 0; kk < CTX + nlat; ++kk) {
            const int kr = kk < CTX ? NL + b * CTX + kk : b * SEQ + klo + (kk - CTX);
            const bf16* kp = Kb + (size_t)kr * 256 + hk * 64; const bf16* vp = Vb + (size_t)kr * 256 + hk * 64;
            float s = 0.f;
#pragma unroll
            for (int d = 0; d < 64; ++d) s += q[d] * bf2f(kp[d]);
            const float mn = fmaxf(m, s), sc = exp2f(m - mn), pe = exp2f(s - mn);
            l = l * sc + pe; m = mn;
#pragma unroll
            for (int d = 0; d < 64; ++d) acc[d] = acc[d] * sc + pe * bf2f(vp[d]);
        }
        const float il = 1.f / l;
#pragma unroll
        for (int d = 0; d < 64; ++d) O[(size_t)r * 1024 + hq * 64 + d] = (bf16)f2bf(acc[d] * il);
    }
}
__device__ __forceinline__ f32x4 mfma16(bf16x8 a, bf16x8 b, f32x4 c) { return __builtin_amdgcn_mfma_f32_16x16x32_bf16(a, b, c, 0, 0, 0); }
__device__ __forceinline__ int gla_rowmap(int b, int dir, int s) { return s < CTX ? NL + b * CTX + (dir ? CTX - 1 - s : s) : b * SEQ + (dir ? SEQ - 1 - (s - CTX) : s - CTX); }
__device__ __forceinline__ void glaprep_unit(const P& p, Frame& F, int uu, const bf16x8 (&lrf)[4], const v2u (&kk4)[2][4], const v2u (&qq4)[2][4], const LAS float* w2s, const LAS float* bs2) {
    bf16* QT = WSP(bf16, WS_QT); bf16* KT = WSP(bf16, WS_KT); float* DEC = WSP(float, WS_DEC);
    const int lane = F.lane, w = F.wave, c16 = lane & 15, g = lane >> 4;
    const int hf = uu & 1, u = uu >> 1, c = u % 36, dir = (u / 36) & 1, b = u / 72;
    const size_t obase = ((size_t)(dir * NB + b) * 2304 + 64 * c) * 512;
#pragma unroll
    for (int ctl = 0; ctl < 2; ++ctl) { const int col0 = 256 * hf + 16 * (2 * w + ctl);
        v4u wp = (v4u){0u, 0u, 0u, 0u};
        if (g < 2) { const LAS float* wsrc = w2s + (dir * 16 + 8 * g) * 512 + col0 + c16;
            wp.x = pk2(wsrc[0], wsrc[512]); wp.y = pk2(wsrc[1024], wsrc[1536]); wp.z = pk2(wsrc[2048], wsrc[2560]); wp.w = pk2(wsrc[3072], wsrc[3584]); }
        const bf16x8 wf = __builtin_bit_cast(bf16x8, wp);
        const f32x4 bias = *(const LAS f32x4*)(bs2 + dir * 512 + col0 + 4 * g);
        f32x4 carry = (f32x4){0.f, 0.f, 0.f, 0.f};
#pragma unroll
        for (int tt = 0; tt < 4; ++tt) {
            const int tok = 16 * tt + c16;
            const v2u kk = kk4[ctl][tt], qq = qq4[ctl][tt];
            const f32x4 z = mfma16(wf, lrf[tt], bias);
            f32x4 ls;
#pragma unroll
            for (int r = 0; r < 4; ++r) ls[r] = (fminf(z[r], 0.f) - flog(1.f + fexp(-fabsf(z[r])))) * (1.f / 16.f);
#pragma unroll
            for (int r = 0; r < 4; ++r) { ls[r] += dpp_shr<1>(ls[r]); ls[r] += dpp_shr<2>(ls[r]); ls[r] += dpp_shr<4>(ls[r]); ls[r] += dpp_shr<8>(ls[r]); }
            f32x4 bs = carry + ls;
#pragma unroll
            for (int r = 0; r < 4; ++r) carry[r] += __shfl(ls[r], 15, 16);
            const float k0 = __uint_as_float(kk.x << 16), k1 = __uint_as_float(kk.x & 0xffff0000u), k2 = __uint_as_float(kk.y << 16), k3 = __uint_as_float(kk.y & 0xffff0000u);
            v2u ko; ko.x = pk2(k0 * fexp(-bs[0]), k1 * fexp(-bs[1])); ko.y = pk2(k2 * fexp(-bs[2]), k3 * fexp(-bs[3]));
            *(v2u*)(KT + obase + (size_t)tok * 512 + col0 + 4 * g) = ko;
            if (c >= 4) { const float q0 = __uint_as_float(qq.x << 16), q1 = __uint_as_float(qq.x & 0xffff0000u), q2 = __uint_as_float(qq.y << 16), q3 = __uint_as_float(qq.y & 0xffff0000u);
                v2u qo; qo.x = pk2(q0 * GLA_QS * fexp(bs[0]), q1 * GLA_QS * fexp(bs[1])); qo.y = pk2(q2 * GLA_QS * fexp(bs[2]), q3 * GLA_QS * fexp(bs[3]));
                *(v2u*)(QT + obase + (size_t)tok * 512 + col0 + 4 * g) = qo; }
        }
        if (c16 == 15) { f32x4 dv; dv[0] = fexp(carry[0]); dv[1] = fexp(carry[1]); dv[2] = fexp(carry[2]); dv[3] = fexp(carry[3]);
            *(f32x4*)(DEC + ((size_t)(dir * NB + b) * 36 + c) * 512 + col0 + 4 * g) = dv; }
    }
}
__device__ __forceinline__ void ph_glaprep(const P& p, Frame& F) {
    const bf16* PG = WSP(bf16, WS_PG);
    const int lane = F.lane, w = F.wave, c16 = lane & 15, g = lane >> 4;
    LAS float* w2s = (LAS float*)F.lds; LAS float* bs2 = w2s + 2 * 16 * 512;
    for (int i = F.tid; i < 2 * 16 * 512 / 4; i += 512) ((LAS f32x4*)w2s)[i] = ((const f32x4*)p.gla_gate_w2)[i];
    for (int i = F.tid; i < 2 * 512 / 4; i += 512) ((LAS f32x4*)bs2)[i] = ((const f32x4*)p.gla_gate_b)[i];
    constexpr int NU = NB * 2 * 36 * 2;
#define PREP_LOAD(uu_, LRF, KK, QQ) do { const int hf_ = (uu_) & 1, u_ = (uu_) >> 1, c_ = u_ % 36, dir_ = (u_ / 36) & 1, b_ = u_ / 72; \
        const int rowA_ = gla_rowmap(b_, dir_, 64 * c_), rstep_ = dir_ ? -1 : 1;         \
        _Pragma("unroll") for (int tt = 0; tt < 4; ++tt) { LRF[tt] = (bf16x8){0, 0, 0, 0, 0, 0, 0, 0}; \
            if (g < 2) LRF[tt] = *(const bf16x8*)(PG + (size_t)(rowA_ + rstep_ * (16 * tt + c16)) * GIN + 3072 + 16 * dir_ + 8 * g); } \
        _Pragma("unroll") for (int ctl = 0; ctl < 2; ++ctl) { const int col0_ = 256 * hf_ + 16 * (2 * w + ctl); \
            _Pragma("unroll") for (int tt = 0; tt < 4; ++tt) { const bf16* pr_ = PG + (size_t)(rowA_ + rstep_ * (16 * tt + c16)) * GIN + col0_ + 4 * g; \
                KK[ctl][tt] = *(const v2u*)(pr_ + GQR); QQ[ctl][tt] = (v2u){0u, 0u}; if (c_ >= 4) QQ[ctl][tt] = *(const v2u*)pr_; } } } while (0)
    bf16x8 lrA[4], lrB[4]; v2u kkA[2][4], qqA[2][4], kkB[2][4], qqB[2][4];
    int uu = F.vcu;
    if (uu < NU) PREP_LOAD(uu, lrA, kkA, qqA);
    LDS_SYNC();
#pragma clang loop unroll(disable)
    for (; uu < NU; uu += 2 * F.G) {
        const bool has1 = uu + F.G < NU, has2 = uu + 2 * F.G < NU;
        if (has1) PREP_LOAD(uu + F.G, lrB, kkB, qqB);
        glaprep_unit(p, F, uu, lrA, kkA, qqA, w2s, bs2);
        if (has1) { if (has2) PREP_LOAD(uu + 2 * F.G, lrA, kkA, qqA);
            glaprep_unit(p, F, uu + F.G, lrB, kkB, qqB, w2s, bs2); }
    }
#undef PREP_LOAD
    __syncthreads();
}
__device__ __forceinline__ void ph_glascan(const P& p, Frame& F) {
    const bf16* PG = WSP(bf16, WS_PG); const bf16* QT = WSP(bf16, WS_QT); const bf16* KT = WSP(bf16, WS_KT); const float* DEC = WSP(float, WS_DEC);
    const int lane = F.lane, w = F.wave, g = lane >> 4, c16 = lane & 15, qrow = c16 >> 2, pp = c16 & 3;
    constexpr int BUF = 49152, QOFF = 0, KOFF = 16384, VOFF = 32768, AM = 98304, DCO = 106496;
    LAS unsigned char* L = F.lds; LAS unsigned char* stg = L + DCO + 1024 + w * 2048;
    for (int u = F.vcu; u < 256; u += F.G) {
        const int dvh = u & 1, dir = (u >> 1) & 1, h = (u >> 2) & 3, b = u >> 4;
        bf16* OUT = WSP(bf16, WS_OF) + (dir ? (size_t)(WS_OB - WS_OF) / 2 : 0);
        const size_t seqbase = (size_t)(dir * NB + b) * 2304;
#define GLA_STAGE(c, bufi) do { _Pragma("unroll") for (int pc = 0; pc < 2; ++pc) { const int piece = w + 8 * pc, row = piece * 4 + g, chs = c16 ^ (row & 15); \
            const size_t srow = seqbase + 64 * (c) + row; const unsigned ldst = (bufi) * BUF + piece * 1024; \
            if ((c) >= 4) __builtin_amdgcn_global_load_lds((const unsigned*)((const char*)(QT + srow * 512 + h * 128) + chs * 16), (LAS unsigned*)(L + QOFF + ldst), 16, 0, 0); \
            __builtin_amdgcn_global_load_lds((const unsigned*)((const char*)(KT + srow * 512 + h * 128) + chs * 16), (LAS unsigned*)(L + KOFF + ldst), 16, 0, 0); \
            __builtin_amdgcn_global_load_lds((const unsigned*)((const char*)(PG + (size_t)gla_rowmap(b, dir, 64 * (c) + row) * GIN + GQR + GQK + h * 256 + dvh * 128) + chs * 16), (LAS unsigned*)(L + VOFF + ldst), 16, 0, 0); } \
            if (w == 0 && lane < 32) __builtin_amdgcn_global_load_lds((const unsigned*)((const char*)(DEC + ((size_t)(dir * NB + b) * 36 + (c)) * 512 + h * 128) + lane * 16), (LAS unsigned*)(L + DCO + (bufi) * 512), 16, 0, 0); } while (0)
        f32x4 S[8];
#pragma unroll
        for (int t = 0; t < 8; ++t) S[t] = (f32x4){0.f, 0.f, 0.f, 0.f};
        GLA_STAGE(0, 0);
        asm volatile("s_waitcnt vmcnt(0)" ::: "memory"); __builtin_amdgcn_s_barrier(); asm volatile("" ::: "memory");
#pragma clang loop unroll(disable)
        for (int c = 0; c < 36; ++c) {
            const int bi = c & 1; LAS unsigned char* Qs = L + bi * BUF + QOFF; LAS unsigned char* Ksm = L + bi * BUF + KOFF; LAS unsigned char* Vsm = L + bi * BUF + VOFF; LAS unsigned char* Am = L + AM;
            if (c + 1 < 36) GLA_STAGE(c + 1, bi ^ 1);
            if (c >= 4) {
#pragma unroll
                for (int q2 = 0; q2 < 2; ++q2) { const int id = 2 * w + q2, ti = id >> 2, tj = id & 3; f32x4 a = (f32x4){0.f, 0.f, 0.f, 0.f};
                    if (tj <= ti) {
#pragma unroll
                        for (int ks = 0; ks < 4; ++ks) { const int co = ((4 * ks + g) ^ c16) * 16;
                            const bf16x8 qa = *(const LAS bf16x8*)(Qs + (16 * ti + c16) * 256 + co), kb = *(const LAS bf16x8*)(Ksm + (16 * tj + c16) * 256 + co);
                            a = mfma16(qa, kb, a); }
                        asm volatile("s_nop 7\n\ts_nop 7" : "+v"(a));
                        if (tj == ti) {
#pragma unroll
                            for (int r = 0; r < 4; ++r) a[r] = c16 > 4 * g + r ? 0.f : a[r]; } }
#pragma unroll
                    for (int r = 0; r < 4; ++r) { const int i = 16 * ti + 4 * g + r; *(LAS bf16*)(Am + i * 128 + (((2 * tj + (c16 >> 3)) ^ (i & 7)) * 16) + (c16 & 7) * 2) = (bf16)f2bf(a[r]); } }
            }
            asm volatile("s_waitcnt lgkmcnt(0)" ::: "memory"); __builtin_amdgcn_s_barrier(); asm volatile("" ::: "memory");
            bf16x8 vf[2];
            { s16x4 t0, t1, t2, t3; const int ch = 2 * w + (pp >> 1), bo = (pp & 1) * 8, rl = 8 * g + qrow;
              TR_RD(t0, Vsm + rl * 256 + ((ch ^ (rl & 15)) * 16) + bo); TR_RD(t1, Vsm + (rl + 4) * 256 + ((ch ^ ((rl + 4) & 15)) * 16) + bo);
              TR_RD(t2, Vsm + (rl + 32) * 256 + ((ch ^ (rl & 15)) * 16) + bo); TR_RD(t3, Vsm + (rl + 36) * 256 + ((ch ^ ((rl + 4) & 15)) * 16) + bo);
              TR_WAIT4(t0, t1, t2, t3);
              vf[0] = (bf16x8){t0[0], t0[1], t0[2], t0[3], t1[0], t1[1], t1[2], t1[3]}; vf[1] = (bf16x8){t2[0], t2[1], t2[2], t2[3], t3[0], t3[1], t3[2], t3[3]}; }
            if (c >= 4) {
                bf16x8 sf[4];
#pragma unroll
                for (int ks = 0; ks < 4; ++ks) { v4u t4; t4.x = pk2(S[2 * ks][0], S[2 * ks][1]); t4.y = pk2(S[2 * ks][2], S[2 * ks][3]); t4.z = pk2(S[2 * ks + 1][0], S[2 * ks + 1][1]); t4.w = pk2(S[2 * ks + 1][2], S[2 * ks + 1][3]); sf[ks] = __builtin_bit_cast(bf16x8, t4); }
#pragma unroll
                for (int tt = 0; tt < 4; ++tt) { f32x4 o = (f32x4){0.f, 0.f, 0.f, 0.f}; const int row = 16 * tt + c16;
#pragma unroll
                    for (int ks = 0; ks < 4; ++ks) { const int ch0 = 4 * ks + (g >> 1), bo = (g & 1) * 8;
                        const s16x4 alo = *(const LAS s16x4*)(Qs + row * 256 + ((ch0 ^ c16) * 16) + bo), ahi = *(const LAS s16x4*)(Qs + row * 256 + (((ch0 + 2) ^ c16) * 16) + bo);
                        o = mfma16((bf16x8){alo[0], alo[1], alo[2], alo[3], ahi[0], ahi[1], ahi[2], ahi[3]}, sf[ks], o); }
#pragma unroll
                    for (int ks2 = 0; ks2 < 2; ++ks2) { const bf16x8 am = *(const LAS bf16x8*)(Am + row * 128 + (((4 * ks2 + g) ^ (row & 7)) * 16)); o = mfma16(am, vf[ks2], o); }
#pragma unroll
                    for (int r = 0; r < 4; ++r) *(LAS bf16*)(stg + (16 * tt + 4 * g + r) * 32 + c16 * 2) = (bf16)f2bf(o[r]); }
#pragma unroll
                for (int pc = 0; pc < 2; ++pc) { const int pi = lane + 64 * pc, tok = pi >> 1; const v4u ov = *(const LAS v4u*)(stg + pi * 16);
                    *(v4u*)(OUT + (size_t)gla_rowmap(b, dir, 64 * c + tok) * GV + h * 256 + dvh * 128 + 16 * w + (pi & 1) * 8) = ov; }
            }
#pragma unroll
            for (int t = 0; t < 8; ++t) { f32x4 acc = S[t];
                { s16x4 t0, t1, t2, t3; const int ch = 2 * t + (pp >> 1), bo = (pp & 1) * 8, rl = 8 * g + qrow;
                  TR_RD(t0, Ksm + rl * 256 + ((ch ^ (rl & 15)) * 16) + bo); TR_RD(t1, Ksm + (rl + 4) * 256 + ((ch ^ ((rl + 4) & 15)) * 16) + bo);
                  TR_RD(t2, Ksm + (rl + 32) * 256 + ((ch ^ (rl & 15)) * 16) + bo); TR_RD(t3, Ksm + (rl + 36) * 256 + ((ch ^ ((rl + 4) & 15)) * 16) + bo);
                  TR_WAIT4(t0, t1, t2, t3);
                  acc = mfma16((bf16x8){t0[0], t0[1], t0[2], t0[3], t1[0], t1[1], t1[2], t1[3]}, vf[0], acc);
                  acc = mfma16((bf16x8){t2[0], t2[1], t2[2], t2[3], t3[0], t3[1], t3[2], t3[3]}, vf[1], acc); }
                const f32x4 d4 = *(const LAS f32x4*)(L + DCO + bi * 512 + (16 * t + 4 * g) * 4);
                S[t] = acc * d4; }
            if (c >= 4) asm volatile("s_waitcnt vmcnt(2) lgkmcnt(0)" ::: "memory"); else asm volatile("s_waitcnt vmcnt(0) lgkmcnt(0)" ::: "memory");
            __builtin_amdgcn_s_barrier(); asm volatile("" ::: "memory");
        }
#undef GLA_STAGE
    }
}
__device__ __forceinline__ void ph_scan_naive(const P& p, Frame& F) {
    const bf16* PG = WSP(bf16, WS_PG);
    LAS float* sq = (LAS float*)F.lds; LAS float* sk = sq + 128; LAS float* sa = sk + 128; LAS float* sv = sa + 128; LAS float* so = sv + 64;
    const int tid = F.tid, e = tid & 63, w = tid >> 6;
    for (int u = F.vcu; u < 512; u += F.G) {
        const int sl = u & 3, dir = (u >> 2) & 1, h = (u >> 3) & 3, b = u >> 5;
        float S[16];
#pragma unroll
        for (int i = 0; i < 16; ++i) S[i] = 0.f;
        bf16* OUT = WSP(bf16, WS_OF) + (dir ? (size_t)(WS_OB - WS_OF) / 2 : 0);
        for (int step = 0; step < CTX + SEQ; ++step) {
            int row; if (step < CTX) row = NL + b * CTX + (dir ? CTX - 1 - step : step); else { const int t = step - CTX; row = b * SEQ + (dir ? SEQ - 1 - t : t); }
            const bf16* pr = PG + (size_t)row * GIN;
            if (tid < 128) { const int col = h * 128 + tid; float z = p.gla_gate_b[dir * 512 + col];
#pragma unroll
                for (int r = 0; r < 16; ++r) z += bf2f(pr[3072 + dir * 16 + r]) * p.gla_gate_w2[(size_t)(dir * 16 + r) * 512 + col];
                const float ls = fminf(z, 0.f) - log1pf(expf(-fabsf(z)));
                sq[tid] = bf2f(pr[col]) * GLA_QS; sk[tid] = bf2f(pr[GQR + col]); sa[tid] = expf(ls * (1.f / 16.f)); }
            else if (tid < 192) sv[tid - 128] = bf2f(pr[GQR + GQK + h * 256 + sl * 64 + tid - 128]);
            __syncthreads();
            const float v = sv[e]; float o = 0.f;
#pragma unroll
            for (int i = 0; i < 16; ++i) { const int d = 16 * w + i; S[i] = sa[d] * S[i] + sk[d] * v; o += sq[d] * S[i]; }
            so[w * 64 + e] = o;
            __syncthreads();
            if (step >= CTX && tid < 64) { float s = 0.f;
#pragma unroll
                for (int q = 0; q < 8; ++q) s += so[q * 64 + tid];
                OUT[(size_t)row * GV + h * 256 + sl * 64 + tid] = (bf16)f2bf(s); }
        }
        __syncthreads();
    }
}

enum Phase { PH_PRO = 0, PH_NORM1_0, PH_QKV, PH_ATTN, PH_OUT0, PH_N2R0, PH_TOPK0, PH_UP0, PH_DN0, PH_COMB0, PH_GLAIN, PH_PREP, PH_SCAN, PH_READ, PH_OUT1, PH_N2R1, PH_TOPK1, PH_UP1, PH_DN1, PH_COMB1, PH_END };

__global__ void __launch_bounds__(NWAVES * 64, 2) k_fwd(P p) {
    extern __shared__ __attribute__((aligned(16))) unsigned char lds[];
    Frame F;
    F.lds = (LAS unsigned char*)lds;
    F.tid = threadIdx.x; F.lane = F.tid & 63; F.wave = __builtin_amdgcn_readfirstlane(F.tid >> 6);
    F.G = gridDim.x; { const int bx = blockIdx.x; F.vcu = (F.G % 8 == 0) ? (bx % 8) * (F.G / 8) + bx / 8 : bx; }
    F.ws = p.ws;
    volatile LAS unsigned* MISC = (volatile LAS unsigned*)(F.lds + MISC_OFF);
    for (int u = F.tid; u < (LDS_BYTES - LDSCTL_OFF) / 4; u += NWAVES * 64) ((LAS unsigned*)(F.lds + LDSCTL_OFF))[u] = 0u;
    __syncthreads();
    const int lo = p.lo, hi = p.hi;
    XcdBarrier bar; bar.bar = (unsigned*)(F.ws + WS_CTL) + CW_BAR; bar.x = 0; bar.st = nullptr;
    if (hi - lo > 1) bar = xcd_barrier_post((unsigned*)(F.ws + WS_CTL) + CW_BAR, MISC + 8);
#define IN(k) (lo <= (k) && (k) < hi)
#define SEAM(k) do { if (IN(k) && IN((k) + 1)) xcd_barrier(bar, F.tid == 0); } while (0)
#define PHASE(k, ...) do { if (IN(k)) { F.lane = (int)__builtin_amdgcn_mbcnt_hi(~0u, __builtin_amdgcn_mbcnt_lo(~0u, 0u)); F.tid = F.wave * 64 + F.lane; __VA_ARGS__; if ((PROBE_MASK >> (k)) & 1) { xcd_barrier(bar, F.tid == 0); __VA_ARGS__; } } SEAM(k); } while (0)
    PHASE(PH_PRO, ph_pro(p, F, (OPT_MASK & 0xff) != 0));
    PHASE(PH_NORM1_0, ph_norm1(p, F, 0));
    PHASE(PH_QKV, {
        pg8::Gemm g{WSP(bf16, WS_H), WSP(bf16, WS_WQKV), D * 2, nullptr}; pg8::TileOrder S; S.init(1, NT / 256, ATT_N / 256, NT / 256, F.G, (int)blockIdx.x);
        pg8::EpiQKV E{WSP(bf16, WS_Q), WSP(bf16, WS_K), WSP(bf16, WS_V), WSP(float, WS_ROPE)};
        pg8::gemm_phase<pg8::EpiQKV, pg8::TileOrder>(F.lds, g, S, E, F.tid);
        BG_SLOT(96, CVT_SPLIT0, CVT_Q1); });
    PHASE(PH_ATTN, { if (OPT_MASK & 256) ph_attn(p, F); else ph_attn_naive(p, F); });
    PHASE(PH_OUT0, {
        pg8::Gemm g{WSP(bf16, WS_O), WSP(bf16, WS_WO0), D * 2, nullptr}; pg8::TileOrder S; S.init(1, NT / 256, D / 256, NT / 256, F.G, (int)blockIdx.x);
        pg8::EpiResidT<false> E{p.x, p.ctx, WSP(xa_t, WS_XA), WSP(float, WS_MOD) + 2048};
        pg8::gemm_phase<pg8::EpiResidT<false>, pg8::TileOrder>(F.lds, g, S, E, F.tid);
        BG_SLOT(64, CVT_Q1, CVT_Q2); });
    PHASE(PH_N2R0, ph_norm2r(p, F, 0));
    PHASE(PH_TOPK0, ph_topkg(p, F, 0));
    PHASE(PH_UP0, {
        pg8::Gemm g{MOE_FP8 ? (const void*)WSP(unsigned char, WS_H8) : (const void*)WSP(bf16, WS_H), WSP(unsigned char, WS_WUP), D * EB, WSP(int, WS_ROWIDX)}; pg8::TileOrder S; S.init(NE, ESLOTS / 256, FF / 128, ESLOTS / 256, F.G, (int)blockIdx.x);
        pg8::EpiSwiglu E{WSP(unsigned char, WS_ACT)};
        pg8::gemm_phase<pg8::EpiSwiglu, pg8::TileOrder, MOE_FP8 != 0, true, true>(F.lds, g, S, E, F.tid);
        BG_SLOT(192, CVT_Q2, CVT_Q3); });
    PHASE(PH_DN0, {
        pg8::Gemm g{WSP(unsigned char, WS_ACT), WSP(unsigned char, WS_WDN), FF * EB, nullptr}; pg8::TileOrder S; S.init(NE, ESLOTS / 256, D / 256, ESLOTS / 256, F.G, (int)blockIdx.x);
        pg8::EpiDown E{WSP(bf16, WS_YS), WSP(float, WS_ROWG)};
        pg8::gemm_phase<pg8::EpiDown, pg8::TileOrder, MOE_FP8 != 0>(F.lds, g, S, E, F.tid);
        BG_SLOT(128, CVT_Q3, NPAIR_ALL); });
    PHASE(PH_COMB0, ph_combine(p, F, 0));
    PHASE(PH_GLAIN, {
        pg8::Gemm g{WSP(bf16, WS_H), WSP(bf16, WS_WGIN), D * 2, nullptr}; pg8::GlaInOrder S{F.G, (int)blockIdx.x};
        pg8::EpiGlaIn E{WSP(bf16, WS_PG)};
        pg8::gemm_phase<pg8::EpiGlaIn, pg8::GlaInOrder>(F.lds, g, S, E, F.tid); });
    PHASE(PH_PREP, { if (OPT_MASK & 512) ph_glaprep(p, F); });
    PHASE(PH_SCAN, { if (OPT_MASK & 512) ph_glascan(p, F); else ph_scan_naive(p, F); });
    PHASE(PH_READ, ph_readout(p, F));
    PHASE(PH_OUT1, {
        pg8::Gemm g{WSP(bf16, WS_H), WSP(bf16, WS_WO1), D * 2, nullptr}; pg8::TileOrder S; S.init(1, NL / 256, D / 256, NL / 256, F.G, (int)blockIdx.x);
        pg8::EpiResidT<true> E{nullptr, nullptr, WSP(xa_t, WS_XA), WSP(float, WS_MOD) + 17 * 6144 + 2048};
        pg8::gemm_phase<pg8::EpiResidT<true>, pg8::TileOrder>(F.lds, g, S, E, F.tid); });
    PHASE(PH_N2R1, ph_norm2r(p, F, 1));
    PHASE(PH_TOPK1, ph_topkg(p, F, 1));
    PHASE(PH_UP1, {
        pg8::Gemm g{MOE_FP8 ? (const void*)WSP(unsigned char, WS_H8) : (const void*)WSP(bf16, WS_H), WSP(unsigned char, WS_WUP) + (size_t)NE * 5632 * D * EB, D * EB, WSP(int, WS_ROWIDX)}; pg8::TileOrder S; S.init(NE, NB * CAPL / 256, FF / 128, ESLOTS / 256, F.G, (int)blockIdx.x);
        pg8::EpiSwiglu E{WSP(unsigned char, WS_ACT)};
        pg8::gemm_phase<pg8::EpiSwiglu, pg8::TileOrder, MOE_FP8 != 0, true, true>(F.lds, g, S, E, F.tid); });
    PHASE(PH_DN1, {
        pg8::Gemm g{WSP(unsigned char, WS_ACT), WSP(unsigned char, WS_WDN) + (size_t)NE * D * FF * EB, FF * EB, nullptr}; pg8::TileOrder S; S.init(NE, NB * CAPL / 256, D / 256, ESLOTS / 256, F.G, (int)blockIdx.x);
        pg8::EpiDown E{WSP(bf16, WS_YS), WSP(float, WS_ROWG)};
        pg8::gemm_phase<pg8::EpiDown, pg8::TileOrder, MOE_FP8 != 0>(F.lds, g, S, E, F.tid); });
    PHASE(PH_COMB1, ph_combine(p, F, 1));
#undef PHASE
#undef IN
#undef SEAM
}

__global__ void __launch_bounds__(256) n_gemm(const bf16* A, int lda, const float* W, int ldw, float* C, int ldc, int M, int N, int K) {
    __shared__ float As[16][65], Bs[16][64];
    const int t = threadIdx.x, tx = t & 15, ty = t >> 4, m0 = blockIdx.y * 64, n0 = blockIdx.x * 64;
    float acc[4][4];
#pragma unroll
    for (int i = 0; i < 4; ++i)
#pragma unroll
        for (int j = 0; j < 4; ++j) acc[i][j] = 0.f;
    for (int k0 = 0; k0 < K; k0 += 16) {
        { const int r = t >> 2, kq = (t & 3) * 4; const v2u w = *(const v2u*)(A + (size_t)(m0 + r) * lda + k0 + kq);
          As[kq + 0][r] = __uint_as_float(w.x << 16); As[kq + 1][r] = __uint_as_float(w.x & 0xffff0000u); As[kq + 2][r] = __uint_as_float(w.y << 16); As[kq + 3][r] = __uint_as_float(w.y & 0xffff0000u); }
        { const int k = t >> 4, n = (t & 15) * 4;
#pragma unroll
          for (int j = 0; j < 4; ++j) Bs[k][n + j] = (n0 + n + j < N) ? W[(size_t)(k0 + k) * ldw + n0 + n + j] : 0.f; }
        __syncthreads();
#pragma unroll
        for (int kk = 0; kk < 16; ++kk) { float a[4], b[4];
#pragma unroll
            for (int i = 0; i < 4; ++i) { a[i] = As[kk][ty * 4 + i]; b[i] = Bs[kk][tx * 4 + i]; }
#pragma unroll
            for (int i = 0; i < 4; ++i)
#pragma unroll
                for (int j = 0; j < 4; ++j) acc[i][j] += a[i] * b[j]; }
        __syncthreads();
    }
#pragma unroll
    for (int i = 0; i < 4; ++i)
#pragma unroll
        for (int j = 0; j < 4; ++j) if (n0 + tx * 4 + j < N) C[(size_t)(m0 + ty * 4 + i) * ldc + n0 + tx * 4 + j] = acc[i][j];
}
__global__ void n_post_qkv(const float* T, int r0, int rows, bf16* Q, bf16* Kb, bf16* Vb) {
    const size_t i = (size_t)blockIdx.x * blockDim.x + threadIdx.x; if (i >= (size_t)rows * ATT_N) return;
    const int rl = (int)(i / ATT_N), c = (int)(i % ATT_N), r = r0 + rl; float val = T[i];
    if (c < 1280 && r < NL) { const int d = c & 63, a = d >> 5, s = (d >> 4) & 1, f = d & 15, t = r & (SEQ - 1); const float xp = T[(size_t)rl * ATT_N + (s ? c - 16 : c + 16)];
        const float inv = powf(10000.f, -(float)f / 16.f), ang = (float)(a ? (t & 63) : (t >> 6)) * inv, cs = cosf(ang), sn = sinf(ang);
        val = s == 0 ? val * cs - xp * sn : val * cs + xp * sn; }
    if (c < 1024) Q[(size_t)r * 1024 + c] = (bf16)f2bf(val * QSCALE); else if (c < 1280) Kb[(size_t)r * 256 + c - 1024] = (bf16)f2bf(val); else Vb[(size_t)r * 256 + c - 1280] = (bf16)f2bf(val);
}
__global__ void n_post_resid(const float* T, int r0, int rows, const float* xlat, const float* xctx, float* XA, const float* mod_g) {
    const size_t i = (size_t)blockIdx.x * blockDim.x + threadIdx.x; if (i >= (size_t)rows * D) return;
    const int rl = (int)(i / D), c = (int)(i % D), r = r0 + rl; const int j = r < NL ? r / SEQ : 16;
    const float xs = r < NL ? xlat[(size_t)r * D + c] : xctx[(size_t)(r - NL) * D + c];
    XA[(size_t)r * D + c] = xs + mod_g[(size_t)j * 6144 + c] * T[i];
}
__global__ void n_post_swiglu(const float* T, int rows, bf16* ACTrow0) {
    const size_t i = (size_t)blockIdx.x * blockDim.x + threadIdx.x; if (i >= (size_t)rows * FF) return;
    const int rl = (int)(i / FF), f = (int)(i % FF); const float g = T[(size_t)rl * 5632 + f], u = T[(size_t)rl * 5632 + FF + f];
    ACTrow0[(size_t)rl * FF + f] = (bf16)f2bf(silu_f(g) * u);
}
__global__ void n_post_down(const float* T, int rows, bf16* YSrow0, const float* rowg0) {
    const size_t i = (size_t)blockIdx.x * blockDim.x + threadIdx.x; if (i >= (size_t)rows * D) return;
    const int rl = (int)(i / D); YSrow0[i] = (bf16)f2bf(rowg0[rl] * T[i]);
}
__global__ void n_post_cast(const float* T, size_t n, bf16* O) { const size_t i = (size_t)blockIdx.x * blockDim.x + threadIdx.x; if (i < n) O[i] = (bf16)f2bf(T[i]); }
__global__ void __launch_bounds__(256) n_attn(const bf16* Q, const bf16* Kb, const bf16* Vb, const float* sink, bf16* O) {
    const int i = blockIdx.x * blockDim.x + threadIdx.x; if (i >= NT * NQH) return;
    const int r = i >> 4, hq = i & 15, hk = hq >> 2;
    float q[64], acc[64];
#pragma unroll
    for (int d = 0; d < 64; ++d) { q[d] = bf2f(Q[(size_t)r * 1024 + hq * 64 + d]); acc[d] = 0.f; }
    float m = sink[hq] * LOG2E, l = 1.f;
    const bool lat = r < NL; const int b = lat ? r / SEQ : (r - NL) / CTX, t = r & (SEQ - 1);
    const int nlat = lat ? (min(SEQ - 1, t + 128) - max(0, t - 128) + 1) : 0, klo = max(0, t - 128);
    for (int kk = 0; kk < CTX + nlat; ++kk) {
        const int kr = kk < CTX ? NL + b * CTX + kk : b * SEQ + klo + (kk - CTX);
        const bf16* kp = Kb + (size_t)kr * 256 + hk * 64; const bf16* vp = Vb + (size_t)kr * 256 + hk * 64;
        float s = 0.f;
#pragma unroll
        for (int d = 0; d < 64; ++d) s += q[d] * bf2f(kp[d]);
        const float mn = fmaxf(m, s), sc = exp2f(m - mn), pe = exp2f(s - mn);
        l = l * sc + pe; m = mn;
#pragma unroll
        for (int d = 0; d < 64; ++d) acc[d] = acc[d] * sc + pe * bf2f(vp[d]);
    }
    const float il = 1.f / l;
#pragma unroll
    for (int d = 0; d < 64; ++d) O[(size_t)r * 1024 + hq * 64 + d] = (bf16)f2bf(acc[d] * il);
}
__global__ void __launch_bounds__(512) n_glascan(const bf16* PG, const float* w2, const float* gb, bf16* OF, bf16* OB) {
    const int u = blockIdx.x, sl = u & 3, dir = (u >> 2) & 1, h = (u >> 3) & 3, b = u >> 5;
    __shared__ float sq[128], sk[128], sa[128], sv[64], so[8][64];
    const int tid = threadIdx.x, e = tid & 63, w = tid >> 6;
    float S[16];
#pragma unroll
    for (int i = 0; i < 16; ++i) S[i] = 0.f;
    bf16* OUT = dir ? OB : OF;
    for (int step = 0; step < CTX + SEQ; ++step) {
        int row; if (step < CTX) row = NL + b * CTX + (dir ? CTX - 1 - step : step); else { const int t = step - CTX; row = b * SEQ + (dir ? SEQ - 1 - t : t); }
        const bf16* pr = PG + (size_t)row * GIN;
        if (tid < 128) { const int col = h * 128 + tid; float z = gb[dir * 512 + col];
#pragma unroll
            for (int r = 0; r < 16; ++r) z += bf2f(pr[3072 + dir * 16 + r]) * w2[(size_t)(dir * 16 + r) * 512 + col];
            const float ls = fminf(z, 0.f) - log1pf(expf(-fabsf(z)));
            sq[tid] = bf2f(pr[col]) * GLA_QS; sk[tid] = bf2f(pr[GQR + col]); sa[tid] = expf(ls * (1.f / 16.f)); }
        else if (tid < 192) sv[tid - 128] = bf2f(pr[GQR + GQK + h * 256 + sl * 64 + tid - 128]);
        __syncthreads();
        const float v = sv[e]; float o = 0.f;
#pragma unroll
        for (int i = 0; i < 16; ++i) { const int d = 16 * w + i; S[i] = sa[d] * S[i] + sk[d] * v; o += sq[d] * S[i]; }
        so[w][e] = o;
        __syncthreads();
        if (step >= CTX && tid < 64) { float s = 0.f;
#pragma unroll
            for (int q = 0; q < 8; ++q) s += so[q][tid];
            OUT[(size_t)row * GV + h * 256 + sl * 64 + tid] = (bf16)f2bf(s); }
    }
}

static void launch_phase(P p, int lo, int hi, int grid, hipStream_t stream) { p.lo = lo; p.hi = hi; hipLaunchKernelGGL(k_fwd, dim3(grid), dim3(NWAVES * 64), LDS_BYTES, stream, p); }
static void naive_gemm(const bf16* A, int lda, const float* W, int ldw, float* C, int ldc, int M, int N, int K, hipStream_t s) {
    hipLaunchKernelGGL(n_gemm, dim3((N + 63) / 64, M / 64), dim3(256), 0, s, A, lda, W, ldw, C, ldc, M, N, K);
}
#define EW_GRID(n) dim3((unsigned)(((size_t)(n) + 255) / 256)), dim3(256), 0, stream

extern "C" void kernel_launch(void* const* d_in, const int* in_sizes, int n_in, void* d_out, int out_size, void* d_ws, size_t ws_size, hipStream_t stream) {
    static int grid = 0;
    if (grid == 0) {
        if (n_in != 21 || out_size != NL * D || ws_size < WS_END) { fprintf(stderr, "kernel_launch: unexpected shapes (n_in %d out %d ws %zu need %zu)\n", n_in, out_size, ws_size, (size_t)WS_END); grid = -1; return; }
        int dev = 0, cus = 0;
        if (hipGetDevice(&dev) != hipSuccess || hipDeviceGetAttribute(&cus, hipDeviceAttributeMultiprocessorCount, dev) != hipSuccess) { grid = -1; return; }
        if (hipFuncSetAttribute((const void*)k_fwd, hipFuncAttributeMaxDynamicSharedMemorySize, LDS_BYTES) != hipSuccess) { fprintf(stderr, "kernel_launch: hipFuncSetAttribute failed\n"); grid = -1; return; }
        int per_cu = 0;
        if (hipOccupancyMaxActiveBlocksPerMultiprocessor(&per_cu, (const void*)k_fwd, NWAVES * 64, LDS_BYTES) != hipSuccess || per_cu < 1) fprintf(stderr, "kernel_launch: occupancy query says %d\n", per_cu);
        (void)hipGetLastError();
        grid = cus;
    }
    if (grid < 0) return;
    hipMemsetAsync((char*)d_ws + WS_CTL, 0, CTL_ZERO_BYTES, stream);
    P p{};
    const float** pp = (const float**)&p;
    for (int i = 0; i < 21; ++i) pp[i] = (const float*)d_in[i];
    p.out = (float*)d_out; p.ws = (unsigned char*)d_ws; p.lo = 0; p.hi = 0;
    unsigned char* ws = (unsigned char*)d_ws;
#define WS(T, off) ((T*)(ws + (off)))
#if ONE_LAUNCH
    launch_phase(p, 0, PH_END, grid, stream);
#else
    float* TMP = WS(float, WS_TMP);
    launch_phase(p, PH_PRO, PH_PRO + 1, grid, stream);
    launch_phase(p, PH_NORM1_0, PH_NORM1_0 + 1, grid, stream);
    if (OPT_MASK & 1) launch_phase(p, PH_QKV, PH_QKV + 1, grid, stream);
    else for (int ch = 0; ch < NT / 2048; ++ch) { const int r0 = ch * 2048;
        naive_gemm(WS(bf16, WS_H) + (size_t)r0 * D, D, p.attn_w_in, ATT_N, TMP, ATT_N, 2048, ATT_N, D, stream);
        hipLaunchKernelGGL(n_post_qkv, EW_GRID((size_t)2048 * ATT_N), TMP, r0, 2048, WS(bf16, WS_Q), WS(bf16, WS_K), WS(bf16, WS_V)); }
    if (OPT_MASK & 256) launch_phase(p, PH_ATTN, PH_ATTN + 1, grid, stream);
    else hipLaunchKernelGGL(n_attn, dim3(NT * NQH / 256), dim3(256), 0, stream, WS(bf16, WS_Q), WS(bf16, WS_K), WS(bf16, WS_V), p.attn_sink, WS(bf16, WS_O));
    if (OPT_MASK & 2) launch_phase(p, PH_OUT0, PH_OUT0 + 1, grid, stream);
    else for (int ch = 0; ch < NT / 2048; ++ch) { const int r0 = ch * 2048;
        naive_gemm(WS(bf16, WS_O) + (size_t)r0 * D, D, p.attn_w_out, D, TMP, D, 2048, D, D, stream);
        hipLaunchKernelGGL(n_post_resid, EW_GRID((size_t)2048 * D), TMP, r0, 2048, p.x, p.ctx, WS(float, WS_XA), WS(float, WS_MOD) + 2048); }
    launch_phase(p, PH_N2R0, PH_N2R0 + 1, grid, stream);
    launch_phase(p, PH_TOPK0, PH_TOPK0 + 1, grid, stream);
    for (int l = 0; l < 2; ++l) {
        if (l == 1) {
            if (OPT_MASK & 16) launch_phase(p, PH_GLAIN, PH_GLAIN + 1, grid, stream);
            else for (int ch = 0; ch < NT / 2048; ++ch) { const int r0 = ch * 2048;
                naive_gemm(WS(bf16, WS_H) + (size_t)r0 * D, D, p.gla_w_in, GIN, TMP, GIN, 2048, GIN, D, stream);
                hipLaunchKernelGGL(n_post_cast, EW_GRID((size_t)2048 * GIN), TMP, (size_t)2048 * GIN, WS(bf16, WS_PG) + (size_t)r0 * GIN); }
            if (OPT_MASK & 512) launch_phase(p, PH_SCAN, PH_SCAN + 1, grid, stream);
            else hipLaunchKernelGGL(n_glascan, dim3(512), dim3(512), 0, stream, WS(bf16, WS_PG), p.gla_gate_w2, p.gla_gate_b, WS(bf16, WS_OF), WS(bf16, WS_OB));
            launch_phase(p, PH_READ, PH_READ + 1, grid, stream);
            if (OPT_MASK & 32) launch_phase(p, PH_OUT1, PH_OUT1 + 1, grid, stream);
            else for (int ch = 0; ch < NL / 2048; ++ch) { const int r0 = ch * 2048;
                naive_gemm(WS(bf16, WS_H) + (size_t)r0 * D, D, p.gla_w_out, D, TMP, D, 2048, D, D, stream);
                hipLaunchKernelGGL(n_post_resid, EW_GRID((size_t)2048 * D), TMP, r0, 2048, WS(float, WS_XA), WS(float, WS_XA), WS(float, WS_XA), WS(float, WS_MOD) + 17 * 6144 + 2048); }
            launch_phase(p, PH_N2R1, PH_N2R1 + 1, grid, stream);
            launch_phase(p, PH_TOPK1, PH_TOPK1 + 1, grid, stream);
        }
        const int rows_e = l == 0 ? ESLOTS : NB * CAPL, chunk = l == 0 ? 2304 : 2048;
        const bool up_opt = OPT_MASK & (l == 0 ? 4 : 64), dn_opt = OPT_MASK & (l == 0 ? 8 : 128);
        if (up_opt && dn_opt) { launch_phase(p, l == 0 ? PH_UP0 : PH_UP1, (l == 0 ? PH_UP0 : PH_UP1) + 1, grid, stream); launch_phase(p, l == 0 ? PH_DN0 : PH_DN1, (l == 0 ? PH_DN0 : PH_DN1) + 1, grid, stream); }
        else {
            if (up_opt) launch_phase(p, l == 0 ? PH_UP0 : PH_UP1, (l == 0 ? PH_UP0 : PH_UP1) + 1, grid, stream);
            else for (int e = 0; e < NE; ++e) for (int r0 = 0; r0 < rows_e; r0 += chunk) {
                const size_t row = (size_t)e * ESLOTS + r0; const size_t le = (size_t)(l * NE + e);
                naive_gemm(WS(bf16, WS_XG) + row * D, D, p.exp_w_gate + le * D * FF, FF, TMP, 5632, chunk, FF, D, stream);
                naive_gemm(WS(bf16, WS_XG) + row * D, D, p.exp_w_up + le * D * FF, FF, TMP + FF, 5632, chunk, FF, D, stream);
                hipLaunchKernelGGL(n_post_swiglu, EW_GRID((size_t)chunk * FF), TMP, chunk, WS(bf16, WS_ACT) + row * FF); }
            if (dn_opt) launch_phase(p, l == 0 ? PH_DN0 : PH_DN1, (l == 0 ? PH_DN0 : PH_DN1) + 1, grid, stream);
            else for (int e = 0; e < NE; ++e) for (int r0 = 0; r0 < rows_e; r0 += chunk) {
                const size_t row = (size_t)e * ESLOTS + r0; const size_t le = (size_t)(l * NE + e);
                naive_gemm(WS(bf16, WS_ACT) + row * FF, FF, p.exp_w_down + le * FF * D, D, TMP, D, chunk, D, FF, stream);
                hipLaunchKernelGGL(n_post_down, EW_GRID((size_t)chunk * D), TMP, chunk, WS(bf16, WS_YS) + row * D, WS(float, WS_ROWG) + row); }
        }
        launch_phase(p, l == 0 ? PH_COMB0 : PH_COMB1, (l == 0 ? PH_COMB0 : PH_COMB1) + 1, grid, stream);
    }
#endif
}
```
